# Optimizing an MI355X kernel written in HIP

```python
import math
import jax, jax.numpy as jnp
from jax import lax
import numpy as np

D_MODEL = 1024
BATCH = 8
SEQ = 2048
DEPTH = 2
DEC_BATCH = 128
DEC_SEQ = 1
PAST_LEN = 16384
PAGE_SIZE = 128

PLE_DIM = 256
D_FF = 4 * D_MODEL
CONV_W = 4
EPS = 1e-6
RG_WIDTH = D_MODEL // 2
RG_HEADS = 8
RG_HEAD_DIM = RG_WIDTH // RG_HEADS
RG_C = 8.0
SSD_WIDTH = D_MODEL // 2
SSD_HEAD_DIM = 64
SSD_HEADS = SSD_WIDTH // SSD_HEAD_DIM
SSD_STATE = 128
SSD_CHUNK = 128
SSD_CONV_DIM = SSD_WIDTH + 2 * SSD_STATE
HG_WIDTH = D_MODEL // 2
HG_HEADS = 8
HG_HEAD_DIM = HG_WIDTH // HG_HEADS
HG_CHUNK = 64
D_MIX = RG_WIDTH + SSD_WIDTH + HG_WIDTH
IN_SPLITS = (RG_WIDTH, RG_WIDTH, SSD_WIDTH, SSD_CONV_DIM, SSD_HEADS, HG_WIDTH, HG_WIDTH, HG_WIDTH, HG_WIDTH)
D_IN_PROJ = RG_WIDTH * 2 + SSD_WIDTH + SSD_CONV_DIM + SSD_HEADS + HG_WIDTH * 4

kernel_name = 'hymba_style_rglru_ssd_hgrn2_decoder'


def rmsnorm(x, g):
    xf = x.astype(jnp.float32)
    y = xf * lax.rsqrt(jnp.mean(xf * xf, axis=-1, keepdims=True) + EPS)
    return (y * g.astype(jnp.float32)).astype(x.dtype)


def causal_conv(x, buf, w, b):
    xe = jnp.concatenate([buf.astype(x.dtype), x], axis=1)
    L = x.shape[1]
    y = sum(xe[:, k:k + L] * w[k] for k in range(CONV_W)) + b
    return y, xe[:, -(CONV_W - 1):]


def to_chunks(t, q):
    bsz, L = t.shape[:2]
    lp = -(-L // q) * q
    t = jnp.pad(t, [(0, 0), (0, lp - L)] + [(0, 0)] * (t.ndim - 2))
    return jnp.moveaxis(t.reshape(bsz, lp // q, q, *t.shape[2:]), 1, 0)


def from_chunks(t, L):
    nc, bsz, q = t.shape[:3]
    return jnp.moveaxis(t, 0, 1).reshape(bsz, nc * q, *t.shape[3:])[:, :L]


def rg_lru(x, wa, ba, wx, bx, lam, h0, pos0):
    bsz, L, _ = x.shape
    xh = x.reshape(bsz, L, RG_HEADS, RG_HEAD_DIM)
    r = jax.nn.sigmoid(jnp.einsum('blhi,hij->blhj', xh, wa).reshape(bsz, L, RG_WIDTH) + ba)
    i = jax.nn.sigmoid(jnp.einsum('blhi,hij->blhj', xh, wx).reshape(bsz, L, RG_WIDTH) + bx)
    log_a = (-RG_C * r * jax.nn.softplus(-lam)).astype(jnp.float32)
    a = jnp.exp(log_a)
    mult = jnp.sqrt(-jnp.expm1(2.0 * log_a))
    pos = pos0 + jnp.arange(L)
    mult = jnp.where((pos == 0)[None, :, None], 1.0, mult)
    b = mult * (i * x).astype(jnp.float32)
    b = b.at[:, 0].add(a[:, 0] * h0.astype(jnp.float32))

    def combine(c1, c2):
        a1, b1 = c1
        a2, b2 = c2
        return a1 * a2, a2 * b1 + b2

    _, h = lax.associative_scan(combine, (a, b), axis=1)
    return h.astype(x.dtype), h[:, -1]


def ssd_chunked(x, dt, a_neg, bm, cm, s0):
    L = x.shape[1]
    q = min(SSD_CHUNK, L)
    causal = jnp.tril(jnp.ones((q, q), bool))
    xs = (to_chunks(x, q), to_chunks(dt, q), to_chunks(bm, q), to_chunks(cm, q))

    def step(s, inp):
        xc, dtc, bc, cc = inp
        cum = jnp.cumsum(dtc * a_neg, axis=1)
        seg = cum[:, :, None, :] - cum[:, None, :, :]
        lmat = jnp.exp(jnp.where(causal[None, :, :, None], seg, -jnp.inf))
        cb = jnp.einsum('btn,bsn->bts', cc, bc)
        y = jnp.einsum('bts,btsh,bsh,bshp->bthp', cb, lmat, dtc, xc)
        y = y + jnp.einsum('btn,bhpn,bth->bthp', cc, s, jnp.exp(cum))
        w_in = jnp.exp(cum[:, -1:, :] - cum) * dtc
        s = jnp.exp(cum[:, -1])[:, :, None, None] * s + jnp.einsum('bsn,bsh,bshp->bhpn', bc, w_in, xc)
        return s, y

    s, ys = lax.scan(step, s0.astype(jnp.float32), xs)
    return from_chunks(ys, L), s


def hgrn_chunked(qv, kv, logf, v, s0):
    L = qv.shape[1]
    q = min(HG_CHUNK, L)
    causal = jnp.tril(jnp.ones((q, q), bool))
    xs = (to_chunks(qv, q), to_chunks(kv, q), to_chunks(logf, q), to_chunks(v, q))

    def step(s, inp):
        qc, kc, gc, vc = inp
        b = jnp.cumsum(gc, axis=1)
        seg = b[:, :, None] - b[:, None]
        dec = jnp.exp(jnp.where(causal[None, :, :, None, None], seg, -jnp.inf))
        att = jnp.einsum('bthd,bshd,btshd->bhts', qc, kc, dec)
        o = jnp.einsum('bhts,bshe->bthe', att, vc)
        o = o + jnp.einsum('bthd,bhde->bthe', qc * jnp.exp(b), s)
        s = jnp.exp(b[:, -1])[..., None] * s + jnp.einsum('bshd,bshe->bhde', kc * jnp.exp(b[:, -1:] - b), vc)
        return s, o

    s, os_ = lax.scan(step, s0.astype(jnp.float32), xs)
    return from_chunks(os_, L), s


def layer_forward(h, p_i, rg_conv, rg_h, ssd_conv, ssd_s, hg_s, lw, lb, pos0):
    f32 = jnp.float32
    bsz, L, _ = h.shape
    u = rmsnorm(h, lw['norm_mix'])
    proj = u @ lw['w_in']
    cuts = [int(c) for c in np.cumsum(IN_SPLITS)[:-1]]
    a_x, a_g, b_z, b_xbc, b_dt, c_q, c_f, c_i, c_g = jnp.split(proj, cuts, axis=-1)

    xa, new_rg_conv = causal_conv(a_x, rg_conv, lw['conv_a_w'], lw['conv_a_b'])
    ha, new_rg_h = rg_lru(xa, lw['rg_wa'], lw['rg_ba'], lw['rg_wx'], lw['rg_bx'], lw['rg_lambda'], rg_h, pos0)
    y_a = ha * jax.nn.gelu(a_g)

    xbc, new_ssd_conv = causal_conv(b_xbc, ssd_conv, lw['conv_b_w'], lw['conv_b_b'])
    xbc = jax.nn.silu(xbc).astype(f32)
    xs, bm, cm = jnp.split(xbc, [SSD_WIDTH, SSD_WIDTH + SSD_STATE], axis=-1)
    xs = xs.reshape(bsz, L, SSD_HEADS, SSD_HEAD_DIM)
    dt = jax.nn.softplus(b_dt.astype(f32) + lw['ssd_dt_bias'].astype(f32))
    a_neg = -jnp.exp(lw['ssd_a_log'].astype(f32))
    yb, new_ssd_s = ssd_chunked(xs, dt, a_neg, bm, cm, ssd_s)
    yb = (yb + lw['ssd_d'].astype(f32)[:, None] * xs).reshape(bsz, L, SSD_WIDTH).astype(h.dtype)
    y_b = rmsnorm(yb * jax.nn.silu(b_z), lw['ssd_norm'])

    qv = jax.nn.silu(c_q.astype(f32)).reshape(bsz, L, HG_HEADS, HG_HEAD_DIM)
    lbh = lb.reshape(HG_HEADS, HG_HEAD_DIM)
    g = lbh + (1.0 - lbh) * jax.nn.sigmoid(c_f.astype(f32).reshape(bsz, L, HG_HEADS, HG_HEAD_DIM))
    kv = 1.0 - g
    logf = jnp.log(g)
    v = c_i.astype(f32).reshape(bsz, L, HG_HEADS, HG_HEAD_DIM)
    o, new_hg_s = hgrn_chunked(qv, kv, logf, v, hg_s)
    o = rmsnorm(o.astype(h.dtype), lw['hg_norm']) * jax.nn.silu(c_g.reshape(bsz, L, HG_HEADS, HG_HEAD_DIM))
    y_c = o.reshape(bsz, L, HG_WIDTH)

    h = h + jnp.concatenate([y_a, y_b, y_c], axis=-1) @ lw['w_out']
    z = jnp.square(jax.nn.relu(rmsnorm(h, lw['norm_ffn']) @ lw['w_up']))
    h = h + z @ lw['w_down']
    gate = jax.nn.sigmoid(rmsnorm(h, lw['norm_ple']) @ lw['w_ple_gate'])
    h = h + gate * (p_i @ lw['w_ple_proj'])
    return h, (new_rg_conv, new_rg_h, new_ssd_conv, new_ssd_s, new_hg_s)


def run_trunk(x, p, rg_conv, rg_h, ssd_conv, ssd_s, hg_s, W, norm_final, lbs, pos0):
    h = x
    outs = ([], [], [], [], [])
    for i in range(DEPTH):
        lw = {name: arr[i] for name, arr in W.items()}
        h, st = layer_forward(h, p[i], rg_conv[i], rg_h[i], ssd_conv[i], ssd_s[i], hg_s[i], lw, lbs[i], pos0)
        for lst, s in zip(outs, st):
            lst.append(s)
    y = rmsnorm(h, norm_final)
    return y, [jnp.stack(lst) for lst in outs]


def setup_inputs(seed: int = 0) -> dict:
    key = jax.random.key(seed)
    ks = iter(jax.random.split(key, 48))
    f32 = jnp.float32

    def nrm(shape, s):
        return jax.random.normal(next(ks), shape, f32) * s

    x_prompt = nrm((BATCH, SEQ, D_MODEL), 1.0)
    x_sample = nrm((DEC_BATCH, DEC_SEQ, D_MODEL), 1.0)
    state_rg_conv = nrm((DEPTH, DEC_BATCH, CONV_W - 1, RG_WIDTH), 1.0)
    state_rg_h = nrm((DEPTH, DEC_BATCH, RG_WIDTH), 0.5)
    state_ssd_conv = nrm((DEPTH, DEC_BATCH, CONV_W - 1, SSD_CONV_DIM), 1.0)
    state_ssd = nrm((DEPTH, DEC_BATCH, SSD_HEADS, SSD_HEAD_DIM, SSD_STATE), 0.1)
    state_hgrn = nrm((DEPTH, DEC_BATCH, HG_HEADS, HG_HEAD_DIM, HG_HEAD_DIM), 0.3)
    p_prompt = nrm((DEPTH, BATCH, SEQ, PLE_DIM), 1.0)
    p_sample = nrm((DEPTH, DEC_BATCH, DEC_SEQ, PLE_DIM), 1.0)

    norm_mix = 1.0 + nrm((DEPTH, D_MODEL), 0.05)
    w_in = nrm((DEPTH, D_MODEL, D_IN_PROJ), D_MODEL ** -0.5)
    conv_a_w = nrm((DEPTH, CONV_W, RG_WIDTH), CONV_W ** -0.5)
    conv_a_b = nrm((DEPTH, RG_WIDTH), 0.01)
    rg_wa = nrm((DEPTH, RG_HEADS, RG_HEAD_DIM, RG_HEAD_DIM), RG_HEAD_DIM ** -0.5)
    rg_ba = nrm((DEPTH, RG_WIDTH), 0.01)
    rg_wx = nrm((DEPTH, RG_HEADS, RG_HEAD_DIM, RG_HEAD_DIM), RG_HEAD_DIM ** -0.5)
    rg_bx = nrm((DEPTH, RG_WIDTH), 0.01)
    u = jax.random.uniform(next(ks), (DEPTH, RG_WIDTH), f32, 0.9, 0.999)
    a0 = u ** (1.0 / RG_C)
    rg_lambda = jnp.log(a0) - jnp.log1p(-a0)
    conv_b_w = nrm((DEPTH, CONV_W, SSD_CONV_DIM), CONV_W ** -0.5)
    conv_b_b = nrm((DEPTH, SSD_CONV_DIM), 0.01)
    dt0 = jnp.exp(jax.random.uniform(next(ks), (DEPTH, SSD_HEADS), f32, math.log(1e-3), math.log(1e-1)))
    ssd_dt_bias = dt0 + jnp.log(-jnp.expm1(-dt0))
    ssd_a_log = jnp.log(jax.random.uniform(next(ks), (DEPTH, SSD_HEADS), f32, 1.0, 16.0))
    ssd_d = 1.0 + nrm((DEPTH, SSD_HEADS), 0.1)
    ssd_norm = 1.0 + nrm((DEPTH, SSD_WIDTH), 0.05)
    hg_lower_bounds = nrm((DEPTH, HG_WIDTH), 0.5)
    hg_norm = 1.0 + nrm((DEPTH, HG_HEAD_DIM), 0.05)
    w_out = nrm((DEPTH, D_MIX, D_MODEL), D_MIX ** -0.5)
    norm_ffn = 1.0 + nrm((DEPTH, D_MODEL), 0.05)
    w_up = nrm((DEPTH, D_MODEL, D_FF), D_MODEL ** -0.5)
    w_down = nrm((DEPTH, D_FF, D_MODEL), D_FF ** -0.5)
    norm_ple = 1.0 + nrm((DEPTH, D_MODEL), 0.05)
    w_ple_gate = nrm((DEPTH, D_MODEL, D_MODEL), D_MODEL ** -0.5)
    w_ple_proj = nrm((DEPTH, PLE_DIM, D_MODEL), PLE_DIM ** -0.5)
    norm_final = 1.0 + nrm((D_MODEL,), 0.05)
    return {
        'x_prompt': x_prompt, 'x_sample': x_sample,
        'state_rg_conv': state_rg_conv, 'state_rg_h': state_rg_h,
        'state_ssd_conv': state_ssd_conv, 'state_ssd': state_ssd, 'state_hgrn': state_hgrn,
        'p_prompt': p_prompt, 'p_sample': p_sample,
        'norm_mix': norm_mix, 'w_in': w_in,
        'conv_a_w': conv_a_w, 'conv_a_b': conv_a_b,
        'rg_wa': rg_wa, 'rg_ba': rg_ba, 'rg_wx': rg_wx, 'rg_bx': rg_bx, 'rg_lambda': rg_lambda,
        'conv_b_w': conv_b_w, 'conv_b_b': conv_b_b,
        'ssd_dt_bias': ssd_dt_bias, 'ssd_a_log': ssd_a_log, 'ssd_d': ssd_d, 'ssd_norm': ssd_norm,
        'hg_lower_bounds': hg_lower_bounds, 'hg_norm': hg_norm,
        'w_out': w_out, 'norm_ffn': norm_ffn, 'w_up': w_up, 'w_down': w_down,
        'norm_ple': norm_ple, 'w_ple_gate': w_ple_gate, 'w_ple_proj': w_ple_proj,
        'norm_final': norm_final,
    }


def reference(x_prompt, x_sample, state_rg_conv, state_rg_h, state_ssd_conv, state_ssd, state_hgrn,
              p_prompt, p_sample, norm_mix, w_in, conv_a_w, conv_a_b, rg_wa, rg_ba, rg_wx, rg_bx,
              rg_lambda, conv_b_w, conv_b_b, ssd_dt_bias, ssd_a_log, ssd_d, ssd_norm,
              hg_lower_bounds, hg_norm, w_out, norm_ffn, w_up, w_down, norm_ple, w_ple_gate,
              w_ple_proj, norm_final):
    W = dict(norm_mix=norm_mix, w_in=w_in, conv_a_w=conv_a_w, conv_a_b=conv_a_b,
             rg_wa=rg_wa, rg_ba=rg_ba, rg_wx=rg_wx, rg_bx=rg_bx, rg_lambda=rg_lambda,
             conv_b_w=conv_b_w, conv_b_b=conv_b_b, ssd_dt_bias=ssd_dt_bias, ssd_a_log=ssd_a_log,
             ssd_d=ssd_d, ssd_norm=ssd_norm, hg_norm=hg_norm, w_out=w_out, norm_ffn=norm_ffn,
             w_up=w_up, w_down=w_down, norm_ple=norm_ple, w_ple_gate=w_ple_gate, w_ple_proj=w_ple_proj)
    sm = jax.nn.softmax(hg_lower_bounds.astype(jnp.float32), axis=0)
    cs = jnp.cumsum(sm, axis=0)
    lbs = cs - cs[0:1]

    f32 = jnp.float32
    z_rc = jnp.zeros((DEPTH, BATCH, CONV_W - 1, RG_WIDTH), x_prompt.dtype)
    z_rh = jnp.zeros((DEPTH, BATCH, RG_WIDTH), f32)
    z_sc = jnp.zeros((DEPTH, BATCH, CONV_W - 1, SSD_CONV_DIM), x_prompt.dtype)
    z_ss = jnp.zeros((DEPTH, BATCH, SSD_HEADS, SSD_HEAD_DIM, SSD_STATE), f32)
    z_hs = jnp.zeros((DEPTH, BATCH, HG_HEADS, HG_HEAD_DIM, HG_HEAD_DIM), f32)

    y_prompt, st_p = run_trunk(x_prompt, p_prompt, z_rc, z_rh, z_sc, z_ss, z_hs, W, norm_final, lbs, 0)
    y_sample, st_s = run_trunk(x_sample, p_sample, state_rg_conv, state_rg_h, state_ssd_conv,
                               state_ssd, state_hgrn, W, norm_final, lbs, PAST_LEN)
    rc_p, rh_p, sc_p, ss_p, hs_p = st_p
    rc_s, rh_s, sc_s, ss_s, hs_s = st_s
    return (y_prompt, y_sample, rc_p, rh_p, sc_p, ss_p, hs_p, rc_s, rh_s, sc_s, ss_s, hs_s)
```

```cpp
#include <hip/hip_runtime.h>
#include <cstdio>
#include <cstdint>

#define LAS __attribute__((address_space(3)))
#define GAS __attribute__((address_space(1)))
typedef unsigned short bf16;
typedef short bf16x8 __attribute__((ext_vector_type(8)));
typedef float f32x4 __attribute__((ext_vector_type(4)));
typedef float f32x16 __attribute__((ext_vector_type(16)));
typedef unsigned u32x4 __attribute__((ext_vector_type(4)));
typedef unsigned u32x2 __attribute__((ext_vector_type(2)));
typedef GAS unsigned gu32;

#ifndef MK_N_LAUNCHES
#define MK_N_LAUNCHES 1
#endif

constexpr int DM = 1024, NBATCH = 8, SEQ = 2048, MPR = NBATCH * SEQ, MSM = 128, MREAL = MPR + MSM, MP = 16640  ;
constexpr int NPJ = 4352, NPJP = 4608, DFF = 4096, PLE = 256, DMIX = 1536, NL = 2, DIN = 4360;
constexpr int PC_XS = 0, PC_AX = 512, PC_CQ = 1024, PC_B = 1536, PC_C = 1664, PC_AG = 1792, PC_BZ = 2304, PC_CF = 2816, PC_CI = 3328, PC_CG = 3840;
constexpr float EPS = 1e-6f;
enum { I_XP = 0, I_XS, I_SRC, I_SRH, I_SSC, I_SSS, I_SHG, I_PP, I_PS, I_NMIX, I_WIN, I_CAW, I_CAB, I_WA, I_BA, I_WX, I_BX, I_LAM, I_CBW, I_CBB, I_DTB, I_ALOG, I_SSD_D, I_SNORM,
       I_HLB, I_HNORM, I_WOUT, I_NFFN, I_WUP, I_WDN, I_NPLE, I_WG, I_WPJ, I_NFIN, N_IN };
constexpr size_t O_Y = 0, O_RCP = (size_t)MREAL * DM, O_RHP = O_RCP + 2 * 8 * 3 * 512, O_SCP = O_RHP + 2 * 8 * 512, O_SSP = O_SCP + 2 * 8 * 3 * 768, O_HSP = O_SSP + 2 * 8 * 8 * 64 * 128,
                 O_RCS = O_HSP + 2 * 8 * 8 * 64 * 64, O_RHS = O_RCS + 2 * 128 * 3 * 512, O_SCS = O_RHS + 2 * 128 * 512, O_SSS = O_SCS + 2 * 128 * 3 * 768, O_HSS = O_SSS + (size_t)2 * 128 * 8 * 64 * 128,
                 O_END = O_HSS + (size_t)2 * 128 * 8 * 64 * 64;
static_assert(O_END == 44830720, "output size");

constexpr size_t MiB = 1u << 20;
constexpr size_t WS_CTL = 0, CTL_ZERO_BYTES = 1 * MiB;
constexpr size_t WS_WIN = 1 * MiB, WS_WOUT = 19 * MiB, WS_WUP = 25 * MiB, WS_WDN = 41 * MiB, WS_WG = 57 * MiB, WS_WPJ = 61 * MiB, WS_WAT = 62 * MiB, WS_LBS = 62 * MiB + 512 * 1024;
constexpr size_t KiB64 = 65536;
constexpr size_t WS_PB = 63 * MiB, WS_HB = WS_PB + 132 * KiB64  , WS_BIG = WS_HB + 520 * KiB64  , WS_RT = WS_BIG + 2211 * KiB64  ;
constexpr size_t WS_LA = WS_RT, WS_BB = WS_RT + 16 * MiB, WS_XA = WS_RT + 32 * MiB, WS_PPB = WS_RT, WS_HB2 = WS_RT + 520 * KiB64;
constexpr size_t WS_DT = WS_RT + 1040 * KiB64  , WS_SSQ_MIX = WS_DT + 12 * KiB64, WS_SSQ_FFN = WS_SSQ_MIX + 17 * KiB64, WS_SSQ_PLE = WS_SSQ_FFN + 17 * KiB64, WS_SSDP = WS_SSQ_PLE + 17 * KiB64, WS_END = WS_SSDP + 17 * KiB64;
static_assert(WS_PB + (size_t)MP * PLE * 2 <= WS_HB && WS_HB + (size_t)MP * DM * 2 <= WS_BIG && WS_BIG + (size_t)MP * NPJ * 2 <= WS_RT && WS_XA + (size_t)MPR * 768 * 2 <= WS_DT && WS_PPB + (size_t)MP * DM * 2 <= WS_HB2 &&
              WS_HB2 + (size_t)MP * DM * 2 <= WS_DT && WS_DT + (size_t)MP * 8 * 4 <= WS_SSQ_MIX && (size_t)MP * 16 * 4 <= 17 * KiB64 && WS_END <= 313 * MiB, "ws map");
constexpr int CW_TMO = 0, CW_BAR = 4096;

constexpr int SCR_BYTES = 147456, LDSCTL_OFF = SCR_BYTES, LDS_BYTES = SCR_BYTES + 1024;

typedef float f32x2v_ __attribute__((ext_vector_type(2))); typedef __bf16 bf16x2v_ __attribute__((ext_vector_type(2)));
__device__ __forceinline__ unsigned pk2(float lo, float hi) { const f32x2v_ v = {lo, hi}; return __builtin_bit_cast(unsigned, __builtin_convertvector(v, bf16x2v_)); }
__device__ __forceinline__ bf16 f2bf(float f) { return (bf16)(pk2(f, 0.f) & 0xffffu); }
__device__ __forceinline__ float bf2f(bf16 b) { return __uint_as_float(((unsigned)b) << 16); }
__device__ __forceinline__ float bflo(unsigned w) { return __uint_as_float(w << 16); }
__device__ __forceinline__ float bfhi(unsigned w) { return __uint_as_float(w & 0xffff0000u); }
__device__ __forceinline__ float fexp(float x) { return __builtin_amdgcn_exp2f(x * 1.44269504089f); }
__device__ __forceinline__ float frcp(float x) { return __builtin_amdgcn_rcpf(x); }
__device__ __forceinline__ float fsigmoid(float x) { return frcp(1.f + fexp(-x)); }
__device__ __forceinline__ float fsilu(float x) { return x * fsigmoid(x); }
__device__ __forceinline__ float fgelu(float x) { const float u = x + 0.044715f * x * x * x; return x * frcp(1.f + fexp(-1.5957691216f * u)); }
__device__ __forceinline__ float flog(float x) { return __builtin_amdgcn_logf(x) * 0.69314718056f; }
__device__ __forceinline__ float fsoftplus(float x) {
    if (x > 20.f) return x;
    const float e = fexp(x);
    if (e < 0.05f) return e * (1.f - e * (0.5f - e * (0.33333333f - e * (0.25f - 0.2f * e))));
    return flog(1.f + e);
}
__device__ __forceinline__ float fnegexpm1(float x) {
    if (x > -0.5f && x < 0.5f) return -(x * (1.f + x * 0.5f * (1.f + x * 0.33333333f * (1.f + x * 0.25f * (1.f + x * 0.2f * (1.f + x * 0.16666667f))))));
    return 1.f - fexp(x);
}
template <int X> __device__ __forceinline__ float swz_xor(float v) { return __int_as_float(__builtin_amdgcn_ds_swizzle(__float_as_int(v), (X << 10) | 0x1f)); }
__device__ __forceinline__ float sum_halves(float v) {
    const unsigned u = __float_as_uint(v); auto r = __builtin_amdgcn_permlane32_swap(u, u, false, false); return __uint_as_float(r[0]) + __uint_as_float(r[1]); }
__device__ __forceinline__ float sum32(float v) { v += swz_xor<1>(v); v += swz_xor<2>(v); v += swz_xor<4>(v); v += swz_xor<8>(v); v += swz_xor<16>(v); return v; }
__device__ __forceinline__ float wave_sum(float v) { return sum_halves(sum32(v)); }
__device__ __forceinline__ float bperm(float v, int srclane) { return __int_as_float(__builtin_amdgcn_ds_bpermute(srclane << 2, __float_as_int(v))); }
__device__ __forceinline__ f32x16 mfma32(bf16x8 a, bf16x8 b, f32x16 c) { return __builtin_amdgcn_mfma_f32_32x32x16_bf16(a, b, c, 0, 0, 0); }
__device__ __forceinline__ int rowoff(int reg, int hf) { return (reg & 3) + 8 * (reg >> 2) + 4 * hf; }
#ifndef DBG_V
#define DBG_V 0
#endif
#if DBG_V == 3
#define WG_BARRIER() do { asm volatile("s_waitcnt vmcnt(0) lgkmcnt(0)" ::: "memory"); __syncthreads(); } while (0)
#else
#define WG_BARRIER() __syncthreads()
#endif

namespace pg8 {
constexpr int BM = 256, BK = 64, HALF = 128, HTB = HALF * BK * 2, STAGE_BYTES = 8 * HTB, NXCD = 8, WGM = 8;
__host__ __device__ __forceinline__ int lds_byte(int r, int c) { const int st = (r >> 4) * 2 + (c >> 5), rr = r & 15, cc = c & 31, ob = rr * 64 + cc * 2; return st * 1024 + (ob ^ (((ob >> 9) & 1) << 5)); }
__host__ __device__ __forceinline__ void stage_rc(int b, int& R, int& C) { const int st = b / 1024, sb = b % 1024, swz = sb ^ (((sb >> 9) & 1) << 5); R = (st >> 1) * 16 + swz / 64; C = (st & 1) * 32 + (swz % 64) / 2; }
__host__ __device__ __forceinline__ int perm32(int rho) { const int n = rho >> 4, i = rho & 15; return 8 * (i >> 2) + 4 * n + (i & 3); }
struct Unit { int pm, pn; };
struct Gemm { const GAS bf16* A; const GAS bf16* Bt; int lda, K; };
struct StaticOrder {
    int nM, nN, nwg, G, c;
    __device__ void init(int M, int N, int G_, int c_) { nM = M / BM; nN = N / BM; nwg = nM * nN; G = G_; c = c_; }
    __device__ bool next(int i, Unit& u) const {
        const long L = (long)i * G + c; if (L >= nwg) return false;
        int wgid = (int)L; { const int q = nwg / NXCD, r = nwg % NXCD, xcd = wgid % NXCD, off = wgid / NXCD; wgid = (xcd < r ? xcd * (q + 1) : r * (q + 1) + (xcd - r) * q) + off; }
        const int nig = WGM * nN, gid = wgid / nig, fm = gid * WGM, gsz = (nM - fm) < WGM ? (nM - fm) : WGM;
        u.pm = fm + ((wgid % nig) % gsz); u.pn = (wgid % nig) / gsz; return true;
    }
};
typedef f32x4 Acc[2][2][4][2];

template <class Epi, bool ALIGN_EPI>
__device__ __forceinline__ void gemm_phase(LAS unsigned char* lds, const int tid, const Gemm g, const StaticOrder& S, const Epi& E) {
    const int wid = __builtin_amdgcn_readfirstlane(tid >> 6), lane = tid & 63, wr = wid >> 2, wc = wid & 3, fr = lane & 15, fq = lane >> 4;
    const int K = g.K, nt = K / BK, lda = g.lda;
    unsigned voffA[2], voffB[2];
#pragma unroll
    for (int i = 0; i < 2; ++i) { int R, C; stage_rc(tid * 16 + i * 8192, R, C); const int Rb = Epi::PERM ? ((R & ~31) + perm32(R & 31)) : R;
        voffA[i] = (unsigned)(R * lda + C) * 2u; voffB[i] = (unsigned)(Rb * K + C) * 2u; }
    const size_t kstep = (size_t)(BK * 2);
    const size_t hA = (size_t)HALF * lda * 2, hB = (size_t)HALF * K * 2, tA = 2 * hA, tB = 2 * hB;
    const unsigned ldsw = (unsigned)wid * 1024u;
    const int aoff = lds_byte(wr * 64 + fr, fq * 8), boff = lds_byte(wc * 32 + fr, fq * 8);
#define PG8_SA(b, h) (((b) * 2 + (h)) * HTB)
#define PG8_SB(b, h) ((4 + (b) * 2 + (h)) * HTB)
#define PG8_STAGE(bufoff, gbase, voff) do { _Pragma("unroll") for (int _i = 0; _i < 2; ++_i) \
        __builtin_amdgcn_global_load_lds((const GAS unsigned*)((const GAS char*)(gbase) + (voff)[_i]), (LAS unsigned*)(lds + (bufoff) + ldsw + _i * 8192), 16, 0, 0); } while (0)
#define PG8_LDA(dst, b, h) do { _Pragma("unroll") for (int m = 0; m < 4; ++m) _Pragma("unroll") for (int k = 0; k < 2; ++k) dst[m][k] = *(const LAS bf16x8*)(lds + PG8_SA(b, h) + aoff + m * 2048 + k * 1024); } while (0)
#define PG8_LDB(dst, b, h) do { _Pragma("unroll") for (int n = 0; n < 2; ++n) _Pragma("unroll") for (int k = 0; k < 2; ++k) dst[n][k] = *(const LAS bf16x8*)(lds + PG8_SB(b, h) + boff + n * 2048 + k * 1024); } while (0)
#define PG8_MMA(ai, bj, At, Bt) do { __builtin_amdgcn_s_setprio(1); _Pragma("unroll") for (int m = 0; m < 4; ++m) _Pragma("unroll") for (int n = 0; n < 2; ++n) _Pragma("unroll") for (int k = 0; k < 2; ++k) \
        acc[ai][bj][m][n] = __builtin_amdgcn_mfma_f32_16x16x32_bf16(Bt[n][k], At[m][k], acc[ai][bj][m][n], 0, 0, 0); __builtin_amdgcn_s_setprio(0); } while (0)
#define PG8_WAIT_V(n) asm volatile("s_waitcnt vmcnt(" #n ")" ::: "memory")
#define PG8_WAIT_L(n) asm volatile("s_waitcnt lgkmcnt(" #n ")" ::: "memory")
#define PG8_BAR __builtin_amdgcn_s_barrier()
#define PG8_SCHED __builtin_amdgcn_sched_barrier(0)
    Unit cur, nxt; int ui = 0;
    if (!S.next(0, cur)) return;
    f32x4 acc[2][2][4][2];
#pragma unroll
    for (int a = 0; a < 2; ++a)
#pragma unroll
        for (int b = 0; b < 2; ++b)
#pragma unroll
            for (int m = 0; m < 4; ++m)
#pragma unroll
                for (int n = 0; n < 2; ++n) acc[a][b][m][n] = (f32x4){0.f, 0.f, 0.f, 0.f};
    bf16x8 At[4][2], B0[2][2], B1[2][2];
    const GAS char* cA = (const GAS char*)g.A + (size_t)cur.pm * tA; const GAS char* cB = (const GAS char*)g.Bt + (size_t)cur.pn * tB;
    PG8_STAGE(PG8_SB(0, 0), cB, voffB); PG8_STAGE(PG8_SB(0, 1), cB + hB, voffB); PG8_STAGE(PG8_SA(0, 0), cA, voffA); PG8_STAGE(PG8_SA(0, 1), cA + hA, voffA);
    if (wr == 1) PG8_BAR;
    PG8_WAIT_V(2); PG8_BAR;
    PG8_STAGE(PG8_SB(1, 0), cB + kstep, voffB); PG8_STAGE(PG8_SA(1, 0), cA + kstep, voffA); PG8_STAGE(PG8_SB(1, 1), cB + hB + kstep, voffB);
    PG8_WAIT_V(6); PG8_BAR;
    for (;;) {
        const bool has_next = S.next(ui + 1, nxt);
        const GAS char* nA = has_next ? (const GAS char*)g.A + (size_t)nxt.pm * tA : cA; const GAS char* nB = has_next ? (const GAS char*)g.Bt + (size_t)nxt.pn * tB : cB;
        for (int t = 0; t < nt; t += 2) {
            const bool last = (t == nt - 2);
            const GAS char* a1 = cA + (size_t)(t + 1) * kstep;
            const GAS char* a2 = last ? nA : cA + (size_t)(t + 2) * kstep; const GAS char* b2 = last ? nB : cB + (size_t)(t + 2) * kstep;
            const GAS char* a3 = a2 + kstep; const GAS char* b3 = b2 + kstep;
            if constexpr (Epi::MIDK > 0) { if (t == Epi::MIDK) E.mid(acc, cur, wr, wc, fr, fq); }
            PG8_LDB(B0, 0, 0); PG8_LDB(B1, 0, 1); PG8_SCHED; PG8_LDA(At, 0, 0); PG8_STAGE(PG8_SA(1, 1), a1 + hA, voffA);
            PG8_WAIT_V(8); PG8_WAIT_L(0); PG8_BAR; PG8_MMA(0, 0, At, B0); PG8_MMA(0, 1, At, B1); PG8_BAR; PG8_SCHED;
            PG8_LDA(At, 0, 1); PG8_STAGE(PG8_SB(0, 0), b2, voffB); PG8_STAGE(PG8_SB(0, 1), b2 + hB, voffB); PG8_STAGE(PG8_SA(0, 0), a2, voffA);
            PG8_WAIT_V(8); PG8_WAIT_L(0); PG8_BAR; PG8_MMA(1, 0, At, B0); PG8_MMA(1, 1, At, B1); PG8_BAR; PG8_SCHED;
            PG8_LDB(B0, 1, 0); PG8_LDB(B1, 1, 1); PG8_SCHED; PG8_LDA(At, 1, 0); PG8_STAGE(PG8_SA(0, 1), a2 + hA, voffA);
            PG8_WAIT_V(8); PG8_WAIT_L(0); PG8_BAR; PG8_MMA(0, 0, At, B0); PG8_MMA(0, 1, At, B1); PG8_BAR; PG8_SCHED;
            PG8_LDA(At, 1, 1); PG8_STAGE(PG8_SB(1, 0), b3, voffB); PG8_STAGE(PG8_SB(1, 1), b3 + hB, voffB); PG8_STAGE(PG8_SA(1, 0), a3, voffA);
            PG8_WAIT_V(8); PG8_WAIT_L(0); PG8_BAR; PG8_MMA(1, 0, At, B0); PG8_MMA(1, 1, At, B1); PG8_BAR; PG8_SCHED;
        }
        if constexpr (ALIGN_EPI) { if (wr == 0) PG8_BAR; }
        E(acc, cur, wr, wc, fr, fq);
        PG8_WAIT_V(0);
        if (!has_next) break;
#pragma unroll
        for (int a = 0; a < 2; ++a)
#pragma unroll
            for (int b = 0; b < 2; ++b)
#pragma unroll
                for (int m = 0; m < 4; ++m)
#pragma unroll
                    for (int n = 0; n < 2; ++n) acc[a][b][m][n] = (f32x4){0.f, 0.f, 0.f, 0.f};
        cur = nxt; cA = nA; cB = nB; ++ui;
        if constexpr (ALIGN_EPI) { if (wr == 1) PG8_BAR; }
    }
    PG8_WAIT_V(0);
    if constexpr (!ALIGN_EPI) { if (wr == 0) PG8_BAR; }
    PG8_BAR;
#undef PG8_SA
#undef PG8_SB
#undef PG8_STAGE
#undef PG8_LDA
#undef PG8_LDB
#undef PG8_MMA
#undef PG8_WAIT_V
#undef PG8_WAIT_L
#undef PG8_BAR
#undef PG8_SCHED
}
}
using pg8::Unit; using pg8::Acc; using pg8::BM; using pg8::HALF;

__device__ __forceinline__ float rstd16(const GAS float* ssq, int row) {
    const GAS f32x4* p = (const GAS f32x4*)(ssq + (size_t)row * 16); const f32x4 a = p[0], b = p[1], c = p[2], d = p[3];
    const float s = ((a[0] + a[1]) + (a[2] + a[3])) + ((b[0] + b[1]) + (b[2] + b[3])) + ((c[0] + c[1]) + (c[2] + c[3])) + ((d[0] + d[1]) + (d[2] + d[3]));
    return __builtin_amdgcn_rsqf(s * (1.f / DM) + EPS);
}
template <int MODE> __device__ __forceinline__ float act1(float v, float lb) {
    if (MODE == 1) return fsilu(v);
    if (MODE == 2) return fgelu(v);
    if (MODE == 3) { const float g = lb + (1.f - lb) * fsigmoid(v); return fmaxf(flog(g), -30.f); }
    return v;
}
struct EpiProj {
    static constexpr bool PERM = true; static constexpr int MIDK = 0;
    GAS bf16* P; GAS float* DT; const GAS float* ssq; const GAS float* lbs;
    __device__ __forceinline__ void mid(Acc&, const Unit&, int, int, int, int) const {}
    template <int MODE> __device__ __forceinline__ void body(const Acc& acc, const Unit& u, int wr, int wc, int fr, int fq) const {
        const int row0 = u.pm * BM + wr * 64 + fr, col0 = u.pn * BM + wc * 32 + 8 * fq;
        f32x4 lb[2][2];
#pragma unroll
        for (int bj = 0; bj < 2; ++bj)
#pragma unroll
            for (int n = 0; n < 2; ++n) lb[bj][n] = (MODE == 3) ? *(const GAS f32x4*)(lbs + (col0 - PC_CF) + bj * HALF + 4 * n) : (f32x4){0.f, 0.f, 0.f, 0.f};
#pragma unroll
        for (int ai = 0; ai < 2; ++ai)
#pragma unroll
            for (int m = 0; m < 4; ++m) { const int row = row0 + ai * HALF + m * 16; const float rs = rstd16(ssq, row); GAS bf16* rowp = P + (size_t)row * NPJ + col0;
#pragma unroll
                for (int bj = 0; bj < 2; ++bj) { const f32x4 v0 = acc[ai][bj][m][0] * rs, v1 = acc[ai][bj][m][1] * rs; u32x4 w;
                    w.x = pk2(act1<MODE>(v0[0], lb[bj][0][0]), act1<MODE>(v0[1], lb[bj][0][1])); w.y = pk2(act1<MODE>(v0[2], lb[bj][0][2]), act1<MODE>(v0[3], lb[bj][0][3]));
                    w.z = pk2(act1<MODE>(v1[0], lb[bj][1][0]), act1<MODE>(v1[1], lb[bj][1][1])); w.w = pk2(act1<MODE>(v1[2], lb[bj][1][2]), act1<MODE>(v1[3], lb[bj][1][3]));
                    *(GAS u32x4*)(rowp + bj * HALF) = w; } }
    }
    __device__ __forceinline__ void operator()(const Acc& acc, const Unit& u, int wr, int wc, int fr, int fq) const {
        const int pn = u.pn;
        if (pn == 17) {
            if (wc == 0 && fq == 0) {
#pragma unroll
                for (int ai = 0; ai < 2; ++ai)
#pragma unroll
                    for (int m = 0; m < 4; ++m) { const int row = u.pm * BM + wr * 64 + fr + ai * HALF + m * 16; const float rs = rstd16(ssq, row);
                        *(GAS f32x4*)(DT + (size_t)row * 8) = acc[ai][0][m][0] * rs; *(GAS f32x4*)(DT + (size_t)row * 8 + 4) = acc[ai][0][m][1] * rs; }
            }
            return;
        }
        if (pn == 4 || pn == 5 || pn == 9 || pn == 10 || pn == 15 || pn == 16) body<1>(acc, u, wr, wc, fr, fq);
        else if (pn == 7 || pn == 8) body<2>(acc, u, wr, wc, fr, fq);
        else if (pn == 11 || pn == 12) body<3>(acc, u, wr, wc, fr, fq);
        else body<0>(acc, u, wr, wc, fr, fq);
    }
};
template <bool MID> struct EpiRes {
    static constexpr bool PERM = false; static constexpr int MIDK = MID ? 8 : 0;
    const GAS float* basep; const GAS float* bases; GAS float* hout; GAS bf16* hb; GAS float* ssq; const GAS float* ssdp;
    __device__ __forceinline__ void mid(Acc& acc, const Unit& u, int wr, int wc, int fr, int fq) const {
#pragma unroll
        for (int ai = 0; ai < 2; ++ai)
#pragma unroll
            for (int m = 0; m < 4; ++m) { const int row = u.pm * BM + wr * 64 + fr + ai * HALF + m * 16;
                const GAS f32x4* p = (const GAS f32x4*)(ssdp + (size_t)row * 16); const f32x4 a = p[0], b = p[1], c = p[2], d = p[3];
                const float s = ((a[0] + a[1]) + (a[2] + a[3])) + ((b[0] + b[1]) + (b[2] + b[3])) + ((c[0] + c[1]) + (c[2] + c[3])) + ((d[0] + d[1]) + (d[2] + d[3]));
                const float rs = __builtin_amdgcn_rsqf(s * (1.f / 512.f) + EPS);
#pragma unroll
                for (int bj = 0; bj < 2; ++bj)
#pragma unroll
                    for (int n = 0; n < 2; ++n) acc[ai][bj][m][n] = acc[ai][bj][m][n] * rs; }
    }
    __device__ __forceinline__ void operator()(const Acc& acc, const Unit& u, int wr, int wc, int fr, int fq) const {
        const int row0 = u.pm * BM + wr * 64 + fr, col0 = u.pn * BM + wc * 32 + 4 * fq;
        const GAS float* base = (u.pm < MPR / BM) ? basep : bases;
#pragma unroll
        for (int ai = 0; ai < 2; ++ai)
#pragma unroll
            for (int m = 0; m < 4; ++m) { const int row = row0 + ai * HALF + m * 16; const size_t off = (size_t)row * DM + col0; float ss = 0.f;
                if (row < MREAL) {
#pragma unroll
                    for (int bj = 0; bj < 2; ++bj)
#pragma unroll
                        for (int n = 0; n < 2; ++n) { const f32x4 v = *(const GAS f32x4*)(base + off + bj * HALF + n * 16) + acc[ai][bj][m][n];
                            *(GAS f32x4*)(hout + off + bj * HALF + n * 16) = v; u32x2 w; w.x = pk2(v[0], v[1]); w.y = pk2(v[2], v[3]); *(GAS u32x2*)(hb + off + bj * HALF + n * 16) = w;
                            ss += (v[0] * v[0] + v[1] * v[1]) + (v[2] * v[2] + v[3] * v[3]); }
                }
                ss += swz_xor<16>(ss); ss = sum_halves(ss);
                if (fq == 0) ssq[(size_t)row * 16 + u.pn * 4 + wc] = ss;
                asm volatile("" ::: "memory"); }
    }
};
struct EpiDbg {
    static constexpr bool PERM = false; static constexpr int MIDK = 8;
    const GAS float* basep; GAS float* hout; const GAS float* ssdp;
    __device__ __forceinline__ void mid(Acc& acc, const Unit& u, int wr, int wc, int fr, int fq) const {
#pragma unroll
        for (int ai = 0; ai < 2; ++ai)
#pragma unroll
            for (int m = 0; m < 4; ++m) { const int row = u.pm * BM + wr * 64 + fr + ai * HALF + m * 16;
                const GAS f32x4* p = (const GAS f32x4*)(ssdp + (size_t)row * 16); const f32x4 a = p[0], b = p[1], c = p[2], d = p[3];
                const float s = ((a[0] + a[1]) + (a[2] + a[3])) + ((b[0] + b[1]) + (b[2] + b[3])) + ((c[0] + c[1]) + (c[2] + c[3])) + ((d[0] + d[1]) + (d[2] + d[3]));
                const float rs = __builtin_amdgcn_rsqf(s * (1.f / 512.f) + EPS);
#pragma unroll
                for (int bj = 0; bj < 2; ++bj)
#pragma unroll
                    for (int n = 0; n < 2; ++n) acc[ai][bj][m][n] = acc[ai][bj][m][n] * rs; }
    }
    __device__ __forceinline__ void operator()(const Acc& acc, const Unit& u, int wr, int wc, int fr, int fq) const {
        const int row0 = u.pm * BM + wr * 64 + fr, col0 = u.pn * BM + wc * 32 + 4 * fq;
#pragma unroll
        for (int ai = 0; ai < 2; ++ai)
#pragma unroll
            for (int m = 0; m < 4; ++m) { const int row = row0 + ai * HALF + m * 16; const size_t off = (size_t)row * DM + col0;
#pragma unroll
                for (int bj = 0; bj < 2; ++bj)
#pragma unroll
                    for (int n = 0; n < 2; ++n) { const f32x4 v = *(const GAS f32x4*)(basep + off + bj * HALF + n * 16) + acc[ai][bj][m][n]; *(GAS f32x4*)(hout + off + bj * HALF + n * 16) = v; }
                asm volatile("" ::: "memory"); }
    }
};
struct EpiUp {
    static constexpr bool PERM = true; static constexpr int MIDK = 0;
    GAS bf16* Z; const GAS float* ssq;
    __device__ __forceinline__ void mid(Acc&, const Unit&, int, int, int, int) const {}
    __device__ __forceinline__ void operator()(const Acc& acc, const Unit& u, int wr, int wc, int fr, int fq) const {
        const int row0 = u.pm * BM + wr * 64 + fr, col0 = u.pn * BM + wc * 32 + 8 * fq;
#pragma unroll
        for (int ai = 0; ai < 2; ++ai)
#pragma unroll
            for (int m = 0; m < 4; ++m) { const int row = row0 + ai * HALF + m * 16; const float rs = rstd16(ssq, row); GAS bf16* rowp = Z + (size_t)row * DFF + col0;
#pragma unroll
                for (int bj = 0; bj < 2; ++bj) { f32x4 v0 = acc[ai][bj][m][0] * rs, v1 = acc[ai][bj][m][1] * rs;
#pragma unroll
                    for (int i = 0; i < 4; ++i) { const float a = fmaxf(v0[i], 0.f), b = fmaxf(v1[i], 0.f); v0[i] = a * a; v1[i] = b * b; }
                    u32x4 w; w.x = pk2(v0[0], v0[1]); w.y = pk2(v0[2], v0[3]); w.z = pk2(v1[0], v1[1]); w.w = pk2(v1[2], v1[3]); *(GAS u32x4*)(rowp + bj * HALF) = w; } }
    }
};
struct EpiPP {
    static constexpr bool PERM = false; static constexpr int MIDK = 0;
    GAS bf16* PPB;
    __device__ __forceinline__ void mid(Acc&, const Unit&, int, int, int, int) const {}
    __device__ __forceinline__ void operator()(const Acc& acc, const Unit& u, int wr, int wc, int fr, int fq) const {
        const int row0 = u.pm * BM + wr * 64 + fr, col0 = u.pn * BM + wc * 32 + 4 * fq;
#pragma unroll
        for (int ai = 0; ai < 2; ++ai)
#pragma unroll
            for (int m = 0; m < 4; ++m) { const size_t off = (size_t)(row0 + ai * HALF + m * 16) * DM + col0;
#pragma unroll
                for (int bj = 0; bj < 2; ++bj)
#pragma unroll
                    for (int n = 0; n < 2; ++n) { const f32x4 v = acc[ai][bj][m][n]; u32x2 w; w.x = pk2(v[0], v[1]); w.y = pk2(v[2], v[3]); *(GAS u32x2*)(PPB + off + bj * HALF + n * 16) = w; } }
    }
};
struct EpiGate {
    static constexpr bool PERM = false; static constexpr int MIDK = 0;
    GAS float* h; GAS bf16* hb; const GAS bf16* PPB; const GAS float* ssq_in; GAS float* ssq_out;
    __device__ __forceinline__ void mid(Acc&, const Unit&, int, int, int, int) const {}
    __device__ __forceinline__ void operator()(const Acc& acc, const Unit& u, int wr, int wc, int fr, int fq) const {
        const int row0 = u.pm * BM + wr * 64 + fr, col0 = u.pn * BM + wc * 32 + 4 * fq;
#pragma unroll
        for (int ai = 0; ai < 2; ++ai)
#pragma unroll
            for (int m = 0; m < 4; ++m) { const int row = row0 + ai * HALF + m * 16; const size_t off = (size_t)row * DM + col0; float ss = 0.f;
                if (row < MREAL) { const float rs = rstd16(ssq_in, row);
#pragma unroll
                    for (int bj = 0; bj < 2; ++bj)
#pragma unroll
                        for (int n = 0; n < 2; ++n) { const f32x4 a = acc[ai][bj][m][n] * rs; const u32x2 pw = *(const GAS u32x2*)(PPB + off + bj * HALF + n * 16);
                            f32x4 v = *(const GAS f32x4*)(h + off + bj * HALF + n * 16);
                            v[0] += fsigmoid(a[0]) * bflo(pw.x); v[1] += fsigmoid(a[1]) * bfhi(pw.x); v[2] += fsigmoid(a[2]) * bflo(pw.y); v[3] += fsigmoid(a[3]) * bfhi(pw.y);
                            *(GAS f32x4*)(h + off + bj * HALF + n * 16) = v; u32x2 w; w.x = pk2(v[0], v[1]); w.y = pk2(v[2], v[3]); *(GAS u32x2*)(hb + off + bj * HALF + n * 16) = w;
                            ss += (v[0] * v[0] + v[1] * v[1]) + (v[2] * v[2] + v[3] * v[3]); }
                }
                ss += swz_xor<16>(ss); ss = sum_halves(ss);
                if (fq == 0) ssq_out[(size_t)row * 16 + u.pn * 4 + wc] = ss;
                asm volatile("" ::: "memory"); }
    }
};

#define RLX_AGENT __ATOMIC_RELAXED, __HIP_MEMORY_SCOPE_AGENT
#define XB_TMO      128
#define XB_XCNT(j)  (256  + 64 * (j))
#define XB_XSUB(j)  (1280 + 64 * (j))
#define XB_XGEN(j)  (2304 + 64 * (j))
#define XB_TOP      3328
#define XB_TOPGEN   3392
#define XCD_BAR_WORDS 3456
#define XB_SPIN_CAP (1u << 20)
__device__ __forceinline__ unsigned xb_ld(GAS unsigned* p)              { return __hip_atomic_load(p, __ATOMIC_RELAXED, __HIP_MEMORY_SCOPE_AGENT); }
__device__ __forceinline__ unsigned xb_add(GAS unsigned* p, unsigned v) { return __hip_atomic_fetch_add(p, v, __ATOMIC_RELAXED, __HIP_MEMORY_SCOPE_AGENT); }
__device__ __forceinline__ unsigned xb_xcc_id() { return (unsigned)__builtin_amdgcn_s_getreg((3 << 11) | 20) & 0xFu; }
#define XB_SPIN(cond, bar) do { unsigned _sp = 0; while (cond) { __builtin_amdgcn_s_sleep(1); \
    if ((++_sp & 255u) == 0u) { if (xb_ld(&(bar)[XB_TMO])) break; if (_sp > XB_SPIN_CAP) { (void)xb_add(&(bar)[XB_TMO], 1u); break; } } } } while (0)
struct XcdBarrier { GAS unsigned* bar; unsigned x; volatile LAS unsigned* st; };
__device__ __forceinline__ XcdBarrier xcd_barrier_post(GAS unsigned* bar, volatile LAS unsigned* st) {
    XcdBarrier b; b.bar = bar; b.x = xb_xcc_id(); b.st = st;
    if (threadIdx.x == 0) (void)xb_add(&bar[XB_XCNT(b.x)], 1u);
    return b;
}
__device__ __forceinline__ void xcd_barrier_complete(GAS unsigned* bar, unsigned x, unsigned& nloc, unsigned& nx) {
    const unsigned G = gridDim.x * gridDim.y * gridDim.z;
    unsigned sum, cnt, mine, sp = 0u;
    for (;;) {
        sum = 0u; cnt = 0u; mine = 0u;
#pragma unroll
        for (unsigned j = 0; j < 16; ++j) { const unsigned c = xb_ld(&bar[XB_XCNT(j)]); sum += c; cnt += (c > 0u) ? 1u : 0u; mine = (j == x) ? c : mine; }
        if (sum == G) break;
        __builtin_amdgcn_s_sleep(1);
        if ((++sp & 255u) == 0u) { if (xb_ld(&bar[XB_TMO])) break; if (sp > XB_SPIN_CAP) { (void)xb_add(&bar[XB_TMO], 1u); break; } }
    }
    nloc = mine > 0u ? mine : 1u; nx = cnt > 0u ? cnt : 1u;
}
__device__ __forceinline__ void xcd_barrier(const XcdBarrier& b, const int tid) {
    asm volatile("s_waitcnt vmcnt(0)" ::: "memory");
    __syncthreads();
    if (tid == 0) {
        GAS unsigned* bar = b.bar;
        __builtin_amdgcn_s_waitcnt(0);
        unsigned nloc = b.st[0], nx = b.st[1];
        if (nloc == 0u) { xcd_barrier_complete(bar, b.x, nloc, nx); b.st[0] = nloc; b.st[1] = nx; }
        const unsigned old = xb_add(&bar[XB_XSUB(b.x)], 1u);
        const unsigned gen = old / nloc;
        if (old + 1u == (gen + 1u) * nloc) {
            __builtin_amdgcn_fence(__ATOMIC_RELEASE, "agent");
            asm volatile("s_waitcnt vmcnt(0)" ::: "memory");
            const unsigned og = xb_add(&bar[XB_TOP], 1u);
            const unsigned tg = og / nx;
            if (og + 1u == (tg + 1u) * nx) xb_add(&bar[XB_TOPGEN], 1u);
            else XB_SPIN(xb_ld(&bar[XB_TOPGEN]) == tg, bar);
            __builtin_amdgcn_fence(__ATOMIC_ACQUIRE, "agent");
            xb_add(&bar[XB_XGEN(b.x)], 1u);
            asm volatile("s_waitcnt vmcnt(0)" ::: "memory");
        } else {
            XB_SPIN(xb_ld(&bar[XB_XGEN(b.x)]) == gen, bar);
            __builtin_amdgcn_fence(__ATOMIC_ACQUIRE, "agent");
            asm volatile("s_waitcnt vmcnt(0)" ::: "memory");
        }
    }
    __syncthreads();
}

struct Frame {
    LAS unsigned char* lds;
    int tid, lane, wave, G, bx;
    const LAS unsigned long long* intab;
    struct InAcc { const LAS unsigned long long* t; __device__ __forceinline__ const GAS float* operator[](int i) const { const unsigned long long v = t[i];
        const unsigned lo = __builtin_amdgcn_readfirstlane((unsigned)v), hi = __builtin_amdgcn_readfirstlane((unsigned)(v >> 32)); return (const GAS float*)(((unsigned long long)hi << 32) | lo); } } in;
    GAS float* out; GAS unsigned char* ws;
#define FPTR(name, type, off) __device__ __forceinline__ GAS type* name() const { return (GAS type*)(ws + (off)); }
    FPTR(BIG, bf16, WS_BIG) FPTR(HB, bf16, WS_HB) FPTR(HB2, bf16, WS_HB2) FPTR(PB, bf16, WS_PB) FPTR(LA, bf16, WS_LA) FPTR(BB, bf16, WS_BB) FPTR(XA, bf16, WS_XA) FPTR(PPB, bf16, WS_PPB)
    FPTR(DT, float, WS_DT) FPTR(SSQ_MIX, float, WS_SSQ_MIX) FPTR(SSQ_FFN, float, WS_SSQ_FFN) FPTR(SSQ_PLE, float, WS_SSQ_PLE) FPTR(SSDP, float, WS_SSDP) FPTR(LBS, float, WS_LBS) FPTR(WAT, bf16, WS_WAT)
#undef FPTR
};
__device__ __forceinline__ GAS bf16* w_in_t(GAS unsigned char* ws, int l) { return (GAS bf16*)(ws + WS_WIN) + (size_t)l * NPJP * DM; }
__device__ __forceinline__ GAS bf16* w_out_t(GAS unsigned char* ws, int l) { return (GAS bf16*)(ws + WS_WOUT) + (size_t)l * DM * DMIX; }
__device__ __forceinline__ GAS bf16* w_up_t(GAS unsigned char* ws, int l) { return (GAS bf16*)(ws + WS_WUP) + (size_t)l * DFF * DM; }
__device__ __forceinline__ GAS bf16* w_dn_t(GAS unsigned char* ws, int l) { return (GAS bf16*)(ws + WS_WDN) + (size_t)l * DM * DFF; }
__device__ __forceinline__ GAS bf16* w_g_t(GAS unsigned char* ws, int l) { return (GAS bf16*)(ws + WS_WG) + (size_t)l * DM * DM; }
__device__ __forceinline__ GAS bf16* w_pj_t(GAS unsigned char* ws, int l) { return (GAS bf16*)(ws + WS_WPJ) + (size_t)l * DM * PLE; }

__device__ __forceinline__ int win_src(int n0) {
    if (n0 < 512) return 1536 + n0;
    if (n0 < 1024) return n0 - 512;
    if (n0 < 1536) return 2312 + (n0 - 1024);
    if (n0 < 1792) return 2048 + (n0 - 1536);
    if (n0 < 2304) return 512 + (n0 - 1792);
    if (n0 < 2816) return 1024 + (n0 - 2304);
    if (n0 < 3328) return 2824 + (n0 - 2816);
    if (n0 < 3840) return 3336 + (n0 - 3328);
    if (n0 < 4352) return 3848 + (n0 - 3840);
    return 2304 + (n0 - 4352);
}
__device__ __forceinline__ void p0_item(const GAS float* W, int ldw, GAS bf16* WT, int K, int N, int mode, const GAS float* ks, LAS float* scr, int item, int lane) {
    const int nblk = N / 32, kb = item / nblk, nb = item % nblk, k0 = 64 * kb, n0 = 32 * nb;
    int sn0 = n0, nvalid = 32;
    if (mode == 1) { sn0 = win_src(n0); if (n0 >= NPJ) nvalid = (n0 == NPJ) ? 8 : 0; }
#pragma unroll 8
    for (int i = 0; i < 32; ++i) { const int kk = 2 * i + (lane >> 5), k = k0 + kk; int sk = k; float sc = 1.f;
        if (mode == 2) { sk = (k < 512) ? 512 + k : (k < 1024 ? k - 512 : k); if (k < 512) sc = ks[k]; } else if (ks) sc = ks[k];
        float v = 0.f; if ((lane & 31) < nvalid) v = W[(size_t)sk * ldw + sn0 + (lane & 31)];
        scr[kk * 33 + (lane & 31)] = v * sc; }
    asm volatile("s_waitcnt lgkmcnt(0)" ::: "memory");
    const int c = lane & 7;
#pragma unroll
    for (int j = 0; j < 4; ++j) { const int n = (lane >> 3) + 8 * j; const LAS float* s = scr + (8 * c) * 33 + n;
        u32x4 o; o.x = pk2(s[0 * 33], s[1 * 33]); o.y = pk2(s[2 * 33], s[3 * 33]); o.z = pk2(s[4 * 33], s[5 * 33]); o.w = pk2(s[6 * 33], s[7 * 33]);
        *(GAS u32x4*)(WT + (size_t)(n0 + n) * K + k0 + 8 * c) = o; }
    asm volatile("s_waitcnt lgkmcnt(0)" ::: "memory");
}
__device__ __forceinline__ void p0_prologue(Frame& F) {
    LAS float* scr = (LAS float*)(F.lds + F.wave * 16384);
    const int gw = F.bx * 8 + F.wave, NGW = F.G * 8;
    constexpr int I_IN = (DM / 64) * (NPJP / 32), I_OUT = (DMIX / 64) * (DM / 32), I_UP = (DM / 64) * (DFF / 32), I_DN = (DFF / 64) * (DM / 32), I_G = (DM / 64) * (DM / 32), I_PJ = (PLE / 64) * (DM / 32);
    constexpr int PER_L = I_IN + I_OUT + I_UP + I_DN + I_G + I_PJ;
    for (int it = gw; it < NL * PER_L; it += NGW) {
        const int l = it / PER_L; int r = it % PER_L;
        if (r < I_IN) { p0_item(F.in[I_WIN] + (size_t)l * DM * DIN, DIN, w_in_t(F.ws, l), DM, NPJP, 1, F.in[I_NMIX] + l * DM, scr, r, F.lane); continue; } r -= I_IN;
        if (r < I_OUT) { p0_item(F.in[I_WOUT] + (size_t)l * DMIX * DM, DM, w_out_t(F.ws, l), DMIX, DM, 2, F.in[I_SNORM] + l * 512, scr, r, F.lane); continue; } r -= I_OUT;
        if (r < I_UP) { p0_item(F.in[I_WUP] + (size_t)l * DM * DFF, DFF, w_up_t(F.ws, l), DM, DFF, 0, F.in[I_NFFN] + l * DM, scr, r, F.lane); continue; } r -= I_UP;
        if (r < I_DN) { p0_item(F.in[I_WDN] + (size_t)l * DFF * DM, DM, w_dn_t(F.ws, l), DFF, DM, 0, nullptr, scr, r, F.lane); continue; } r -= I_DN;
        if (r < I_G) { p0_item(F.in[I_WG] + (size_t)l * DM * DM, DM, w_g_t(F.ws, l), DM, DM, 0, F.in[I_NPLE] + l * DM, scr, r, F.lane); continue; } r -= I_G;
        p0_item(F.in[I_WPJ] + (size_t)l * PLE * DM, DM, w_pj_t(F.ws, l), PLE, DM, 0, nullptr, scr, r, F.lane);
    }
    for (int m = gw; m < MREAL; m += NGW) {
        const GAS float* xr = (m < MPR) ? F.in[I_XP] + (size_t)m * DM : F.in[I_XS] + (size_t)(m - MPR) * DM;
        f32x4 v[4]; float s = 0.f;
#pragma unroll
        for (int j = 0; j < 4; ++j) { v[j] = ((const GAS f32x4*)xr)[F.lane + 64 * j]; s += (v[j][0] * v[j][0] + v[j][1] * v[j][1]) + (v[j][2] * v[j][2] + v[j][3] * v[j][3]); }
        s = wave_sum(s);
#pragma unroll
        for (int j = 0; j < 4; ++j) { u32x2 w; w.x = pk2(v[j][0], v[j][1]); w.y = pk2(v[j][2], v[j][3]); ((GAS u32x2*)(F.HB() + (size_t)m * DM))[F.lane + 64 * j] = w; }
        if (F.lane < 16) F.SSQ_MIX()[(size_t)m * 16 + F.lane] = (F.lane == 0) ? s : 0.f;
    }
    const int gt = F.bx * 512 + F.tid, NGT = F.G * 512;
    for (int e = gt; e < NL * 2 * 8 * 64 * 64; e += NGT) { const int i = e & 63, j = (e >> 6) & 63, h = (e >> 12) & 7, g = (e >> 15) & 1, l = e >> 16;
        F.WAT()[e] = f2bf(F.in[g ? I_WX : I_WA][(((size_t)l * 8 + h) * 64 + i) * 64 + j]); }
    for (int e = gt; e < NL * 512; e += NGT) { const int l = e / 512, c = e % 512;
        float mx = -1e30f; for (int q = 0; q < NL; ++q) mx = fmaxf(mx, F.in[I_HLB][q * 512 + c]);
        float den = 0.f, cs = 0.f, c0 = 0.f; for (int q = 0; q < NL; ++q) den += __expf(F.in[I_HLB][q * 512 + c] - mx);
        for (int q = 0; q <= l; ++q) { const float p = __expf(F.in[I_HLB][q * 512 + c] - mx) / den; cs += p; if (q == 0) c0 = p; }
        F.LBS()[e] = cs - c0; }
}

__device__ __forceinline__ void p2a_rg_item(Frame& F, int l, int item) {
    const int tt = item >> 3, h = item & 7, row0 = tt * 32, lane = F.lane, r = lane & 31, hf = lane >> 5;
    LAS float* xt = (LAS float*)(F.lds + F.wave * 8704);
    const int gc = 64 * h + lane;
    const GAS float* cw = F.in[I_CAW] + l * 4 * 512; const float w0 = cw[gc], w1 = cw[512 + gc], w2 = cw[1024 + gc], w3 = cw[1536 + gc], cb = F.in[I_CAB][l * 512 + gc];
    const GAS bf16* ax = F.BIG() + (size_t)row0 * NPJ + PC_AX + gc;
    const bool first = (row0 % SEQ) == 0;
    float p3 = 0.f, p2 = 0.f, p1 = 0.f;
    if (!first) { p3 = bf2f(ax[-3 * NPJ]); p2 = bf2f(ax[-2 * NPJ]); p1 = bf2f(ax[-1 * NPJ]); }
#pragma unroll 8
    for (int t = 0; t < 32; ++t) { const float cur = bf2f(ax[(size_t)t * NPJ]); xt[t * 68 + lane] = w0 * p3 + w1 * p2 + w2 * p1 + w3 * cur + cb; p3 = p2; p2 = p1; p1 = cur; }
    if ((row0 + 32) % SEQ == 0) { const int b = row0 / SEQ; GAS float* o = F.out + O_RCP + ((size_t)(l * 8 + b) * 3) * 512 + gc; o[0] = p3; o[512] = p2; o[1024] = p1; }
    bf16x8 af[4];
#pragma unroll
    for (int s = 0; s < 4; ++s) { const f32x4 a = *(const LAS f32x4*)(xt + r * 68 + 16 * s + 8 * hf), b = *(const LAS f32x4*)(xt + r * 68 + 16 * s + 8 * hf + 4);
        u32x4 w; w.x = pk2(a[0], a[1]); w.y = pk2(a[2], a[3]); w.z = pk2(b[0], b[1]); w.w = pk2(b[2], b[3]); af[s] = __builtin_bit_cast(bf16x8, w); }
#pragma unroll
    for (int jb = 0; jb < 2; ++jb) {
        f32x16 ar, ai;
#pragma unroll
        for (int q = 0; q < 16; ++q) { ar[q] = 0.f; ai[q] = 0.f; }
        const GAS bf16* wr_ = F.WAT() + ((((size_t)l * 2 + 0) * 8 + h) * 64 + 32 * jb + r) * 64 + 8 * hf;
        const GAS bf16* wi_ = F.WAT() + ((((size_t)l * 2 + 1) * 8 + h) * 64 + 32 * jb + r) * 64 + 8 * hf;
#pragma unroll
        for (int s = 0; s < 4; ++s) { const bf16x8 br = *(const GAS bf16x8*)(wr_ + 16 * s), bi = *(const GAS bf16x8*)(wi_ + 16 * s); ar = mfma32(af[s], br, ar); ai = mfma32(af[s], bi, ai); }
        const int j = 32 * jb + r, gj = 64 * h + j;
        const float ba = F.in[I_BA][l * 512 + gj], bx = F.in[I_BX][l * 512 + gj], c8 = -8.f * fsoftplus(-F.in[I_LAM][l * 512 + gj]);
#pragma unroll
        for (int q = 0; q < 16; ++q) { const int t = rowoff(q, hf); const float rr = fsigmoid(ar[q] + ba), ii = fsigmoid(ai[q] + bx), la = c8 * rr;
            float mult = __builtin_amdgcn_sqrtf(fmaxf(fnegexpm1(2.f * la), 0.f)); if (((row0 + t) % SEQ) == 0) mult = 1.f;
            const float bv = mult * ii * xt[t * 68 + j]; const size_t o = (size_t)(row0 + t) * 512 + gj; F.LA()[o] = f2bf(la); F.BB()[o] = f2bf(bv); }
    }
}
__device__ __forceinline__ void p2a_conv_item(Frame& F, int l, int item) {
    const int tt = item / 3, g = item % 3, row0 = tt * 32, ch = 256 * g + 4 * F.lane, col = ch < 512 ? PC_XS + ch : PC_B + (ch - 512);
    const GAS float* cw = F.in[I_CBW] + l * 4 * 768 + ch; const f32x4 w0 = *(const GAS f32x4*)cw, w1 = *(const GAS f32x4*)(cw + 768), w2 = *(const GAS f32x4*)(cw + 1536), w3 = *(const GAS f32x4*)(cw + 2304), cb = *(const GAS f32x4*)(F.in[I_CBB] + l * 768 + ch);
    const GAS bf16* src = F.BIG() + (size_t)row0 * NPJ + col;
    const bool first = (row0 % SEQ) == 0;
    f32x4 p3 = {0.f, 0.f, 0.f, 0.f}, p2 = p3, p1 = p3;
    auto ld4 = [](const GAS bf16* p) { const u32x2 w = *(const GAS u32x2*)p; return (f32x4){bflo(w.x), bfhi(w.x), bflo(w.y), bfhi(w.y)}; };
    if (!first) { p3 = ld4(src - 3 * NPJ); p2 = ld4(src - 2 * NPJ); p1 = ld4(src - NPJ); }
#pragma unroll 4
    for (int t = 0; t < 32; ++t) { const f32x4 cur = ld4(src + (size_t)t * NPJ); const f32x4 y = w0 * p3 + w1 * p2 + w2 * p1 + w3 * cur + cb;
        u32x2 w; w.x = pk2(fsilu(y[0]), fsilu(y[1])); w.y = pk2(fsilu(y[2]), fsilu(y[3])); *(GAS u32x2*)(F.XA() + (size_t)(row0 + t) * 768 + ch) = w; p3 = p2; p2 = p1; p1 = cur; }
    if ((row0 + 32) % SEQ == 0) { const int b = row0 / SEQ; GAS float* o = F.out + O_SCP + ((size_t)(l * 8 + b) * 3) * 768 + ch; *(GAS f32x4*)o = p3; *(GAS f32x4*)(o + 768) = p2; *(GAS f32x4*)(o + 1536) = p1; }
}
__device__ __forceinline__ void p2a_pb_item(Frame& F, int l, int item) {
#pragma unroll
    for (int rr = 0; rr < 8; ++rr) { const int row = 8 * item + rr;
        if (row < MREAL) { const GAS float* s = (row < MPR) ? F.in[I_PP] + ((size_t)l * MPR + row) * PLE : F.in[I_PS] + ((size_t)l * MSM + row - MPR) * PLE;
            const f32x4 v = ((const GAS f32x4*)s)[F.lane]; u32x2 w; w.x = pk2(v[0], v[1]); w.y = pk2(v[2], v[3]); ((GAS u32x2*)(F.PB() + (size_t)row * PLE))[F.lane] = w; } }
}
__device__ __forceinline__ void p2a_phase(Frame& F, int l) {
    const int gw = F.bx * 8 + F.wave, NGW = F.G * 8;
    constexpr int N_RG = (MPR / 32) * 8, N_CV = (MPR / 32) * 3, N_PB = MP / 8;
#pragma nounroll
    for (int it = gw; it < N_RG + N_CV + N_PB; it += NGW) {
        if (it < N_RG) p2a_rg_item(F, l, it);
        else if (it < N_RG + N_CV) p2a_conv_item(F, l, it - N_RG);
        else p2a_pb_item(F, l, it - N_RG - N_CV);
    }
}

__device__ __forceinline__ void rg_scan_role(Frame& F, int l, int rid) {
    const int b = rid >> 3, h = rid & 7, lane = F.lane, w = F.wave, gj = 64 * h + lane;
    LAS float* sA = (LAS float*)F.lds; LAS float* sB = sA + 512;
    const size_t rb = (size_t)b * SEQ + 256 * w;
    const GAS bf16* la = F.LA() + rb * 512 + gj; const GAS bf16* bb = F.BB() + rb * 512 + gj;
    float A = 1.f, B = 0.f;
#pragma nounroll
    for (int t = 0; t < 256; t += 8) { float av[8], bv[8];
#pragma unroll
        for (int k = 0; k < 8; ++k) { av[k] = bf2f(la[(size_t)(t + k) * 512]); bv[k] = bf2f(bb[(size_t)(t + k) * 512]); }
#pragma unroll
        for (int k = 0; k < 8; ++k) { const float a = fexp(av[k]); B = a * B + bv[k]; A *= a; } }
    sA[w * 64 + lane] = A; sB[w * 64 + lane] = B;
    WG_BARRIER();
    float hh = 0.f;
    for (int q = 0; q < w; ++q) hh = sA[q * 64 + lane] * hh + sB[q * 64 + lane];
    GAS bf16* pr = F.BIG() + rb * NPJ;
#pragma nounroll
    for (int t = 0; t < 256; t += 8) { float av[8], bv[8], gv[8];
#pragma unroll
        for (int k = 0; k < 8; ++k) { av[k] = bf2f(la[(size_t)(t + k) * 512]); bv[k] = bf2f(bb[(size_t)(t + k) * 512]); gv[k] = bf2f(pr[(size_t)(t + k) * NPJ + PC_AG + gj]); }
#pragma unroll
        for (int k = 0; k < 8; ++k) { hh = fexp(av[k]) * hh + bv[k]; pr[(size_t)(t + k) * NPJ + PC_AX + gj] = f2bf(hh * gv[k]); } }
    if (w == 7) F.out[O_RHP + (size_t)(l * 8 + b) * 512 + gj] = hh;
    WG_BARRIER();
}

constexpr int SLD = 136;
__device__ __forceinline__ void ssd_role(Frame& F, int l, int rid) {
    const int b = rid >> 3, h = rid & 7, tid = F.tid, lane = F.lane, w = F.wave, r = lane & 31, hf = lane >> 5;
    LAS bf16* sC = (LAS bf16*)F.lds; LAS bf16* sBG = sC + 128 * SLD; LAS bf16* sBw = sBG + 128 * SLD; LAS bf16* sXT = sBw + 128 * SLD; LAS bf16* sS = sXT + 64 * SLD;
    LAS float* sCum = (LAS float*)(sS + 64 * SLD); LAS float* sDt = sCum + 128; LAS float* sW = sDt + 128; LAS float* sEc = sW + 128; LAS float* sTmp = sEc + 128;
    const float a_neg = -__expf(F.in[I_ALOG][l * 8 + h]), dtb = F.in[I_DTB][l * 8 + h], Dh = F.in[I_SSD_D][l * 8 + h];
    f32x16 accS;
#ifdef DBG_SSD2
    unsigned mism = 0;
#pragma nounroll
    for (int rep = 0; rep < 2; ++rep) {
#endif
#pragma unroll
    for (int q = 0; q < 16; ++q) accS[q] = 0.f;
    for (int e = tid; e < 64 * SLD; e += 512) sS[e] = 0;
    WG_BARRIER();
#pragma nounroll
    for (int c = 0; c < 16; ++c) {
        const size_t row0 = (size_t)b * SEQ + 128 * c;
#pragma unroll
        for (int i = 0; i < 4; ++i) { const int rr = (tid >> 4) + 32 * i, ck = tid & 15; const GAS bf16* src = F.XA() + (row0 + rr) * 768 + 512 + 8 * ck;
            *(LAS u32x4*)(sBG + rr * SLD + 8 * ck) = *(const GAS u32x4*)src; *(LAS u32x4*)(sC + rr * SLD + 8 * ck) = *(const GAS u32x4*)(src + 128); }
        if (w == 0) { const int t0 = 2 * lane; const float d0 = fsoftplus(F.DT()[(row0 + t0) * 8 + h] + dtb), d1 = fsoftplus(F.DT()[(row0 + t0 + 1) * 8 + h] + dtb);
            const float a0 = d0 * a_neg, a1 = d1 * a_neg; float s = a0 + a1;
#pragma unroll
            for (int o = 1; o < 64; o <<= 1) { const float v = bperm(s, lane - o); if (lane >= o) s += v; }
            const float c1 = s, c0 = s - a1, last = __int_as_float(__builtin_amdgcn_readlane(__float_as_int(s), 63));
            sCum[t0] = c0; sCum[t0 + 1] = c1; sEc[t0] = fexp(c0); sEc[t0 + 1] = fexp(c1); sW[t0] = fexp(last - c0) * d0; sW[t0 + 1] = fexp(last - c1) * d1; sDt[t0] = d0; sDt[t0 + 1] = d1;
            if (lane == 0) sTmp[0] = fexp(last); }
        WG_BARRIER();
        { const int s = tid & 127, pg = tid >> 7; const GAS bf16* src = F.XA() + (row0 + s) * 768;
            const u32x4 x0 = *(const GAS u32x4*)(src + 64 * h + 16 * pg), x1 = *(const GAS u32x4*)(src + 64 * h + 16 * pg + 8);
            const unsigned xw[8] = {x0.x, x0.y, x0.z, x0.w, x1.x, x1.y, x1.z, x1.w};
#pragma unroll
            for (int j = 0; j < 8; ++j) { sXT[(16 * pg + 2 * j) * SLD + s] = (bf16)(xw[j] & 0xffffu); sXT[(16 * pg + 2 * j + 1) * SLD + s] = (bf16)(xw[j] >> 16); }
            const float ws = sW[s];
#pragma unroll
            for (int q4 = 0; q4 < 4; ++q4) { const u32x4 bq = *(const GAS u32x4*)(src + 512 + 32 * pg + 8 * q4); const unsigned bw[4] = {bq.x, bq.y, bq.z, bq.w};
#pragma unroll
                for (int j = 0; j < 4; ++j) { const int n = 32 * pg + 8 * q4 + 2 * j; sBw[n * SLD + s] = f2bf(bflo(bw[j]) * ws); sBw[(n + 1) * SLD + s] = f2bf(bfhi(bw[j]) * ws); } } }
#if DBG_V == 1
        WG_BARRIER();
#endif
        f32x16 cbv[2];
#pragma unroll
        for (int q = 0; q < 2; ++q) { const int blk = 2 * w + q, tb = blk >> 2, sb = blk & 3; f32x16 a_;
#pragma unroll
            for (int z = 0; z < 16; ++z) a_[z] = 0.f;
            if (sb <= tb) {
#pragma unroll
                for (int ks = 0; ks < 8; ++ks) { const bf16x8 a = *(const LAS bf16x8*)(sC + (32 * tb + r) * SLD + 16 * ks + 8 * hf), bb = *(const LAS bf16x8*)(sBG + (32 * sb + r) * SLD + 16 * ks + 8 * hf); a_ = mfma32(a, bb, a_); } }
            cbv[q] = a_; }
        const int tby = w >> 1, pb = w & 1;
        f32x16 y;
#pragma unroll
        for (int z = 0; z < 16; ++z) y[z] = 0.f;
#pragma unroll
        for (int ks = 0; ks < 8; ++ks) { const bf16x8 a = *(const LAS bf16x8*)(sC + (32 * tby + r) * SLD + 16 * ks + 8 * hf), bs = *(const LAS bf16x8*)(sS + (32 * pb + r) * SLD + 16 * ks + 8 * hf); y = mfma32(a, bs, y); }
        WG_BARRIER();
#pragma unroll
        for (int q = 0; q < 2; ++q) { const int blk = 2 * w + q, tb = blk >> 2, sb = blk & 3;
            if (sb <= tb) { const int s_ = 32 * sb + r; const float cs = sCum[s_], ds = sDt[s_];
#pragma unroll
                for (int z = 0; z < 16; ++z) { const int t = 32 * tb + rowoff(z, hf); const float gv = (s_ <= t) ? cbv[q][z] * fexp(sCum[t] - cs) * ds : 0.f; sBG[t * SLD + s_] = f2bf(gv); } } }
#pragma unroll
        for (int z = 0; z < 16; ++z) y[z] *= sEc[32 * tby + rowoff(z, hf)];
        WG_BARRIER();
        for (int ks = 0; ks < 2 * (tby + 1); ++ks) { const bf16x8 a = *(const LAS bf16x8*)(sBG + (32 * tby + r) * SLD + 16 * ks + 8 * hf), bx = *(const LAS bf16x8*)(sXT + (32 * pb + r) * SLD + 16 * ks + 8 * hf); y = mfma32(a, bx, y); }
        { const int p = 32 * pb + r, col = 64 * h + p;
#pragma unroll
            for (int z = 0; z < 16; ++z) { const int t = 32 * tby + rowoff(z, hf); GAS bf16* pr = F.BIG() + (row0 + t) * NPJ;
                const float yv = y[z] + Dh * bf2f(sXT[p * SLD + t]); const float yg = yv * bf2f(pr[PC_BZ + col]);
#ifdef DBG_SSD2
                if (rep == 1) { if (l == 1 && pr[PC_XS + col] != f2bf(yg)) ++mism; } else
#endif
                pr[PC_XS + col] = f2bf(yg);
                const float ss = sum32(yg * yg);
                if (r == 0) F.SSDP()[(row0 + t) * 16 + 2 * h + pb] = ss; } }
#if DBG_V == 2
        WG_BARRIER();
#endif
        { const int pbs = w >> 2, nb = w & 3; const float dec = sTmp[0];
#pragma unroll
            for (int z = 0; z < 16; ++z) accS[z] *= dec;
#pragma unroll
            for (int ks = 0; ks < 8; ++ks) { const bf16x8 a = *(const LAS bf16x8*)(sXT + (32 * pbs + r) * SLD + 16 * ks + 8 * hf), bw = *(const LAS bf16x8*)(sBw + (32 * nb + r) * SLD + 16 * ks + 8 * hf); accS = mfma32(a, bw, accS); }
#pragma unroll
            for (int z = 0; z < 16; ++z) sS[(32 * pbs + rowoff(z, hf)) * SLD + 32 * nb + r] = f2bf(accS[z]); }
        WG_BARRIER();
    }
#ifdef DBG_SSD2
    }
    { const float mt = wave_sum((float)mism); if (lane == 0 && l == 1) F.out[(size_t)(16000 + rid * 8 + w) * DM] = 1000.f * mt; }
#endif
    { const int pbs = w >> 2, nb = w & 3; GAS float* o = F.out + O_SSP + ((size_t)(l * 8 + b) * 8 + h) * 64 * 128;
#pragma unroll
        for (int z = 0; z < 16; ++z) o[(32 * pbs + rowoff(z, hf)) * 128 + 32 * nb + r] = accS[z]; }
}

constexpr int HLD = 72;
__device__ __forceinline__ void hgrn_role(Frame& F, int l, int rid) {
    const int b = rid >> 3, h = rid & 7, tid = F.tid, lane = F.lane, w = F.wave, r = lane & 31, hf = lane >> 5;
    LAS bf16* sQe = (LAS bf16*)F.lds; LAS bf16* sKe = sQe + 64 * HLD; LAS bf16* sQb = sKe + 64 * HLD; LAS bf16* sKdT = sQb + 64 * HLD; LAS bf16* sVT = sKdT + 64 * HLD; LAS bf16* sAtt = sVT + 64 * HLD; LAS bf16* sST = sAtt + 64 * HLD;
    LAS float* sO = (LAS float*)(sST + 64 * HLD); LAS float* sPart = sO + 64 * 68; LAS float* sBl = sPart + 512;
    f32x16 accS;
#pragma unroll
    for (int q = 0; q < 16; ++q) accS[q] = 0.f;
    for (int e = tid; e < 64 * HLD; e += 512) sST[e] = 0;
    WG_BARRIER();
    const int d = lane, col = 64 * h + d;
#pragma nounroll
    for (int c = 0; c < 32; ++c) {
        const size_t row0 = (size_t)b * SEQ + 64 * c;
        float q[8], lf[8], v[8], bc[8];
#pragma unroll
        for (int i = 0; i < 8; ++i) { const GAS bf16* pr = F.BIG() + (row0 + 8 * w + i) * NPJ; q[i] = bf2f(pr[PC_CQ + col]); lf[i] = bf2f(pr[PC_CF + col]); v[i] = bf2f(pr[PC_CI + col]); }
        float run = 0.f;
#pragma unroll
        for (int i = 0; i < 8; ++i) { run += lf[i]; bc[i] = run; }
        sPart[w * 64 + d] = run;
        WG_BARRIER();
        float pre = 0.f, bm = 0.f, bl = 0.f;
#pragma unroll
        for (int q8 = 0; q8 < 8; ++q8) { const float pv = sPart[q8 * 64 + d]; if (q8 < w) pre += pv; if (q8 < 4) bm += pv; bl += pv; }
        unsigned kdw[4], vw[4];
#pragma unroll
        for (int i = 0; i < 8; i += 2) { float kd2[2];
#pragma unroll
            for (int u = 0; u < 2; ++u) { const int ii = i + u; const float bt = pre + bc[ii]; const float k = fnegexpm1(lf[ii]);
                const float e1 = fexp(fminf(fmaxf(bt - bm, -80.f), 80.f)), e2 = fexp(fminf(fmaxf(bm - bt, -80.f), 80.f));
                const int t = 8 * w + ii; sQe[t * HLD + d] = f2bf(q[ii] * e1); sKe[t * HLD + d] = f2bf(k * e2); sQb[t * HLD + d] = f2bf(q[ii] * fexp(bt)); kd2[u] = k * fexp(bl - bt); }
            kdw[i >> 1] = pk2(kd2[0], kd2[1]); vw[i >> 1] = pk2(v[i], v[i + 1]); }
        *(LAS u32x4*)(sKdT + d * HLD + 8 * w) = (u32x4){kdw[0], kdw[1], kdw[2], kdw[3]};
        *(LAS u32x4*)(sVT + d * HLD + 8 * w) = (u32x4){vw[0], vw[1], vw[2], vw[3]};
        if (w == 0) sBl[d] = fexp(bl);
        WG_BARRIER();
        f32x16 o;
#pragma unroll
        for (int z = 0; z < 16; ++z) o[z] = 0.f;
        const int tb = (w >> 1) & 1, eb = w & 1;
        if (w < 4) {
#pragma unroll
            for (int ks = 0; ks < 4; ++ks) { const bf16x8 a = *(const LAS bf16x8*)(sQb + (32 * tb + r) * HLD + 16 * ks + 8 * hf), bs = *(const LAS bf16x8*)(sST + (32 * eb + r) * HLD + 16 * ks + 8 * hf); o = mfma32(a, bs, o); }
        } else if (w < 7) { const int blk = w - 4, tba = blk == 0 ? 0 : 1, sba = blk == 2 ? 1 : 0;
#pragma unroll
            for (int ks = 0; ks < 4; ++ks) { const bf16x8 a = *(const LAS bf16x8*)(sQe + (32 * tba + r) * HLD + 16 * ks + 8 * hf), bk = *(const LAS bf16x8*)(sKe + (32 * sba + r) * HLD + 16 * ks + 8 * hf); o = mfma32(a, bk, o); }
#pragma unroll
            for (int z = 0; z < 16; ++z) { const int t = 32 * tba + rowoff(z, hf), s_ = 32 * sba + r; sAtt[t * HLD + s_] = f2bf((s_ <= t) ? o[z] : 0.f); }
        }
        WG_BARRIER();
        if (w < 4) {
            for (int ks = 0; ks < 2 * (tb + 1); ++ks) { const bf16x8 a = *(const LAS bf16x8*)(sAtt + (32 * tb + r) * HLD + 16 * ks + 8 * hf), bv = *(const LAS bf16x8*)(sVT + (32 * eb + r) * HLD + 16 * ks + 8 * hf); o = mfma32(a, bv, o); }
#pragma unroll
            for (int z = 0; z < 16; ++z) sO[(32 * tb + rowoff(z, hf)) * 68 + 32 * eb + r] = o[z];
        } else { const int db = (w >> 1) & 1;
#pragma unroll
            for (int z = 0; z < 16; ++z) accS[z] *= sBl[32 * db + rowoff(z, hf)];
#pragma unroll
            for (int ks = 0; ks < 4; ++ks) { const bf16x8 a = *(const LAS bf16x8*)(sKdT + (32 * db + r) * HLD + 16 * ks + 8 * hf), bv = *(const LAS bf16x8*)(sVT + (32 * eb + r) * HLD + 16 * ks + 8 * hf); accS = mfma32(a, bv, accS); }
#pragma unroll
            for (int z = 0; z < 16; ++z) sST[(32 * eb + r) * HLD + 32 * db + rowoff(z, hf)] = f2bf(accS[z]);
        }
        WG_BARRIER();
        { const int t = tid >> 3, eg = tid & 7; const f32x4 o0 = *(const LAS f32x4*)(sO + t * 68 + 8 * eg), o1 = *(const LAS f32x4*)(sO + t * 68 + 8 * eg + 4);
            float ss = (o0[0] * o0[0] + o0[1] * o0[1]) + (o0[2] * o0[2] + o0[3] * o0[3]) + (o1[0] * o1[0] + o1[1] * o1[1]) + (o1[2] * o1[2] + o1[3] * o1[3]);
            ss += swz_xor<1>(ss); ss += swz_xor<2>(ss); ss += swz_xor<4>(ss);
            const float rs = __builtin_amdgcn_rsqf(ss * (1.f / 64.f) + EPS);
            GAS bf16* pr = F.BIG() + (row0 + t) * NPJ; const u32x4 gz = *(const GAS u32x4*)(pr + PC_CG + 64 * h + 8 * eg);
            const f32x4 n0 = *(const GAS f32x4*)(F.in[I_HNORM] + l * 64 + 8 * eg), n1 = *(const GAS f32x4*)(F.in[I_HNORM] + l * 64 + 8 * eg + 4);
            u32x4 ow; ow.x = pk2(o0[0] * rs * n0[0] * bflo(gz.x), o0[1] * rs * n0[1] * bfhi(gz.x)); ow.y = pk2(o0[2] * rs * n0[2] * bflo(gz.y), o0[3] * rs * n0[3] * bfhi(gz.y));
            ow.z = pk2(o1[0] * rs * n1[0] * bflo(gz.z), o1[1] * rs * n1[1] * bfhi(gz.z)); ow.w = pk2(o1[2] * rs * n1[2] * bflo(gz.w), o1[3] * rs * n1[3] * bfhi(gz.w));
            *(GAS u32x4*)(pr + PC_CQ + 64 * h + 8 * eg) = ow; }
    }
    if (w >= 4) { const int db = (w >> 1) & 1, eb = w & 1; GAS float* o = F.out + O_HSP + ((size_t)(l * 8 + b) * 8 + h) * 64 * 64;
#pragma unroll
        for (int z = 0; z < 16; ++z) o[(32 * db + rowoff(z, hf)) * 64 + 32 * eb + r] = accS[z]; }
    WG_BARRIER();
}

#ifndef SAMPLE_MASK
#define SAMPLE_MASK 7
#endif
__device__ __forceinline__ void sample_role(Frame& F, int l, int rid) {
    const int tid = F.tid, lane = F.lane, w = F.wave;
    LAS float* sXa = (LAS float*)F.lds; LAS float* sX = sXa + 512; LAS float* sQ = sX + 768; LAS float* sFd = sQ + 512; LAS float* sK = sFd + 512; LAS float* sDt = sK + 512; LAS float* sY = sDt + 32;
#pragma nounroll
    for (int k2 = 0; k2 < 2; ++k2) {
        const int i = 2 * rid + k2; const size_t row = (size_t)MPR + i; GAS bf16* pr = F.BIG() + row * NPJ;
        { const int c = tid; const GAS float* st = F.in[I_SRC] + ((size_t)(l * MSM + i) * 3) * 512 + c; const float b0 = st[0], b1 = st[512], b2 = st[1024], cur = bf2f(pr[PC_AX + c]);
            const GAS float* cw = F.in[I_CAW] + l * 4 * 512; sXa[c] = cw[c] * b0 + cw[512 + c] * b1 + cw[1024 + c] * b2 + cw[1536 + c] * cur + F.in[I_CAB][l * 512 + c];
            GAS float* o = F.out + O_RCS + ((size_t)(l * MSM + i) * 3) * 512 + c; o[0] = b1; o[512] = b2; o[1024] = cur; }
        for (int ch = tid; ch < 768; ch += 512) { const int col = ch < 512 ? PC_XS + ch : PC_B + (ch - 512);
            const GAS float* st = F.in[I_SSC] + ((size_t)(l * MSM + i) * 3) * 768 + ch; const float b0 = st[0], b1 = st[768], b2 = st[1536], cur = bf2f(pr[col]);
            const GAS float* cw = F.in[I_CBW] + l * 4 * 768; sX[ch] = fsilu(cw[ch] * b0 + cw[768 + ch] * b1 + cw[1536 + ch] * b2 + cw[2304 + ch] * cur + F.in[I_CBB][l * 768 + ch]);
            GAS float* o = F.out + O_SCS + ((size_t)(l * MSM + i) * 3) * 768 + ch; o[0] = b1; o[768] = b2; o[1536] = cur; }
        { const int c = tid; sQ[c] = bf2f(pr[PC_CQ + c]); const float lf = bf2f(pr[PC_CF + c]); sFd[c] = fexp(lf); sK[c] = fnegexpm1(lf); }
        if (tid < 8) { const float dtv = fsoftplus(F.DT()[row * 8 + tid] + F.in[I_DTB][l * 8 + tid]); sDt[tid] = dtv; sDt[8 + tid] = fexp(-dtv * __expf(F.in[I_ALOG][l * 8 + tid])); }
        WG_BARRIER();
        if (SAMPLE_MASK & 1) { const int c = tid, hh = c >> 6, j = c & 63; const GAS float* wa = F.in[I_WA] + ((size_t)(l * 8 + hh) * 64) * 64 + j; const GAS float* wx = F.in[I_WX] + ((size_t)(l * 8 + hh) * 64) * 64 + j;
            float ar = 0.f, ai = 0.f;
#pragma unroll 4
            for (int q = 0; q < 64; ++q) { const float xv = sXa[64 * hh + q]; ar += xv * wa[q * 64]; ai += xv * wx[q * 64]; }
            const float rr = fsigmoid(ar + F.in[I_BA][l * 512 + c]), ii = fsigmoid(ai + F.in[I_BX][l * 512 + c]), la = -8.f * fsoftplus(-F.in[I_LAM][l * 512 + c]) * rr;
            const float a = fexp(la), mult = __builtin_amdgcn_sqrtf(fmaxf(fnegexpm1(2.f * la), 0.f));
            const float hn = a * F.in[I_SRH][(size_t)(l * MSM + i) * 512 + c] + mult * ii * sXa[c];
            F.out[O_RHS + (size_t)(l * MSM + i) * 512 + c] = hn; pr[PC_AX + c] = f2bf(hn * bf2f(pr[PC_AG + c])); }
#ifdef DBG_BAR
        asm volatile("s_waitcnt vmcnt(0) lgkmcnt(0)" ::: "memory");
#endif
        if (SAMPLE_MASK & 2) { const int hh = w, half = lane >> 5, ln = lane & 31, n0 = 4 * ln; const float dA = sDt[8 + hh], dtv = sDt[hh], Dh = F.in[I_SSD_D][l * 8 + hh];
            const f32x4 Bn = *(const LAS f32x4*)(sX + 512 + n0), Cn = *(const LAS f32x4*)(sX + 640 + n0);
            const GAS float* sin_ = F.in[I_SSS] + (((size_t)(l * MSM + i) * 8 + hh) * 64) * 128; GAS float* sout = F.out + O_SSS + (((size_t)(l * MSM + i) * 8 + hh) * 64) * 128;
#pragma unroll 2
            for (int it = 0; it < 32; ++it) { const int p = 2 * it + half; const f32x4 s = *(const GAS f32x4*)(sin_ + p * 128 + n0); const float xv = sX[64 * hh + p], xdt = dtv * xv;
                f32x4 sn = s * dA + Bn * xdt;
#ifdef DBG_SAN
                for (int q_ = 0; q_ < 4; ++q_) if (!(fabsf(sn[q_]) < 1e30f)) sn[q_] = 0.f;
#endif
#ifndef DBG_NOSOUT
                *(GAS f32x4*)(sout + p * 128 + n0) = sn;
#endif
                float yv = (Cn[0] * sn[0] + Cn[1] * sn[1]) + (Cn[2] * sn[2] + Cn[3] * sn[3]);
                yv = sum32(yv);
                if (ln == 0) sY[64 * hh + p] = yv + Dh * xv; }
            { const float yg = sY[64 * hh + lane] * bf2f(pr[PC_BZ + 64 * hh + lane]); pr[PC_XS + 64 * hh + lane] = f2bf(yg);
              const float ssq = wave_sum(yg * yg);
#ifdef DBG_YG
              if (l == 1) { F.out[(size_t)i * DM + 64 * hh + lane] = yg; F.out[(size_t)(128 + i) * DM + 64 * hh + lane] = bf2f(pr[PC_BZ + 64 * hh + lane]); F.out[(size_t)(256 + i) * DM + 64 * hh + lane] = sY[64 * hh + lane]; F.out[(size_t)(384 + i) * DM + 64 * hh + lane] = ssq; }
#endif
              if (lane == 0) { F.SSDP()[row * 16 + 2 * hh] = ssq; F.SSDP()[row * 16 + 2 * hh + 1] = 0.f; } } }
        if (SAMPLE_MASK & 4) { const int hh = w, e = lane; const float vv = bf2f(pr[PC_CI + 64 * hh + e]);
            const GAS float* sin_ = F.in[I_SHG] + (((size_t)(l * MSM + i) * 8 + hh) * 64) * 64 + e; GAS float* sout = F.out + O_HSS + (((size_t)(l * MSM + i) * 8 + hh) * 64) * 64 + e;
            float o = 0.f;
#pragma unroll 4
            for (int dd = 0; dd < 64; ++dd) { const float sn = sFd[64 * hh + dd] * sin_[dd * 64] + sK[64 * hh + dd] * vv; sout[dd * 64] = sn; o += sQ[64 * hh + dd] * sn; }
            const float ss = wave_sum(o * o); const float rs = __builtin_amdgcn_rsqf(ss * (1.f / 64.f) + EPS);
            pr[PC_CQ + 64 * hh + e] = f2bf(o * rs * F.in[I_HNORM][l * 64 + e] * bf2f(pr[PC_CG + 64 * hh + e])); }
        WG_BARRIER();
    }
}
__device__ __forceinline__ void p2b_phase(Frame& F, int l) {
#pragma nounroll
    for (int rid = F.bx; rid < 256; rid += F.G) {
        { int t_ = F.tid; asm volatile("" : "+v"(t_)); F.tid = t_; F.lane = t_ & 63; }
        const int kind = rid >> 6, sub = rid & 63;
#ifndef ROLE_MASK
#define ROLE_MASK 15
#endif

        switch (kind) {
        case 0: if (ROLE_MASK & 1) ssd_role(F, l, sub); break;
        case 1: if (ROLE_MASK & 2) hgrn_role(F, l, sub); break;
        case 2: if (ROLE_MASK & 4) rg_scan_role(F, l, sub); break;
        default: if (ROLE_MASK & 8) sample_role(F, l, sub); break;
        }
    }
}

__device__ __forceinline__ void final_phase(Frame& F) {
    const int gw = F.bx * 8 + F.wave, NGW = F.G * 8;
    for (int m = gw; m < MREAL; m += NGW) { const float rs = rstd16(F.SSQ_MIX(), m); GAS f32x4* hr = (GAS f32x4*)(F.out + (size_t)m * DM);
#pragma unroll
        for (int j = 0; j < 4; ++j) { const f32x4 g = ((const GAS f32x4*)F.in[I_NFIN])[F.lane + 64 * j]; hr[F.lane + 64 * j] = hr[F.lane + 64 * j] * rs * g; } }
}

struct Args { const float* in[N_IN]; float* out; unsigned char* ws; int ph_lo, ph_hi, li, pad; };
constexpr int N_PHASES = 16;
#ifdef DBG_OUTMASK
#define DBG_EXTRA_PH 1
#else
#define DBG_EXTRA_PH 0
#endif

__global__ void __launch_bounds__(512, 2) fwd_kernel(Args args) {
    extern __shared__ __attribute__((aligned(16))) unsigned char lds_raw[];
    volatile LAS unsigned* MISC = (volatile LAS unsigned*)((LAS unsigned char*)lds_raw + LDSCTL_OFF);
    for (int u = threadIdx.x; u < (LDS_BYTES - LDSCTL_OFF) / 4; u += 512) MISC[u] = 0u;
    __syncthreads();
    if (threadIdx.x < N_IN) ((LAS unsigned long long*)((LAS unsigned char*)lds_raw + LDSCTL_OFF + 256))[threadIdx.x] = (unsigned long long)args.in[threadIdx.x];
    __syncthreads();
    XcdBarrier bar; bar.bar = (GAS unsigned*)(args.ws + WS_CTL) + CW_BAR; bar.x = 0; bar.st = nullptr;
    if (MK_N_LAUNCHES == 1) bar = xcd_barrier_post((GAS unsigned*)(args.ws + WS_CTL) + CW_BAR, MISC + 8);
    const int lo = args.ph_lo, hi = args.ph_hi;
#ifndef PHASE_MASK
#define PHASE_MASK 0xFFFFu
#endif
    const int wave0 = __builtin_amdgcn_readfirstlane(threadIdx.x >> 6);
#pragma nounroll
    for (int ph = lo; ph < hi; ++ph) {
        if (ph > lo) { XcdBarrier b2 = bar; int w_ = wave0, z_ = 0; asm volatile("" : "+s"(b2.bar), "+s"(b2.x), "+s"(w_), "+v"(z_)); xcd_barrier(b2, w_ * 64 + (int)__builtin_amdgcn_mbcnt_hi(~0u, __builtin_amdgcn_mbcnt_lo(~0u, z_))); }
        Frame F;
        F.lds = (LAS unsigned char*)lds_raw;
        int wv_ = wave0, g_ = gridDim.x, b_ = blockIdx.x; GAS unsigned char* ws = (GAS unsigned char*)args.ws;
        asm volatile("" : "+s"(wv_), "+s"(g_), "+s"(b_), "+s"(ws));
        F.wave = wv_; F.G = g_; F.bx = b_;
#define FRESH() do { int z_ = 0; asm volatile("" : "+v"(z_)); F.lane = __builtin_amdgcn_mbcnt_hi(~0u, __builtin_amdgcn_mbcnt_lo(~0u, z_)); F.tid = F.wave * 64 + F.lane; } while (0)
        GAS float* out_ = (GAS float*)args.out; asm volatile("" : "+s"(out_));
        F.intab = (const LAS unsigned long long*)((LAS unsigned char*)lds_raw + LDSCTL_OFF + 256); F.in.t = F.intab; F.out = out_; F.ws = ws;
#ifdef DBG_OUTMASK
        if (ph == 16) {
            const size_t offs[13] = {0, (size_t)MPR * DM, O_RCP, O_RHP, O_SCP, O_SSP, O_HSP, O_RCS, O_RHS, O_SCS, O_SSS, O_HSS, O_END};
            int z2_ = 0; asm volatile("" : "+v"(z2_)); const int ln_ = __builtin_amdgcn_mbcnt_hi(~0u, __builtin_amdgcn_mbcnt_lo(~0u, z2_));
            for (int o_ = 0; o_ < 12; ++o_) { const float sc_ = ((DBG_OUTMASK >> o_) & 1) ? DBG_OUTSCALE : 0.f;
                for (size_t e = offs[o_] + (size_t)F.bx * 512 + F.wave * 64 + ln_; e < offs[o_ + 1]; e += (size_t)F.G * 512) F.out[e] = F.out[e] * sc_; }
            continue; }
#endif
        const int l = (ph - 1) / 7; const int k = (ph == 0) ? 0 : (ph == 15 ? 8 : 1 + (ph - 1) % 7);
        if (!((PHASE_MASK >> k) & 1u)) continue;
#ifdef DBG_CUT
        if (ph > DBG_CUT && ph != 15) continue;
#endif
#ifdef DBG_CUT2
        if (ph > DBG_CUT2) continue;
#endif
        switch (k) {
        case 0: FRESH(); p0_prologue(F);
#ifdef DBG_CUT
            { const int sizes[N_IN] = {16777216,131072,393216,131072,589824,16777216,8388608,8388608,65536,2048,8929280,4096,1024,65536,1024,65536,1024,1024,6144,1536,16,16,16,1024,1024,128,3145728,2048,8388608,8388608,2048,2097152,524288,1024};
              for (int t = F.bx; t < N_IN * 4; t += F.G) { const int ti = t >> 2, part = t & 3; const int n = sizes[ti]; const int q0 = (int)((long)n * part / 4), q1 = (int)((long)n * (part + 1) / 4);
                  const GAS float* p = F.in[ti]; float sacc = 0.f; for (int e = q0 + F.tid; e < q1; e += 512) sacc += fabsf(p[e]);
                  sacc = wave_sum(sacc); if (F.lane == 0) __hip_atomic_fetch_add((GAS float*)(F.ws + 65536) + t, sacc, __ATOMIC_RELAXED, __HIP_MEMORY_SCOPE_AGENT); } }
#endif
            break;
        case 1: {
            FRESH();
            pg8::Gemm g{F.HB(), w_in_t(ws, l), DM, DM}; pg8::StaticOrder S; S.init(MP, NPJP, F.G, F.bx);
            EpiProj E{F.BIG(), F.DT(), F.SSQ_MIX(), F.LBS() + l * 512};
            pg8::gemm_phase<EpiProj, true>(F.lds, F.tid, g, S, E); } break;
        case 2: FRESH(); p2a_phase(F, l); break;
        case 3: FRESH(); p2b_phase(F, l); break;
        case 4: {
            FRESH();
#ifdef DBG_SELF
            if (l == 1) {
                for (int rep = 0; rep < 2; ++rep) {
                    FRESH();
                    pg8::Gemm g{F.BIG(), w_out_t(ws, l), NPJ, DMIX}; pg8::StaticOrder S; S.init(8192, DM, F.G, F.bx);
                    EpiDbg E{F.out, (GAS float*)(F.ws + WS_RT) + (size_t)rep * 8192 * DM + (rep ? 131072 : 0), F.SSDP()};
                    pg8::gemm_phase<EpiDbg, true>(F.lds, F.tid, g, S, E);
                    asm volatile("s_waitcnt vmcnt(0)" ::: "memory"); __syncthreads();
                }
                break; }
#endif
#ifdef DBG_RD
            if (l == 1) { if (F.bx < 4) { for (int e = F.tid; e < 128 * 1536; e += 512) { const int r_ = e / 1536, c_ = e % 1536;
                    F.out[(size_t)(F.bx * 256 + 2 * r_ + (c_ >> 10)) * DM + (c_ & 1023)] = bf2f(F.BIG()[(size_t)(MPR + r_) * NPJ + c_]); }
                  for (int e = F.tid; e < 128 * 16; e += 512) F.out[(size_t)(1024 + F.bx * 2) * DM + e] = F.SSDP()[(size_t)MPR * 16 + e]; }
                break; }
#endif
            pg8::Gemm g{F.BIG(), w_out_t(ws, l), NPJ, DMIX}; pg8::StaticOrder S; S.init(MP, DM, F.G, F.bx);
            const GAS float* bp = (l == 0) ? F.in[I_XP] : F.out; const GAS float* bs = (l == 0) ? F.in[I_XS] - (size_t)MPR * DM : F.out;
            EpiRes<true> E{bp, bs, F.out, F.HB(), F.SSQ_FFN(), F.SSDP()};
            pg8::gemm_phase<EpiRes<true>, true>(F.lds, F.tid, g, S, E); } break;
        case 5: {
            FRESH();
            pg8::Gemm g{F.HB(), w_up_t(ws, l), DM, DM}; pg8::StaticOrder S; S.init(MP, DFF, F.G, F.bx);
            EpiUp E{F.BIG(), F.SSQ_FFN()};
            pg8::gemm_phase<EpiUp, true>(F.lds, F.tid, g, S, E); } break;
        case 6: {
            FRESH();
            pg8::Gemm g{F.BIG(), w_dn_t(ws, l), DFF, DFF}; pg8::StaticOrder S; S.init(MP, DM, F.G, F.bx);
            EpiRes<false> E{F.out, F.out, F.out, F.HB2(), F.SSQ_PLE(), nullptr};
            pg8::gemm_phase<EpiRes<false>, true>(F.lds, F.tid, g, S, E); } break;
        case 7: {
            FRESH();
            { pg8::Gemm g{F.PB(), w_pj_t(ws, l), PLE, PLE}; pg8::StaticOrder S; S.init(MP, DM, F.G, F.bx); EpiPP E{F.PPB()}; pg8::gemm_phase<EpiPP, true>(F.lds, F.tid, g, S, E); }
            asm volatile("s_waitcnt vmcnt(0)" ::: "memory"); __syncthreads();
            FRESH();
            { pg8::Gemm g{F.HB2(), w_g_t(ws, l), DM, DM}; pg8::StaticOrder S; S.init(MP, DM, F.G, F.bx); EpiGate E{F.out, F.HB(), F.PPB(), F.SSQ_PLE(), F.SSQ_MIX()}; pg8::gemm_phase<EpiGate, true>(F.lds, F.tid, g, S, E); } } break;
        default: FRESH();
#ifdef DBG_SELF
            { const GAS float* t1 = (const GAS float*)(F.ws + WS_RT); const GAS float* t2 = t1 + (size_t)8192 * DM + 131072; unsigned cnt = 0;
              for (size_t e = (size_t)F.bx * 512 + F.tid; e < (size_t)8192 * DM; e += (size_t)F.G * 512) cnt += (t1[e] != t2[e]) ? 1u : 0u;
              cnt = (unsigned)wave_sum((float)cnt);
              if (F.lane == 0) F.out[(size_t)(F.bx * 8 + F.wave) * DM] = 1000.f * (float)cnt; }
            break;
#endif
#ifdef DBG_CK
            { GAS float* yo = F.out + (size_t)MPR * DM;
              const int gw = F.bx * 8 + F.wave, NGW = F.G * 8;
              for (int it = gw; it < 128 * (24 + 16 + 1); it += NGW) { const int blk = it % 128, g = it / 128; float sacc = 0.f;
#ifdef DBG_CK2
                  if (g < 12) { for (int e = F.lane; e < 128 * 64; e += 64) sacc += fabsf(bf2f(F.XA()[(size_t)(blk * 128 + (e >> 6)) * 768 + g * 64 + (e & 63)])); }
                  else if (g < 20) { for (int e = F.lane; e < 128 * 64; e += 64) sacc += fabsf(bf2f(F.BIG()[(size_t)(blk * 128 + (e >> 6)) * NPJ + PC_BZ + (g - 12) * 64 + (e & 63)])); }
                  else if (g < 21) { for (int e = F.lane; e < 128 * 8; e += 64) sacc += fabsf(F.DT()[(size_t)blk * 128 * 8 + e]); }
                  else if (g < 24) { }
#else
                  if (g < 24) { for (int e = F.lane; e < 128 * 64; e += 64) sacc += fabsf(bf2f(F.BIG()[(size_t)(blk * 128 + (e >> 6)) * NPJ + g * 64 + (e & 63)])); }
#endif
                  else if (g < 40) { for (int e = F.lane; e < 128 * 64; e += 64) sacc += fabsf(F.out[(size_t)(blk * 128 + (e >> 6)) * DM + (g - 24) * 64 + (e & 63)]); }
                  else { for (int e = F.lane; e < 128 * 16; e += 64) sacc += fabsf(F.SSDP()[(size_t)blk * 128 * 16 + e]); }
                  sacc = wave_sum(sacc); if (F.lane == 0) yo[it] = (g >= DBG_CK_LO && g < DBG_CK_HI) ? sacc : 0.f; } }
            break;
#endif
#ifdef DBG_COPY
            for (int e = F.bx * 512 + F.tid; e < 128 * DM; e += F.G * 512) F.out[(size_t)MPR * DM + e] = F.out[(size_t)DBG_COPY * DM + e];
            break;
#endif
#ifdef DBG_CUT
            { const int gw = F.bx * 8 + F.wave, NGW = F.G * 8;
              for (int m = gw; m < MREAL; m += NGW) { float s0 = 0.f, s1 = 0.f, s2 = 0.f;
                  const GAS bf16* b = F.BIG() + (size_t)m * NPJ; for (int c = F.lane; c < NPJ; c += 64) s0 += fabsf(bf2f(b[c]));
                  const GAS bf16* hb = F.HB() + (size_t)m * DM; for (int c = F.lane; c < DM; c += 64) s1 += fabsf(bf2f(hb[c]));
                  const GAS bf16* h2 = F.HB2() + (size_t)m * DM; for (int c = F.lane; c < DM; c += 64) s2 += fabsf(bf2f(h2[c]));
                  s0 = wave_sum(s0); s1 = wave_sum(s1); s2 = wave_sum(s2);
                  float s3 = 0.f, s4 = 0.f; if (m < 1024) { const GAS float* si = F.in[I_SSS] + ((size_t)(1024 + m)) * 8192; for (int c = F.lane; c < 8192; c += 64) s3 += fabsf(si[c]);
                      const GAS float* s0i = F.in[I_SSS] + ((size_t)m) * 8192; for (int c = F.lane; c < 8192; c += 64) s4 += fabsf(s0i[c]); }
                  s3 = wave_sum(s3); s4 = wave_sum(s4);
                  if (F.lane == 0) { GAS float* o = F.out + (size_t)m * DM; o[8] = s3; o[9] = s4; if (m < N_IN * 4) o[10] = ((GAS float*)(F.ws + 65536))[m]; o[0] = s0; o[1] = s1; o[2] = s2; o[3] = F.DT()[(size_t)m * 8 + 3]; o[4] = F.SSQ_MIX()[(size_t)m * 16 + 5]; o[5] = F.SSQ_FFN()[(size_t)m * 16 + 5]; o[6] = F.SSQ_PLE()[(size_t)m * 16 + 5]; o[7] = F.SSDP()[(size_t)m * 16 + 5]; } } }
#else
#ifndef DBG_NOFINAL
            final_phase(F);
#endif
#ifdef DBG_SANOUT
            asm volatile("s_waitcnt vmcnt(0)" ::: "memory"); { XcdBarrier b3 = bar; xcd_barrier(b3, F.tid); }
            for (size_t e = (size_t)F.bx * 512 + F.tid; e < O_END; e += (size_t)F.G * 512) { const float v = F.out[e]; if (!(fabsf(v) < 1e30f)) F.out[e] = 12345.f; }
#endif
#endif
            break;
        }
    }
}

extern "C" void kernel_launch(void* const* d_in, const int* in_sizes, int n_in, void* d_out, int out_size, void* d_ws, size_t ws_size, hipStream_t stream) {
    static int grid = 0;
    if (grid == 0) {
        if (n_in != N_IN || (size_t)out_size != O_END || ws_size < WS_END) { fprintf(stderr, "kernel_launch: unexpected shapes: n_in %d out %d ws %zu (need %zu)\n", n_in, out_size, ws_size, (size_t)WS_END); grid = -1; return; }
        int dev = 0, cus = 0, per_cu = 0;
        if (hipGetDevice(&dev) != hipSuccess || hipDeviceGetAttribute(&cus, hipDeviceAttributeMultiprocessorCount, dev) != hipSuccess) { grid = -1; return; }
        if (hipFuncSetAttribute((const void*)fwd_kernel, hipFuncAttributeMaxDynamicSharedMemorySize, LDS_BYTES) != hipSuccess) { fprintf(stderr, "kernel_launch: hipFuncSetAttribute failed\n"); grid = -1; return; }
        if (hipOccupancyMaxActiveBlocksPerMultiprocessor(&per_cu, (const void*)fwd_kernel, 512, LDS_BYTES) != hipSuccess || per_cu < 1) { fprintf(stderr, "kernel_launch: occupancy query says %d blocks per CU\n", per_cu); (void)hipGetLastError(); grid = -1; return; }
        grid = cus;
        if (grid > 256) grid = 256;
    }
    if (grid < 0) return;
    if (hipMemsetAsync((char*)d_ws + WS_CTL, 0, CTL_ZERO_BYTES, stream) != hipSuccess) return;
#ifdef DBG_FILLOUT
    (void)hipMemsetAsync(d_out, 0, (size_t)O_END * 4, stream);
#endif
#ifdef DBG_FILL
    (void)hipMemsetAsync((char*)d_ws + CTL_ZERO_BYTES, DBG_FILL, WS_END - CTL_ZERO_BYTES, stream);
#endif
    Args a{};
    for (int i = 0; i < N_IN; ++i) a.in[i] = (const float*)d_in[i];
    a.out = (float*)d_out; a.ws = (unsigned char*)d_ws;
    if (MK_N_LAUNCHES == 1) { a.ph_lo = 0; a.ph_hi = N_PHASES; a.li = 0; hipLaunchKernelGGL(fwd_kernel, dim3(grid), dim3(512), LDS_BYTES, stream, a); }
    else for (int p = 0; p < N_PHASES + DBG_EXTRA_PH; ++p) { a.ph_lo = p; a.ph_hi = p + 1; a.li = p; hipLaunchKernelGGL(fwd_kernel, dim3(grid), dim3(512), LDS_BYTES, stream, a); }
}
```

```cpp
#include <hip/hip_runtime.h>
#include <cstdio>
#include <cstdint>

#define LAS __attribute__((address_space(3)))
#define GAS __attribute__((address_space(1)))
typedef unsigned short bf16;
typedef short bf16x8 __attribute__((ext_vector_type(8)));
typedef float f32x4 __attribute__((ext_vector_type(4)));
typedef float f32x16 __attribute__((ext_vector_type(16)));
typedef unsigned u32x4 __attribute__((ext_vector_type(4)));
typedef unsigned u32x2 __attribute__((ext_vector_type(2)));
typedef GAS unsigned gu32;

#ifndef MK_N_LAUNCHES
#define MK_N_LAUNCHES 1
#endif

constexpr int DM = 1024, NBATCH = 8, SEQ = 2048, MPR = NBATCH * SEQ, MSM = 128, MREAL = MPR + MSM, MP = 16640  ;
constexpr int NPJ = 4352, NPJP = 4608, DFF = 4096, PLE = 256, DMIX = 1536, NL = 2, DIN = 4360;
constexpr int PC_XS = 0, PC_AX = 512, PC_CQ = 1024, PC_B = 1536, PC_C = 1664, PC_AG = 1792, PC_BZ = 2304, PC_CF = 2816, PC_CI = 3328, PC_CG = 3840;
constexpr float EPS = 1e-6f;
enum { I_XP = 0, I_XS, I_SRC, I_SRH, I_SSC, I_SSS, I_SHG, I_PP, I_PS, I_NMIX, I_WIN, I_CAW, I_CAB, I_WA, I_BA, I_WX, I_BX, I_LAM, I_CBW, I_CBB, I_DTB, I_ALOG, I_SSD_D, I_SNORM,
       I_HLB, I_HNORM, I_WOUT, I_NFFN, I_WUP, I_WDN, I_NPLE, I_WG, I_WPJ, I_NFIN, N_IN };
constexpr size_t O_Y = 0, O_RCP = (size_t)MREAL * DM, O_RHP = O_RCP + 2 * 8 * 3 * 512, O_SCP = O_RHP + 2 * 8 * 512, O_SSP = O_SCP + 2 * 8 * 3 * 768, O_HSP = O_SSP + 2 * 8 * 8 * 64 * 128,
                 O_RCS = O_HSP + 2 * 8 * 8 * 64 * 64, O_RHS = O_RCS + 2 * 128 * 3 * 512, O_SCS = O_RHS + 2 * 128 * 512, O_SSS = O_SCS + 2 * 128 * 3 * 768, O_HSS = O_SSS + (size_t)2 * 128 * 8 * 64 * 128,
                 O_END = O_HSS + (size_t)2 * 128 * 8 * 64 * 64;
static_assert(O_END == 44830720, "output size");

constexpr size_t MiB = 1u << 20;
constexpr size_t WS_CTL = 0, CTL_ZERO_BYTES = 1 * MiB;
constexpr size_t WS_WIN = 1 * MiB, WS_WOUT = 19 * MiB, WS_WUP = 25 * MiB, WS_WDN = 41 * MiB, WS_WG = 57 * MiB, WS_WPJ = 61 * MiB, WS_WAT = 62 * MiB, WS_LBS = 62 * MiB + 512 * 1024;
constexpr size_t KiB64 = 65536;
constexpr size_t WS_PB = 63 * MiB, WS_HB = WS_PB + 132 * KiB64  , WS_BIG = WS_HB + 520 * KiB64  , WS_RT = WS_BIG + 2211 * KiB64  ;
constexpr size_t WS_LA = WS_RT, WS_BB = WS_RT + 16 * MiB, WS_XA = WS_RT + 32 * MiB, WS_PPB = WS_RT, WS_HB2 = WS_RT + 520 * KiB64;
constexpr size_t WS_DT = WS_RT + 1040 * KiB64  , WS_SSQ_MIX = WS_DT + 12 * KiB64, WS_SSQ_FFN = WS_SSQ_MIX + 17 * KiB64, WS_SSQ_PLE = WS_SSQ_FFN + 17 * KiB64, WS_SSDP = WS_SSQ_PLE + 17 * KiB64, WS_END = WS_SSDP + 17 * KiB64;
static_assert(WS_PB + (size_t)MP * PLE * 2 <= WS_HB && WS_HB + (size_t)MP * DM * 2 <= WS_BIG && WS_BIG + (size_t)MP * NPJ * 2 <= WS_RT && WS_XA + (size_t)MPR * 768 * 2 <= WS_DT && WS_PPB + (size_t)MP * DM * 2 <= WS_HB2 &&
              WS_HB2 + (size_t)MP * DM * 2 <= WS_DT && WS_DT + (size_t)MP * 8 * 4 <= WS_SSQ_MIX && (size_t)MP * 16 * 4 <= 17 * KiB64 && WS_END <= 313 * MiB, "ws map");
constexpr int CW_TMO = 0, CW_BAR = 4096;

constexpr int SCR_BYTES = 147456, LDSCTL_OFF = SCR_BYTES, LDS_BYTES = SCR_BYTES + 1024;

typedef float f32x2v_ __attribute__((ext_vector_type(2))); typedef __bf16 bf16x2v_ __attribute__((ext_vector_type(2)));
__device__ __forceinline__ unsigned pk2(float lo, float hi) { const f32x2v_ v = {lo, hi}; return __builtin_bit_cast(unsigned, __builtin_convertvector(v, bf16x2v_)); }
__device__ __forceinline__ bf16 f2bf(float f) { return (bf16)(pk2(f, 0.f) & 0xffffu); }
__device__ __forceinline__ float bf2f(bf16 b) { return __uint_as_float(((unsigned)b) << 16); }
__device__ __forceinline__ float bflo(unsigned w) { return __uint_as_float(w << 16); }
__device__ __forceinline__ float bfhi(unsigned w) { return __uint_as_float(w & 0xffff0000u); }
__device__ __forceinline__ float fexp(float x) { return __builtin_amdgcn_exp2f(x * 1.44269504089f); }
__device__ __forceinline__ float frcp(float x) { return __builtin_amdgcn_rcpf(x); }
__device__ __forceinline__ float fsigmoid(float x) { return frcp(1.f + fexp(-x)); }
__device__ __forceinline__ float fsilu(float x) { return x * fsigmoid(x); }
__device__ __forceinline__ float fgelu(float x) { const float u = x + 0.044715f * x * x * x; return x * frcp(1.f + fexp(-1.5957691216f * u)); }
__device__ __forceinline__ float flog(float x) { return __builtin_amdgcn_logf(x) * 0.69314718056f; }
__device__ __forceinline__ float fsoftplus(float x) {
    if (x > 20.f) return x;
    const float e = fexp(x);
    if (e < 0.05f) return e * (1.f - e * (0.5f - e * (0.33333333f - e * (0.25f - 0.2f * e))));
    return flog(1.f + e);
}
__device__ __forceinline__ float fnegexpm1(float x) {
    if (x > -0.5f && x < 0.5f) return -(x * (1.f + x * 0.5f * (1.f + x * 0.33333333f * (1.f + x * 0.25f * (1.f + x * 0.2f * (1.f + x * 0.16666667f))))));
    return 1.f - fexp(x);
}
template <int X> __device__ __forceinline__ float swz_xor(float v) { return __int_as_float(__builtin_amdgcn_ds_swizzle(__float_as_int(v), (X << 10) | 0x1f)); }
__device__ __forceinline__ float sum_halves(float v) {
    const unsigned u = __float_as_uint(v); auto r = __builtin_amdgcn_permlane32_swap(u, u, false, false); return __uint_as_float(r[0]) + __uint_as_float(r[1]); }
__device__ __forceinline__ float sum32(float v) { v += swz_xor<1>(v); v += swz_xor<2>(v); v += swz_xor<4>(v); v += swz_xor<8>(v); v += swz_xor<16>(v); return v; }
__device__ __forceinline__ float wave_sum(float v) { return sum_halves(sum32(v)); }
__device__ __forceinline__ float bperm(float v, int srclane) { return __int_as_float(__builtin_amdgcn_ds_bpermute(srclane << 2, __float_as_int(v))); }
__device__ __forceinline__ f32x16 mfma32(bf16x8 a, bf16x8 b, f32x16 c) { return __builtin_amdgcn_mfma_f32_32x32x16_bf16(a, b, c, 0, 0, 0); }
__device__ __forceinline__ int rowoff(int reg, int hf) { return (reg & 3) + 8 * (reg >> 2) + 4 * hf; }
#ifndef DBG_V
#define DBG_V 0
#endif
#if DBG_V == 3
#define WG_BARRIER() do { asm volatile("s_waitcnt vmcnt(0) lgkmcnt(0)" ::: "memory"); __syncthreads(); } while (0)
#else
#define WG_BARRIER() __syncthreads()
#endif

namespace pg8 {
constexpr int BM = 256, BK = 64, HALF = 128, HTB = HALF * BK * 2, STAGE_BYTES = 8 * HTB, NXCD = 8, WGM = 8;
__host__ __device__ __forceinline__ int lds_byte(int r, int c) { const int st = (r >> 4) * 2 + (c >> 5), rr = r & 15, cc = c & 31, ob = rr * 64 + cc * 2; return st * 1024 + (ob ^ (((ob >> 9) & 1) << 5)); }
__host__ __device__ __forceinline__ void stage_rc(int b, int& R, int& C) { const int st = b / 1024, sb = b % 1024, swz = sb ^ (((sb >> 9) & 1) << 5); R = (st >> 1) * 16 + swz / 64; C = (st & 1) * 32 + (swz % 64) / 2; }
__host__ __device__ __forceinline__ int perm32(int rho) { const int n = rho >> 4, i = rho & 15; return 8 * (i >> 2) + 4 * n + (i & 3); }
struct Unit { int pm, pn; };
struct Gemm { const GAS bf16* A; const GAS bf16* Bt; int lda, K; };
struct StaticOrder {
    int nM, nN, nwg, G, c;
    __device__ void init(int M, int N, int G_, int c_) { nM = M / BM; nN = N / BM; nwg = nM * nN; G = G_; c = c_; }
    __device__ bool next(int i, Unit& u) const {
        const long L = (long)i * G + c; if (L >= nwg) return false;
        int wgid = (int)L; { const int q = nwg / NXCD, r = nwg % NXCD, xcd = wgid % NXCD, off = wgid / NXCD; wgid = (xcd < r ? xcd * (q + 1) : r * (q + 1) + (xcd - r) * q) + off; }
        const int nig = WGM * nN, gid = wgid / nig, fm = gid * WGM, gsz = (nM - fm) < WGM ? (nM - fm) : WGM;
        u.pm = fm + ((wgid % nig) % gsz); u.pn = (wgid % nig) / gsz; return true;
    }
};
typedef f32x4 Acc[2][2][4][2];

template <class Epi, bool ALIGN_EPI>
__device__ __forceinline__ void gemm_phase(LAS unsigned char* lds, const int tid, const Gemm g, const StaticOrder& S, const Epi& E) {
    const int wid = __builtin_amdgcn_readfirstlane(tid >> 6), lane = tid & 63, wr = wid >> 2, wc = wid & 3, fr = lane & 15, fq = lane >> 4;
    const int K = g.K, nt = K / BK, lda = g.lda;
    unsigned voffA[2], voffB[2];
#pragma unroll
    for (int i = 0; i < 2; ++i) { int R, C; stage_rc(tid * 16 + i * 8192, R, C); const int Rb = Epi::PERM ? ((R & ~31) + perm32(R & 31)) : R;
        voffA[i] = (unsigned)(R * lda + C) * 2u; voffB[i] = (unsigned)(Rb * K + C) * 2u; }
    const size_t kstep = (size_t)(BK * 2);
    const size_t hA = (size_t)HALF * lda * 2, hB = (size_t)HALF * K * 2, tA = 2 * hA, tB = 2 * hB;
    const unsigned ldsw = (unsigned)wid * 1024u;
    const int aoff = lds_byte(wr * 64 + fr, fq * 8), boff = lds_byte(wc * 32 + fr, fq * 8);
#define PG8_SA(b, h) (((b) * 2 + (h)) * HTB)
#define PG8_SB(b, h) ((4 + (b) * 2 + (h)) * HTB)
#define PG8_STAGE(bufoff, gbase, voff) do { _Pragma("unroll") for (int _i = 0; _i < 2; ++_i) \
        __builtin_amdgcn_global_load_lds((const GAS unsigned*)((const GAS char*)(gbase) + (voff)[_i]), (LAS unsigned*)(lds + (bufoff) + ldsw + _i * 8192), 16, 0, 0); } while (0)
#define PG8_LDA(dst, b, h) do { _Pragma("unroll") for (int m = 0; m < 4; ++m) _Pragma("unroll") for (int k = 0; k < 2; ++k) dst[m][k] = *(const LAS bf16x8*)(lds + PG8_SA(b, h) + aoff + m * 2048 + k * 1024); } while (0)
#define PG8_LDB(dst, b, h) do { _Pragma("unroll") for (int n = 0; n < 2; ++n) _Pragma("unroll") for (int k = 0; k < 2; ++k) dst[n][k] = *(const LAS bf16x8*)(lds + PG8_SB(b, h) + boff + n * 2048 + k * 1024); } while (0)
#define PG8_MMA(ai, bj, At, Bt) do { __builtin_amdgcn_s_setprio(1); _Pragma("unroll") for (int m = 0; m < 4; ++m) _Pragma("unroll") for (int n = 0; n < 2; ++n) _Pragma("unroll") for (int k = 0; k < 2; ++k) \
        acc[ai][bj][m][n] = __builtin_amdgcn_mfma_f32_16x16x32_bf16(Bt[n][k], At[m][k], acc[ai][bj][m][n], 0, 0, 0); __builtin_amdgcn_s_setprio(0); } while (0)
#define PG8_WAIT_V(n) asm volatile("s_waitcnt vmcnt(" #n ")" ::: "memory")
#define PG8_WAIT_L(n) asm volatile("s_waitcnt lgkmcnt(" #n ")" ::: "memory")
#define PG8_BAR __builtin_amdgcn_s_barrier()
#define PG8_SCHED __builtin_amdgcn_sched_barrier(0)
    Unit cur, nxt; int ui = 0;
    if (!S.next(0, cur)) return;
    f32x4 acc[2][2][4][2];
#pragma unroll
    for (int a = 0; a < 2; ++a)
#pragma unroll
        for (int b = 0; b < 2; ++b)
#pragma unroll
            for (int m = 0; m < 4; ++m)
#pragma unroll
                for (int n = 0; n < 2; ++n) acc[a][b][m][n] = (f32x4){0.f, 0.f, 0.f, 0.f};
    bf16x8 At[4][2], B0[2][2], B1[2][2];
    const GAS char* cA = (const GAS char*)g.A + (size_t)cur.pm * tA; const GAS char* cB = (const GAS char*)g.Bt + (size_t)cur.pn * tB;
    PG8_STAGE(PG8_SB(0, 0), cB, voffB); PG8_STAGE(PG8_SB(0, 1), cB + hB, voffB); PG8_STAGE(PG8_SA(0, 0), cA, voffA); PG8_STAGE(PG8_SA(0, 1), cA + hA, voffA);
    if (wr == 1) PG8_BAR;
    PG8_WAIT_V(2); PG8_BAR;
    PG8_STAGE(PG8_SB(1, 0), cB + kstep, voffB); PG8_STAGE(PG8_SA(1, 0), cA + kstep, voffA); PG8_STAGE(PG8_SB(1, 1), cB + hB + kstep, voffB);
    PG8_WAIT_V(6); PG8_BAR;
    for (;;) {
        const bool has_next = S.next(ui + 1, nxt);
        const GAS char* nA = has_next ? (const GAS char*)g.A + (size_t)nxt.pm * tA : cA; const GAS char* nB = has_next ? (const GAS char*)g.Bt + (size_t)nxt.pn * tB : cB;
        for (int t = 0; t < nt; t += 2) {
            const bool last = (t == nt - 2);
            const GAS char* a1 = cA + (size_t)(t + 1) * kstep;
            const GAS char* a2 = last ? nA : cA + (size_t)(t + 2) * kstep; const GAS char* b2 = last ? nB : cB + (size_t)(t + 2) * kstep;
            const GAS char* a3 = a2 + kstep; const GAS char* b3 = b2 + kstep;
            if constexpr (Epi::MIDK > 0) { if (t == Epi::MIDK) E.mid(acc, cur, wr, wc, fr, fq); }
            PG8_LDB(B0, 0, 0); PG8_LDB(B1, 0, 1); PG8_SCHED; PG8_LDA(At, 0, 0); PG8_STAGE(PG8_SA(1, 1), a1 + hA, voffA);
            PG8_WAIT_V(8); PG8_WAIT_L(0); PG8_BAR; PG8_MMA(0, 0, At, B0); PG8_MMA(0, 1, At, B1); PG8_BAR; PG8_SCHED;
            PG8_LDA(At, 0, 1); PG8_STAGE(PG8_SB(0, 0), b2, voffB); PG8_STAGE(PG8_SB(0, 1), b2 + hB, voffB); PG8_STAGE(PG8_SA(0, 0), a2, voffA);
            PG8_WAIT_V(8); PG8_WAIT_L(0); PG8_BAR; PG8_MMA(1, 0, At, B0); PG8_MMA(1, 1, At, B1); PG8_BAR; PG8_SCHED;
            PG8_LDB(B0, 1, 0); PG8_LDB(B1, 1, 1); PG8_SCHED; PG8_LDA(At, 1, 0); PG8_STAGE(PG8_SA(0, 1), a2 + hA, voffA);
            PG8_WAIT_V(8); PG8_WAIT_L(0); PG8_BAR; PG8_MMA(0, 0, At, B0); PG8_MMA(0, 1, At, B1); PG8_BAR; PG8_SCHED;
            PG8_LDA(At, 1, 1); PG8_STAGE(PG8_SB(1, 0), b3, voffB); PG8_STAGE(PG8_SB(1, 1), b3 + hB, voffB); PG8_STAGE(PG8_SA(1, 0), a3, voffA);
            PG8_WAIT_V(8); PG8_WAIT_L(0); PG8_BAR; PG8_MMA(1, 0, At, B0); PG8_MMA(1, 1, At, B1); PG8_BAR; PG8_SCHED;
        }
        if constexpr (ALIGN_EPI) { if (wr == 0) PG8_BAR; }
        E(acc, cur, wr, wc, fr, fq);
        if (!has_next) break;
#pragma unroll
        for (int a = 0; a < 2; ++a)
#pragma unroll
            for (int b = 0; b < 2; ++b)
#pragma unroll
                for (int m = 0; m < 4; ++m)
#pragma unroll
                    for (int n = 0; n < 2; ++n) acc[a][b][m][n] = (f32x4){0.f, 0.f, 0.f, 0.f};
        cur = nxt; cA = nA; cB = nB; ++ui;
        if constexpr (ALIGN_EPI) { if (wr == 1) PG8_BAR; }
    }
    PG8_WAIT_V(0);
    if constexpr (!ALIGN_EPI) { if (wr == 0) PG8_BAR; }
    PG8_BAR;
#undef PG8_SA
#undef PG8_SB
#undef PG8_STAGE
#undef PG8_LDA
#undef PG8_LDB
#undef PG8_MMA
#undef PG8_WAIT_V
#undef PG8_WAIT_L
#undef PG8_BAR
#undef PG8_SCHED
}
}
using pg8::Unit; using pg8::Acc; using pg8::BM; using pg8::HALF;

__device__ __forceinline__ float rstd16(const GAS float* ssq, int row) {
    const GAS f32x4* p = (const GAS f32x4*)(ssq + (size_t)row * 16); const f32x4 a = p[0], b = p[1], c = p[2], d = p[3];
    const float s = ((a[0] + a[1]) + (a[2] + a[3])) + ((b[0] + b[1]) + (b[2] + b[3])) + ((c[0] + c[1]) + (c[2] + c[3])) + ((d[0] + d[1]) + (d[2] + d[3]));
    return __builtin_amdgcn_rsqf(s * (1.f / DM) + EPS);
}
template <int MODE> __device__ __forceinline__ float act1(float v, float lb) {
    if (MODE == 1) return fsilu(v);
    if (MODE == 2) return fgelu(v);
    if (MODE == 3) { const float g = lb + (1.f - lb) * fsigmoid(v); return fmaxf(flog(g), -30.f); }
    return v;
}
struct EpiProj {
    static constexpr bool PERM = true; static constexpr int MIDK = 0;
    GAS bf16* P; GAS float* DT; const GAS float* ssq; const GAS float* lbs;
    __device__ __forceinline__ void mid(Acc&, const Unit&, int, int, int, int) const {}
    template <int MODE> __device__ __forceinline__ void body(const Acc& acc, const Unit& u, int wr, int wc, int fr, int fq) const {
        const int row0 = u.pm * BM + wr * 64 + fr, col0 = u.pn * BM + wc * 32 + 8 * fq;
        f32x4 lb[2][2];
#pragma unroll
        for (int bj = 0; bj < 2; ++bj)
#pragma unroll
            for (int n = 0; n < 2; ++n) lb[bj][n] = (MODE == 3) ? *(const GAS f32x4*)(lbs + (col0 - PC_CF) + bj * HALF + 4 * n) : (f32x4){0.f, 0.f, 0.f, 0.f};
#pragma unroll
        for (int ai = 0; ai < 2; ++ai)
#pragma unroll
            for (int m = 0; m < 4; ++m) { const int row = row0 + ai * HALF + m * 16; const float rs = rstd16(ssq, row); GAS bf16* rowp = P + (size_t)row * NPJ + col0;
#pragma unroll
                for (int bj = 0; bj < 2; ++bj) { const f32x4 v0 = acc[ai][bj][m][0] * rs, v1 = acc[ai][bj][m][1] * rs; u32x4 w;
                    w.x = pk2(act1<MODE>(v0[0], lb[bj][0][0]), act1<MODE>(v0[1], lb[bj][0][1])); w.y = pk2(act1<MODE>(v0[2], lb[bj][0][2]), act1<MODE>(v0[3], lb[bj][0][3]));
                    w.z = pk2(act1<MODE>(v1[0], lb[bj][1][0]), act1<MODE>(v1[1], lb[bj][1][1])); w.w = pk2(act1<MODE>(v1[2], lb[bj][1][2]), act1<MODE>(v1[3], lb[bj][1][3]));
                    *(GAS u32x4*)(rowp + bj * HALF) = w; } }
    }
    __device__ __forceinline__ void operator()(const Acc& acc, const Unit& u, int wr, int wc, int fr, int fq) const {
        const int pn = u.pn;
        if (pn == 17) {
            if (wc == 0 && fq == 0) {
#pragma unroll
                for (int ai = 0; ai < 2; ++ai)
#pragma unroll
                    for (int m = 0; m < 4; ++m) { const int row = u.pm * BM + wr * 64 + fr + ai * HALF + m * 16; const float rs = rstd16(ssq, row);
                        *(GAS f32x4*)(DT + (size_t)row * 8) = acc[ai][0][m][0] * rs; *(GAS f32x4*)(DT + (size_t)row * 8 + 4) = acc[ai][0][m][1] * rs; }
            }
            return;
        }
        if (pn == 4 || pn == 5 || pn == 9 || pn == 10 || pn == 15 || pn == 16) body<1>(acc, u, wr, wc, fr, fq);
        else if (pn == 7 || pn == 8) body<2>(acc, u, wr, wc, fr, fq);
        else if (pn == 11 || pn == 12) body<3>(acc, u, wr, wc, fr, fq);
        else body<0>(acc, u, wr, wc, fr, fq);
    }
};
template <bool MID> struct EpiRes {
    static constexpr bool PERM = false; static constexpr int MIDK = MID ? 8 : 0;
    const GAS float* basep; const GAS float* bases; GAS float* hout; GAS bf16* hb; GAS float* ssq; const GAS float* ssdp;
    __device__ __forceinline__ void mid(Acc& acc, const Unit& u, int wr, int wc, int fr, int fq) const {
#pragma unroll
        for (int ai = 0; ai < 2; ++ai)
#pragma unroll
            for (int m = 0; m < 4; ++m) { const int row = u.pm * BM + wr * 64 + fr + ai * HALF + m * 16;
                const GAS f32x4* p = (const GAS f32x4*)(ssdp + (size_t)row * 16); const f32x4 a = p[0], b = p[1], c = p[2], d = p[3];
                const float s = ((a[0] + a[1]) + (a[2] + a[3])) + ((b[0] + b[1]) + (b[2] + b[3])) + ((c[0] + c[1]) + (c[2] + c[3])) + ((d[0] + d[1]) + (d[2] + d[3]));
                const float rs = __builtin_amdgcn_rsqf(s * (1.f / 512.f) + EPS);
#pragma unroll
                for (int bj = 0; bj < 2; ++bj)
#pragma unroll
                    for (int n = 0; n < 2; ++n) acc[ai][bj][m][n] = acc[ai][bj][m][n] * rs; }
    }
    __device__ __forceinline__ void operator()(const Acc& acc, const Unit& u, int wr, int wc, int fr, int fq) const {
        const int row0 = u.pm * BM + wr * 64 + fr, col0 = u.pn * BM + wc * 32 + 4 * fq;
        const GAS float* base = (u.pm < MPR / BM) ? basep : bases;
#pragma unroll
        for (int ai = 0; ai < 2; ++ai)
#pragma unroll
            for (int m = 0; m < 4; ++m) { const int row = row0 + ai * HALF + m * 16; const size_t off = (size_t)row * DM + col0; float ss = 0.f;
                if (row < MREAL) {
#pragma unroll
                    for (int bj = 0; bj < 2; ++bj)
#pragma unroll
                        for (int n = 0; n < 2; ++n) { const f32x4 v = *(const GAS f32x4*)(base + off + bj * HALF + n * 16) + acc[ai][bj][m][n];
                            *(GAS f32x4*)(hout + off + bj * HALF + n * 16) = v; u32x2 w; w.x = pk2(v[0], v[1]); w.y = pk2(v[2], v[3]); *(GAS u32x2*)(hb + off + bj * HALF + n * 16) = w;
                            ss += (v[0] * v[0] + v[1] * v[1]) + (v[2] * v[2] + v[3] * v[3]); }
                }
                ss += swz_xor<16>(ss); ss = sum_halves(ss);
                if (fq == 0) ssq[(size_t)row * 16 + u.pn * 4 + wc] = ss;
                asm volatile("" ::: "memory"); }
    }
};
struct EpiDbg {
    static constexpr bool PERM = false; static constexpr int MIDK = 8;
    const GAS float* basep; GAS float* hout; const GAS float* ssdp;
    __device__ __forceinline__ void mid(Acc& acc, const Unit& u, int wr, int wc, int fr, int fq) const {
#pragma unroll
        for (int ai = 0; ai < 2; ++ai)
#pragma unroll
            for (int m = 0; m < 4; ++m) { const int row = u.pm * BM + wr * 64 + fr + ai * HALF + m * 16;
                const GAS f32x4* p = (const GAS f32x4*)(ssdp + (size_t)row * 16); const f32x4 a = p[0], b = p[1], c = p[2], d = p[3];
                const float s = ((a[0] + a[1]) + (a[2] + a[3])) + ((b[0] + b[1]) + (b[2] + b[3])) + ((c[0] + c[1]) + (c[2] + c[3])) + ((d[0] + d[1]) + (d[2] + d[3]));
                const float rs = __builtin_amdgcn_rsqf(s * (1.f / 512.f) + EPS);
#pragma unroll
                for (int bj = 0; bj < 2; ++bj)
#pragma unroll
                    for (int n = 0; n < 2; ++n) acc[ai][bj][m][n] = acc[ai][bj][m][n] * rs; }
    }
    __device__ __forceinline__ void operator()(const Acc& acc, const Unit& u, int wr, int wc, int fr, int fq) const {
        const int row0 = u.pm * BM + wr * 64 + fr, col0 = u.pn * BM + wc * 32 + 4 * fq;
#pragma unroll
        for (int ai = 0; ai < 2; ++ai)
#pragma unroll
            for (int m = 0; m < 4; ++m) { const int row = row0 + ai * HALF + m * 16; const size_t off = (size_t)row * DM + col0;
#pragma unroll
                for (int bj = 0; bj < 2; ++bj)
#pragma unroll
                    for (int n = 0; n < 2; ++n) { const f32x4 v = *(const GAS f32x4*)(basep + off + bj * HALF + n * 16) + acc[ai][bj][m][n]; *(GAS f32x4*)(hout + off + bj * HALF + n * 16) = v; }
                asm volatile("" ::: "memory"); }
    }
};
struct EpiUp {
    static constexpr bool PERM = true; static constexpr int MIDK = 0;
    GAS bf16* Z; const GAS float* ssq;
    __device__ __forceinline__ void mid(Acc&, const Unit&, int, int, int, int) const {}
    __device__ __forceinline__ void operator()(const Acc& acc, const Unit& u, int wr, int wc, int fr, int fq) const {
        const int row0 = u.pm * BM + wr * 64 + fr, col0 = u.pn * BM + wc * 32 + 8 * fq;
#pragma unroll
        for (int ai = 0; ai < 2; ++ai)
#pragma unroll
            for (int m = 0; m < 4; ++m) { const int row = row0 + ai * HALF + m * 16; const float rs = rstd16(ssq, row); GAS bf16* rowp = Z + (size_t)row * DFF + col0;
#pragma unroll
                for (int bj = 0; bj < 2; ++bj) { f32x4 v0 = acc[ai][bj][m][0] * rs, v1 = acc[ai][bj][m][1] * rs;
#pragma unroll
                    for (int i = 0; i < 4; ++i) { const float a = fmaxf(v0[i], 0.f), b = fmaxf(v1[i], 0.f); v0[i] = a * a; v1[i] = b * b; }
                    u32x4 w; w.x = pk2(v0[0], v0[1]); w.y = pk2(v0[2], v0[3]); w.z = pk2(v1[0], v1[1]); w.w = pk2(v1[2], v1[3]); *(GAS u32x4*)(rowp + bj * HALF) = w; } }
    }
};
struct EpiPP {
    static constexpr bool PERM = false; static constexpr int MIDK = 0;
    GAS bf16* PPB;
    __device__ __forceinline__ void mid(Acc&, const Unit&, int, int, int, int) const {}
    __device__ __forceinline__ void operator()(const Acc& acc, const Unit& u, int wr, int wc, int fr, int fq) const {
        const int row0 = u.pm * BM + wr * 64 + fr, col0 = u.pn * BM + wc * 32 + 4 * fq;
#pragma unroll
        for (int ai = 0; ai < 2; ++ai)
#pragma unroll
            for (int m = 0; m < 4; ++m) { const size_t off = (size_t)(row0 + ai * HALF + m * 16) * DM + col0;
#pragma unroll
                for (int bj = 0; bj < 2; ++bj)
#pragma unroll
                    for (int n = 0; n < 2; ++n) { const f32x4 v = acc[ai][bj][m][n]; u32x2 w; w.x = pk2(v[0], v[1]); w.y = pk2(v[2], v[3]); *(GAS u32x2*)(PPB + off + bj * HALF + n * 16) = w; } }
    }
};
struct EpiGate {
    static constexpr bool PERM = false; static constexpr int MIDK = 0;
    GAS float* h; GAS bf16* hb; const GAS bf16* PPB; const GAS float* ssq_in; GAS float* ssq_out;
    __device__ __forceinline__ void mid(Acc&, const Unit&, int, int, int, int) const {}
    __device__ __forceinline__ void operator()(const Acc& acc, const Unit& u, int wr, int wc, int fr, int fq) const {
        const int row0 = u.pm * BM + wr * 64 + fr, col0 = u.pn * BM + wc * 32 + 4 * fq;
#pragma unroll
        for (int ai = 0; ai < 2; ++ai)
#pragma unroll
            for (int m = 0; m < 4; ++m) { const int row = row0 + ai * HALF + m * 16; const size_t off = (size_t)row * DM + col0; float ss = 0.f;
                if (row < MREAL) { const float rs = rstd16(ssq_in, row);
#pragma unroll
                    for (int bj = 0; bj < 2; ++bj)
#pragma unroll
                        for (int n = 0; n < 2; ++n) { const f32x4 a = acc[ai][bj][m][n] * rs; const u32x2 pw = *(const GAS u32x2*)(PPB + off + bj * HALF + n * 16);
                            f32x4 v = *(const GAS f32x4*)(h + off + bj * HALF + n * 16);
                            v[0] += fsigmoid(a[0]) * bflo(pw.x); v[1] += fsigmoid(a[1]) * bfhi(pw.x); v[2] += fsigmoid(a[2]) * bflo(pw.y); v[3] += fsigmoid(a[3]) * bfhi(pw.y);
                            *(GAS f32x4*)(h + off + bj * HALF + n * 16) = v; u32x2 w; w.x = pk2(v[0], v[1]); w.y = pk2(v[2], v[3]); *(GAS u32x2*)(hb + off + bj * HALF + n * 16) = w;
                            ss += (v[0] * v[0] + v[1] * v[1]) + (v[2] * v[2] + v[3] * v[3]); }
                }
                ss += swz_xor<16>(ss); ss = sum_halves(ss);
                if (fq == 0) ssq_out[(size_t)row * 16 + u.pn * 4 + wc] = ss;
                asm volatile("" ::: "memory"); }
    }
};

#define RLX_AGENT __ATOMIC_RELAXED, __HIP_MEMORY_SCOPE_AGENT
#define XB_TMO      128
#define XB_XCNT(j)  (256  + 64 * (j))
#define XB_XSUB(j)  (1280 + 64 * (j))
#define XB_XGEN(j)  (2304 + 64 * (j))
#define XB_TOP      3328
#define XB_TOPGEN   3392
#define XCD_BAR_WORDS 3456
#define XB_SPIN_CAP (1u << 20)
__device__ __forceinline__ unsigned xb_ld(GAS unsigned* p)              { return __hip_atomic_load(p, __ATOMIC_RELAXED, __HIP_MEMORY_SCOPE_AGENT); }
__device__ __forceinline__ unsigned xb_add(GAS unsigned* p, unsigned v) { return __hip_atomic_fetch_add(p, v, __ATOMIC_RELAXED, __HIP_MEMORY_SCOPE_AGENT); }
__device__ __forceinline__ unsigned xb_xcc_id() { return (unsigned)__builtin_amdgcn_s_getreg((3 << 11) | 20) & 0xFu; }
#define XB_SPIN(cond, bar) do { unsigned _sp = 0; while (cond) { __builtin_amdgcn_s_sleep(1); \
    if ((++_sp & 255u) == 0u) { if (xb_ld(&(bar)[XB_TMO])) break; if (_sp > XB_SPIN_CAP) { (void)xb_add(&(bar)[XB_TMO], 1u); break; } } } } while (0)
struct XcdBarrier { GAS unsigned* bar; unsigned x; volatile LAS unsigned* st; };
__device__ __forceinline__ XcdBarrier xcd_barrier_post(GAS unsigned* bar, volatile LAS unsigned* st) {
    XcdBarrier b; b.bar = bar; b.x = xb_xcc_id(); b.st = st;
    if (threadIdx.x == 0) (void)xb_add(&bar[XB_XCNT(b.x)], 1u);
    return b;
}
__device__ __forceinline__ void xcd_barrier_complete(GAS unsigned* bar, unsigned x, unsigned& nloc, unsigned& nx) {
    const unsigned G = gridDim.x * gridDim.y * gridDim.z;
    unsigned sum, cnt, mine, sp = 0u;
    for (;;) {
        sum = 0u; cnt = 0u; mine = 0u;
#pragma unroll
        for (unsigned j = 0; j < 16; ++j) { const unsigned c = xb_ld(&bar[XB_XCNT(j)]); sum += c; cnt += (c > 0u) ? 1u : 0u; mine = (j == x) ? c : mine; }
        if (sum == G) break;
        __builtin_amdgcn_s_sleep(1);
        if ((++sp & 255u) == 0u) { if (xb_ld(&bar[XB_TMO])) break; if (sp > XB_SPIN_CAP) { (void)xb_add(&bar[XB_TMO], 1u); break; } }
    }
    nloc = mine > 0u ? mine : 1u; nx = cnt > 0u ? cnt : 1u;
}
__device__ __forceinline__ void xcd_barrier(const XcdBarrier& b, const int tid) {
    asm volatile("s_waitcnt vmcnt(0)" ::: "memory");
    __syncthreads();
    if (tid == 0) {
        GAS unsigned* bar = b.bar;
        __builtin_amdgcn_s_waitcnt(0);
        unsigned nloc = b.st[0], nx = b.st[1];
        if (nloc == 0u) { xcd_barrier_complete(bar, b.x, nloc, nx); b.st[0] = nloc; b.st[1] = nx; }
        const unsigned old = xb_add(&bar[XB_XSUB(b.x)], 1u);
        const unsigned gen = old / nloc;
        if (old + 1u == (gen + 1u) * nloc) {
            __builtin_amdgcn_fence(__ATOMIC_RELEASE, "agent");
            asm volatile("s_waitcnt vmcnt(0)" ::: "memory");
            const unsigned og = xb_add(&bar[XB_TOP], 1u);
            const unsigned tg = og / nx;
            if (og + 1u == (tg + 1u) * nx) xb_add(&bar[XB_TOPGEN], 1u);
            else XB_SPIN(xb_ld(&bar[XB_TOPGEN]) == tg, bar);
            __builtin_amdgcn_fence(__ATOMIC_ACQUIRE, "agent");
            xb_add(&bar[XB_XGEN(b.x)], 1u);
            asm volatile("s_waitcnt vmcnt(0)" ::: "memory");
        } else {
            XB_SPIN(xb_ld(&bar[XB_XGEN(b.x)]) == gen, bar);
            __builtin_amdgcn_fence(__ATOMIC_ACQUIRE, "agent");
            asm volatile("s_waitcnt vmcnt(0)" ::: "memory");
        }
    }
    __syncthreads();
}

struct Frame {
    LAS unsigned char* lds;
    int tid, lane, wave, G, bx;
    const LAS unsigned long long* intab;
    struct InAcc { const LAS unsigned long long* t; __device__ __forceinline__ const GAS float* operator[](int i) const { const unsigned long long v = t[i];
        const unsigned lo = __builtin_amdgcn_readfirstlane((unsigned)v), hi = __builtin_amdgcn_readfirstlane((unsigned)(v >> 32)); return (const GAS float*)(((unsigned long long)hi << 32) | lo); } } in;
    GAS float* out; GAS unsigned char* ws;
#define FPTR(name, type, off) __device__ __forceinline__ GAS type* name() const { return (GAS type*)(ws + (off)); }
    FPTR(BIG, bf16, WS_BIG) FPTR(HB, bf16, WS_HB) FPTR(HB2, bf16, WS_HB2) FPTR(PB, bf16, WS_PB) FPTR(LA, bf16, WS_LA) FPTR(BB, bf16, WS_BB) FPTR(XA, bf16, WS_XA) FPTR(PPB, bf16, WS_PPB)
    FPTR(DT, float, WS_DT) FPTR(SSQ_MIX, float, WS_SSQ_MIX) FPTR(SSQ_FFN, float, WS_SSQ_FFN) FPTR(SSQ_PLE, float, WS_SSQ_PLE) FPTR(SSDP, float, WS_SSDP) FPTR(LBS, float, WS_LBS) FPTR(WAT, bf16, WS_WAT)
#undef FPTR
};
__device__ __forceinline__ GAS bf16* w_in_t(GAS unsigned char* ws, int l) { return (GAS bf16*)(ws + WS_WIN) + (size_t)l * NPJP * DM; }
__device__ __forceinline__ GAS bf16* w_out_t(GAS unsigned char* ws, int l) { return (GAS bf16*)(ws + WS_WOUT) + (size_t)l * DM * DMIX; }
__device__ __forceinline__ GAS bf16* w_up_t(GAS unsigned char* ws, int l) { return (GAS bf16*)(ws + WS_WUP) + (size_t)l * DFF * DM; }
__device__ __forceinline__ GAS bf16* w_dn_t(GAS unsigned char* ws, int l) { return (GAS bf16*)(ws + WS_WDN) + (size_t)l * DM * DFF; }
__device__ __forceinline__ GAS bf16* w_g_t(GAS unsigned char* ws, int l) { return (GAS bf16*)(ws + WS_WG) + (size_t)l * DM * DM; }
__device__ __forceinline__ GAS bf16* w_pj_t(GAS unsigned char* ws, int l) { return (GAS bf16*)(ws + WS_WPJ) + (size_t)l * DM * PLE; }

__device__ __forceinline__ int win_src(int n0) {
    if (n0 < 512) return 1536 + n0;
    if (n0 < 1024) return n0 - 512;
    if (n0 < 1536) return 2312 + (n0 - 1024);
    if (n0 < 1792) return 2048 + (n0 - 1536);
    if (n0 < 2304) return 512 + (n0 - 1792);
    if (n0 < 2816) return 1024 + (n0 - 2304);
    if (n0 < 3328) return 2824 + (n0 - 2816);
    if (n0 < 3840) return 3336 + (n0 - 3328);
    if (n0 < 4352) return 3848 + (n0 - 3840);
    return 2304 + (n0 - 4352);
}
__device__ __forceinline__ void p0_item(const GAS float* W, int ldw, GAS bf16* WT, int K, int N, int mode, const GAS float* ks, LAS float* scr, int item, int lane) {
    const int nblk = N / 32, kb = item / nblk, nb = item % nblk, k0 = 64 * kb, n0 = 32 * nb;
    int sn0 = n0, nvalid = 32;
    if (mode == 1) { sn0 = win_src(n0); if (n0 >= NPJ) nvalid = (n0 == NPJ) ? 8 : 0; }
#pragma unroll 8
    for (int i = 0; i < 32; ++i) { const int kk = 2 * i + (lane >> 5), k = k0 + kk; int sk = k; float sc = 1.f;
        if (mode == 2) { sk = (k < 512) ? 512 + k : (k < 1024 ? k - 512 : k); if (k < 512) sc = ks[k]; } else if (ks) sc = ks[k];
        float v = 0.f; if ((lane & 31) < nvalid) v = W[(size_t)sk * ldw + sn0 + (lane & 31)];
        scr[kk * 33 + (lane & 31)] = v * sc; }
    asm volatile("s_waitcnt lgkmcnt(0)" ::: "memory");
    const int c = lane & 7;
#pragma unroll
    for (int j = 0; j < 4; ++j) { const int n = (lane >> 3) + 8 * j; const LAS float* s = scr + (8 * c) * 33 + n;
        u32x4 o; o.x = pk2(s[0 * 33], s[1 * 33]); o.y = pk2(s[2 * 33], s[3 * 33]); o.z = pk2(s[4 * 33], s[5 * 33]); o.w = pk2(s[6 * 33], s[7 * 33]);
        *(GAS u32x4*)(WT + (size_t)(n0 + n) * K + k0 + 8 * c) = o; }
    asm volatile("s_waitcnt lgkmcnt(0)" ::: "memory");
}
__device__ __forceinline__ void p0_prologue(Frame& F) {
    LAS float* scr = (LAS float*)(F.lds + F.wave * 16384);
    const int gw = F.bx * 8 + F.wave, NGW = F.G * 8;
    constexpr int I_IN = (DM / 64) * (NPJP / 32), I_OUT = (DMIX / 64) * (DM / 32), I_UP = (DM / 64) * (DFF / 32), I_DN = (DFF / 64) * (DM / 32), I_G = (DM / 64) * (DM / 32), I_PJ = (PLE / 64) * (DM / 32);
    constexpr int PER_L = I_IN + I_OUT + I_UP + I_DN + I_G + I_PJ;
    for (int it = gw; it < NL * PER_L; it += NGW) {
        const int l = it / PER_L; int r = it % PER_L;
        if (r < I_IN) { p0_item(F.in[I_WIN] + (size_t)l * DM * DIN, DIN, w_in_t(F.ws, l), DM, NPJP, 1, F.in[I_NMIX] + l * DM, scr, r, F.lane); continue; } r -= I_IN;
        if (r < I_OUT) { p0_item(F.in[I_WOUT] + (size_t)l * DMIX * DM, DM, w_out_t(F.ws, l), DMIX, DM, 2, F.in[I_SNORM] + l * 512, scr, r, F.lane); continue; } r -= I_OUT;
        if (r < I_UP) { p0_item(F.in[I_WUP] + (size_t)l * DM * DFF, DFF, w_up_t(F.ws, l), DM, DFF, 0, F.in[I_NFFN] + l * DM, scr, r, F.lane); continue; } r -= I_UP;
        if (r < I_DN) { p0_item(F.in[I_WDN] + (size_t)l * DFF * DM, DM, w_dn_t(F.ws, l), DFF, DM, 0, nullptr, scr, r, F.lane); continue; } r -= I_DN;
        if (r < I_G) { p0_item(F.in[I_WG] + (size_t)l * DM * DM, DM, w_g_t(F.ws, l), DM, DM, 0, F.in[I_NPLE] + l * DM, scr, r, F.lane); continue; } r -= I_G;
        p0_item(F.in[I_WPJ] + (size_t)l * PLE * DM, DM, w_pj_t(F.ws, l), PLE, DM, 0, nullptr, scr, r, F.lane);
    }
    for (int m = gw; m < MREAL; m += NGW) {
        const GAS float* xr = (m < MPR) ? F.in[I_XP] + (size_t)m * DM : F.in[I_XS] + (size_t)(m - MPR) * DM;
        f32x4 v[4]; float s = 0.f;
#pragma unroll
        for (int j = 0; j < 4; ++j) { v[j] = ((const GAS f32x4*)xr)[F.lane + 64 * j]; s += (v[j][0] * v[j][0] + v[j][1] * v[j][1]) + (v[j][2] * v[j][2] + v[j][3] * v[j][3]); }
        s = wave_sum(s);
#pragma unroll
        for (int j = 0; j < 4; ++j) { u32x2 w; w.x = pk2(v[j][0], v[j][1]); w.y = pk2(v[j][2], v[j][3]); ((GAS u32x2*)(F.HB() + (size_t)m * DM))[F.lane + 64 * j] = w; }
        if (F.lane < 16) F.SSQ_MIX()[(size_t)m * 16 + F.lane] = (F.lane == 0) ? s : 0.f;
    }
    const int gt = F.bx * 512 + F.tid, NGT = F.G * 512;
    for (int e = gt; e < NL * 2 * 8 * 64 * 64; e += NGT) { const int i = e & 63, j = (e >> 6) & 63, h = (e >> 12) & 7, g = (e >> 15) & 1, l = e >> 16;
        F.WAT()[e] = f2bf(F.in[g ? I_WX : I_WA][(((size_t)l * 8 + h) * 64 + i) * 64 + j]); }
    for (int e = gt; e < NL * 512; e += NGT) { const int l = e / 512, c = e % 512;
        float mx = -1e30f; for (int q = 0; q < NL; ++q) mx = fmaxf(mx, F.in[I_HLB][q * 512 + c]);
        float den = 0.f, cs = 0.f, c0 = 0.f; for (int q = 0; q < NL; ++q) den += __expf(F.in[I_HLB][q * 512 + c] - mx);
        for (int q = 0; q <= l; ++q) { const float p = __expf(F.in[I_HLB][q * 512 + c] - mx) / den; cs += p; if (q == 0) c0 = p; }
        F.LBS()[e] = cs - c0; }
}

__device__ __forceinline__ void p2a_rg_item(Frame& F, int l, int item) {
    const int tt = item >> 3, h = item & 7, row0 = tt * 32, lane = F.lane, r = lane & 31, hf = lane >> 5;
    LAS float* xt = (LAS float*)(F.lds + F.wave * 8704);
    const int gc = 64 * h + lane;
    const GAS float* cw = F.in[I_CAW] + l * 4 * 512; const float w0 = cw[gc], w1 = cw[512 + gc], w2 = cw[1024 + gc], w3 = cw[1536 + gc], cb = F.in[I_CAB][l * 512 + gc];
    const GAS bf16* ax = F.BIG() + (size_t)row0 * NPJ + PC_AX + gc;
    const bool first = (row0 % SEQ) == 0;
    float p3 = 0.f, p2 = 0.f, p1 = 0.f;
    if (!first) { p3 = bf2f(ax[-3 * NPJ]); p2 = bf2f(ax[-2 * NPJ]); p1 = bf2f(ax[-1 * NPJ]); }
#pragma unroll 8
    for (int t = 0; t < 32; ++t) { const float cur = bf2f(ax[(size_t)t * NPJ]); xt[t * 68 + lane] = w0 * p3 + w1 * p2 + w2 * p1 + w3 * cur + cb; p3 = p2; p2 = p1; p1 = cur; }
    if ((row0 + 32) % SEQ == 0) { const int b = row0 / SEQ; GAS float* o = F.out + O_RCP + ((size_t)(l * 8 + b) * 3) * 512 + gc; o[0] = p3; o[512] = p2; o[1024] = p1; }
    bf16x8 af[4];
#pragma unroll
    for (int s = 0; s < 4; ++s) { const f32x4 a = *(const LAS f32x4*)(xt + r * 68 + 16 * s + 8 * hf), b = *(const LAS f32x4*)(xt + r * 68 + 16 * s + 8 * hf + 4);
        u32x4 w; w.x = pk2(a[0], a[1]); w.y = pk2(a[2], a[3]); w.z = pk2(b[0], b[1]); w.w = pk2(b[2], b[3]); af[s] = __builtin_bit_cast(bf16x8, w); }
#pragma unroll
    for (int jb = 0; jb < 2; ++jb) {
        f32x16 ar, ai;
#pragma unroll
        for (int q = 0; q < 16; ++q) { ar[q] = 0.f; ai[q] = 0.f; }
        const GAS bf16* wr_ = F.WAT() + ((((size_t)l * 2 + 0) * 8 + h) * 64 + 32 * jb + r) * 64 + 8 * hf;
        const GAS bf16* wi_ = F.WAT() + ((((size_t)l * 2 + 1) * 8 + h) * 64 + 32 * jb + r) * 64 + 8 * hf;
#pragma unroll
        for (int s = 0; s < 4; ++s) { const bf16x8 br = *(const GAS bf16x8*)(wr_ + 16 * s), bi = *(const GAS bf16x8*)(wi_ + 16 * s); ar = mfma32(af[s], br, ar); ai = mfma32(af[s], bi, ai); }
        const int j = 32 * jb + r, gj = 64 * h + j;
        const float ba = F.in[I_BA][l * 512 + gj], bx = F.in[I_BX][l * 512 + gj], c8 = -8.f * fsoftplus(-F.in[I_LAM][l * 512 + gj]);
#pragma unroll
        for (int q = 0; q < 16; ++q) { const int t = rowoff(q, hf); const float rr = fsigmoid(ar[q] + ba), ii = fsigmoid(ai[q] + bx), la = c8 * rr;
            float mult = __builtin_amdgcn_sqrtf(fmaxf(fnegexpm1(2.f * la), 0.f)); if (((row0 + t) % SEQ) == 0) mult = 1.f;
            const float bv = mult * ii * xt[t * 68 + j]; const size_t o = (size_t)(row0 + t) * 512 + gj; F.LA()[o] = f2bf(la); F.BB()[o] = f2bf(bv); }
    }
}
__device__ __forceinline__ void p2a_conv_item(Frame& F, int l, int item) {
    const int tt = item / 3, g = item % 3, row0 = tt * 32, ch = 256 * g + 4 * F.lane, col = ch < 512 ? PC_XS + ch : PC_B + (ch - 512);
    const GAS float* cw = F.in[I_CBW] + l * 4 * 768 + ch; const f32x4 w0 = *(const GAS f32x4*)cw, w1 = *(const GAS f32x4*)(cw + 768), w2 = *(const GAS f32x4*)(cw + 1536), w3 = *(const GAS f32x4*)(cw + 2304), cb = *(const GAS f32x4*)(F.in[I_CBB] + l * 768 + ch);
    const GAS bf16* src = F.BIG() + (size_t)row0 * NPJ + col;
    const bool first = (row0 % SEQ) == 0;
    f32x4 p3 = {0.f, 0.f, 0.f, 0.f}, p2 = p3, p1 = p3;
    auto ld4 = [](const GAS bf16* p) { const u32x2 w = *(const GAS u32x2*)p; return (f32x4){bflo(w.x), bfhi(w.x), bflo(w.y), bfhi(w.y)}; };
    if (!first) { p3 = ld4(src - 3 * NPJ); p2 = ld4(src - 2 * NPJ); p1 = ld4(src - NPJ); }
#pragma unroll 4
    for (int t = 0; t < 32; ++t) { const f32x4 cur = ld4(src + (size_t)t * NPJ); const f32x4 y = w0 * p3 + w1 * p2 + w2 * p1 + w3 * cur + cb;
        u32x2 w; w.x = pk2(fsilu(y[0]), fsilu(y[1])); w.y = pk2(fsilu(y[2]), fsilu(y[3])); *(GAS u32x2*)(F.XA() + (size_t)(row0 + t) * 768 + ch) = w; p3 = p2; p2 = p1; p1 = cur; }
    if ((row0 + 32) % SEQ == 0) { const int b = row0 / SEQ; GAS float* o = F.out + O_SCP + ((size_t)(l * 8 + b) * 3) * 768 + ch; *(GAS f32x4*)o = p3; *(GAS f32x4*)(o + 768) = p2; *(GAS f32x4*)(o + 1536) = p1; }
}
__device__ __forceinline__ void p2a_pb_item(Frame& F, int l, int item) {
#pragma unroll
    for (int rr = 0; rr < 8; ++rr) { const int row = 8 * item + rr;
        if (row < MREAL) { const GAS float* s = (row < MPR) ? F.in[I_PP] + ((size_t)l * MPR + row) * PLE : F.in[I_PS] + ((size_t)l * MSM + row - MPR) * PLE;
            const f32x4 v = ((const GAS f32x4*)s)[F.lane]; u32x2 w; w.x = pk2(v[0], v[1]); w.y = pk2(v[2], v[3]); ((GAS u32x2*)(F.PB() + (size_t)row * PLE))[F.lane] = w; } }
}
__device__ __forceinline__ void p2a_phase(Frame& F, int l) {
    const int gw = F.bx * 8 + F.wave, NGW = F.G * 8;
    constexpr int N_RG = (MPR / 32) * 8, N_CV = (MPR / 32) * 3, N_PB = MP / 8;
#pragma nounroll
    for (int it = gw; it < N_RG + N_CV + N_PB; it += NGW) {
        if (it < N_RG) p2a_rg_item(F, l, it);
        else if (it < N_RG + N_CV) p2a_conv_item(F, l, it - N_RG);
        else p2a_pb_item(F, l, it - N_RG - N_CV);
    }
}

__device__ __forceinline__ void rg_scan_role(Frame& F, int l, int rid) {
    const int b = rid >> 3, h = rid & 7, lane = F.lane, w = F.wave, gj = 64 * h + lane;
    LAS float* sA = (LAS float*)F.lds; LAS float* sB = sA + 512;
    const size_t rb = (size_t)b * SEQ + 256 * w;
    const GAS bf16* la = F.LA() + rb * 512 + gj; const GAS bf16* bb = F.BB() + rb * 512 + gj;
    float A = 1.f, B = 0.f;
#pragma nounroll
    for (int t = 0; t < 256; t += 8) { float av[8], bv[8];
#pragma unroll
        for (int k = 0; k < 8; ++k) { av[k] = bf2f(la[(size_t)(t + k) * 512]); bv[k] = bf2f(bb[(size_t)(t + k) * 512]); }
#pragma unroll
        for (int k = 0; k < 8; ++k) { const float a = fexp(av[k]); B = a * B + bv[k]; A *= a; } }
    sA[w * 64 + lane] = A; sB[w * 64 + lane] = B;
    WG_BARRIER();
    float hh = 0.f;
    for (int q = 0; q < w; ++q) hh = sA[q * 64 + lane] * hh + sB[q * 64 + lane];
    GAS bf16* pr = F.BIG() + rb * NPJ;
#pragma nounroll
    for (int t = 0; t < 256; t += 8) { float av[8], bv[8], gv[8];
#pragma unroll
        for (int k = 0; k < 8; ++k) { av[k] = bf2f(la[(size_t)(t + k) * 512]); bv[k] = bf2f(bb[(size_t)(t + k) * 512]); gv[k] = bf2f(pr[(size_t)(t + k) * NPJ + PC_AG + gj]); }
#pragma unroll
        for (int k = 0; k < 8; ++k) { hh = fexp(av[k]) * hh + bv[k]; pr[(size_t)(t + k) * NPJ + PC_AX + gj] = f2bf(hh * gv[k]); } }
    if (w == 7) F.out[O_RHP + (size_t)(l * 8 + b) * 512 + gj] = hh;
    WG_BARRIER();
}

constexpr int SLD = 136;
__device__ __forceinline__ void ssd_role(Frame& F, int l, int rid) {
    const int b = rid >> 3, h = rid & 7, tid = F.tid, lane = F.lane, w = F.wave, r = lane & 31, hf = lane >> 5;
    LAS bf16* sC = (LAS bf16*)F.lds; LAS bf16* sBG = sC + 128 * SLD; LAS bf16* sBw = sBG + 128 * SLD; LAS bf16* sXT = sBw + 128 * SLD; LAS bf16* sS = sXT + 64 * SLD;
    LAS float* sCum = (LAS float*)(sS + 64 * SLD); LAS float* sDt = sCum + 128; LAS float* sW = sDt + 128; LAS float* sEc = sW + 128; LAS float* sTmp = sEc + 128;
    const float a_neg = -__expf(F.in[I_ALOG][l * 8 + h]), dtb = F.in[I_DTB][l * 8 + h], Dh = F.in[I_SSD_D][l * 8 + h];
    f32x16 accS;
#ifdef DBG_SSD2
    unsigned mism = 0;
#pragma nounroll
    for (int rep = 0; rep < 2; ++rep) {
#endif
#pragma unroll
    for (int q = 0; q < 16; ++q) accS[q] = 0.f;
    for (int e = tid; e < 64 * SLD; e += 512) sS[e] = 0;
    WG_BARRIER();
#pragma nounroll
    for (int c = 0; c < 16; ++c) {
        const size_t row0 = (size_t)b * SEQ + 128 * c;
#pragma unroll
        for (int i = 0; i < 4; ++i) { const int rr = (tid >> 4) + 32 * i, ck = tid & 15; const GAS bf16* src = F.XA() + (row0 + rr) * 768 + 512 + 8 * ck;
            *(LAS u32x4*)(sBG + rr * SLD + 8 * ck) = *(const GAS u32x4*)src; *(LAS u32x4*)(sC + rr * SLD + 8 * ck) = *(const GAS u32x4*)(src + 128); }
        if (w == 0) { const int t0 = 2 * lane; const float d0 = fsoftplus(F.DT()[(row0 + t0) * 8 + h] + dtb), d1 = fsoftplus(F.DT()[(row0 + t0 + 1) * 8 + h] + dtb);
            const float a0 = d0 * a_neg, a1 = d1 * a_neg; float s = a0 + a1;
#pragma unroll
            for (int o = 1; o < 64; o <<= 1) { const float v = bperm(s, lane - o); if (lane >= o) s += v; }
            const float c1 = s, c0 = s - a1, last = __int_as_float(__builtin_amdgcn_readlane(__float_as_int(s), 63));
            sCum[t0] = c0; sCum[t0 + 1] = c1; sEc[t0] = fexp(c0); sEc[t0 + 1] = fexp(c1); sW[t0] = fexp(last - c0) * d0; sW[t0 + 1] = fexp(last - c1) * d1; sDt[t0] = d0; sDt[t0 + 1] = d1;
            if (lane == 0) sTmp[0] = fexp(last); }
        WG_BARRIER();
        { const int s = tid & 127, pg = tid >> 7; const GAS bf16* src = F.XA() + (row0 + s) * 768;
            const u32x4 x0 = *(const GAS u32x4*)(src + 64 * h + 16 * pg), x1 = *(const GAS u32x4*)(src + 64 * h + 16 * pg + 8);
            const unsigned xw[8] = {x0.x, x0.y, x0.z, x0.w, x1.x, x1.y, x1.z, x1.w};
#pragma unroll
            for (int j = 0; j < 8; ++j) { sXT[(16 * pg + 2 * j) * SLD + s] = (bf16)(xw[j] & 0xffffu); sXT[(16 * pg + 2 * j + 1) * SLD + s] = (bf16)(xw[j] >> 16); }
            const float ws = sW[s];
#pragma unroll
            for (int q4 = 0; q4 < 4; ++q4) { const u32x4 bq = *(const GAS u32x4*)(src + 512 + 32 * pg + 8 * q4); const unsigned bw[4] = {bq.x, bq.y, bq.z, bq.w};
#pragma unroll
                for (int j = 0; j < 4; ++j) { const int n = 32 * pg + 8 * q4 + 2 * j; sBw[n * SLD + s] = f2bf(bflo(bw[j]) * ws); sBw[(n + 1) * SLD + s] = f2bf(bfhi(bw[j]) * ws); } } }
#if DBG_V == 1
        WG_BARRIER();
#endif
        f32x16 cbv[2];
#pragma unroll
        for (int q = 0; q < 2; ++q) { const int blk = 2 * w + q, tb = blk >> 2, sb = blk & 3; f32x16 a_;
#pragma unroll
            for (int z = 0; z < 16; ++z) a_[z] = 0.f;
            if (sb <= tb) {
#pragma unroll
                for (int ks = 0; ks < 8; ++ks) { const bf16x8 a = *(const LAS bf16x8*)(sC + (32 * tb + r) * SLD + 16 * ks + 8 * hf), bb = *(const LAS bf16x8*)(sBG + (32 * sb + r) * SLD + 16 * ks + 8 * hf); a_ = mfma32(a, bb, a_); } }
            cbv[q] = a_; }
        const int tby = w >> 1, pb = w & 1;
        f32x16 y;
#pragma unroll
        for (int z = 0; z < 16; ++z) y[z] = 0.f;
#pragma unroll
        for (int ks = 0; ks < 8; ++ks) { const bf16x8 a = *(const LAS bf16x8*)(sC + (32 * tby + r) * SLD + 16 * ks + 8 * hf), bs = *(const LAS bf16x8*)(sS + (32 * pb + r) * SLD + 16 * ks + 8 * hf); y = mfma32(a, bs, y); }
        WG_BARRIER();
#pragma unroll
        for (int q = 0; q < 2; ++q) { const int blk = 2 * w + q, tb = blk >> 2, sb = blk & 3;
            if (sb <= tb) { const int s_ = 32 * sb + r; const float cs = sCum[s_], ds = sDt[s_];
#pragma unroll
                for (int z = 0; z < 16; ++z) { const int t = 32 * tb + rowoff(z, hf); const float gv = (s_ <= t) ? cbv[q][z] * fexp(sCum[t] - cs) * ds : 0.f; sBG[t * SLD + s_] = f2bf(gv); } } }
#pragma unroll
        for (int z = 0; z < 16; ++z) y[z] *= sEc[32 * tby + rowoff(z, hf)];
        WG_BARRIER();
        for (int ks = 0; ks < 2 * (tby + 1); ++ks) { const bf16x8 a = *(const LAS bf16x8*)(sBG + (32 * tby + r) * SLD + 16 * ks + 8 * hf), bx = *(const LAS bf16x8*)(sXT + (32 * pb + r) * SLD + 16 * ks + 8 * hf); y = mfma32(a, bx, y); }
        { const int p = 32 * pb + r, col = 64 * h + p;
#pragma unroll
            for (int z = 0; z < 16; ++z) { const int t = 32 * tby + rowoff(z, hf); GAS bf16* pr = F.BIG() + (row0 + t) * NPJ;
                const float yv = y[z] + Dh * bf2f(sXT[p * SLD + t]); const float yg = yv * bf2f(pr[PC_BZ + col]);
#ifdef DBG_SSD2
                if (rep == 1) { if (l == 1 && pr[PC_XS + col] != f2bf(yg)) ++mism; } else
#endif
                pr[PC_XS + col] = f2bf(yg);
                const float ss = sum32(yg * yg);
                if (r == 0) F.SSDP()[(row0 + t) * 16 + 2 * h + pb] = ss; } }
#if DBG_V == 2
        WG_BARRIER();
#endif
        { const int pbs = w >> 2, nb = w & 3; const float dec = sTmp[0];
#pragma unroll
            for (int z = 0; z < 16; ++z) accS[z] *= dec;
#pragma unroll
            for (int ks = 0; ks < 8; ++ks) { const bf16x8 a = *(const LAS bf16x8*)(sXT + (32 * pbs + r) * SLD + 16 * ks + 8 * hf), bw = *(const LAS bf16x8*)(sBw + (32 * nb + r) * SLD + 16 * ks + 8 * hf); accS = mfma32(a, bw, accS); }
#pragma unroll
            for (int z = 0; z < 16; ++z) sS[(32 * pbs + rowoff(z, hf)) * SLD + 32 * nb + r] = f2bf(accS[z]); }
        WG_BARRIER();
    }
#ifdef DBG_SSD2
    }
    { const float mt = wave_sum((float)mism); if (lane == 0 && l == 1) F.out[(size_t)(16000 + rid * 8 + w) * DM] = 1000.f * mt; }
#endif
    { const int pbs = w >> 2, nb = w & 3; GAS float* o = F.out + O_SSP + ((size_t)(l * 8 + b) * 8 + h) * 64 * 128;
#pragma unroll
        for (int z = 0; z < 16; ++z) o[(32 * pbs + rowoff(z, hf)) * 128 + 32 * nb + r] = accS[z]; }
}

constexpr int HLD = 72;
__device__ __forceinline__ void hgrn_role(Frame& F, int l, int rid) {
    const int b = rid >> 3, h = rid & 7, tid = F.tid, lane = F.lane, w = F.wave, r = lane & 31, hf = lane >> 5;
    LAS bf16* sQe = (LAS bf16*)F.lds; LAS bf16* sKe = sQe + 64 * HLD; LAS bf16* sQb = sKe + 64 * HLD; LAS bf16* sKdT = sQb + 64 * HLD; LAS bf16* sVT = sKdT + 64 * HLD; LAS bf16* sAtt = sVT + 64 * HLD; LAS bf16* sST = sAtt + 64 * HLD;
    LAS float* sO = (LAS float*)(sST + 64 * HLD); LAS float* sPart = sO + 64 * 68; LAS float* sBl = sPart + 512;
    f32x16 accS;
#pragma unroll
    for (int q = 0; q < 16; ++q) accS[q] = 0.f;
    for (int e = tid; e < 64 * HLD; e += 512) sST[e] = 0;
    WG_BARRIER();
    const int d = lane, col = 64 * h + d;
#pragma nounroll
    for (int c = 0; c < 32; ++c) {
        const size_t row0 = (size_t)b * SEQ + 64 * c;
        float q[8], lf[8], v[8], bc[8];
#pragma unroll
        for (int i = 0; i < 8; ++i) { const GAS bf16* pr = F.BIG() + (row0 + 8 * w + i) * NPJ; q[i] = bf2f(pr[PC_CQ + col]); lf[i] = bf2f(pr[PC_CF + col]); v[i] = bf2f(pr[PC_CI + col]); }
        float run = 0.f;
#pragma unroll
        for (int i = 0; i < 8; ++i) { run += lf[i]; bc[i] = run; }
        sPart[w * 64 + d] = run;
        WG_BARRIER();
        float pre = 0.f, bm = 0.f, bl = 0.f;
#pragma unroll
        for (int q8 = 0; q8 < 8; ++q8) { const float pv = sPart[q8 * 64 + d]; if (q8 < w) pre += pv; if (q8 < 4) bm += pv; bl += pv; }
        unsigned kdw[4], vw[4];
#pragma unroll
        for (int i = 0; i < 8; i += 2) { float kd2[2];
#pragma unroll
            for (int u = 0; u < 2; ++u) { const int ii = i + u; const float bt = pre + bc[ii]; const float k = fnegexpm1(lf[ii]);
                const float e1 = fexp(fminf(fmaxf(bt - bm, -80.f), 80.f)), e2 = fexp(fminf(fmaxf(bm - bt, -80.f), 80.f));
                const int t = 8 * w + ii; sQe[t * HLD + d] = f2bf(q[ii] * e1); sKe[t * HLD + d] = f2bf(k * e2); sQb[t * HLD + d] = f2bf(q[ii] * fexp(bt)); kd2[u] = k * fexp(bl - bt); }
            kdw[i >> 1] = pk2(kd2[0], kd2[1]); vw[i >> 1] = pk2(v[i], v[i + 1]); }
        *(LAS u32x4*)(sKdT + d * HLD + 8 * w) = (u32x4){kdw[0], kdw[1], kdw[2], kdw[3]};
        *(LAS u32x4*)(sVT + d * HLD + 8 * w) = (u32x4){vw[0], vw[1], vw[2], vw[3]};
        if (w == 0) sBl[d] = fexp(bl);
        WG_BARRIER();
        f32x16 o;
#pragma unroll
        for (int z = 0; z < 16; ++z) o[z] = 0.f;
        const int tb = (w >> 1) & 1, eb = w & 1;
        if (w < 4) {
#pragma unroll
            for (int ks = 0; ks < 4; ++ks) { const bf16x8 a = *(const LAS bf16x8*)(sQb + (32 * tb + r) * HLD + 16 * ks + 8 * hf), bs = *(const LAS bf16x8*)(sST + (32 * eb + r) * HLD + 16 * ks + 8 * hf); o = mfma32(a, bs, o); }
        } else if (w < 7) { const int blk = w - 4, tba = blk == 0 ? 0 : 1, sba = blk == 2 ? 1 : 0;
#pragma unroll
            for (int ks = 0; ks < 4; ++ks) { const bf16x8 a = *(const LAS bf16x8*)(sQe + (32 * tba + r) * HLD + 16 * ks + 8 * hf), bk = *(const LAS bf16x8*)(sKe + (32 * sba + r) * HLD + 16 * ks + 8 * hf); o = mfma32(a, bk, o); }
#pragma unroll
            for (int z = 0; z < 16; ++z) { const int t = 32 * tba + rowoff(z, hf), s_ = 32 * sba + r; sAtt[t * HLD + s_] = f2bf((s_ <= t) ? o[z] : 0.f); }
        }
        WG_BARRIER();
        if (w < 4) {
            for (int ks = 0; ks < 2 * (tb + 1); ++ks) { const bf16x8 a = *(const LAS bf16x8*)(sAtt + (32 * tb + r) * HLD + 16 * ks + 8 * hf), bv = *(const LAS bf16x8*)(sVT + (32 * eb + r) * HLD + 16 * ks + 8 * hf); o = mfma32(a, bv, o); }
#pragma unroll
            for (int z = 0; z < 16; ++z) sO[(32 * tb + rowoff(z, hf)) * 68 + 32 * eb + r] = o[z];
        } else { const int db = (w >> 1) & 1;
#pragma unroll
            for (int z = 0; z < 16; ++z) accS[z] *= sBl[32 * db + rowoff(z, hf)];
#pragma unroll
            for (int ks = 0; ks < 4; ++ks) { const bf16x8 a = *(const LAS bf16x8*)(sKdT + (32 * db + r) * HLD + 16 * ks + 8 * hf), bv = *(const LAS bf16x8*)(sVT + (32 * eb + r) * HLD + 16 * ks + 8 * hf); accS = mfma32(a, bv, accS); }
#pragma unroll
            for (int z = 0; z < 16; ++z) sST[(32 * eb + r) * HLD + 32 * db + rowoff(z, hf)] = f2bf(accS[z]);
        }
        WG_BARRIER();
        { const int t = tid >> 3, eg = tid & 7; const f32x4 o0 = *(const LAS f32x4*)(sO + t * 68 + 8 * eg), o1 = *(const LAS f32x4*)(sO + t * 68 + 8 * eg + 4);
            float ss = (o0[0] * o0[0] + o0[1] * o0[1]) + (o0[2] * o0[2] + o0[3] * o0[3]) + (o1[0] * o1[0] + o1[1] * o1[1]) + (o1[2] * o1[2] + o1[3] * o1[3]);
            ss += swz_xor<1>(ss); ss += swz_xor<2>(ss); ss += swz_xor<4>(ss);
            const float rs = __builtin_amdgcn_rsqf(ss * (1.f / 64.f) + EPS);
            GAS bf16* pr = F.BIG() + (row0 + t) * NPJ; const u32x4 gz = *(const GAS u32x4*)(pr + PC_CG + 64 * h + 8 * eg);
            const f32x4 n0 = *(const GAS f32x4*)(F.in[I_HNORM] + l * 64 + 8 * eg), n1 = *(const GAS f32x4*)(F.in[I_HNORM] + l * 64 + 8 * eg + 4);
            u32x4 ow; ow.x = pk2(o0[0] * rs * n0[0] * bflo(gz.x), o0[1] * rs * n0[1] * bfhi(gz.x)); ow.y = pk2(o0[2] * rs * n0[2] * bflo(gz.y), o0[3] * rs * n0[3] * bfhi(gz.y));
            ow.z = pk2(o1[0] * rs * n1[0] * bflo(gz.z), o1[1] * rs * n1[1] * bfhi(gz.z)); ow.w = pk2(o1[2] * rs * n1[2] * bflo(gz.w), o1[3] * rs * n1[3] * bfhi(gz.w));
            *(GAS u32x4*)(pr + PC_CQ + 64 * h + 8 * eg) = ow; }
    }
    if (w >= 4) { const int db = (w >> 1) & 1, eb = w & 1; GAS float* o = F.out + O_HSP + ((size_t)(l * 8 + b) * 8 + h) * 64 * 64;
#pragma unroll
        for (int z = 0; z < 16; ++z) o[(32 * db + rowoff(z, hf)) * 64 + 32 * eb + r] = accS[z]; }
    WG_BARRIER();
}

#ifndef SAMPLE_MASK
#define SAMPLE_MASK 7
#endif
__device__ __forceinline__ void sample_role(Frame& F, int l, int rid) {
    const int tid = F.tid, lane = F.lane, w = F.wave;
    LAS float* sXa = (LAS float*)F.lds; LAS float* sX = sXa + 512; LAS float* sQ = sX + 768; LAS float* sFd = sQ + 512; LAS float* sK = sFd + 512; LAS float* sDt = sK + 512; LAS float* sY = sDt + 32;
#pragma nounroll
    for (int k2 = 0; k2 < 2; ++k2) {
        const int i = 2 * rid + k2; const size_t row = (size_t)MPR + i; GAS bf16* pr = F.BIG() + row * NPJ;
        { const int c = tid; const GAS float* st = F.in[I_SRC] + ((size_t)(l * MSM + i) * 3) * 512 + c; const float b0 = st[0], b1 = st[512], b2 = st[1024], cur = bf2f(pr[PC_AX + c]);
            const GAS float* cw = F.in[I_CAW] + l * 4 * 512; sXa[c] = cw[c] * b0 + cw[512 + c] * b1 + cw[1024 + c] * b2 + cw[1536 + c] * cur + F.in[I_CAB][l * 512 + c];
            GAS float* o = F.out + O_RCS + ((size_t)(l * MSM + i) * 3) * 512 + c; o[0] = b1; o[512] = b2; o[1024] = cur; }
        for (int ch = tid; ch < 768; ch += 512) { const int col = ch < 512 ? PC_XS + ch : PC_B + (ch - 512);
            const GAS float* st = F.in[I_SSC] + ((size_t)(l * MSM + i) * 3) * 768 + ch; const float b0 = st[0], b1 = st[768], b2 = st[1536], cur = bf2f(pr[col]);
            const GAS float* cw = F.in[I_CBW] + l * 4 * 768; sX[ch] = fsilu(cw[ch] * b0 + cw[768 + ch] * b1 + cw[1536 + ch] * b2 + cw[2304 + ch] * cur + F.in[I_CBB][l * 768 + ch]);
            GAS float* o = F.out + O_SCS + ((size_t)(l * MSM + i) * 3) * 768 + ch; o[0] = b1; o[768] = b2; o[1536] = cur; }
        { const int c = tid; sQ[c] = bf2f(pr[PC_CQ + c]); const float lf = bf2f(pr[PC_CF + c]); sFd[c] = fexp(lf); sK[c] = fnegexpm1(lf); }
        if (tid < 8) { const float dtv = fsoftplus(F.DT()[row * 8 + tid] + F.in[I_DTB][l * 8 + tid]); sDt[tid] = dtv; sDt[8 + tid] = fexp(-dtv * __expf(F.in[I_ALOG][l * 8 + tid])); }
        WG_BARRIER();
        if (SAMPLE_MASK & 1) { const int c = tid, hh = c >> 6, j = c & 63; const GAS float* wa = F.in[I_WA] + ((size_t)(l * 8 + hh) * 64) * 64 + j; const GAS float* wx = F.in[I_WX] + ((size_t)(l * 8 + hh) * 64) * 64 + j;
            float ar = 0.f, ai = 0.f;
#pragma unroll 4
            for (int q = 0; q < 64; ++q) { const float xv = sXa[64 * hh + q]; ar += xv * wa[q * 64]; ai += xv * wx[q * 64]; }
            const float rr = fsigmoid(ar + F.in[I_BA][l * 512 + c]), ii = fsigmoid(ai + F.in[I_BX][l * 512 + c]), la = -8.f * fsoftplus(-F.in[I_LAM][l * 512 + c]) * rr;
            const float a = fexp(la), mult = __builtin_amdgcn_sqrtf(fmaxf(fnegexpm1(2.f * la), 0.f));
            const float hn = a * F.in[I_SRH][(size_t)(l * MSM + i) * 512 + c] + mult * ii * sXa[c];
            F.out[O_RHS + (size_t)(l * MSM + i) * 512 + c] = hn; pr[PC_AX + c] = f2bf(hn * bf2f(pr[PC_AG + c])); }
#ifdef DBG_BAR
        asm volatile("s_waitcnt vmcnt(0) lgkmcnt(0)" ::: "memory");
#endif
        if (SAMPLE_MASK & 2) { const int hh = w, half = lane >> 5, ln = lane & 31, n0 = 4 * ln; const float dA = sDt[8 + hh], dtv = sDt[hh], Dh = F.in[I_SSD_D][l * 8 + hh];
            const f32x4 Bn = *(const LAS f32x4*)(sX + 512 + n0), Cn = *(const LAS f32x4*)(sX + 640 + n0);
            const GAS float* sin_ = F.in[I_SSS] + (((size_t)(l * MSM + i) * 8 + hh) * 64) * 128; GAS float* sout = F.out + O_SSS + (((size_t)(l * MSM + i) * 8 + hh) * 64) * 128;
#pragma unroll 2
            for (int it = 0; it < 32; ++it) { const int p = 2 * it + half; const f32x4 s = *(const GAS f32x4*)(sin_ + p * 128 + n0); const float xv = sX[64 * hh + p], xdt = dtv * xv;
                f32x4 sn = s * dA + Bn * xdt;
#ifdef DBG_SAN
                for (int q_ = 0; q_ < 4; ++q_) if (!(fabsf(sn[q_]) < 1e30f)) sn[q_] = 0.f;
#endif
#ifndef DBG_NOSOUT
                *(GAS f32x4*)(sout + p * 128 + n0) = sn;
#endif
                float yv = (Cn[0] * sn[0] + Cn[1] * sn[1]) + (Cn[2] * sn[2] + Cn[3] * sn[3]);
                yv = sum32(yv);
                if (ln == 0) sY[64 * hh + p] = yv + Dh * xv; }
            { const float yg = sY[64 * hh + lane] * bf2f(pr[PC_BZ + 64 * hh + lane]); pr[PC_XS + 64 * hh + lane] = f2bf(yg);
              const float ssq = wave_sum(yg * yg);
#ifdef DBG_YG
              if (l == 1) { F.out[(size_t)i * DM + 64 * hh + lane] = yg; F.out[(size_t)(128 + i) * DM + 64 * hh + lane] = bf2f(pr[PC_BZ + 64 * hh + lane]); F.out[(size_t)(256 + i) * DM + 64 * hh + lane] = sY[64 * hh + lane]; F.out[(size_t)(384 + i) * DM + 64 * hh + lane] = ssq; }
#endif
              if (lane == 0) { F.SSDP()[row * 16 + 2 * hh] = ssq; F.SSDP()[row * 16 + 2 * hh + 1] = 0.f; } } }
        if (SAMPLE_MASK & 4) { const int hh = w, e = lane; const float vv = bf2f(pr[PC_CI + 64 * hh + e]);
            const GAS float* sin_ = F.in[I_SHG] + (((size_t)(l * MSM + i) * 8 + hh) * 64) * 64 + e; GAS float* sout = F.out + O_HSS + (((size_t)(l * MSM + i) * 8 + hh) * 64) * 64 + e;
            float o = 0.f;
#pragma unroll 4
            for (int dd = 0; dd < 64; ++dd) { const float sn = sFd[64 * hh + dd] * sin_[dd * 64] + sK[64 * hh + dd] * vv; sout[dd * 64] = sn; o += sQ[64 * hh + dd] * sn; }
            const float ss = wave_sum(o * o); const float rs = __builtin_amdgcn_rsqf(ss * (1.f / 64.f) + EPS);
            pr[PC_CQ + 64 * hh + e] = f2bf(o * rs * F.in[I_HNORM][l * 64 + e] * bf2f(pr[PC_CG + 64 * hh + e])); }
        WG_BARRIER();
    }
}
__device__ __forceinline__ void p2b_phase(Frame& F, int l) {
#pragma nounroll
    for (int rid = F.bx; rid < 256; rid += F.G) {
        { int t_ = F.tid; asm volatile("" : "+v"(t_)); F.tid = t_; F.lane = t_ & 63; }
        const int kind = rid >> 6, sub = rid & 63;
#ifndef ROLE_MASK
#define ROLE_MASK 15
#endif

        switch (kind) {
        case 0: if (ROLE_MASK & 1) ssd_role(F, l, sub);
#ifdef DBG_REPEAT_SSD
            ssd_role(F, l, sub);
#endif
            break;
        case 1: if (ROLE_MASK & 2) hgrn_role(F, l, sub); break;
        case 2: if (ROLE_MASK & 4) rg_scan_role(F, l, sub);
#ifdef DBG_REPEAT_RG
            rg_scan_role(F, l, sub);
#endif
            break;
        default: if (ROLE_MASK & 8) sample_role(F, l, sub); break;
        }
    }
}


__device__ __forceinline__ f32x4 sgemm_tile(Frame& F, const GAS bf16* A, int lda, const GAS bf16* Bt, int ldb, int kbeg, int klen, int rb, int cg) {
    const int lane = F.lane, w = F.wave, r = lane & 31, hf = lane >> 5, kw = klen >> 3;
    const GAS bf16* ap = A + (size_t)(MPR + 32 * rb + r) * lda + kbeg + w * kw + 8 * hf;
    const GAS bf16* bp0 = Bt + (size_t)(64 * cg + r) * ldb + kbeg + w * kw + 8 * hf; const GAS bf16* bp1 = bp0 + (size_t)32 * ldb;
    f32x16 a0, a1;
#pragma unroll
    for (int q = 0; q < 16; ++q) { a0[q] = 0.f; a1[q] = 0.f; }
#pragma unroll 4
    for (int k = 0; k < kw; k += 16) { const bf16x8 af = *(const GAS bf16x8*)(ap + k), b0 = *(const GAS bf16x8*)(bp0 + k), b1 = *(const GAS bf16x8*)(bp1 + k); a0 = mfma32(af, b0, a0); a1 = mfma32(af, b1, a1); }
    LAS float* part = (LAS float*)F.lds + w * 2048;
#pragma unroll
    for (int q = 0; q < 16; ++q) { const int row = rowoff(q, hf); part[row * 64 + r] = a0[q]; part[row * 64 + 32 + r] = a1[q]; }
    WG_BARRIER();
    const LAS float* pr_ = (const LAS float*)F.lds + (F.tid >> 4) * 64 + 4 * (F.tid & 15);
    f32x4 v = *(const LAS f32x4*)pr_;
#pragma unroll
    for (int q = 1; q < 8; ++q) v = v + *(const LAS f32x4*)(pr_ + q * 2048);
    WG_BARRIER();
    return v;
}
__device__ __forceinline__ float sum16(float v) { v += swz_xor<1>(v); v += swz_xor<2>(v); v += swz_xor<4>(v); v += swz_xor<8>(v); return v; }
__device__ __forceinline__ void store_bf4(GAS bf16* p, f32x4 v) { u32x2 w; w.x = pk2(v[0], v[1]); w.y = pk2(v[2], v[3]); *(GAS u32x2*)p = w; }
template <int MODE> __device__ __forceinline__ f32x4 act4(f32x4 v, f32x4 lb) { return (f32x4){act1<MODE>(v[0], lb[0]), act1<MODE>(v[1], lb[1]), act1<MODE>(v[2], lb[2]), act1<MODE>(v[3], lb[3])}; }
__device__ __forceinline__ void sample_p1(Frame& F, int l, int u0) {
    for (int u = u0; u < 4 * (NPJP / 64); u += F.G) { const int rb = u & 3, cg = u >> 2;
        if (64 * cg >= NPJ + 64) continue;
        const f32x4 v = sgemm_tile(F, F.HB(), DM, w_in_t(F.ws, l), DM, 0, DM, rb, cg);
        const int row = MPR + 32 * rb + (F.tid >> 4), col = 64 * cg + 4 * (F.tid & 15); const float rs = rstd16(F.SSQ_MIX(), row); const f32x4 x = v * rs;
        if (col >= NPJ) { if (col < NPJ + 8) *(GAS f32x4*)(F.DT() + (size_t)row * 8 + (col - NPJ)) = x; continue; }
        const int pn = col >> 8; f32x4 o;
        if (pn == 4 || pn == 5 || pn == 9 || pn == 10 || pn == 15 || pn == 16) o = act4<1>(x, x);
        else if (pn == 7 || pn == 8) o = act4<2>(x, x);
        else if (pn == 11 || pn == 12) o = act4<3>(x, *(const GAS f32x4*)(F.LBS() + l * 512 + (col - PC_CF)));
        else o = x;
        store_bf4(F.BIG() + (size_t)row * NPJ + col, o); }
}
__device__ __forceinline__ void sample_p3(Frame& F, int l, int u0) {
    for (int u = u0; u < 4 * (DM / 64); u += F.G) { const int rb = u & 3, cg = u >> 2;
        const f32x4 vb = sgemm_tile(F, F.BIG(), NPJ, w_out_t(F.ws, l), DMIX, 0, 512, rb, cg);
        const f32x4 va = sgemm_tile(F, F.BIG(), NPJ, w_out_t(F.ws, l), DMIX, 512, 1024, rb, cg);
        const int row = MPR + 32 * rb + (F.tid >> 4), col = 64 * cg + 4 * (F.tid & 15);
        const GAS f32x4* p = (const GAS f32x4*)(F.SSDP() + (size_t)row * 16); const f32x4 a = p[0], b = p[1], c = p[2], d = p[3];
        const float sb = ((a[0] + a[1]) + (a[2] + a[3])) + ((b[0] + b[1]) + (b[2] + b[3])) + ((c[0] + c[1]) + (c[2] + c[3])) + ((d[0] + d[1]) + (d[2] + d[3]));
        const float rsb = __builtin_amdgcn_rsqf(sb * (1.f / 512.f) + EPS);
        const GAS float* base = (l == 0) ? F.in[I_XS] + (size_t)(row - MPR) * DM + col : F.out + (size_t)row * DM + col;
        const f32x4 h = *(const GAS f32x4*)base + vb * rsb + va;
        *(GAS f32x4*)(F.out + (size_t)row * DM + col) = h; store_bf4(F.HB() + (size_t)row * DM + col, h);
        const float ss = sum16((h[0] * h[0] + h[1] * h[1]) + (h[2] * h[2] + h[3] * h[3]));
        if ((F.tid & 15) == 0) F.SSQ_FFN()[(size_t)row * 16 + cg] = ss; }
}
__device__ __forceinline__ void sample_p4(Frame& F, int l, int u0) {
    for (int u = u0; u < 4 * (DFF / 64); u += F.G) { const int rb = u & 3, cg = u >> 2;
        const f32x4 v = sgemm_tile(F, F.HB(), DM, w_up_t(F.ws, l), DM, 0, DM, rb, cg);
        const int row = MPR + 32 * rb + (F.tid >> 4), col = 64 * cg + 4 * (F.tid & 15); const float rs = rstd16(F.SSQ_FFN(), row);
        f32x4 x = v * rs;
#pragma unroll
        for (int i = 0; i < 4; ++i) { const float t_ = fmaxf(x[i], 0.f); x[i] = t_ * t_; }
        store_bf4(F.BIG() + (size_t)row * DFF + col, x); }
}
__device__ __forceinline__ void sample_p5(Frame& F, int l, int u0) {
    for (int u = u0; u < 4 * (DM / 64); u += F.G) { const int rb = u & 3, cg = u >> 2;
        const f32x4 v = sgemm_tile(F, F.BIG(), DFF, w_dn_t(F.ws, l), DFF, 0, DFF, rb, cg);
        const int row = MPR + 32 * rb + (F.tid >> 4), col = 64 * cg + 4 * (F.tid & 15);
        const f32x4 h = *(const GAS f32x4*)(F.out + (size_t)row * DM + col) + v;
        *(GAS f32x4*)(F.out + (size_t)row * DM + col) = h; store_bf4(F.HB2() + (size_t)row * DM + col, h);
        const float ss = sum16((h[0] * h[0] + h[1] * h[1]) + (h[2] * h[2] + h[3] * h[3]));
        if ((F.tid & 15) == 0) F.SSQ_PLE()[(size_t)row * 16 + cg] = ss; }
}
__device__ __forceinline__ void sample_p6(Frame& F, int l, int u0) {
    for (int u = u0; u < 4 * (DM / 64); u += F.G) { const int rb = u & 3, cg = u >> 2;
        const f32x4 pp = sgemm_tile(F, F.PB(), PLE, w_pj_t(F.ws, l), PLE, 0, PLE, rb, cg);
        const f32x4 g = sgemm_tile(F, F.HB2(), DM, w_g_t(F.ws, l), DM, 0, DM, rb, cg);
        const int row = MPR + 32 * rb + (F.tid >> 4), col = 64 * cg + 4 * (F.tid & 15); const float rs = rstd16(F.SSQ_PLE(), row);
        f32x4 h = *(const GAS f32x4*)(F.out + (size_t)row * DM + col);
#pragma unroll
        for (int i = 0; i < 4; ++i) h[i] += fsigmoid(g[i] * rs) * pp[i];
        *(GAS f32x4*)(F.out + (size_t)row * DM + col) = h; store_bf4(F.HB() + (size_t)row * DM + col, h);
        const float ss = sum16((h[0] * h[0] + h[1] * h[1]) + (h[2] * h[2] + h[3] * h[3]));
        if ((F.tid & 15) == 0) F.SSQ_MIX()[(size_t)row * 16 + cg] = ss; }
}

__device__ __forceinline__ void final_phase(Frame& F) {
    const int gw = F.bx * 8 + F.wave, NGW = F.G * 8;
    for (int m = gw; m < MREAL; m += NGW) { const float rs = rstd16(F.SSQ_MIX(), m); GAS f32x4* hr = (GAS f32x4*)(F.out + (size_t)m * DM);
#pragma unroll
        for (int j = 0; j < 4; ++j) { const f32x4 g = ((const GAS f32x4*)F.in[I_NFIN])[F.lane + 64 * j]; hr[F.lane + 64 * j] = hr[F.lane + 64 * j] * rs * g; } }
}

struct Args { const float* in[N_IN]; float* out; unsigned char* ws; int ph_lo, ph_hi, li, pad; };
constexpr int N_PHASES = 16;
#ifdef DBG_OUTMASK
#define DBG_EXTRA_PH 1
#else
#define DBG_EXTRA_PH 0
#endif

__global__ void __launch_bounds__(512, 2) fwd_kernel(Args args) {
    extern __shared__ __attribute__((aligned(16))) unsigned char lds_raw[];
    volatile LAS unsigned* MISC = (volatile LAS unsigned*)((LAS unsigned char*)lds_raw + LDSCTL_OFF);
    for (int u = threadIdx.x; u < (LDS_BYTES - LDSCTL_OFF) / 4; u += 512) MISC[u] = 0u;
    __syncthreads();
    if (threadIdx.x < N_IN) ((LAS unsigned long long*)((LAS unsigned char*)lds_raw + LDSCTL_OFF + 256))[threadIdx.x] = (unsigned long long)args.in[threadIdx.x];
    __syncthreads();
    XcdBarrier bar; bar.bar = (GAS unsigned*)(args.ws + WS_CTL) + CW_BAR; bar.x = 0; bar.st = nullptr;
    if (MK_N_LAUNCHES == 1) bar = xcd_barrier_post((GAS unsigned*)(args.ws + WS_CTL) + CW_BAR, MISC + 8);
    const int lo = args.ph_lo, hi = args.ph_hi;
#ifndef PHASE_MASK
#define PHASE_MASK 0xFFFFu
#endif
    const int wave0 = __builtin_amdgcn_readfirstlane(threadIdx.x >> 6);
#pragma nounroll
    for (int ph = lo; ph < hi; ++ph) {
        if (ph > lo) { XcdBarrier b2 = bar; int w_ = wave0, z_ = 0; asm volatile("" : "+s"(b2.bar), "+s"(b2.x), "+s"(w_), "+v"(z_)); xcd_barrier(b2, w_ * 64 + (int)__builtin_amdgcn_mbcnt_hi(~0u, __builtin_amdgcn_mbcnt_lo(~0u, z_))); }
        Frame F;
        F.lds = (LAS unsigned char*)lds_raw;
        int wv_ = wave0, g_ = gridDim.x, b_ = blockIdx.x; GAS unsigned char* ws = (GAS unsigned char*)args.ws;
        asm volatile("" : "+s"(wv_), "+s"(g_), "+s"(b_), "+s"(ws));
        F.wave = wv_; F.G = g_; F.bx = b_;
#define FRESH() do { int z_ = 0; asm volatile("" : "+v"(z_)); F.lane = __builtin_amdgcn_mbcnt_hi(~0u, __builtin_amdgcn_mbcnt_lo(~0u, z_)); F.tid = F.wave * 64 + F.lane; } while (0)
        GAS float* out_ = (GAS float*)args.out; asm volatile("" : "+s"(out_));
        F.intab = (const LAS unsigned long long*)((LAS unsigned char*)lds_raw + LDSCTL_OFF + 256); F.in.t = F.intab; F.out = out_; F.ws = ws;
#ifdef DBG_OUTMASK
        if (ph == 16) {
            const size_t offs[13] = {0, (size_t)MPR * DM, O_RCP, O_RHP, O_SCP, O_SSP, O_HSP, O_RCS, O_RHS, O_SCS, O_SSS, O_HSS, O_END};
            int z2_ = 0; asm volatile("" : "+v"(z2_)); const int ln_ = __builtin_amdgcn_mbcnt_hi(~0u, __builtin_amdgcn_mbcnt_lo(~0u, z2_));
            for (int o_ = 0; o_ < 12; ++o_) { const float sc_ = ((DBG_OUTMASK >> o_) & 1) ? DBG_OUTSCALE : 0.f;
                for (size_t e = offs[o_] + (size_t)F.bx * 512 + F.wave * 64 + ln_; e < offs[o_ + 1]; e += (size_t)F.G * 512) F.out[e] = F.out[e] * sc_; }
            continue; }
#endif
        const int l = (ph - 1) / 7; const int k = (ph == 0) ? 0 : (ph == 15 ? 8 : 1 + (ph - 1) % 7);
        if (!((PHASE_MASK >> k) & 1u)) continue;
#ifdef DBG_CUT
        if (ph > DBG_CUT && ph != 15) continue;
#endif
#ifdef DBG_CUT2
        if (ph > DBG_CUT2) continue;
#endif
#ifdef DBG_REPEAT_K
        for (int rep_ = 0; rep_ < ((k == DBG_REPEAT_K) ? 2 : 1); ++rep_) {
        if (rep_) { XcdBarrier b4 = bar; int w4_ = wave0, z4_ = 0; asm volatile("" : "+s"(b4.bar), "+s"(b4.x), "+s"(w4_), "+v"(z4_)); xcd_barrier(b4, w4_ * 64 + (int)__builtin_amdgcn_mbcnt_hi(~0u, __builtin_amdgcn_mbcnt_lo(~0u, z4_))); }
#endif
        switch (k) {
        case 0: FRESH(); p0_prologue(F);
#ifdef DBG_CUT
            { const int sizes[N_IN] = {16777216,131072,393216,131072,589824,16777216,8388608,8388608,65536,2048,8929280,4096,1024,65536,1024,65536,1024,1024,6144,1536,16,16,16,1024,1024,128,3145728,2048,8388608,8388608,2048,2097152,524288,1024};
              for (int t = F.bx; t < N_IN * 4; t += F.G) { const int ti = t >> 2, part = t & 3; const int n = sizes[ti]; const int q0 = (int)((long)n * part / 4), q1 = (int)((long)n * (part + 1) / 4);
                  const GAS float* p = F.in[ti]; float sacc = 0.f; for (int e = q0 + F.tid; e < q1; e += 512) sacc += fabsf(p[e]);
                  sacc = wave_sum(sacc); if (F.lane == 0) __hip_atomic_fetch_add((GAS float*)(F.ws + 65536) + t, sacc, __ATOMIC_RELAXED, __HIP_MEMORY_SCOPE_AGENT); } }
#endif
            break;
        case 1: {
            FRESH();
            pg8::Gemm g{F.HB(), w_in_t(ws, l), DM, DM}; pg8::StaticOrder S; S.init(MPR, NPJP, F.G, F.bx);
            EpiProj E{F.BIG(), F.DT(), F.SSQ_MIX(), F.LBS() + l * 512};
            pg8::gemm_phase<EpiProj, true>(F.lds, F.tid, g, S, E); FRESH(); sample_p1(F, l, F.G - 1 - F.bx); } break;
        case 2: FRESH(); p2a_phase(F, l); break;
        case 3: FRESH(); p2b_phase(F, l); break;
        case 4: {
            FRESH();
#ifdef DBG_SELF
            if (l == 1) {
                for (int rep = 0; rep < 2; ++rep) {
                    FRESH();
                    pg8::Gemm g{F.BIG(), w_out_t(ws, l), NPJ, DMIX}; pg8::StaticOrder S; S.init(8192, DM, F.G, F.bx);
                    EpiDbg E{F.out, (GAS float*)(F.ws + WS_RT) + (size_t)rep * 8192 * DM + (rep ? 131072 : 0), F.SSDP()};
                    pg8::gemm_phase<EpiDbg, true>(F.lds, F.tid, g, S, E);
                    asm volatile("s_waitcnt vmcnt(0)" ::: "memory"); __syncthreads();
                }
                break; }
#endif
#ifdef DBG_RD
            if (l == 1) { if (F.bx < 4) { for (int e = F.tid; e < 128 * 1536; e += 512) { const int r_ = e / 1536, c_ = e % 1536;
                    F.out[(size_t)(F.bx * 256 + 2 * r_ + (c_ >> 10)) * DM + (c_ & 1023)] = bf2f(F.BIG()[(size_t)(MPR + r_) * NPJ + c_]); }
                  for (int e = F.tid; e < 128 * 16; e += 512) F.out[(size_t)(1024 + F.bx * 2) * DM + e] = F.SSDP()[(size_t)MPR * 16 + e]; }
                break; }
#endif
            pg8::Gemm g{F.BIG(), w_out_t(ws, l), NPJ, DMIX}; pg8::StaticOrder S; S.init(MPR, DM, F.G, F.bx);
            const GAS float* bp = (l == 0) ? F.in[I_XP] : F.out; const GAS float* bs = (l == 0) ? F.in[I_XS] - (size_t)MPR * DM : F.out;
            EpiRes<true> E{bp, bs, F.out, F.HB(), F.SSQ_FFN(), F.SSDP()};
            pg8::gemm_phase<EpiRes<true>, true>(F.lds, F.tid, g, S, E); FRESH(); sample_p3(F, l, F.G - 1 - F.bx); } break;
        case 5: {
            FRESH();
            pg8::Gemm g{F.HB(), w_up_t(ws, l), DM, DM}; pg8::StaticOrder S; S.init(MPR, DFF, F.G, F.bx);
            EpiUp E{F.BIG(), F.SSQ_FFN()};
            pg8::gemm_phase<EpiUp, true>(F.lds, F.tid, g, S, E); FRESH(); sample_p4(F, l, F.G - 1 - F.bx); } break;
        case 6: {
            FRESH();
            pg8::Gemm g{F.BIG(), w_dn_t(ws, l), DFF, DFF}; pg8::StaticOrder S; S.init(MPR, DM, F.G, F.bx);
            EpiRes<false> E{F.out, F.out, F.out, F.HB2(), F.SSQ_PLE(), nullptr};
            pg8::gemm_phase<EpiRes<false>, true>(F.lds, F.tid, g, S, E); FRESH(); sample_p5(F, l, F.G - 1 - F.bx); } break;
        case 7: {
            FRESH();
            { pg8::Gemm g{F.PB(), w_pj_t(ws, l), PLE, PLE}; pg8::StaticOrder S; S.init(MPR, DM, F.G, F.bx); EpiPP E{F.PPB()}; pg8::gemm_phase<EpiPP, true>(F.lds, F.tid, g, S, E); }
            asm volatile("s_waitcnt vmcnt(0)" ::: "memory"); __syncthreads();
            FRESH();
            { pg8::Gemm g{F.HB2(), w_g_t(ws, l), DM, DM}; pg8::StaticOrder S; S.init(MPR, DM, F.G, F.bx); EpiGate E{F.out, F.HB(), F.PPB(), F.SSQ_PLE(), F.SSQ_MIX()}; pg8::gemm_phase<EpiGate, true>(F.lds, F.tid, g, S, E); } FRESH(); sample_p6(F, l, F.G - 1 - F.bx); } break;
        default: FRESH();
#ifdef DBG_SELF
            { const GAS float* t1 = (const GAS float*)(F.ws + WS_RT); const GAS float* t2 = t1 + (size_t)8192 * DM + 131072; unsigned cnt = 0;
              for (size_t e = (size_t)F.bx * 512 + F.tid; e < (size_t)8192 * DM; e += (size_t)F.G * 512) cnt += (t1[e] != t2[e]) ? 1u : 0u;
              cnt = (unsigned)wave_sum((float)cnt);
              if (F.lane == 0) F.out[(size_t)(F.bx * 8 + F.wave) * DM] = 1000.f * (float)cnt; }
            break;
#endif
#ifdef DBG_CK
            { GAS float* yo = F.out + (size_t)MPR * DM;
              const int gw = F.bx * 8 + F.wave, NGW = F.G * 8;
              for (int it = gw; it < 128 * (24 + 16 + 1); it += NGW) { const int blk = it % 128, g = it / 128; float sacc = 0.f;
#ifdef DBG_CK2
                  if (g < 12) { for (int e = F.lane; e < 128 * 64; e += 64) sacc += fabsf(bf2f(F.XA()[(size_t)(blk * 128 + (e >> 6)) * 768 + g * 64 + (e & 63)])); }
                  else if (g < 20) { for (int e = F.lane; e < 128 * 64; e += 64) sacc += fabsf(bf2f(F.BIG()[(size_t)(blk * 128 + (e >> 6)) * NPJ + PC_BZ + (g - 12) * 64 + (e & 63)])); }
                  else if (g < 21) { for (int e = F.lane; e < 128 * 8; e += 64) sacc += fabsf(F.DT()[(size_t)blk * 128 * 8 + e]); }
                  else if (g < 24) { }
#else
                  if (g < 24) { for (int e = F.lane; e < 128 * 64; e += 64) sacc += fabsf(bf2f(F.BIG()[(size_t)(blk * 128 + (e >> 6)) * NPJ + g * 64 + (e & 63)])); }
#endif
                  else if (g < 40) { for (int e = F.lane; e < 128 * 64; e += 64) sacc += fabsf(F.out[(size_t)(blk * 128 + (e >> 6)) * DM + (g - 24) * 64 + (e & 63)]); }
                  else { for (int e = F.lane; e < 128 * 16; e += 64) sacc += fabsf(F.SSDP()[(size_t)blk * 128 * 16 + e]); }
                  sacc = wave_sum(sacc); if (F.lane == 0) yo[it] = (g >= DBG_CK_LO && g < DBG_CK_HI) ? sacc : 0.f; } }
            break;
#endif
#ifdef DBG_COPY
            for (int e = F.bx * 512 + F.tid; e < 128 * DM; e += F.G * 512) F.out[(size_t)MPR * DM + e] = F.out[(size_t)DBG_COPY * DM + e];
            break;
#endif
#ifdef DBG_CUT
            { const int gw = F.bx * 8 + F.wave, NGW = F.G * 8;
              for (int m = gw; m < MREAL; m += NGW) { float s0 = 0.f, s1 = 0.f, s2 = 0.f;
                  const GAS bf16* b = F.BIG() + (size_t)m * NPJ; for (int c = F.lane; c < NPJ; c += 64) s0 += fabsf(bf2f(b[c]));
                  const GAS bf16* hb = F.HB() + (size_t)m * DM; for (int c = F.lane; c < DM; c += 64) s1 += fabsf(bf2f(hb[c]));
                  const GAS bf16* h2 = F.HB2() + (size_t)m * DM; for (int c = F.lane; c < DM; c += 64) s2 += fabsf(bf2f(h2[c]));
                  s0 = wave_sum(s0); s1 = wave_sum(s1); s2 = wave_sum(s2);
                  float s3 = 0.f, s4 = 0.f; if (m < 1024) { const GAS float* si = F.in[I_SSS] + ((size_t)(1024 + m)) * 8192; for (int c = F.lane; c < 8192; c += 64) s3 += fabsf(si[c]);
                      const GAS float* s0i = F.in[I_SSS] + ((size_t)m) * 8192; for (int c = F.lane; c < 8192; c += 64) s4 += fabsf(s0i[c]); }
                  s3 = wave_sum(s3); s4 = wave_sum(s4);
                  if (F.lane == 0) { GAS float* o = F.out + (size_t)m * DM; o[8] = s3; o[9] = s4; if (m < N_IN * 4) o[10] = ((GAS float*)(F.ws + 65536))[m]; o[0] = s0; o[1] = s1; o[2] = s2; o[3] = F.DT()[(size_t)m * 8 + 3]; o[4] = F.SSQ_MIX()[(size_t)m * 16 + 5]; o[5] = F.SSQ_FFN()[(size_t)m * 16 + 5]; o[6] = F.SSQ_PLE()[(size_t)m * 16 + 5]; o[7] = F.SSDP()[(size_t)m * 16 + 5]; } } }
#else
#ifndef DBG_NOFINAL
            final_phase(F);
#endif
#ifdef DBG_SANOUT
            asm volatile("s_waitcnt vmcnt(0)" ::: "memory"); { XcdBarrier b3 = bar; xcd_barrier(b3, F.tid); }
            for (size_t e = (size_t)F.bx * 512 + F.tid; e < O_END; e += (size_t)F.G * 512) { const float v = F.out[e]; if (!(fabsf(v) < 1e30f)) F.out[e] = 12345.f; }
#endif
#endif
            break;
        }
#ifdef DBG_REPEAT_K
        }
#endif
    }
}

extern "C" void kernel_launch(void* const* d_in, const int* in_sizes, int n_in, void* d_out, int out_size, void* d_ws, size_t ws_size, hipStream_t stream) {
    static int grid = 0;
    if (grid == 0) {
        if (n_in != N_IN || (size_t)out_size != O_END || ws_size < WS_END) { fprintf(stderr, "kernel_launch: unexpected shapes: n_in %d out %d ws %zu (need %zu)\n", n_in, out_size, ws_size, (size_t)WS_END); grid = -1; return; }
        int dev = 0, cus = 0, per_cu = 0;
        if (hipGetDevice(&dev) != hipSuccess || hipDeviceGetAttribute(&cus, hipDeviceAttributeMultiprocessorCount, dev) != hipSuccess) { grid = -1; return; }
        if (hipFuncSetAttribute((const void*)fwd_kernel, hipFuncAttributeMaxDynamicSharedMemorySize, LDS_BYTES) != hipSuccess) { fprintf(stderr, "kernel_launch: hipFuncSetAttribute failed\n"); grid = -1; return; }
        if (hipOccupancyMaxActiveBlocksPerMultiprocessor(&per_cu, (const void*)fwd_kernel, 512, LDS_BYTES) != hipSuccess || per_cu < 1) { fprintf(stderr, "kernel_launch: occupancy query says %d blocks per CU\n", per_cu); (void)hipGetLastError(); grid = -1; return; }
        grid = cus;
        if (grid > 256) grid = 256;
    }
    if (grid < 0) return;
    if (hipMemsetAsync((char*)d_ws + WS_CTL, 0, CTL_ZERO_BYTES, stream) != hipSuccess) return;
#ifdef DBG_FILLOUT
    (void)hipMemsetAsync(d_out, 0, (size_t)O_END * 4, stream);
#endif
#ifdef DBG_FILL
    (void)hipMemsetAsync((char*)d_ws + CTL_ZERO_BYTES, DBG_FILL, WS_END - CTL_ZERO_BYTES, stream);
#endif
    Args a{};
    for (int i = 0; i < N_IN; ++i) a.in[i] = (const float*)d_in[i];
    a.out = (float*)d_out; a.ws = (unsigned char*)d_ws;
    if (MK_N_LAUNCHES == 1) { a.ph_lo = 0; a.ph_hi = N_PHASES; a.li = 0; hipLaunchKernelGGL(fwd_kernel, dim3(grid), dim3(512), LDS_BYTES, stream, a); }
    else for (int p = 0; p < N_PHASES + DBG_EXTRA_PH; ++p) { a.ph_lo = p; a.ph_hi = p + 1; a.li = p; hipLaunchKernelGGL(fwd_kernel, dim3(grid), dim3(512), LDS_BYTES, stream, a); }
}
```

```cpp
#include <hip/hip_runtime.h>
#include <cstdio>
#include <cstdint>

#define LAS __attribute__((address_space(3)))
#define GAS __attribute__((address_space(1)))
typedef unsigned short bf16;
typedef short bf16x8 __attribute__((ext_vector_type(8)));
typedef float f32x4 __attribute__((ext_vector_type(4)));
typedef float f32x16 __attribute__((ext_vector_type(16)));
typedef unsigned u32x4 __attribute__((ext_vector_type(4)));
typedef unsigned u32x2 __attribute__((ext_vector_type(2)));
typedef GAS unsigned gu32;

#ifndef MK_N_LAUNCHES
#define MK_N_LAUNCHES 1
#endif

constexpr int DM = 1024, NBATCH = 8, SEQ = 2048, MPR = NBATCH * SEQ, MSM = 128, MREAL = MPR + MSM, MP = 16640  ;
constexpr int NPJ = 4352, NPJP = 4608, DFF = 4096, PLE = 256, DMIX = 1536, NL = 2, DIN = 4360;
constexpr int PC_XS = 0, PC_AX = 512, PC_CQ = 1024, PC_B = 1536, PC_C = 1664, PC_AG = 1792, PC_BZ = 2304, PC_CF = 2816, PC_CI = 3328, PC_CG = 3840;
constexpr float EPS = 1e-6f;
enum { I_XP = 0, I_XS, I_SRC, I_SRH, I_SSC, I_SSS, I_SHG, I_PP, I_PS, I_NMIX, I_WIN, I_CAW, I_CAB, I_WA, I_BA, I_WX, I_BX, I_LAM, I_CBW, I_CBB, I_DTB, I_ALOG, I_SSD_D, I_SNORM,
       I_HLB, I_HNORM, I_WOUT, I_NFFN, I_WUP, I_WDN, I_NPLE, I_WG, I_WPJ, I_NFIN, N_IN };
constexpr size_t O_Y = 0, O_RCP = (size_t)MREAL * DM, O_RHP = O_RCP + 2 * 8 * 3 * 512, O_SCP = O_RHP + 2 * 8 * 512, O_SSP = O_SCP + 2 * 8 * 3 * 768, O_HSP = O_SSP + 2 * 8 * 8 * 64 * 128,
                 O_RCS = O_HSP + 2 * 8 * 8 * 64 * 64, O_RHS = O_RCS + 2 * 128 * 3 * 512, O_SCS = O_RHS + 2 * 128 * 512, O_SSS = O_SCS + 2 * 128 * 3 * 768, O_HSS = O_SSS + (size_t)2 * 128 * 8 * 64 * 128,
                 O_END = O_HSS + (size_t)2 * 128 * 8 * 64 * 64;
static_assert(O_END == 44830720, "output size");

constexpr size_t MiB = 1u << 20;
constexpr size_t WS_CTL = 0, CTL_ZERO_BYTES = 1 * MiB;
constexpr size_t WS_WIN = 1 * MiB, WS_WOUT = 19 * MiB, WS_WUP = 25 * MiB, WS_WDN = 41 * MiB, WS_WG = 57 * MiB, WS_WPJ = 61 * MiB, WS_WAT = 62 * MiB, WS_LBS = 62 * MiB + 512 * 1024;
constexpr size_t KiB64 = 65536;
constexpr size_t WS_PB = 63 * MiB, WS_HB = WS_PB + 132 * KiB64  , WS_BIG = WS_HB + 520 * KiB64  , WS_RT = WS_BIG + 2211 * KiB64  ;
constexpr size_t WS_LA = WS_RT, WS_BB = WS_RT + 16 * MiB, WS_XA = WS_RT + 32 * MiB, WS_PPB = WS_RT, WS_HB2 = WS_RT + 520 * KiB64, WS_TS = WS_RT + 56 * MiB  ;
constexpr size_t WS_DT = WS_RT + 1040 * KiB64  , WS_SSQ_MIX = WS_DT + 12 * KiB64, WS_SSQ_FFN = WS_SSQ_MIX + 17 * KiB64, WS_SSQ_PLE = WS_SSQ_FFN + 17 * KiB64, WS_SSDP = WS_SSQ_PLE + 17 * KiB64, WS_END = WS_SSDP + 17 * KiB64;
static_assert(WS_PB + (size_t)MP * PLE * 2 <= WS_HB && WS_HB + (size_t)MP * DM * 2 <= WS_BIG && WS_BIG + (size_t)MP * NPJ * 2 <= WS_RT && WS_XA + (size_t)MPR * 768 * 2 <= WS_DT && WS_PPB + (size_t)MP * DM * 2 <= WS_HB2 &&
              WS_HB2 + (size_t)MP * DM * 2 <= WS_DT && WS_DT + (size_t)MP * 8 * 4 <= WS_SSQ_MIX && (size_t)MP * 16 * 4 <= 17 * KiB64 && WS_END <= 313 * MiB, "ws map");
constexpr int CW_TMO = 0, CW_BAR = 4096;

constexpr int SCR_BYTES = 147456, LDSCTL_OFF = SCR_BYTES, LDS_BYTES = SCR_BYTES + 1024;

typedef float f32x2v_ __attribute__((ext_vector_type(2))); typedef __bf16 bf16x2v_ __attribute__((ext_vector_type(2)));
__device__ __forceinline__ unsigned pk2(float lo, float hi) { const f32x2v_ v = {lo, hi}; return __builtin_bit_cast(unsigned, __builtin_convertvector(v, bf16x2v_)); }
__device__ __forceinline__ bf16 f2bf(float f) { return (bf16)(pk2(f, 0.f) & 0xffffu); }
__device__ __forceinline__ float bf2f(bf16 b) { return __uint_as_float(((unsigned)b) << 16); }
__device__ __forceinline__ float bflo(unsigned w) { return __uint_as_float(w << 16); }
__device__ __forceinline__ float bfhi(unsigned w) { return __uint_as_float(w & 0xffff0000u); }
__device__ __forceinline__ float fexp(float x) { return __builtin_amdgcn_exp2f(x * 1.44269504089f); }
__device__ __forceinline__ float frcp(float x) { return __builtin_amdgcn_rcpf(x); }
__device__ __forceinline__ float fsigmoid(float x) { return frcp(1.f + fexp(-x)); }
__device__ __forceinline__ float fsilu(float x) { return x * fsigmoid(x); }
__device__ __forceinline__ float fgelu(float x) { const float u = x + 0.044715f * x * x * x; return x * frcp(1.f + fexp(-1.5957691216f * u)); }
__device__ __forceinline__ float flog(float x) { return __builtin_amdgcn_logf(x) * 0.69314718056f; }
__device__ __forceinline__ float fsoftplus(float x) {
    if (x > 20.f) return x;
    const float e = fexp(x);
    if (e < 0.05f) return e * (1.f - e * (0.5f - e * (0.33333333f - e * (0.25f - 0.2f * e))));
    return flog(1.f + e);
}
__device__ __forceinline__ float fnegexpm1(float x) {
    if (x > -0.5f && x < 0.5f) return -(x * (1.f + x * 0.5f * (1.f + x * 0.33333333f * (1.f + x * 0.25f * (1.f + x * 0.2f * (1.f + x * 0.16666667f))))));
    return 1.f - fexp(x);
}
template <int X> __device__ __forceinline__ float swz_xor(float v) { return __int_as_float(__builtin_amdgcn_ds_swizzle(__float_as_int(v), (X << 10) | 0x1f)); }
__device__ __forceinline__ float sum_halves(float v) {
    const unsigned u = __float_as_uint(v); auto r = __builtin_amdgcn_permlane32_swap(u, u, false, false); return __uint_as_float(r[0]) + __uint_as_float(r[1]); }
template <int CTRL> __device__ __forceinline__ float dpp_f(float v) { return __int_as_float(__builtin_amdgcn_update_dpp(0, __float_as_int(v), CTRL, 0xF, 0xF, true)); }
__device__ __forceinline__ float sum16r(float v) {
    v += dpp_f<0xB1>(v); v += dpp_f<0x4E>(v); v += dpp_f<0x141>(v); v += dpp_f<0x140>(v); return v; }
__device__ __forceinline__ float sum32(float v) { v = sum16r(v); v += swz_xor<16>(v); return v; }
__device__ __forceinline__ float wave_sum(float v) { return sum_halves(sum32(v)); }
__device__ __forceinline__ float bperm(float v, int srclane) { return __int_as_float(__builtin_amdgcn_ds_bpermute(srclane << 2, __float_as_int(v))); }
__device__ __forceinline__ f32x16 mfma32(bf16x8 a, bf16x8 b, f32x16 c) { return __builtin_amdgcn_mfma_f32_32x32x16_bf16(a, b, c, 0, 0, 0); }
__device__ __forceinline__ int rowoff(int reg, int hf) { return (reg & 3) + 8 * (reg >> 2) + 4 * hf; }
#ifndef DBG_V
#define DBG_V 0
#endif
#if DBG_V == 3
#define WG_BARRIER() do { asm volatile("s_waitcnt vmcnt(0) lgkmcnt(0)" ::: "memory"); __syncthreads(); } while (0)
#else
#define WG_BARRIER() __syncthreads()
#endif

namespace pg8 {
constexpr int BM = 256, BK = 64, HALF = 128, HTB = HALF * BK * 2, STAGE_BYTES = 8 * HTB, NXCD = 8, WGM = 8;
__host__ __device__ __forceinline__ int lds_byte(int r, int c) { const int st = (r >> 4) * 2 + (c >> 5), rr = r & 15, cc = c & 31, ob = rr * 64 + cc * 2; return st * 1024 + (ob ^ (((ob >> 9) & 1) << 5)); }
__host__ __device__ __forceinline__ void stage_rc(int b, int& R, int& C) { const int st = b / 1024, sb = b % 1024, swz = sb ^ (((sb >> 9) & 1) << 5); R = (st >> 1) * 16 + swz / 64; C = (st & 1) * 32 + (swz % 64) / 2; }
__host__ __device__ __forceinline__ int perm32(int rho) { const int n = rho >> 4, i = rho & 15; return 8 * (i >> 2) + 4 * n + (i & 3); }
struct Unit { int pm, pn; };
struct Gemm { const GAS bf16* A; const GAS bf16* Bt; int lda, K; };
struct StaticOrder {
    int nM, nN, nwg, G, c;
    __device__ void init(int M, int N, int G_, int c_) { nM = M / BM; nN = N / BM; nwg = nM * nN; G = G_; c = c_; }
    __device__ bool next(int i, Unit& u) const {
        const long L = (long)i * G + c; if (L >= nwg) return false;
        int wgid = (int)L; { const int q = nwg / NXCD, r = nwg % NXCD, xcd = wgid % NXCD, off = wgid / NXCD; wgid = (xcd < r ? xcd * (q + 1) : r * (q + 1) + (xcd - r) * q) + off; }
        const int nig = WGM * nN, gid = wgid / nig, fm = gid * WGM, gsz = (nM - fm) < WGM ? (nM - fm) : WGM;
        u.pm = fm + ((wgid % nig) % gsz); u.pn = (wgid % nig) / gsz; return true;
    }
};
typedef f32x4 Acc[2][2][4][2];

template <class Epi, bool ALIGN_EPI>
__device__ __forceinline__ void gemm_phase(LAS unsigned char* lds, const int tid, const Gemm g, const StaticOrder& S, const Epi& E) {
    const int wid = __builtin_amdgcn_readfirstlane(tid >> 6), lane = tid & 63, wr = wid >> 2, wc = wid & 3, fr = lane & 15, fq = lane >> 4;
    const int K = g.K, nt = K / BK, lda = g.lda;
    unsigned voffA[2], voffB[2];
#pragma unroll
    for (int i = 0; i < 2; ++i) { int R, C; stage_rc(tid * 16 + i * 8192, R, C); const int Rb = Epi::PERM ? ((R & ~31) + perm32(R & 31)) : R;
        voffA[i] = (unsigned)(R * lda + C) * 2u; voffB[i] = (unsigned)(Rb * K + C) * 2u; }
    const size_t kstep = (size_t)(BK * 2);
    const size_t hA = (size_t)HALF * lda * 2, hB = (size_t)HALF * K * 2, tA = 2 * hA, tB = 2 * hB;
    const unsigned ldsw = (unsigned)wid * 1024u;
    const int aoff = lds_byte(wr * 64 + fr, fq * 8), boff = lds_byte(wc * 32 + fr, fq * 8);
#define PG8_SA(b, h) (((b) * 2 + (h)) * HTB)
#define PG8_SB(b, h) ((4 + (b) * 2 + (h)) * HTB)
#define PG8_STAGE(bufoff, gbase, voff) do { _Pragma("unroll") for (int _i = 0; _i < 2; ++_i) \
        __builtin_amdgcn_global_load_lds((const GAS unsigned*)((const GAS char*)(gbase) + (voff)[_i]), (LAS unsigned*)(lds + (bufoff) + ldsw + _i * 8192), 16, 0, 0); } while (0)
#define PG8_LDA(dst, b, h) do { _Pragma("unroll") for (int m = 0; m < 4; ++m) _Pragma("unroll") for (int k = 0; k < 2; ++k) dst[m][k] = *(const LAS bf16x8*)(lds + PG8_SA(b, h) + aoff + m * 2048 + k * 1024); } while (0)
#define PG8_LDB(dst, b, h) do { _Pragma("unroll") for (int n = 0; n < 2; ++n) _Pragma("unroll") for (int k = 0; k < 2; ++k) dst[n][k] = *(const LAS bf16x8*)(lds + PG8_SB(b, h) + boff + n * 2048 + k * 1024); } while (0)
#define PG8_MMA(ai, bj, At, Bt) do { __builtin_amdgcn_s_setprio(1); _Pragma("unroll") for (int m = 0; m < 4; ++m) _Pragma("unroll") for (int n = 0; n < 2; ++n) _Pragma("unroll") for (int k = 0; k < 2; ++k) \
        acc[ai][bj][m][n] = __builtin_amdgcn_mfma_f32_16x16x32_bf16(Bt[n][k], At[m][k], acc[ai][bj][m][n], 0, 0, 0); __builtin_amdgcn_s_setprio(0); } while (0)
#define PG8_WAIT_V(n) asm volatile("s_waitcnt vmcnt(" #n ")" ::: "memory")
#define PG8_WAIT_L(n) asm volatile("s_waitcnt lgkmcnt(" #n ")" ::: "memory")
#define PG8_BAR __builtin_amdgcn_s_barrier()
#define PG8_SCHED __builtin_amdgcn_sched_barrier(0)
    Unit cur, nxt; int ui = 0;
    if (!S.next(0, cur)) return;
    f32x4 acc[2][2][4][2];
#pragma unroll
    for (int a = 0; a < 2; ++a)
#pragma unroll
        for (int b = 0; b < 2; ++b)
#pragma unroll
            for (int m = 0; m < 4; ++m)
#pragma unroll
                for (int n = 0; n < 2; ++n) acc[a][b][m][n] = (f32x4){0.f, 0.f, 0.f, 0.f};
    bf16x8 At[4][2], B0[2][2], B1[2][2];
    const GAS char* cA = (const GAS char*)g.A + (size_t)cur.pm * tA; const GAS char* cB = (const GAS char*)g.Bt + (size_t)cur.pn * tB;
    PG8_STAGE(PG8_SB(0, 0), cB, voffB); PG8_STAGE(PG8_SB(0, 1), cB + hB, voffB); PG8_STAGE(PG8_SA(0, 0), cA, voffA); PG8_STAGE(PG8_SA(0, 1), cA + hA, voffA);
    if (wr == 1) PG8_BAR;
    PG8_WAIT_V(2); PG8_BAR;
    PG8_STAGE(PG8_SB(1, 0), cB + kstep, voffB); PG8_STAGE(PG8_SA(1, 0), cA + kstep, voffA); PG8_STAGE(PG8_SB(1, 1), cB + hB + kstep, voffB);
    PG8_WAIT_V(6); PG8_BAR;
    for (;;) {
        const bool has_next = S.next(ui + 1, nxt);
        const GAS char* nA = has_next ? (const GAS char*)g.A + (size_t)nxt.pm * tA : cA; const GAS char* nB = has_next ? (const GAS char*)g.Bt + (size_t)nxt.pn * tB : cB;
        for (int t = 0; t < nt; t += 2) {
            const bool last = (t == nt - 2);
            const GAS char* a1 = cA + (size_t)(t + 1) * kstep;
            const GAS char* a2 = last ? nA : cA + (size_t)(t + 2) * kstep; const GAS char* b2 = last ? nB : cB + (size_t)(t + 2) * kstep;
            const GAS char* a3 = a2 + kstep; const GAS char* b3 = b2 + kstep;
            if constexpr (Epi::MIDK > 0) { if (t == Epi::MIDK) E.mid(acc, cur, wr, wc, fr, fq); }
            PG8_LDB(B0, 0, 0); PG8_LDB(B1, 0, 1); PG8_SCHED; PG8_LDA(At, 0, 0); PG8_STAGE(PG8_SA(1, 1), a1 + hA, voffA);
            PG8_WAIT_V(8); PG8_WAIT_L(0); PG8_BAR; PG8_MMA(0, 0, At, B0); PG8_MMA(0, 1, At, B1); PG8_BAR; PG8_SCHED;
            PG8_LDA(At, 0, 1); PG8_STAGE(PG8_SB(0, 0), b2, voffB); PG8_STAGE(PG8_SB(0, 1), b2 + hB, voffB); PG8_STAGE(PG8_SA(0, 0), a2, voffA);
            PG8_WAIT_V(8); PG8_WAIT_L(0); PG8_BAR; PG8_MMA(1, 0, At, B0); PG8_MMA(1, 1, At, B1); PG8_BAR; PG8_SCHED;
            PG8_LDB(B0, 1, 0); PG8_LDB(B1, 1, 1); PG8_SCHED; PG8_LDA(At, 1, 0); PG8_STAGE(PG8_SA(0, 1), a2 + hA, voffA);
            PG8_WAIT_V(8); PG8_WAIT_L(0); PG8_BAR; PG8_MMA(0, 0, At, B0); PG8_MMA(0, 1, At, B1); PG8_BAR; PG8_SCHED;
            PG8_LDA(At, 1, 1); PG8_STAGE(PG8_SB(1, 0), b3, voffB); PG8_STAGE(PG8_SB(1, 1), b3 + hB, voffB); PG8_STAGE(PG8_SA(1, 0), a3, voffA);
            PG8_WAIT_V(8); PG8_WAIT_L(0); PG8_BAR; PG8_MMA(1, 0, At, B0); PG8_MMA(1, 1, At, B1); PG8_BAR; PG8_SCHED;
        }
        if constexpr (ALIGN_EPI) { if (wr == 0) PG8_BAR; }
        E(acc, cur, wr, wc, fr, fq);
        if (!has_next) break;
#pragma unroll
        for (int a = 0; a < 2; ++a)
#pragma unroll
            for (int b = 0; b < 2; ++b)
#pragma unroll
                for (int m = 0; m < 4; ++m)
#pragma unroll
                    for (int n = 0; n < 2; ++n) acc[a][b][m][n] = (f32x4){0.f, 0.f, 0.f, 0.f};
        cur = nxt; cA = nA; cB = nB; ++ui;
        if constexpr (ALIGN_EPI) { if (wr == 1) PG8_BAR; }
    }
    PG8_WAIT_V(0);
    if constexpr (!ALIGN_EPI) { if (wr == 0) PG8_BAR; }
    PG8_BAR;
#undef PG8_SA
#undef PG8_SB
#undef PG8_STAGE
#undef PG8_LDA
#undef PG8_LDB
#undef PG8_MMA
#undef PG8_WAIT_V
#undef PG8_WAIT_L
#undef PG8_BAR
#undef PG8_SCHED
}
}
using pg8::Unit; using pg8::Acc; using pg8::BM; using pg8::HALF;

__device__ __forceinline__ float rstd16(const GAS float* ssq, int row) {
    const GAS f32x4* p = (const GAS f32x4*)(ssq + (size_t)row * 16); const f32x4 a = p[0], b = p[1], c = p[2], d = p[3];
    const float s = ((a[0] + a[1]) + (a[2] + a[3])) + ((b[0] + b[1]) + (b[2] + b[3])) + ((c[0] + c[1]) + (c[2] + c[3])) + ((d[0] + d[1]) + (d[2] + d[3]));
    return __builtin_amdgcn_rsqf(s * (1.f / DM) + EPS);
}
template <int MODE> __device__ __forceinline__ float act1(float v, float lb) {
    if (MODE == 1) return fsilu(v);
    if (MODE == 2) return fgelu(v);
    if (MODE == 3) { const float g = lb + (1.f - lb) * fsigmoid(v); return fmaxf(flog(g), -30.f); }
    return v;
}
struct EpiProj {
    static constexpr bool PERM = true; static constexpr int MIDK = 0;
    GAS bf16* P; GAS float* DT; const GAS float* ssq; const GAS float* lbs;
    __device__ __forceinline__ void mid(Acc&, const Unit&, int, int, int, int) const {}
    template <int MODE> __device__ __forceinline__ void body(const Acc& acc, const Unit& u, int wr, int wc, int fr, int fq) const {
        const int row0 = u.pm * BM + wr * 64 + fr, col0 = u.pn * BM + wc * 32 + 8 * fq;
        f32x4 lb[2][2];
#pragma unroll
        for (int bj = 0; bj < 2; ++bj)
#pragma unroll
            for (int n = 0; n < 2; ++n) lb[bj][n] = (MODE == 3) ? *(const GAS f32x4*)(lbs + (col0 - PC_CF) + bj * HALF + 4 * n) : (f32x4){0.f, 0.f, 0.f, 0.f};
#pragma unroll
        for (int ai = 0; ai < 2; ++ai)
#pragma unroll
            for (int m = 0; m < 4; ++m) { const int row = row0 + ai * HALF + m * 16; const float rs = rstd16(ssq, row); GAS bf16* rowp = P + (size_t)row * NPJ + col0;
#pragma unroll
                for (int bj = 0; bj < 2; ++bj) { const f32x4 v0 = acc[ai][bj][m][0] * rs, v1 = acc[ai][bj][m][1] * rs; u32x4 w;
                    w.x = pk2(act1<MODE>(v0[0], lb[bj][0][0]), act1<MODE>(v0[1], lb[bj][0][1])); w.y = pk2(act1<MODE>(v0[2], lb[bj][0][2]), act1<MODE>(v0[3], lb[bj][0][3]));
                    w.z = pk2(act1<MODE>(v1[0], lb[bj][1][0]), act1<MODE>(v1[1], lb[bj][1][1])); w.w = pk2(act1<MODE>(v1[2], lb[bj][1][2]), act1<MODE>(v1[3], lb[bj][1][3]));
                    *(GAS u32x4*)(rowp + bj * HALF) = w; } }
    }
    __device__ __forceinline__ void operator()(const Acc& acc, const Unit& u, int wr, int wc, int fr, int fq) const {
        const int pn = u.pn;
        if (pn == 17) {
            if (wc == 0 && fq == 0) {
#pragma unroll
                for (int ai = 0; ai < 2; ++ai)
#pragma unroll
                    for (int m = 0; m < 4; ++m) { const int row = u.pm * BM + wr * 64 + fr + ai * HALF + m * 16; const float rs = rstd16(ssq, row);
                        *(GAS f32x4*)(DT + (size_t)row * 8) = acc[ai][0][m][0] * rs; *(GAS f32x4*)(DT + (size_t)row * 8 + 4) = acc[ai][0][m][1] * rs; }
            }
            return;
        }
        if (pn == 4 || pn == 5 || pn == 9 || pn == 10 || pn == 15 || pn == 16) body<1>(acc, u, wr, wc, fr, fq);
        else if (pn == 7 || pn == 8) body<2>(acc, u, wr, wc, fr, fq);
        else if (pn == 11 || pn == 12) body<3>(acc, u, wr, wc, fr, fq);
        else body<0>(acc, u, wr, wc, fr, fq);
    }
};
template <bool MID> struct EpiRes {
    static constexpr bool PERM = false; static constexpr int MIDK = MID ? 8 : 0;
    const GAS float* basep; const GAS float* bases; GAS float* hout; GAS bf16* hb; GAS float* ssq; const GAS float* ssdp;
    __device__ __forceinline__ void mid(Acc& acc, const Unit& u, int wr, int wc, int fr, int fq) const {
#pragma unroll
        for (int ai = 0; ai < 2; ++ai)
#pragma unroll
            for (int m = 0; m < 4; ++m) { const int row = u.pm * BM + wr * 64 + fr + ai * HALF + m * 16;
                const GAS f32x4* p = (const GAS f32x4*)(ssdp + (size_t)row * 16); const f32x4 a = p[0], b = p[1], c = p[2], d = p[3];
                const float s = ((a[0] + a[1]) + (a[2] + a[3])) + ((b[0] + b[1]) + (b[2] + b[3])) + ((c[0] + c[1]) + (c[2] + c[3])) + ((d[0] + d[1]) + (d[2] + d[3]));
                const float rs = __builtin_amdgcn_rsqf(s * (1.f / 512.f) + EPS);
#pragma unroll
                for (int bj = 0; bj < 2; ++bj)
#pragma unroll
                    for (int n = 0; n < 2; ++n) acc[ai][bj][m][n] = acc[ai][bj][m][n] * rs; }
    }
    __device__ __forceinline__ void operator()(const Acc& acc, const Unit& u, int wr, int wc, int fr, int fq) const {
        const int row0 = u.pm * BM + wr * 64 + fr, col0 = u.pn * BM + wc * 32 + 4 * fq;
        const GAS float* base = (u.pm < MPR / BM) ? basep : bases;
#pragma unroll
        for (int ai = 0; ai < 2; ++ai)
#pragma unroll
            for (int m = 0; m < 4; ++m) { const int row = row0 + ai * HALF + m * 16; const size_t off = (size_t)row * DM + col0; float ss = 0.f;
                if (row < MREAL) {
#pragma unroll
                    for (int bj = 0; bj < 2; ++bj)
#pragma unroll
                        for (int n = 0; n < 2; ++n) { const f32x4 v = *(const GAS f32x4*)(base + off + bj * HALF + n * 16) + acc[ai][bj][m][n];
                            *(GAS f32x4*)(hout + off + bj * HALF + n * 16) = v; u32x2 w; w.x = pk2(v[0], v[1]); w.y = pk2(v[2], v[3]); *(GAS u32x2*)(hb + off + bj * HALF + n * 16) = w;
                            ss += (v[0] * v[0] + v[1] * v[1]) + (v[2] * v[2] + v[3] * v[3]); }
                }
                ss += swz_xor<16>(ss); ss = sum_halves(ss);
                if (fq == 0) ssq[(size_t)row * 16 + u.pn * 4 + wc] = ss;
                asm volatile("" ::: "memory"); }
    }
};
struct EpiDbg {
    static constexpr bool PERM = false; static constexpr int MIDK = 8;
    const GAS float* basep; GAS float* hout; const GAS float* ssdp;
    __device__ __forceinline__ void mid(Acc& acc, const Unit& u, int wr, int wc, int fr, int fq) const {
#pragma unroll
        for (int ai = 0; ai < 2; ++ai)
#pragma unroll
            for (int m = 0; m < 4; ++m) { const int row = u.pm * BM + wr * 64 + fr + ai * HALF + m * 16;
                const GAS f32x4* p = (const GAS f32x4*)(ssdp + (size_t)row * 16); const f32x4 a = p[0], b = p[1], c = p[2], d = p[3];
                const float s = ((a[0] + a[1]) + (a[2] + a[3])) + ((b[0] + b[1]) + (b[2] + b[3])) + ((c[0] + c[1]) + (c[2] + c[3])) + ((d[0] + d[1]) + (d[2] + d[3]));
                const float rs = __builtin_amdgcn_rsqf(s * (1.f / 512.f) + EPS);
#pragma unroll
                for (int bj = 0; bj < 2; ++bj)
#pragma unroll
                    for (int n = 0; n < 2; ++n) acc[ai][bj][m][n] = acc[ai][bj][m][n] * rs; }
    }
    __device__ __forceinline__ void operator()(const Acc& acc, const Unit& u, int wr, int wc, int fr, int fq) const {
        const int row0 = u.pm * BM + wr * 64 + fr, col0 = u.pn * BM + wc * 32 + 4 * fq;
#pragma unroll
        for (int ai = 0; ai < 2; ++ai)
#pragma unroll
            for (int m = 0; m < 4; ++m) { const int row = row0 + ai * HALF + m * 16; const size_t off = (size_t)row * DM + col0;
#pragma unroll
                for (int bj = 0; bj < 2; ++bj)
#pragma unroll
                    for (int n = 0; n < 2; ++n) { const f32x4 v = *(const GAS f32x4*)(basep + off + bj * HALF + n * 16) + acc[ai][bj][m][n]; *(GAS f32x4*)(hout + off + bj * HALF + n * 16) = v; }
                asm volatile("" ::: "memory"); }
    }
};
struct EpiUp {
    static constexpr bool PERM = true; static constexpr int MIDK = 0;
    GAS bf16* Z; const GAS float* ssq;
    __device__ __forceinline__ void mid(Acc&, const Unit&, int, int, int, int) const {}
    __device__ __forceinline__ void operator()(const Acc& acc, const Unit& u, int wr, int wc, int fr, int fq) const {
        const int row0 = u.pm * BM + wr * 64 + fr, col0 = u.pn * BM + wc * 32 + 8 * fq;
#pragma unroll
        for (int ai = 0; ai < 2; ++ai)
#pragma unroll
            for (int m = 0; m < 4; ++m) { const int row = row0 + ai * HALF + m * 16; const float rs = rstd16(ssq, row); GAS bf16* rowp = Z + (size_t)row * DFF + col0;
#pragma unroll
                for (int bj = 0; bj < 2; ++bj) { f32x4 v0 = acc[ai][bj][m][0] * rs, v1 = acc[ai][bj][m][1] * rs;
#pragma unroll
                    for (int i = 0; i < 4; ++i) { const float a = fmaxf(v0[i], 0.f), b = fmaxf(v1[i], 0.f); v0[i] = a * a; v1[i] = b * b; }
                    u32x4 w; w.x = pk2(v0[0], v0[1]); w.y = pk2(v0[2], v0[3]); w.z = pk2(v1[0], v1[1]); w.w = pk2(v1[2], v1[3]); *(GAS u32x4*)(rowp + bj * HALF) = w; } }
    }
};
struct EpiPP {
    static constexpr bool PERM = false; static constexpr int MIDK = 0;
    GAS bf16* PPB;
    __device__ __forceinline__ void mid(Acc&, const Unit&, int, int, int, int) const {}
    __device__ __forceinline__ void operator()(const Acc& acc, const Unit& u, int wr, int wc, int fr, int fq) const {
        const int row0 = u.pm * BM + wr * 64 + fr, col0 = u.pn * BM + wc * 32 + 4 * fq;
#pragma unroll
        for (int ai = 0; ai < 2; ++ai)
#pragma unroll
            for (int m = 0; m < 4; ++m) { const size_t off = (size_t)(row0 + ai * HALF + m * 16) * DM + col0;
#pragma unroll
                for (int bj = 0; bj < 2; ++bj)
#pragma unroll
                    for (int n = 0; n < 2; ++n) { const f32x4 v = acc[ai][bj][m][n]; u32x2 w; w.x = pk2(v[0], v[1]); w.y = pk2(v[2], v[3]); *(GAS u32x2*)(PPB + off + bj * HALF + n * 16) = w; } }
    }
};
struct EpiGate {
    static constexpr bool PERM = false; static constexpr int MIDK = 0;
    GAS float* h; GAS bf16* hb; const GAS bf16* PPB; const GAS float* ssq_in; GAS float* ssq_out;
    __device__ __forceinline__ void mid(Acc&, const Unit&, int, int, int, int) const {}
    __device__ __forceinline__ void operator()(const Acc& acc, const Unit& u, int wr, int wc, int fr, int fq) const {
        const int row0 = u.pm * BM + wr * 64 + fr, col0 = u.pn * BM + wc * 32 + 4 * fq;
#pragma unroll
        for (int ai = 0; ai < 2; ++ai)
#pragma unroll
            for (int m = 0; m < 4; ++m) { const int row = row0 + ai * HALF + m * 16; const size_t off = (size_t)row * DM + col0; float ss = 0.f;
                if (row < MREAL) { const float rs = rstd16(ssq_in, row);
#pragma unroll
                    for (int bj = 0; bj < 2; ++bj)
#pragma unroll
                        for (int n = 0; n < 2; ++n) { const f32x4 a = acc[ai][bj][m][n] * rs; const u32x2 pw = *(const GAS u32x2*)(PPB + off + bj * HALF + n * 16);
                            f32x4 v = *(const GAS f32x4*)(h + off + bj * HALF + n * 16);
                            v[0] += fsigmoid(a[0]) * bflo(pw.x); v[1] += fsigmoid(a[1]) * bfhi(pw.x); v[2] += fsigmoid(a[2]) * bflo(pw.y); v[3] += fsigmoid(a[3]) * bfhi(pw.y);
                            *(GAS f32x4*)(h + off + bj * HALF + n * 16) = v; u32x2 w; w.x = pk2(v[0], v[1]); w.y = pk2(v[2], v[3]); *(GAS u32x2*)(hb + off + bj * HALF + n * 16) = w;
                            ss += (v[0] * v[0] + v[1] * v[1]) + (v[2] * v[2] + v[3] * v[3]); }
                }
                ss += swz_xor<16>(ss); ss = sum_halves(ss);
                if (fq == 0) ssq_out[(size_t)row * 16 + u.pn * 4 + wc] = ss;
                asm volatile("" ::: "memory"); }
    }
};

#define RLX_AGENT __ATOMIC_RELAXED, __HIP_MEMORY_SCOPE_AGENT
#define XB_TMO      128
#define XB_XCNT(j)  (256  + 64 * (j))
#define XB_XSUB(j)  (1280 + 64 * (j))
#define XB_XGEN(j)  (2304 + 64 * (j))
#define XB_TOP      3328
#define XB_TOPGEN   3392
#define XCD_BAR_WORDS 3456
#define XB_SPIN_CAP (1u << 20)
__device__ __forceinline__ unsigned xb_ld(GAS unsigned* p)              { return __hip_atomic_load(p, __ATOMIC_RELAXED, __HIP_MEMORY_SCOPE_AGENT); }
__device__ __forceinline__ unsigned xb_add(GAS unsigned* p, unsigned v) { return __hip_atomic_fetch_add(p, v, __ATOMIC_RELAXED, __HIP_MEMORY_SCOPE_AGENT); }
__device__ __forceinline__ unsigned xb_xcc_id() { return (unsigned)__builtin_amdgcn_s_getreg((3 << 11) | 20) & 0xFu; }
#define XB_SPIN(cond, bar) do { unsigned _sp = 0; while (cond) { __builtin_amdgcn_s_sleep(1); \
    if ((++_sp & 255u) == 0u) { if (xb_ld(&(bar)[XB_TMO])) break; if (_sp > XB_SPIN_CAP) { (void)xb_add(&(bar)[XB_TMO], 1u); break; } } } } while (0)
struct XcdBarrier { GAS unsigned* bar; unsigned x; volatile LAS unsigned* st; };
__device__ __forceinline__ XcdBarrier xcd_barrier_post(GAS unsigned* bar, volatile LAS unsigned* st) {
    XcdBarrier b; b.bar = bar; b.x = xb_xcc_id(); b.st = st;
    if (threadIdx.x == 0) (void)xb_add(&bar[XB_XCNT(b.x)], 1u);
    return b;
}
__device__ __forceinline__ void xcd_barrier_complete(GAS unsigned* bar, unsigned x, unsigned& nloc, unsigned& nx) {
    const unsigned G = gridDim.x * gridDim.y * gridDim.z;
    unsigned sum, cnt, mine, sp = 0u;
    for (;;) {
        sum = 0u; cnt = 0u; mine = 0u;
#pragma unroll
        for (unsigned j = 0; j < 16; ++j) { const unsigned c = xb_ld(&bar[XB_XCNT(j)]); sum += c; cnt += (c > 0u) ? 1u : 0u; mine = (j == x) ? c : mine; }
        if (sum == G) break;
        __builtin_amdgcn_s_sleep(1);
        if ((++sp & 255u) == 0u) { if (xb_ld(&bar[XB_TMO])) break; if (sp > XB_SPIN_CAP) { (void)xb_add(&bar[XB_TMO], 1u); break; } }
    }
    nloc = mine > 0u ? mine : 1u; nx = cnt > 0u ? cnt : 1u;
}
__device__ __forceinline__ void xcd_barrier(const XcdBarrier& b, const int tid) {
    asm volatile("s_waitcnt vmcnt(0)" ::: "memory");
    __syncthreads();
    if (tid == 0) {
        GAS unsigned* bar = b.bar;
        __builtin_amdgcn_s_waitcnt(0);
        unsigned nloc = b.st[0], nx = b.st[1];
        if (nloc == 0u) { xcd_barrier_complete(bar, b.x, nloc, nx); b.st[0] = nloc; b.st[1] = nx; }
        const unsigned old = xb_add(&bar[XB_XSUB(b.x)], 1u);
        const unsigned gen = old / nloc;
        if (old + 1u == (gen + 1u) * nloc) {
            __builtin_amdgcn_fence(__ATOMIC_RELEASE, "agent");
            asm volatile("s_waitcnt vmcnt(0)" ::: "memory");
            const unsigned og = xb_add(&bar[XB_TOP], 1u);
            const unsigned tg = og / nx;
            if (og + 1u == (tg + 1u) * nx) xb_add(&bar[XB_TOPGEN], 1u);
            else XB_SPIN(xb_ld(&bar[XB_TOPGEN]) == tg, bar);
            __builtin_amdgcn_fence(__ATOMIC_ACQUIRE, "agent");
            xb_add(&bar[XB_XGEN(b.x)], 1u);
            asm volatile("s_waitcnt vmcnt(0)" ::: "memory");
        } else {
            XB_SPIN(xb_ld(&bar[XB_XGEN(b.x)]) == gen, bar);
            __builtin_amdgcn_fence(__ATOMIC_ACQUIRE, "agent");
            asm volatile("s_waitcnt vmcnt(0)" ::: "memory");
        }
    }
    __syncthreads();
}

struct Frame {
    LAS unsigned char* lds;
    int tid, lane, wave, G, bx;
    const LAS unsigned long long* intab;
    struct InAcc { const LAS unsigned long long* t; __device__ __forceinline__ const GAS float* operator[](int i) const { const unsigned long long v = t[i];
        const unsigned lo = __builtin_amdgcn_readfirstlane((unsigned)v), hi = __builtin_amdgcn_readfirstlane((unsigned)(v >> 32)); return (const GAS float*)(((unsigned long long)hi << 32) | lo); } } in;
    GAS float* out; GAS unsigned char* ws;
#define FPTR(name, type, off) __device__ __forceinline__ GAS type* name() const { return (GAS type*)(ws + (off)); }
    FPTR(BIG, bf16, WS_BIG) FPTR(HB, bf16, WS_HB) FPTR(HB2, bf16, WS_HB2) FPTR(PB, bf16, WS_PB) FPTR(LA, bf16, WS_LA) FPTR(BB, bf16, WS_BB) FPTR(XA, bf16, WS_XA) FPTR(TS, float, WS_TS) FPTR(PPB, bf16, WS_PPB)
    FPTR(DT, float, WS_DT) FPTR(SSQ_MIX, float, WS_SSQ_MIX) FPTR(SSQ_FFN, float, WS_SSQ_FFN) FPTR(SSQ_PLE, float, WS_SSQ_PLE) FPTR(SSDP, float, WS_SSDP) FPTR(LBS, float, WS_LBS) FPTR(WAT, bf16, WS_WAT)
#undef FPTR
};
__device__ __forceinline__ GAS bf16* w_in_t(GAS unsigned char* ws, int l) { return (GAS bf16*)(ws + WS_WIN) + (size_t)l * NPJP * DM; }
__device__ __forceinline__ GAS bf16* w_out_t(GAS unsigned char* ws, int l) { return (GAS bf16*)(ws + WS_WOUT) + (size_t)l * DM * DMIX; }
__device__ __forceinline__ GAS bf16* w_up_t(GAS unsigned char* ws, int l) { return (GAS bf16*)(ws + WS_WUP) + (size_t)l * DFF * DM; }
__device__ __forceinline__ GAS bf16* w_dn_t(GAS unsigned char* ws, int l) { return (GAS bf16*)(ws + WS_WDN) + (size_t)l * DM * DFF; }
__device__ __forceinline__ GAS bf16* w_g_t(GAS unsigned char* ws, int l) { return (GAS bf16*)(ws + WS_WG) + (size_t)l * DM * DM; }
__device__ __forceinline__ GAS bf16* w_pj_t(GAS unsigned char* ws, int l) { return (GAS bf16*)(ws + WS_WPJ) + (size_t)l * DM * PLE; }

__device__ __forceinline__ int win_src(int n0) {
    if (n0 < 512) return 1536 + n0;
    if (n0 < 1024) return n0 - 512;
    if (n0 < 1536) return 2312 + (n0 - 1024);
    if (n0 < 1792) return 2048 + (n0 - 1536);
    if (n0 < 2304) return 512 + (n0 - 1792);
    if (n0 < 2816) return 1024 + (n0 - 2304);
    if (n0 < 3328) return 2824 + (n0 - 2816);
    if (n0 < 3840) return 3336 + (n0 - 3328);
    if (n0 < 4352) return 3848 + (n0 - 3840);
    return 2304 + (n0 - 4352);
}
__device__ __forceinline__ void p0_item(const GAS float* W, int ldw, GAS bf16* WT, int K, int N, int mode, const GAS float* ks, LAS float* scr, int item, int lane) {
    const int nblk = N / 32, kb = item / nblk, nb = item % nblk, k0 = 64 * kb, n0 = 32 * nb;
    int sn0 = n0, nvalid = 32;
    if (mode == 1) { sn0 = win_src(n0); if (n0 >= NPJ) nvalid = (n0 == NPJ) ? 8 : 0; }
#pragma unroll 8
    for (int i = 0; i < 32; ++i) { const int kk = 2 * i + (lane >> 5), k = k0 + kk; int sk = k; float sc = 1.f;
        if (mode == 2) { sk = (k < 512) ? 512 + k : (k < 1024 ? k - 512 : k); if (k < 512) sc = ks[k]; } else if (ks) sc = ks[k];
        float v = 0.f; if ((lane & 31) < nvalid) v = W[(size_t)sk * ldw + sn0 + (lane & 31)];
        scr[kk * 33 + (lane & 31)] = v * sc; }
    asm volatile("s_waitcnt lgkmcnt(0)" ::: "memory");
    const int c = lane & 7;
#pragma unroll
    for (int j = 0; j < 4; ++j) { const int n = (lane >> 3) + 8 * j; const LAS float* s = scr + (8 * c) * 33 + n;
        u32x4 o; o.x = pk2(s[0 * 33], s[1 * 33]); o.y = pk2(s[2 * 33], s[3 * 33]); o.z = pk2(s[4 * 33], s[5 * 33]); o.w = pk2(s[6 * 33], s[7 * 33]);
        *(GAS u32x4*)(WT + (size_t)(n0 + n) * K + k0 + 8 * c) = o; }
    asm volatile("s_waitcnt lgkmcnt(0)" ::: "memory");
}
__device__ __forceinline__ void p0_prologue(Frame& F) {
    LAS float* scr = (LAS float*)(F.lds + F.wave * 16384);
    const int gw = F.bx * 8 + F.wave, NGW = F.G * 8;
    constexpr int I_IN = (DM / 64) * (NPJP / 32), I_OUT = (DMIX / 64) * (DM / 32), I_UP = (DM / 64) * (DFF / 32), I_DN = (DFF / 64) * (DM / 32), I_G = (DM / 64) * (DM / 32), I_PJ = (PLE / 64) * (DM / 32);
    constexpr int PER_L = I_IN + I_OUT + I_UP + I_DN + I_G + I_PJ;
    for (int it = gw; it < NL * PER_L; it += NGW) {
        const int l = it / PER_L; int r = it % PER_L;
        if (r < I_IN) { p0_item(F.in[I_WIN] + (size_t)l * DM * DIN, DIN, w_in_t(F.ws, l), DM, NPJP, 1, F.in[I_NMIX] + l * DM, scr, r, F.lane); continue; } r -= I_IN;
        if (r < I_OUT) { p0_item(F.in[I_WOUT] + (size_t)l * DMIX * DM, DM, w_out_t(F.ws, l), DMIX, DM, 2, F.in[I_SNORM] + l * 512, scr, r, F.lane); continue; } r -= I_OUT;
        if (r < I_UP) { p0_item(F.in[I_WUP] + (size_t)l * DM * DFF, DFF, w_up_t(F.ws, l), DM, DFF, 0, F.in[I_NFFN] + l * DM, scr, r, F.lane); continue; } r -= I_UP;
        if (r < I_DN) { p0_item(F.in[I_WDN] + (size_t)l * DFF * DM, DM, w_dn_t(F.ws, l), DFF, DM, 0, nullptr, scr, r, F.lane); continue; } r -= I_DN;
        if (r < I_G) { p0_item(F.in[I_WG] + (size_t)l * DM * DM, DM, w_g_t(F.ws, l), DM, DM, 0, F.in[I_NPLE] + l * DM, scr, r, F.lane); continue; } r -= I_G;
        p0_item(F.in[I_WPJ] + (size_t)l * PLE * DM, DM, w_pj_t(F.ws, l), PLE, DM, 0, nullptr, scr, r, F.lane);
    }
    for (int m = gw; m < MREAL; m += NGW) {
        const GAS float* xr = (m < MPR) ? F.in[I_XP] + (size_t)m * DM : F.in[I_XS] + (size_t)(m - MPR) * DM;
        f32x4 v[4]; float s = 0.f;
#pragma unroll
        for (int j = 0; j < 4; ++j) { v[j] = ((const GAS f32x4*)xr)[F.lane + 64 * j]; s += (v[j][0] * v[j][0] + v[j][1] * v[j][1]) + (v[j][2] * v[j][2] + v[j][3] * v[j][3]); }
        s = wave_sum(s);
#pragma unroll
        for (int j = 0; j < 4; ++j) { u32x2 w; w.x = pk2(v[j][0], v[j][1]); w.y = pk2(v[j][2], v[j][3]); ((GAS u32x2*)(F.HB() + (size_t)m * DM))[F.lane + 64 * j] = w; }
        if (F.lane < 16) F.SSQ_MIX()[(size_t)m * 16 + F.lane] = (F.lane == 0) ? s : 0.f;
    }
    const int gt = F.bx * 512 + F.tid, NGT = F.G * 512;
    for (int e = gt; e < NL * 2 * 8 * 64 * 64; e += NGT) { const int i = e & 63, j = (e >> 6) & 63, h = (e >> 12) & 7, g = (e >> 15) & 1, l = e >> 16;
        F.WAT()[e] = f2bf(F.in[g ? I_WX : I_WA][(((size_t)l * 8 + h) * 64 + i) * 64 + j]); }
    for (int e = gt; e < NL * 512; e += NGT) { const int l = e / 512, c = e % 512;
        float mx = -1e30f; for (int q = 0; q < NL; ++q) mx = fmaxf(mx, F.in[I_HLB][q * 512 + c]);
        float den = 0.f, cs = 0.f, c0 = 0.f; for (int q = 0; q < NL; ++q) den += __expf(F.in[I_HLB][q * 512 + c] - mx);
        for (int q = 0; q <= l; ++q) { const float p = __expf(F.in[I_HLB][q * 512 + c] - mx) / den; cs += p; if (q == 0) c0 = p; }
        F.LBS()[e] = cs - c0; }
}

__device__ __forceinline__ void p2a_rg_item(Frame& F, int l, int item) {
    const int tt = item >> 3, h = item & 7, row0 = tt * 32, lane = F.lane, r = lane & 31, hf = lane >> 5;
    LAS float* xt = (LAS float*)(F.lds + F.wave * 8704);
    const int gc = 64 * h + lane;
    const GAS float* cw = F.in[I_CAW] + l * 4 * 512; const float w0 = cw[gc], w1 = cw[512 + gc], w2 = cw[1024 + gc], w3 = cw[1536 + gc], cb = F.in[I_CAB][l * 512 + gc];
    const GAS bf16* ax = F.BIG() + (size_t)row0 * NPJ + PC_AX + gc;
    const bool first = (row0 % SEQ) == 0;
    float p3 = 0.f, p2 = 0.f, p1 = 0.f;
    if (!first) { p3 = bf2f(ax[-3 * NPJ]); p2 = bf2f(ax[-2 * NPJ]); p1 = bf2f(ax[-1 * NPJ]); }
#pragma unroll 8
    for (int t = 0; t < 32; ++t) { const float cur = bf2f(ax[(size_t)t * NPJ]); xt[t * 68 + lane] = w0 * p3 + w1 * p2 + w2 * p1 + w3 * cur + cb; p3 = p2; p2 = p1; p1 = cur; }
    if ((row0 + 32) % SEQ == 0) { const int b = row0 / SEQ; GAS float* o = F.out + O_RCP + ((size_t)(l * 8 + b) * 3) * 512 + gc; o[0] = p3; o[512] = p2; o[1024] = p1; }
    bf16x8 af[4];
#pragma unroll
    for (int s = 0; s < 4; ++s) { const f32x4 a = *(const LAS f32x4*)(xt + r * 68 + 16 * s + 8 * hf), b = *(const LAS f32x4*)(xt + r * 68 + 16 * s + 8 * hf + 4);
        u32x4 w; w.x = pk2(a[0], a[1]); w.y = pk2(a[2], a[3]); w.z = pk2(b[0], b[1]); w.w = pk2(b[2], b[3]); af[s] = __builtin_bit_cast(bf16x8, w); }
#pragma unroll
    for (int jb = 0; jb < 2; ++jb) {
        f32x16 ar, ai;
#pragma unroll
        for (int q = 0; q < 16; ++q) { ar[q] = 0.f; ai[q] = 0.f; }
        const GAS bf16* wr_ = F.WAT() + ((((size_t)l * 2 + 0) * 8 + h) * 64 + 32 * jb + r) * 64 + 8 * hf;
        const GAS bf16* wi_ = F.WAT() + ((((size_t)l * 2 + 1) * 8 + h) * 64 + 32 * jb + r) * 64 + 8 * hf;
#pragma unroll
        for (int s = 0; s < 4; ++s) { const bf16x8 br = *(const GAS bf16x8*)(wr_ + 16 * s), bi = *(const GAS bf16x8*)(wi_ + 16 * s); ar = mfma32(af[s], br, ar); ai = mfma32(af[s], bi, ai); }
        const int j = 32 * jb + r, gj = 64 * h + j;
        const float ba = F.in[I_BA][l * 512 + gj], bx = F.in[I_BX][l * 512 + gj], c8 = -8.f * fsoftplus(-F.in[I_LAM][l * 512 + gj]);
        bf16 labs[16], bvbs[16];
#pragma unroll
        for (int q = 0; q < 16; ++q) { const int t = rowoff(q, hf); const float rr = fsigmoid(ar[q] + ba), ii = fsigmoid(ai[q] + bx), la = c8 * rr;
            float mult = __builtin_amdgcn_sqrtf(fmaxf(fnegexpm1(2.f * la), 0.f)); if (((row0 + t) % SEQ) == 0) mult = 1.f;
            const float bv = mult * ii * xt[t * 68 + j]; const bf16 lab = f2bf(la), bvb = f2bf(bv); labs[q] = lab; bvbs[q] = bvb;
            ar[q] = fexp(bf2f(lab)); ai[q] = bf2f(bvb); }
#pragma unroll
        for (int k = 0; k < 4; ++k) { const size_t o = (((size_t)tt * 4 + k) * 512 + gj) * 8 + 4 * hf;
            u32x2 wl, wb; wl.x = labs[4 * k] | ((unsigned)labs[4 * k + 1] << 16); wl.y = labs[4 * k + 2] | ((unsigned)labs[4 * k + 3] << 16); wb.x = bvbs[4 * k] | ((unsigned)bvbs[4 * k + 1] << 16); wb.y = bvbs[4 * k + 2] | ((unsigned)bvbs[4 * k + 3] << 16);
            *(GAS u32x2*)(F.LA() + o) = wl; *(GAS u32x2*)(F.BB() + o) = wb; }
        float gA[4], gB[4];
#pragma unroll
        for (int k = 0; k < 4; ++k) { float A_ = 1.f, B_ = 0.f;
#pragma unroll
            for (int i = 0; i < 4; ++i) { B_ = ar[4 * k + i] * B_ + ai[4 * k + i]; A_ *= ar[4 * k + i]; }
            gA[k] = A_; gB[k] = B_; }
        float A_ = 1.f, B_ = 0.f;
#pragma unroll
        for (int k = 0; k < 4; ++k) { const unsigned ua = __float_as_uint(gA[k]), ub = __float_as_uint(gB[k]);
            auto ra = __builtin_amdgcn_permlane32_swap(ua, ua, false, false); auto rb_ = __builtin_amdgcn_permlane32_swap(ub, ub, false, false);
            const float loA = __uint_as_float(ra[0]), hiA = __uint_as_float(ra[1]), loB = __uint_as_float(rb_[0]), hiB = __uint_as_float(rb_[1]);
            B_ = loA * B_ + loB; A_ *= loA; B_ = hiA * B_ + hiB; A_ *= hiA; }
        if (hf == 0) { typedef float f32x2t __attribute__((ext_vector_type(2))); *(GAS f32x2t*)(F.TS() + ((size_t)tt * 512 + gj) * 2) = (f32x2t){A_, B_}; }
    }
}
__device__ __forceinline__ void p2a_conv_item(Frame& F, int l, int item) {
    const int tt = item / 3, g = item % 3, row0 = tt * 32, ch = 256 * g + 4 * F.lane, col = ch < 512 ? PC_XS + ch : PC_B + (ch - 512);
    const GAS float* cw = F.in[I_CBW] + l * 4 * 768 + ch; const f32x4 w0 = *(const GAS f32x4*)cw, w1 = *(const GAS f32x4*)(cw + 768), w2 = *(const GAS f32x4*)(cw + 1536), w3 = *(const GAS f32x4*)(cw + 2304), cb = *(const GAS f32x4*)(F.in[I_CBB] + l * 768 + ch);
    const GAS bf16* src = F.BIG() + (size_t)row0 * NPJ + col;
    const bool first = (row0 % SEQ) == 0;
    f32x4 p3 = {0.f, 0.f, 0.f, 0.f}, p2 = p3, p1 = p3;
    auto ld4 = [](const GAS bf16* p) { const u32x2 w = *(const GAS u32x2*)p; return (f32x4){bflo(w.x), bfhi(w.x), bflo(w.y), bfhi(w.y)}; };
    if (!first) { p3 = ld4(src - 3 * NPJ); p2 = ld4(src - 2 * NPJ); p1 = ld4(src - NPJ); }
#pragma unroll 4
    for (int t = 0; t < 32; ++t) { const f32x4 cur = ld4(src + (size_t)t * NPJ); const f32x4 y = w0 * p3 + w1 * p2 + w2 * p1 + w3 * cur + cb;
        u32x2 w; w.x = pk2(fsilu(y[0]), fsilu(y[1])); w.y = pk2(fsilu(y[2]), fsilu(y[3])); *(GAS u32x2*)(F.XA() + (size_t)(row0 + t) * 768 + ch) = w; p3 = p2; p2 = p1; p1 = cur; }
    if ((row0 + 32) % SEQ == 0) { const int b = row0 / SEQ; GAS float* o = F.out + O_SCP + ((size_t)(l * 8 + b) * 3) * 768 + ch; *(GAS f32x4*)o = p3; *(GAS f32x4*)(o + 768) = p2; *(GAS f32x4*)(o + 1536) = p1; }
}
__device__ __forceinline__ void p2a_pb_item(Frame& F, int l, int item) {
#pragma unroll
    for (int rr = 0; rr < 8; ++rr) { const int row = 8 * item + rr;
        if (row < MREAL) { const GAS float* s = (row < MPR) ? F.in[I_PP] + ((size_t)l * MPR + row) * PLE : F.in[I_PS] + ((size_t)l * MSM + row - MPR) * PLE;
            const f32x4 v = ((const GAS f32x4*)s)[F.lane]; u32x2 w; w.x = pk2(v[0], v[1]); w.y = pk2(v[2], v[3]); ((GAS u32x2*)(F.PB() + (size_t)row * PLE))[F.lane] = w; } }
}
__device__ __forceinline__ void p2a_phase(Frame& F, int l) {
    const int gw = F.bx * 8 + F.wave, NGW = F.G * 8;
    constexpr int N_RG = (MPR / 32) * 8, N_CV = (MPR / 32) * 3, N_PB = MP / 8;
#pragma nounroll
    for (int it = gw; it < N_RG + N_CV + N_PB; it += NGW) {
        if (it < N_RG) p2a_rg_item(F, l, it);
        else if (it < N_RG + N_CV) p2a_conv_item(F, l, it - N_RG);
        else p2a_pb_item(F, l, it - N_RG - N_CV);
    }
}

__device__ __forceinline__ void rg_scan_role(Frame& F, int l, int rid) {
    const int b = rid >> 3, h = rid & 7, lane = F.lane, w = F.wave, gj = 64 * h + lane;
    LAS float* sA = (LAS float*)F.lds; LAS float* sB = sA + 512;
    const size_t rb = (size_t)b * SEQ + 256 * w;
    const GAS bf16* la = F.LA() + rb * 512 + gj; const GAS bf16* bb = F.BB() + rb * 512 + gj;
    float A = 1.f, B = 0.f;
#pragma nounroll
    for (int t = 0; t < 256; t += 8) { float av[8], bv[8];
#pragma unroll
        for (int k = 0; k < 8; ++k) { av[k] = bf2f(la[(size_t)(t + k) * 512]); bv[k] = bf2f(bb[(size_t)(t + k) * 512]); }
#pragma unroll
        for (int k = 0; k < 8; ++k) { const float a = fexp(av[k]); B = a * B + bv[k]; A *= a; } }
    sA[w * 64 + lane] = A; sB[w * 64 + lane] = B;
    WG_BARRIER();
    float hh = 0.f;
    for (int q = 0; q < w; ++q) hh = sA[q * 64 + lane] * hh + sB[q * 64 + lane];
    GAS bf16* pr = F.BIG() + rb * NPJ;
#pragma nounroll
    for (int t = 0; t < 256; t += 8) { float av[8], bv[8], gv[8];
#pragma unroll
        for (int k = 0; k < 8; ++k) { av[k] = bf2f(la[(size_t)(t + k) * 512]); bv[k] = bf2f(bb[(size_t)(t + k) * 512]); gv[k] = bf2f(pr[(size_t)(t + k) * NPJ + PC_AG + gj]); }
#pragma unroll
        for (int k = 0; k < 8; ++k) { hh = fexp(av[k]) * hh + bv[k]; pr[(size_t)(t + k) * NPJ + PC_AX + gj] = f2bf(hh * gv[k]); } }
    if (w == 7) F.out[O_RHP + (size_t)(l * 8 + b) * 512 + gj] = hh;
    WG_BARRIER();
}

__device__ __forceinline__ void rg_apply_role(Frame& F, int l, int rid, int nrole) {
    typedef float f32x2t __attribute__((ext_vector_type(2)));
#pragma nounroll
    for (int bh = rid; bh < 64; bh += nrole) { const int b = bh >> 3, h = bh & 7, lane = F.lane, w = F.wave, gj = 64 * h + lane;
        float hh = 0.f;
        for (int q0 = 0; q0 < 8 * w; q0 += 8) { f32x2t ab[8];
#pragma unroll
            for (int k = 0; k < 8; ++k) ab[k] = *(const GAS f32x2t*)(F.TS() + ((size_t)(64 * b + q0 + k) * 512 + gj) * 2);
#pragma unroll
            for (int k = 0; k < 8; ++k) hh = ab[k].x * hh + ab[k].y; }
        const size_t rb = (size_t)b * SEQ + 256 * w;
        GAS bf16* pr = F.BIG() + rb * NPJ;
#pragma nounroll
        for (int t0 = 0; t0 < 256; t0 += 32) { float av[32], bv[32], gv[32]; u32x4 lw[4], bw_[4];
            const size_t to = (((rb + t0) >> 5) * 4 * 512 + gj) * 8;
#pragma unroll
            for (int g = 0; g < 4; ++g) { lw[g] = *(const GAS u32x4*)(F.LA() + to + (size_t)g * 512 * 8); bw_[g] = *(const GAS u32x4*)(F.BB() + to + (size_t)g * 512 * 8); }
#pragma unroll
            for (int k = 0; k < 32; ++k) gv[k] = bf2f(pr[(size_t)(t0 + k) * NPJ + PC_AG + gj]);
#pragma unroll
            for (int g = 0; g < 4; ++g) { const unsigned lws[4] = {lw[g].x, lw[g].y, lw[g].z, lw[g].w}, bws[4] = {bw_[g].x, bw_[g].y, bw_[g].z, bw_[g].w};
#pragma unroll
                for (int j = 0; j < 4; ++j) { av[8 * g + 2 * j] = bflo(lws[j]); av[8 * g + 2 * j + 1] = bfhi(lws[j]); bv[8 * g + 2 * j] = bflo(bws[j]); bv[8 * g + 2 * j + 1] = bfhi(bws[j]); } }
#pragma unroll
            for (int k = 0; k < 32; ++k) { hh = fexp(av[k]) * hh + bv[k]; gv[k] = hh * gv[k]; }
#pragma unroll
            for (int k = 0; k < 32; ++k) pr[(size_t)(t0 + k) * NPJ + PC_AX + gj] = f2bf(gv[k]); }
        if (w == 7) F.out[O_RHP + (size_t)(l * 8 + b) * 512 + gj] = hh; }
}

constexpr int SLD = 136;
__device__ __forceinline__ void ssd_role(Frame& F, int l, int rid) {
    const int b = rid >> 3, h = rid & 7, tid = F.tid, lane = F.lane, w = F.wave, r = lane & 31, hf = lane >> 5;
    LAS bf16* sC = (LAS bf16*)F.lds; LAS bf16* sBG = sC + 128 * SLD; LAS bf16* sBw = sBG + 128 * SLD; LAS bf16* sXT = sBw + 128 * SLD; LAS bf16* sS = sXT + 64 * SLD;
    LAS float* sCum = (LAS float*)(sS + 64 * SLD); LAS float* sDt = sCum + 128; LAS float* sW = sDt + 128; LAS float* sEc = sW + 128; LAS float* sTmp = sEc + 128;
    const float a_neg = -__expf(F.in[I_ALOG][l * 8 + h]), dtb = F.in[I_DTB][l * 8 + h], Dh = F.in[I_SSD_D][l * 8 + h];
    f32x16 accS;
#ifdef DBG_SSD2
    unsigned mism = 0;
#pragma nounroll
    for (int rep = 0; rep < 2; ++rep) {
#endif
#pragma unroll
    for (int q = 0; q < 16; ++q) accS[q] = 0.f;
    for (int e = tid; e < 64 * SLD; e += 512) sS[e] = 0;
    WG_BARRIER();
#pragma nounroll
    for (int c = 0; c < 16; ++c) {
        const size_t row0 = (size_t)b * SEQ + 128 * c;
#pragma unroll
        for (int i = 0; i < 4; ++i) { const int rr = (tid >> 4) + 32 * i, ck = tid & 15; const GAS bf16* src = F.XA() + (row0 + rr) * 768 + 512 + 8 * ck;
            *(LAS u32x4*)(sBG + rr * SLD + 8 * ck) = *(const GAS u32x4*)src; *(LAS u32x4*)(sC + rr * SLD + 8 * ck) = *(const GAS u32x4*)(src + 128); }
        if (w == 0) { const int t0 = 2 * lane; const float d0 = fsoftplus(F.DT()[(row0 + t0) * 8 + h] + dtb), d1 = fsoftplus(F.DT()[(row0 + t0 + 1) * 8 + h] + dtb);
            const float a0 = d0 * a_neg, a1 = d1 * a_neg; float s = a0 + a1;
#pragma unroll
            for (int o = 1; o < 64; o <<= 1) { const float v = bperm(s, lane - o); if (lane >= o) s += v; }
            const float c1 = s, c0 = s - a1, last = __int_as_float(__builtin_amdgcn_readlane(__float_as_int(s), 63));
            sCum[t0] = c0; sCum[t0 + 1] = c1; sEc[t0] = fexp(c0); sEc[t0 + 1] = fexp(c1); sW[t0] = fexp(last - c0) * d0; sW[t0 + 1] = fexp(last - c1) * d1; sDt[t0] = d0; sDt[t0 + 1] = d1;
            if (lane == 0) sTmp[0] = fexp(last); }
        WG_BARRIER();
        { const int s = tid & 127, pg = tid >> 7; const GAS bf16* src = F.XA() + (row0 + s) * 768;
            const u32x4 x0 = *(const GAS u32x4*)(src + 64 * h + 16 * pg), x1 = *(const GAS u32x4*)(src + 64 * h + 16 * pg + 8);
            const unsigned xw[8] = {x0.x, x0.y, x0.z, x0.w, x1.x, x1.y, x1.z, x1.w};
#pragma unroll
            for (int j = 0; j < 8; ++j) { sXT[(16 * pg + 2 * j) * SLD + s] = (bf16)(xw[j] & 0xffffu); sXT[(16 * pg + 2 * j + 1) * SLD + s] = (bf16)(xw[j] >> 16); }
            const float ws = sW[s];
#pragma unroll
            for (int q4 = 0; q4 < 4; ++q4) { const u32x4 bq = *(const GAS u32x4*)(src + 512 + 32 * pg + 8 * q4); const unsigned bw[4] = {bq.x, bq.y, bq.z, bq.w};
#pragma unroll
                for (int j = 0; j < 4; ++j) { const int n = 32 * pg + 8 * q4 + 2 * j; sBw[n * SLD + s] = f2bf(bflo(bw[j]) * ws); sBw[(n + 1) * SLD + s] = f2bf(bfhi(bw[j]) * ws); } } }
#if DBG_V == 1
        WG_BARRIER();
#endif
        f32x16 cbv[2];
#pragma unroll
        for (int q = 0; q < 2; ++q) { const int blk = 2 * w + q, tb = blk >> 2, sb = blk & 3; f32x16 a_;
#pragma unroll
            for (int z = 0; z < 16; ++z) a_[z] = 0.f;
            if (sb <= tb) {
#pragma unroll
                for (int ks = 0; ks < 8; ++ks) { const bf16x8 a = *(const LAS bf16x8*)(sC + (32 * tb + r) * SLD + 16 * ks + 8 * hf), bb = *(const LAS bf16x8*)(sBG + (32 * sb + r) * SLD + 16 * ks + 8 * hf); a_ = mfma32(a, bb, a_); } }
            cbv[q] = a_; }
        const int tby = w >> 1, pb = w & 1;
        f32x16 y;
#pragma unroll
        for (int z = 0; z < 16; ++z) y[z] = 0.f;
#pragma unroll
        for (int ks = 0; ks < 8; ++ks) { const bf16x8 a = *(const LAS bf16x8*)(sC + (32 * tby + r) * SLD + 16 * ks + 8 * hf), bs = *(const LAS bf16x8*)(sS + (32 * pb + r) * SLD + 16 * ks + 8 * hf); y = mfma32(a, bs, y); }
        WG_BARRIER();
#pragma unroll
        for (int q = 0; q < 2; ++q) { const int blk = 2 * w + q, tb = blk >> 2, sb = blk & 3;
            if (sb <= tb) { const int s_ = 32 * sb + r; const float cs = sCum[s_], ds = sDt[s_];
#pragma unroll
                for (int z = 0; z < 16; ++z) { const int t = 32 * tb + rowoff(z, hf); const float gv = (s_ <= t) ? cbv[q][z] * fexp(sCum[t] - cs) * ds : 0.f; sBG[t * SLD + s_] = f2bf(gv); } } }
#pragma unroll
        for (int z = 0; z < 16; ++z) y[z] *= sEc[32 * tby + rowoff(z, hf)];
        WG_BARRIER();
        for (int ks = 0; ks < 2 * (tby + 1); ++ks) { const bf16x8 a = *(const LAS bf16x8*)(sBG + (32 * tby + r) * SLD + 16 * ks + 8 * hf), bx = *(const LAS bf16x8*)(sXT + (32 * pb + r) * SLD + 16 * ks + 8 * hf); y = mfma32(a, bx, y); }
        { const int p = 32 * pb + r, col = 64 * h + p;
#pragma unroll
            for (int z = 0; z < 16; ++z) { const int t = 32 * tby + rowoff(z, hf); GAS bf16* pr = F.BIG() + (row0 + t) * NPJ;
                const float yv = y[z] + Dh * bf2f(sXT[p * SLD + t]); const float yg = yv * bf2f(pr[PC_BZ + col]);
#ifdef DBG_SSD2
                if (rep == 1) { if (l == 1 && pr[PC_XS + col] != f2bf(yg)) ++mism; } else
#endif
                pr[PC_XS + col] = f2bf(yg);
                const float ss = sum32(yg * yg);
                if (r == 0) F.SSDP()[(row0 + t) * 16 + 2 * h + pb] = ss; } }
#if DBG_V == 2
        WG_BARRIER();
#endif
        { const int pbs = w >> 2, nb = w & 3; const float dec = sTmp[0];
#pragma unroll
            for (int z = 0; z < 16; ++z) accS[z] *= dec;
#pragma unroll
            for (int ks = 0; ks < 8; ++ks) { const bf16x8 a = *(const LAS bf16x8*)(sXT + (32 * pbs + r) * SLD + 16 * ks + 8 * hf), bw = *(const LAS bf16x8*)(sBw + (32 * nb + r) * SLD + 16 * ks + 8 * hf); accS = mfma32(a, bw, accS); }
#pragma unroll
            for (int z = 0; z < 16; ++z) sS[(32 * pbs + rowoff(z, hf)) * SLD + 32 * nb + r] = f2bf(accS[z]); }
        WG_BARRIER();
    }
#ifdef DBG_SSD2
    }
    { const float mt = wave_sum((float)mism); if (lane == 0 && l == 1) F.out[(size_t)(16000 + rid * 8 + w) * DM] = 1000.f * mt; }
#endif
    { const int pbs = w >> 2, nb = w & 3; GAS float* o = F.out + O_SSP + ((size_t)(l * 8 + b) * 8 + h) * 64 * 128;
#pragma unroll
        for (int z = 0; z < 16; ++z) o[(32 * pbs + rowoff(z, hf)) * 128 + 32 * nb + r] = accS[z]; }
}


__device__ __forceinline__ void ssd_role2(Frame& F, int l, int rid) {
    const int b = rid >> 4, h = (rid >> 1) & 7, ph = rid & 1, tid = F.tid, lane = F.lane, w = F.wave, r = lane & 31, hf = lane >> 5;
    LAS bf16* sC = (LAS bf16*)F.lds; LAS bf16* sBG = sC + 128 * SLD; LAS bf16* sBw = sBG + 128 * SLD; LAS bf16* sXT = sBw + 128 * SLD; LAS bf16* sS = sXT + 32 * SLD;
    LAS float* sCum = (LAS float*)(sS + 32 * SLD); LAS float* sDt = sCum + 128; LAS float* sW = sDt + 128; LAS float* sEc = sW + 128; LAS float* sTmp = sEc + 128;
    const float a_neg = -__expf(F.in[I_ALOG][l * 8 + h]), dtb = F.in[I_DTB][l * 8 + h], Dh = F.in[I_SSD_D][l * 8 + h];
    const int pcol = 64 * h + 32 * ph;
    f32x16 accS;
#pragma unroll
    for (int q = 0; q < 16; ++q) accS[q] = 0.f;
    for (int e = tid; e < 32 * SLD; e += 512) sS[e] = 0;
    WG_BARRIER();
#pragma nounroll
    for (int c = 0; c < 16; ++c) {
        const size_t row0 = (size_t)b * SEQ + 128 * c;
#pragma unroll
        for (int i = 0; i < 4; ++i) { const int rr = (tid >> 4) + 32 * i, ck = tid & 15; const GAS bf16* src = F.XA() + (row0 + rr) * 768 + 512 + 8 * ck;
            *(LAS u32x4*)(sBG + rr * SLD + 8 * ck) = *(const GAS u32x4*)src; *(LAS u32x4*)(sC + rr * SLD + 8 * ck) = *(const GAS u32x4*)(src + 128); }
        if (w == 0) { const int t0 = 2 * lane; const float d0 = fsoftplus(F.DT()[(row0 + t0) * 8 + h] + dtb), d1 = fsoftplus(F.DT()[(row0 + t0 + 1) * 8 + h] + dtb);
            const float a0 = d0 * a_neg, a1 = d1 * a_neg; float s_ = a0 + a1;
#pragma unroll
            for (int o = 1; o < 64; o <<= 1) { const float v = bperm(s_, lane - o); if (lane >= o) s_ += v; }
            const float c1 = s_, c0 = s_ - a1, last = __int_as_float(__builtin_amdgcn_readlane(__float_as_int(s_), 63));
            sCum[t0] = c0; sCum[t0 + 1] = c1; sEc[t0] = fexp(c0); sEc[t0 + 1] = fexp(c1); sW[t0] = fexp(last - c0) * d0; sW[t0 + 1] = fexp(last - c1) * d1; sDt[t0] = d0; sDt[t0 + 1] = d1;
            if (lane == 0) sTmp[0] = fexp(last); }
        WG_BARRIER();
        { const int s_ = tid & 127, pg = tid >> 7; const GAS bf16* src = F.XA() + (row0 + s_) * 768;
            const u32x4 x0 = *(const GAS u32x4*)(src + pcol + 8 * pg); const unsigned xw[4] = {x0.x, x0.y, x0.z, x0.w};
#pragma unroll
            for (int j = 0; j < 4; ++j) { sXT[(8 * pg + 2 * j) * SLD + s_] = (bf16)(xw[j] & 0xffffu); sXT[(8 * pg + 2 * j + 1) * SLD + s_] = (bf16)(xw[j] >> 16); }
            const float ws_ = sW[s_];
#pragma unroll
            for (int q4 = 0; q4 < 4; ++q4) { const u32x4 bq = *(const GAS u32x4*)(src + 512 + 32 * pg + 8 * q4); const unsigned bw[4] = {bq.x, bq.y, bq.z, bq.w};
#pragma unroll
                for (int j = 0; j < 4; ++j) { const int n = 32 * pg + 8 * q4 + 2 * j; sBw[n * SLD + s_] = f2bf(bflo(bw[j]) * ws_); sBw[(n + 1) * SLD + s_] = f2bf(bfhi(bw[j]) * ws_); } } }
        f32x16 cbv[2];
#pragma unroll
        for (int q = 0; q < 2; ++q) { const int blk = 2 * w + q, tb = blk >> 2, sb = blk & 3; f32x16 a_;
#pragma unroll
            for (int z = 0; z < 16; ++z) a_[z] = 0.f;
            if (sb <= tb) {
#pragma unroll
                for (int ks = 0; ks < 8; ++ks) { const bf16x8 a = *(const LAS bf16x8*)(sC + (32 * tb + r) * SLD + 16 * ks + 8 * hf), bb = *(const LAS bf16x8*)(sBG + (32 * sb + r) * SLD + 16 * ks + 8 * hf); a_ = mfma32(a, bb, a_); } }
            cbv[q] = a_; }
        f32x16 y;
#pragma unroll
        for (int z = 0; z < 16; ++z) y[z] = 0.f;
        if (w < 4) {
#pragma unroll
            for (int ks = 0; ks < 8; ++ks) { const bf16x8 a = *(const LAS bf16x8*)(sC + (32 * w + r) * SLD + 16 * ks + 8 * hf), bs = *(const LAS bf16x8*)(sS + r * SLD + 16 * ks + 8 * hf); y = mfma32(a, bs, y); } }
        WG_BARRIER();
#pragma unroll
        for (int q = 0; q < 2; ++q) { const int blk = 2 * w + q, tb = blk >> 2, sb = blk & 3;
            if (sb <= tb) { const int s_ = 32 * sb + r; const float cs = sCum[s_], ds = sDt[s_];
#pragma unroll
                for (int z = 0; z < 16; ++z) { const int t = 32 * tb + rowoff(z, hf); const float gv = (s_ <= t) ? cbv[q][z] * fexp(sCum[t] - cs) * ds : 0.f; sBG[t * SLD + s_] = f2bf(gv); } } }
        if (w < 4) {
#pragma unroll
            for (int z = 0; z < 16; ++z) y[z] *= sEc[32 * w + rowoff(z, hf)]; }
        WG_BARRIER();
        if (w < 4) {
            for (int ks = 0; ks < 2 * (w + 1); ++ks) { const bf16x8 a = *(const LAS bf16x8*)(sBG + (32 * w + r) * SLD + 16 * ks + 8 * hf), bx = *(const LAS bf16x8*)(sXT + r * SLD + 16 * ks + 8 * hf); y = mfma32(a, bx, y); }
            const int col = pcol + r;
#pragma unroll
            for (int z = 0; z < 16; ++z) { const int t = 32 * w + rowoff(z, hf); GAS bf16* pr = F.BIG() + (row0 + t) * NPJ;
                const float yv = y[z] + Dh * bf2f(sXT[r * SLD + t]); const float yg = yv * bf2f(pr[PC_BZ + col]); pr[PC_XS + col] = f2bf(yg);
                const float ss = sum32(yg * yg);
                if (r == 0) F.SSDP()[(row0 + t) * 16 + 2 * h + ph] = ss; }
        } else { const int nb = w - 4; const float dec = sTmp[0];
#pragma unroll
            for (int z = 0; z < 16; ++z) accS[z] *= dec;
#pragma unroll
            for (int ks = 0; ks < 8; ++ks) { const bf16x8 a = *(const LAS bf16x8*)(sXT + r * SLD + 16 * ks + 8 * hf), bw = *(const LAS bf16x8*)(sBw + (32 * nb + r) * SLD + 16 * ks + 8 * hf); accS = mfma32(a, bw, accS); }
#pragma unroll
            for (int z = 0; z < 16; ++z) sS[rowoff(z, hf) * SLD + 32 * nb + r] = f2bf(accS[z]); }
        WG_BARRIER();
    }
    if (w >= 4) { const int nb = w - 4; GAS float* o = F.out + O_SSP + ((size_t)(l * 8 + b) * 8 + h) * 64 * 128;
#pragma unroll
        for (int z = 0; z < 16; ++z) o[(32 * ph + rowoff(z, hf)) * 128 + 32 * nb + r] = accS[z]; }
}

constexpr int HLD = 72;
template <bool DRY> __device__ __forceinline__ void hgrn_role(Frame& F, int l, int rid) {
    const int b = rid >> 3, h = rid & 7, tid = F.tid, lane = F.lane, w = F.wave, r = lane & 31, hf = lane >> 5;
    LAS bf16* sQe = (LAS bf16*)F.lds; LAS bf16* sKe = sQe + 64 * HLD; LAS bf16* sQb = sKe + 64 * HLD; LAS bf16* sKdT = sQb + 64 * HLD; LAS bf16* sVT = sKdT + 64 * HLD; LAS bf16* sAtt = sVT + 64 * HLD; LAS bf16* sST = sAtt + 64 * HLD;
    LAS float* sO = (LAS float*)(sST + 64 * HLD); LAS float* sPart = sO + 64 * 68; LAS float* sBl = sPart + 512;
    f32x16 accS;
#pragma unroll
    for (int q = 0; q < 16; ++q) accS[q] = 0.f;
    for (int e = tid; e < 64 * HLD; e += 512) sST[e] = 0;
    WG_BARRIER();
    const int d = lane, col = 64 * h + d;
#pragma nounroll
    for (int c = 0; c < 32; ++c) {
        const size_t row0 = (size_t)b * SEQ + 64 * c;
        float q[8], lf[8], v[8], bc[8];
#pragma unroll
        for (int i = 0; i < 8; ++i) { const GAS bf16* pr = F.BIG() + (row0 + 8 * w + i) * NPJ; q[i] = bf2f(pr[PC_CQ + col]); lf[i] = bf2f(pr[PC_CF + col]); v[i] = bf2f(pr[PC_CI + col]); }
        float run = 0.f;
#pragma unroll
        for (int i = 0; i < 8; ++i) { run += lf[i]; bc[i] = run; }
        sPart[w * 64 + d] = run;
        WG_BARRIER();
        float pre = 0.f, bm = 0.f, bl = 0.f;
#pragma unroll
        for (int q8 = 0; q8 < 8; ++q8) { const float pv = sPart[q8 * 64 + d]; if (q8 < w) pre += pv; if (q8 < 4) bm += pv; bl += pv; }
        unsigned kdw[4], vw[4];
#pragma unroll
        for (int i = 0; i < 8; i += 2) { float kd2[2];
#pragma unroll
            for (int u = 0; u < 2; ++u) { const int ii = i + u; const float bt = pre + bc[ii]; const float k = fnegexpm1(lf[ii]);
                const float e1 = fexp(fminf(fmaxf(bt - bm, -80.f), 80.f)), e2 = fexp(fminf(fmaxf(bm - bt, -80.f), 80.f));
                const int t = 8 * w + ii; sQe[t * HLD + d] = f2bf(q[ii] * e1); sKe[t * HLD + d] = f2bf(k * e2); sQb[t * HLD + d] = f2bf(q[ii] * fexp(bt)); kd2[u] = k * fexp(bl - bt); }
            kdw[i >> 1] = pk2(kd2[0], kd2[1]); vw[i >> 1] = pk2(v[i], v[i + 1]); }
        *(LAS u32x4*)(sKdT + d * HLD + 8 * w) = (u32x4){kdw[0], kdw[1], kdw[2], kdw[3]};
        *(LAS u32x4*)(sVT + d * HLD + 8 * w) = (u32x4){vw[0], vw[1], vw[2], vw[3]};
        if (w == 0) sBl[d] = fexp(bl);
        WG_BARRIER();
        f32x16 o;
#pragma unroll
        for (int z = 0; z < 16; ++z) o[z] = 0.f;
        const int tb = (w >> 1) & 1, eb = w & 1;
        if (w < 4) {
#pragma unroll
            for (int ks = 0; ks < 4; ++ks) { const bf16x8 a = *(const LAS bf16x8*)(sQb + (32 * tb + r) * HLD + 16 * ks + 8 * hf), bs = *(const LAS bf16x8*)(sST + (32 * eb + r) * HLD + 16 * ks + 8 * hf); o = mfma32(a, bs, o); }
        } else if (w < 7) { const int blk = w - 4, tba = blk == 0 ? 0 : 1, sba = blk == 2 ? 1 : 0;
#pragma unroll
            for (int ks = 0; ks < 4; ++ks) { const bf16x8 a = *(const LAS bf16x8*)(sQe + (32 * tba + r) * HLD + 16 * ks + 8 * hf), bk = *(const LAS bf16x8*)(sKe + (32 * sba + r) * HLD + 16 * ks + 8 * hf); o = mfma32(a, bk, o); }
#pragma unroll
            for (int z = 0; z < 16; ++z) { const int t = 32 * tba + rowoff(z, hf), s_ = 32 * sba + r; sAtt[t * HLD + s_] = f2bf((s_ <= t) ? o[z] : 0.f); }
        }
        WG_BARRIER();
        if (w < 4) {
            for (int ks = 0; ks < 2 * (tb + 1); ++ks) { const bf16x8 a = *(const LAS bf16x8*)(sAtt + (32 * tb + r) * HLD + 16 * ks + 8 * hf), bv = *(const LAS bf16x8*)(sVT + (32 * eb + r) * HLD + 16 * ks + 8 * hf); o = mfma32(a, bv, o); }
#pragma unroll
            for (int z = 0; z < 16; ++z) sO[(32 * tb + rowoff(z, hf)) * 68 + 32 * eb + r] = o[z];
        } else { const int db = (w >> 1) & 1;
#pragma unroll
            for (int z = 0; z < 16; ++z) accS[z] *= sBl[32 * db + rowoff(z, hf)];
#pragma unroll
            for (int ks = 0; ks < 4; ++ks) { const bf16x8 a = *(const LAS bf16x8*)(sKdT + (32 * db + r) * HLD + 16 * ks + 8 * hf), bv = *(const LAS bf16x8*)(sVT + (32 * eb + r) * HLD + 16 * ks + 8 * hf); accS = mfma32(a, bv, accS); }
#pragma unroll
            for (int z = 0; z < 16; ++z) sST[(32 * eb + r) * HLD + 32 * db + rowoff(z, hf)] = f2bf(accS[z]);
        }
        WG_BARRIER();
        { const int t = tid >> 3, eg = tid & 7; const f32x4 o0 = *(const LAS f32x4*)(sO + t * 68 + 8 * eg), o1 = *(const LAS f32x4*)(sO + t * 68 + 8 * eg + 4);
            float ss = (o0[0] * o0[0] + o0[1] * o0[1]) + (o0[2] * o0[2] + o0[3] * o0[3]) + (o1[0] * o1[0] + o1[1] * o1[1]) + (o1[2] * o1[2] + o1[3] * o1[3]);
            ss += swz_xor<1>(ss); ss += swz_xor<2>(ss); ss += swz_xor<4>(ss);
            const float rs = __builtin_amdgcn_rsqf(ss * (1.f / 64.f) + EPS);
            GAS bf16* pr = F.BIG() + (row0 + t) * NPJ; const u32x4 gz = *(const GAS u32x4*)(pr + PC_CG + 64 * h + 8 * eg);
            const f32x4 n0 = *(const GAS f32x4*)(F.in[I_HNORM] + l * 64 + 8 * eg), n1 = *(const GAS f32x4*)(F.in[I_HNORM] + l * 64 + 8 * eg + 4);
            u32x4 ow; ow.x = pk2(o0[0] * rs * n0[0] * bflo(gz.x), o0[1] * rs * n0[1] * bfhi(gz.x)); ow.y = pk2(o0[2] * rs * n0[2] * bflo(gz.y), o0[3] * rs * n0[3] * bfhi(gz.y));
            ow.z = pk2(o1[0] * rs * n1[0] * bflo(gz.z), o1[1] * rs * n1[1] * bfhi(gz.z)); ow.w = pk2(o1[2] * rs * n1[2] * bflo(gz.w), o1[3] * rs * n1[3] * bfhi(gz.w));
            if (DRY) *(GAS u32x4*)(F.HB() + (size_t)(row0 + t) * DM + 64 * h + 8 * eg) = ow; else *(GAS u32x4*)(pr + PC_CQ + 64 * h + 8 * eg) = ow; }
    }
    if (w >= 4 && !DRY) { const int db = (w >> 1) & 1, eb = w & 1; GAS float* o = F.out + O_HSP + ((size_t)(l * 8 + b) * 8 + h) * 64 * 64;
#pragma unroll
        for (int z = 0; z < 16; ++z) o[(32 * db + rowoff(z, hf)) * 64 + 32 * eb + r] = accS[z]; }
    WG_BARRIER();
}

#ifndef SAMPLE_MASK
#define SAMPLE_MASK 7
#endif
__device__ __forceinline__ void sample_role(Frame& F, int l, int rid, int nrole) {
    const int tid = F.tid, lane = F.lane, w = F.wave;
    LAS float* sXa = (LAS float*)F.lds; LAS float* sX = sXa + 512; LAS float* sQ = sX + 768; LAS float* sFd = sQ + 512; LAS float* sK = sFd + 512; LAS float* sDt = sK + 512; LAS float* sY = sDt + 32;
#pragma nounroll
    for (int i = rid; i < MSM; i += nrole) { const size_t row = (size_t)MPR + i; GAS bf16* pr = F.BIG() + row * NPJ;
        { const int c = tid; const GAS float* st = F.in[I_SRC] + ((size_t)(l * MSM + i) * 3) * 512 + c; const float b0 = st[0], b1 = st[512], b2 = st[1024], cur = bf2f(pr[PC_AX + c]);
            const GAS float* cw = F.in[I_CAW] + l * 4 * 512; sXa[c] = cw[c] * b0 + cw[512 + c] * b1 + cw[1024 + c] * b2 + cw[1536 + c] * cur + F.in[I_CAB][l * 512 + c];
            GAS float* o = F.out + O_RCS + ((size_t)(l * MSM + i) * 3) * 512 + c; o[0] = b1; o[512] = b2; o[1024] = cur; }
        for (int ch = tid; ch < 768; ch += 512) { const int col = ch < 512 ? PC_XS + ch : PC_B + (ch - 512);
            const GAS float* st = F.in[I_SSC] + ((size_t)(l * MSM + i) * 3) * 768 + ch; const float b0 = st[0], b1 = st[768], b2 = st[1536], cur = bf2f(pr[col]);
            const GAS float* cw = F.in[I_CBW] + l * 4 * 768; sX[ch] = fsilu(cw[ch] * b0 + cw[768 + ch] * b1 + cw[1536 + ch] * b2 + cw[2304 + ch] * cur + F.in[I_CBB][l * 768 + ch]);
            GAS float* o = F.out + O_SCS + ((size_t)(l * MSM + i) * 3) * 768 + ch; o[0] = b1; o[768] = b2; o[1536] = cur; }
        { const int c = tid; sQ[c] = bf2f(pr[PC_CQ + c]); const float lf = bf2f(pr[PC_CF + c]); sFd[c] = fexp(lf); sK[c] = fnegexpm1(lf); }
        if (tid < 8) { const float dtv = fsoftplus(F.DT()[row * 8 + tid] + F.in[I_DTB][l * 8 + tid]); sDt[tid] = dtv; sDt[8 + tid] = fexp(-dtv * __expf(F.in[I_ALOG][l * 8 + tid])); }
        WG_BARRIER();
        if (SAMPLE_MASK & 1) { const int c = tid, hh = c >> 6, j = c & 63; const GAS float* wa = F.in[I_WA] + ((size_t)(l * 8 + hh) * 64) * 64 + j; const GAS float* wx = F.in[I_WX] + ((size_t)(l * 8 + hh) * 64) * 64 + j;
            float ar = 0.f, ai = 0.f;
#pragma unroll 32
            for (int q = 0; q < 64; ++q) { const float xv = sXa[64 * hh + q]; ar += xv * wa[q * 64]; ai += xv * wx[q * 64]; }
            const float rr = fsigmoid(ar + F.in[I_BA][l * 512 + c]), ii = fsigmoid(ai + F.in[I_BX][l * 512 + c]), la = -8.f * fsoftplus(-F.in[I_LAM][l * 512 + c]) * rr;
            const float a = fexp(la), mult = __builtin_amdgcn_sqrtf(fmaxf(fnegexpm1(2.f * la), 0.f));
            const float hn = a * F.in[I_SRH][(size_t)(l * MSM + i) * 512 + c] + mult * ii * sXa[c];
            F.out[O_RHS + (size_t)(l * MSM + i) * 512 + c] = hn; pr[PC_AX + c] = f2bf(hn * bf2f(pr[PC_AG + c])); }
#ifdef DBG_BAR
        asm volatile("s_waitcnt vmcnt(0) lgkmcnt(0)" ::: "memory");
#endif
        if (SAMPLE_MASK & 2) { const int hh = w, half = lane >> 5, ln = lane & 31, n0 = 4 * ln; const float dA = sDt[8 + hh], dtv = sDt[hh], Dh = F.in[I_SSD_D][l * 8 + hh];
            const f32x4 Bn = *(const LAS f32x4*)(sX + 512 + n0), Cn = *(const LAS f32x4*)(sX + 640 + n0);
            const GAS float* sin_ = F.in[I_SSS] + (((size_t)(l * MSM + i) * 8 + hh) * 64) * 128; GAS float* sout = F.out + O_SSS + (((size_t)(l * MSM + i) * 8 + hh) * 64) * 128;
#pragma unroll
            for (int hb_ = 0; hb_ < 2; ++hb_) { f32x4 sv[16];
#pragma unroll
                for (int k = 0; k < 16; ++k) sv[k] = *(const GAS f32x4*)(sin_ + (2 * (16 * hb_ + k) + half) * 128 + n0);
#pragma unroll
                for (int k = 0; k < 16; ++k) { const int p = 2 * (16 * hb_ + k) + half; const float xv = sX[64 * hh + p], xdt = dtv * xv;
                    const f32x4 sn = sv[k] * dA + Bn * xdt; *(GAS f32x4*)(sout + p * 128 + n0) = sn;
                    float yv = (Cn[0] * sn[0] + Cn[1] * sn[1]) + (Cn[2] * sn[2] + Cn[3] * sn[3]);
                    yv = sum32(yv);
                    if (ln == 0) sY[64 * hh + p] = yv + Dh * xv; } }
            { const float yg = sY[64 * hh + lane] * bf2f(pr[PC_BZ + 64 * hh + lane]); pr[PC_XS + 64 * hh + lane] = f2bf(yg);
              const float ssq = wave_sum(yg * yg);
#ifdef DBG_YG
              if (l == 1) { F.out[(size_t)i * DM + 64 * hh + lane] = yg; F.out[(size_t)(128 + i) * DM + 64 * hh + lane] = bf2f(pr[PC_BZ + 64 * hh + lane]); F.out[(size_t)(256 + i) * DM + 64 * hh + lane] = sY[64 * hh + lane]; F.out[(size_t)(384 + i) * DM + 64 * hh + lane] = ssq; }
#endif
              if (lane == 0) { F.SSDP()[row * 16 + 2 * hh] = ssq; F.SSDP()[row * 16 + 2 * hh + 1] = 0.f; } } }
        if (SAMPLE_MASK & 4) { const int hh = w, e = lane; const float vv = bf2f(pr[PC_CI + 64 * hh + e]);
            const GAS float* sin_ = F.in[I_SHG] + (((size_t)(l * MSM + i) * 8 + hh) * 64) * 64 + e; GAS float* sout = F.out + O_HSS + (((size_t)(l * MSM + i) * 8 + hh) * 64) * 64 + e;
            float o = 0.f;
#pragma unroll
            for (int hb_ = 0; hb_ < 2; ++hb_) { float sv[32];
#pragma unroll
                for (int k = 0; k < 32; ++k) sv[k] = sin_[(32 * hb_ + k) * 64];
#pragma unroll
                for (int k = 0; k < 32; ++k) { const int dd = 32 * hb_ + k; const float sn = sFd[64 * hh + dd] * sv[k] + sK[64 * hh + dd] * vv; sout[dd * 64] = sn; o += sQ[64 * hh + dd] * sn; } }
            const float ss = wave_sum(o * o); const float rs = __builtin_amdgcn_rsqf(ss * (1.f / 64.f) + EPS);
            pr[PC_CQ + 64 * hh + e] = f2bf(o * rs * F.in[I_HNORM][l * 64 + e] * bf2f(pr[PC_CG + 64 * hh + e])); }
        WG_BARRIER();
    }
}
__device__ __forceinline__ void p2b_phase(Frame& F, int l) {
    constexpr int N_SSD = 128, N_HG = 64, N_SMP = 32, N_RGA = 32;
#pragma nounroll
    for (int rid = F.bx; rid < 256; rid += F.G) {
        { int t_ = F.tid; asm volatile("" : "+v"(t_)); F.tid = t_; F.lane = t_ & 63; }
        const int kind = rid < N_SSD ? 0 : (rid < N_SSD + N_HG ? 1 : (rid < N_SSD + N_HG + N_SMP ? 2 : 3));
        switch (kind) {
        case 0: ssd_role2(F, l, rid);
#ifdef DBG_REPEAT_SSD
            ssd_role2(F, l, rid);
#endif
            break;
        case 1: hgrn_role<false>(F, l, rid - N_SSD); break;
        case 2: sample_role(F, l, rid - N_SSD - N_HG, N_SMP); break;
        default: rg_apply_role(F, l, rid - N_SSD - N_HG - N_SMP, N_RGA);
#ifdef DBG_REPEAT_RG
            rg_apply_role(F, l, rid - N_SSD - N_HG - N_SMP, N_RGA);
#endif
            break;
        }
    }
}


__device__ __forceinline__ f32x4 sgemm_tile(Frame& F, const GAS bf16* A, int lda, const GAS bf16* Bt, int ldb, int kbeg, int klen, int rb, int cg) {
    const int lane = F.lane, w = F.wave, r = lane & 31, hf = lane >> 5, kw = klen >> 3;
    const GAS bf16* ap = A + (size_t)(MPR + 32 * rb + r) * lda + kbeg + w * kw + 8 * hf;
    const GAS bf16* bp0 = Bt + (size_t)(64 * cg + r) * ldb + kbeg + w * kw + 8 * hf; const GAS bf16* bp1 = bp0 + (size_t)32 * ldb;
    f32x16 a0, a1;
#pragma unroll
    for (int q = 0; q < 16; ++q) { a0[q] = 0.f; a1[q] = 0.f; }
#pragma unroll 4
    for (int k = 0; k < kw; k += 16) { const bf16x8 af = *(const GAS bf16x8*)(ap + k), b0 = *(const GAS bf16x8*)(bp0 + k), b1 = *(const GAS bf16x8*)(bp1 + k); a0 = mfma32(af, b0, a0); a1 = mfma32(af, b1, a1); }
    LAS float* part = (LAS float*)F.lds + w * 2048;
#pragma unroll
    for (int q = 0; q < 16; ++q) { const int row = rowoff(q, hf); part[row * 64 + r] = a0[q]; part[row * 64 + 32 + r] = a1[q]; }
    WG_BARRIER();
    const LAS float* pr_ = (const LAS float*)F.lds + (F.tid >> 4) * 64 + 4 * (F.tid & 15);
    f32x4 v = *(const LAS f32x4*)pr_;
#pragma unroll
    for (int q = 1; q < 8; ++q) v = v + *(const LAS f32x4*)(pr_ + q * 2048);
    WG_BARRIER();
    return v;
}
__device__ __forceinline__ float sum16(float v) { return sum16r(v); }
__device__ __forceinline__ void store_bf4(GAS bf16* p, f32x4 v) { u32x2 w; w.x = pk2(v[0], v[1]); w.y = pk2(v[2], v[3]); *(GAS u32x2*)p = w; }
template <int MODE> __device__ __forceinline__ f32x4 act4(f32x4 v, f32x4 lb) { return (f32x4){act1<MODE>(v[0], lb[0]), act1<MODE>(v[1], lb[1]), act1<MODE>(v[2], lb[2]), act1<MODE>(v[3], lb[3])}; }
__device__ __forceinline__ void sample_p1(Frame& F, int l, int u0) {
    for (int u = u0; u < 4 * (NPJP / 64); u += F.G) { const int rb = u & 3, cg = u >> 2;
        if (64 * cg >= NPJ + 64) continue;
        const f32x4 v = sgemm_tile(F, F.HB(), DM, w_in_t(F.ws, l), DM, 0, DM, rb, cg);
        const int row = MPR + 32 * rb + (F.tid >> 4), col = 64 * cg + 4 * (F.tid & 15); const float rs = rstd16(F.SSQ_MIX(), row); const f32x4 x = v * rs;
        if (col >= NPJ) { if (col < NPJ + 8) *(GAS f32x4*)(F.DT() + (size_t)row * 8 + (col - NPJ)) = x; continue; }
        const int pn = col >> 8; f32x4 o;
        if (pn == 4 || pn == 5 || pn == 9 || pn == 10 || pn == 15 || pn == 16) o = act4<1>(x, x);
        else if (pn == 7 || pn == 8) o = act4<2>(x, x);
        else if (pn == 11 || pn == 12) o = act4<3>(x, *(const GAS f32x4*)(F.LBS() + l * 512 + (col - PC_CF)));
        else o = x;
        store_bf4(F.BIG() + (size_t)row * NPJ + col, o); }
}
__device__ __forceinline__ void sample_p3(Frame& F, int l, int u0) {
    for (int u = u0; u < 4 * (DM / 64); u += F.G) { const int rb = u & 3, cg = u >> 2;
        const f32x4 vb = sgemm_tile(F, F.BIG(), NPJ, w_out_t(F.ws, l), DMIX, 0, 512, rb, cg);
        const f32x4 va = sgemm_tile(F, F.BIG(), NPJ, w_out_t(F.ws, l), DMIX, 512, 1024, rb, cg);
        const int row = MPR + 32 * rb + (F.tid >> 4), col = 64 * cg + 4 * (F.tid & 15);
        const GAS f32x4* p = (const GAS f32x4*)(F.SSDP() + (size_t)row * 16); const f32x4 a = p[0], b = p[1], c = p[2], d = p[3];
        const float sb = ((a[0] + a[1]) + (a[2] + a[3])) + ((b[0] + b[1]) + (b[2] + b[3])) + ((c[0] + c[1]) + (c[2] + c[3])) + ((d[0] + d[1]) + (d[2] + d[3]));
        const float rsb = __builtin_amdgcn_rsqf(sb * (1.f / 512.f) + EPS);
        const GAS float* base = (l == 0) ? F.in[I_XS] + (size_t)(row - MPR) * DM + col : F.out + (size_t)row * DM + col;
        const f32x4 h = *(const GAS f32x4*)base + vb * rsb + va;
        *(GAS f32x4*)(F.out + (size_t)row * DM + col) = h; store_bf4(F.HB() + (size_t)row * DM + col, h);
        const float ss = sum16((h[0] * h[0] + h[1] * h[1]) + (h[2] * h[2] + h[3] * h[3]));
        if ((F.tid & 15) == 0) F.SSQ_FFN()[(size_t)row * 16 + cg] = ss; }
}
__device__ __forceinline__ void sample_p4(Frame& F, int l, int u0) {
    for (int u = u0; u < 4 * (DFF / 64); u += F.G) { const int rb = u & 3, cg = u >> 2;
        const f32x4 v = sgemm_tile(F, F.HB(), DM, w_up_t(F.ws, l), DM, 0, DM, rb, cg);
        const int row = MPR + 32 * rb + (F.tid >> 4), col = 64 * cg + 4 * (F.tid & 15); const float rs = rstd16(F.SSQ_FFN(), row);
        f32x4 x = v * rs;
#pragma unroll
        for (int i = 0; i < 4; ++i) { const float t_ = fmaxf(x[i], 0.f); x[i] = t_ * t_; }
        store_bf4(F.BIG() + (size_t)row * DFF + col, x); }
}
__device__ __forceinline__ void sample_p5(Frame& F, int l, int u0) {
    for (int u = u0; u < 4 * (DM / 64); u += F.G) { const int rb = u & 3, cg = u >> 2;
        const f32x4 v = sgemm_tile(F, F.BIG(), DFF, w_dn_t(F.ws, l), DFF, 0, DFF, rb, cg);
        const int row = MPR + 32 * rb + (F.tid >> 4), col = 64 * cg + 4 * (F.tid & 15);
        const f32x4 h = *(const GAS f32x4*)(F.out + (size_t)row * DM + col) + v;
        *(GAS f32x4*)(F.out + (size_t)row * DM + col) = h; store_bf4(F.HB2() + (size_t)row * DM + col, h);
        const float ss = sum16((h[0] * h[0] + h[1] * h[1]) + (h[2] * h[2] + h[3] * h[3]));
        if ((F.tid & 15) == 0) F.SSQ_PLE()[(size_t)row * 16 + cg] = ss; }
}
__device__ __forceinline__ void sample_p6(Frame& F, int l, int u0) {
    for (int u = u0; u < 4 * (DM / 64); u += F.G) { const int rb = u & 3, cg = u >> 2;
        const f32x4 pp = sgemm_tile(F, F.PB(), PLE, w_pj_t(F.ws, l), PLE, 0, PLE, rb, cg);
        const f32x4 g = sgemm_tile(F, F.HB2(), DM, w_g_t(F.ws, l), DM, 0, DM, rb, cg);
        const int row = MPR + 32 * rb + (F.tid >> 4), col = 64 * cg + 4 * (F.tid & 15); const float rs = rstd16(F.SSQ_PLE(), row);
        f32x4 h = *(const GAS f32x4*)(F.out + (size_t)row * DM + col);
#pragma unroll
        for (int i = 0; i < 4; ++i) h[i] += fsigmoid(g[i] * rs) * pp[i];
        *(GAS f32x4*)(F.out + (size_t)row * DM + col) = h; store_bf4(F.HB() + (size_t)row * DM + col, h);
        const float ss = sum16((h[0] * h[0] + h[1] * h[1]) + (h[2] * h[2] + h[3] * h[3]));
        if ((F.tid & 15) == 0) F.SSQ_MIX()[(size_t)row * 16 + cg] = ss; }
}

__device__ __forceinline__ void final_phase(Frame& F) {
    const int gw = F.bx * 8 + F.wave, NGW = F.G * 8;
    for (int m = gw; m < MREAL; m += NGW) { const float rs = rstd16(F.SSQ_MIX(), m); GAS f32x4* hr = (GAS f32x4*)(F.out + (size_t)m * DM);
#pragma unroll
        for (int j = 0; j < 4; ++j) { const f32x4 g = ((const GAS f32x4*)F.in[I_NFIN])[F.lane + 64 * j]; hr[F.lane + 64 * j] = hr[F.lane + 64 * j] * rs * g; } }
}

struct Args { const float* in[N_IN]; float* out; unsigned char* ws; int ph_lo, ph_hi, li, pad; };
constexpr int N_PHASES = 16;
#ifdef DBG_OUTMASK
#define DBG_EXTRA_PH 1
#else
#define DBG_EXTRA_PH 0
#endif

__global__ void __launch_bounds__(512, 2) fwd_kernel(Args args) {
    extern __shared__ __attribute__((aligned(16))) unsigned char lds_raw[];
    volatile LAS unsigned* MISC = (volatile LAS unsigned*)((LAS unsigned char*)lds_raw + LDSCTL_OFF);
    for (int u = threadIdx.x; u < (LDS_BYTES - LDSCTL_OFF) / 4; u += 512) MISC[u] = 0u;
    __syncthreads();
    if (threadIdx.x < N_IN) ((LAS unsigned long long*)((LAS unsigned char*)lds_raw + LDSCTL_OFF + 256))[threadIdx.x] = (unsigned long long)args.in[threadIdx.x];
    __syncthreads();
    XcdBarrier bar; bar.bar = (GAS unsigned*)(args.ws + WS_CTL) + CW_BAR; bar.x = 0; bar.st = nullptr;
    if (MK_N_LAUNCHES == 1) bar = xcd_barrier_post((GAS unsigned*)(args.ws + WS_CTL) + CW_BAR, MISC + 8);
    const int lo = args.ph_lo, hi = args.ph_hi;
#ifndef PHASE_MASK
#define PHASE_MASK 0xFFFFu
#endif
    const int wave0 = __builtin_amdgcn_readfirstlane(threadIdx.x >> 6);
#pragma nounroll
    for (int ph = lo; ph < hi; ++ph) {
        if (ph > lo) { XcdBarrier b2 = bar; int w_ = wave0, z_ = 0; asm volatile("" : "+s"(b2.bar), "+s"(b2.x), "+s"(w_), "+v"(z_)); xcd_barrier(b2, w_ * 64 + (int)__builtin_amdgcn_mbcnt_hi(~0u, __builtin_amdgcn_mbcnt_lo(~0u, z_))); }
        Frame F;
        F.lds = (LAS unsigned char*)lds_raw;
        int wv_ = wave0, g_ = gridDim.x, b_ = blockIdx.x; GAS unsigned char* ws = (GAS unsigned char*)args.ws;
        asm volatile("" : "+s"(wv_), "+s"(g_), "+s"(b_), "+s"(ws));
        F.wave = wv_; F.G = g_; F.bx = b_;
#define FRESH() do { int z_ = 0; asm volatile("" : "+v"(z_)); F.lane = __builtin_amdgcn_mbcnt_hi(~0u, __builtin_amdgcn_mbcnt_lo(~0u, z_)); F.tid = F.wave * 64 + F.lane; } while (0)
        GAS float* out_ = (GAS float*)args.out; asm volatile("" : "+s"(out_));
        F.intab = (const LAS unsigned long long*)((LAS unsigned char*)lds_raw + LDSCTL_OFF + 256); F.in.t = F.intab; F.out = out_; F.ws = ws;
#ifdef DBG_OUTMASK
        if (ph == 16) {
            const size_t offs[13] = {0, (size_t)MPR * DM, O_RCP, O_RHP, O_SCP, O_SSP, O_HSP, O_RCS, O_RHS, O_SCS, O_SSS, O_HSS, O_END};
            int z2_ = 0; asm volatile("" : "+v"(z2_)); const int ln_ = __builtin_amdgcn_mbcnt_hi(~0u, __builtin_amdgcn_mbcnt_lo(~0u, z2_));
            for (int o_ = 0; o_ < 12; ++o_) { const float sc_ = ((DBG_OUTMASK >> o_) & 1) ? DBG_OUTSCALE : 0.f;
                for (size_t e = offs[o_] + (size_t)F.bx * 512 + F.wave * 64 + ln_; e < offs[o_ + 1]; e += (size_t)F.G * 512) F.out[e] = F.out[e] * sc_; }
            continue; }
#endif
        const int l = (ph - 1) / 7; const int k = (ph == 0) ? 0 : (ph == 15 ? 8 : 1 + (ph - 1) % 7);
        if (!((PHASE_MASK >> k) & 1u)) continue;
#ifdef DBG_CUT
        if (ph > DBG_CUT && ph != 15) continue;
#endif
#ifdef DBG_CUT2
        if (ph > DBG_CUT2) continue;
#endif
#ifdef DBG_REPEAT_K
        for (int rep_ = 0; rep_ < ((k == DBG_REPEAT_K) ? 2 : 1); ++rep_) {
        if (rep_) { XcdBarrier b4 = bar; int w4_ = wave0, z4_ = 0; asm volatile("" : "+s"(b4.bar), "+s"(b4.x), "+s"(w4_), "+v"(z4_)); xcd_barrier(b4, w4_ * 64 + (int)__builtin_amdgcn_mbcnt_hi(~0u, __builtin_amdgcn_mbcnt_lo(~0u, z4_))); }
#endif
        switch (k) {
        case 0: FRESH(); p0_prologue(F);
#ifdef DBG_CUT
            { const int sizes[N_IN] = {16777216,131072,393216,131072,589824,16777216,8388608,8388608,65536,2048,8929280,4096,1024,65536,1024,65536,1024,1024,6144,1536,16,16,16,1024,1024,128,3145728,2048,8388608,8388608,2048,2097152,524288,1024};
              for (int t = F.bx; t < N_IN * 4; t += F.G) { const int ti = t >> 2, part = t & 3; const int n = sizes[ti]; const int q0 = (int)((long)n * part / 4), q1 = (int)((long)n * (part + 1) / 4);
                  const GAS float* p = F.in[ti]; float sacc = 0.f; for (int e = q0 + F.tid; e < q1; e += 512) sacc += fabsf(p[e]);
                  sacc = wave_sum(sacc); if (F.lane == 0) __hip_atomic_fetch_add((GAS float*)(F.ws + 65536) + t, sacc, __ATOMIC_RELAXED, __HIP_MEMORY_SCOPE_AGENT); } }
#endif
            break;
        case 1: {
            FRESH();
            pg8::Gemm g{F.HB(), w_in_t(ws, l), DM, DM}; pg8::StaticOrder S; S.init(MPR, NPJP, F.G, F.bx);
            EpiProj E{F.BIG(), F.DT(), F.SSQ_MIX(), F.LBS() + l * 512};
            pg8::gemm_phase<EpiProj, true>(F.lds, F.tid, g, S, E); FRESH(); sample_p1(F, l, F.G - 1 - F.bx); } break;
        case 2: FRESH(); p2a_phase(F, l); break;
        case 3: FRESH(); p2b_phase(F, l); break;
        case 4: {
            FRESH();
#ifdef DBG_SELF
            if (l == 1) {
                for (int rep = 0; rep < 2; ++rep) {
                    FRESH();
                    pg8::Gemm g{F.BIG(), w_out_t(ws, l), NPJ, DMIX}; pg8::StaticOrder S; S.init(8192, DM, F.G, F.bx);
                    EpiDbg E{F.out, (GAS float*)(F.ws + WS_RT) + (size_t)rep * 8192 * DM + (rep ? 131072 : 0), F.SSDP()};
                    pg8::gemm_phase<EpiDbg, true>(F.lds, F.tid, g, S, E);
                    asm volatile("s_waitcnt vmcnt(0)" ::: "memory"); __syncthreads();
                }
                break; }
#endif
#ifdef DBG_RD
            if (l == 1) { if (F.bx < 4) { for (int e = F.tid; e < 128 * 1536; e += 512) { const int r_ = e / 1536, c_ = e % 1536;
                    F.out[(size_t)(F.bx * 256 + 2 * r_ + (c_ >> 10)) * DM + (c_ & 1023)] = bf2f(F.BIG()[(size_t)(MPR + r_) * NPJ + c_]); }
                  for (int e = F.tid; e < 128 * 16; e += 512) F.out[(size_t)(1024 + F.bx * 2) * DM + e] = F.SSDP()[(size_t)MPR * 16 + e]; }
                break; }
#endif
            pg8::Gemm g{F.BIG(), w_out_t(ws, l), NPJ, DMIX}; pg8::StaticOrder S; S.init(MPR, DM, F.G, F.bx);
            const GAS float* bp = (l == 0) ? F.in[I_XP] : F.out; const GAS float* bs = (l == 0) ? F.in[I_XS] - (size_t)MPR * DM : F.out;
            EpiRes<true> E{bp, bs, F.out, F.HB(), F.SSQ_FFN(), F.SSDP()};
            pg8::gemm_phase<EpiRes<true>, true>(F.lds, F.tid, g, S, E); FRESH(); sample_p3(F, l, F.G - 1 - F.bx); } break;
        case 5: {
            FRESH();
            pg8::Gemm g{F.HB(), w_up_t(ws, l), DM, DM}; pg8::StaticOrder S; S.init(MPR, DFF, F.G, F.bx);
            EpiUp E{F.BIG(), F.SSQ_FFN()};
            pg8::gemm_phase<EpiUp, true>(F.lds, F.tid, g, S, E); FRESH(); sample_p4(F, l, F.G - 1 - F.bx); } break;
        case 6: {
            FRESH();
            pg8::Gemm g{F.BIG(), w_dn_t(ws, l), DFF, DFF}; pg8::StaticOrder S; S.init(MPR, DM, F.G, F.bx);
            EpiRes<false> E{F.out, F.out, F.out, F.HB2(), F.SSQ_PLE(), nullptr};
            pg8::gemm_phase<EpiRes<false>, true>(F.lds, F.tid, g, S, E); FRESH(); sample_p5(F, l, F.G - 1 - F.bx); } break;
        case 7: {
            FRESH();
            { pg8::Gemm g{F.PB(), w_pj_t(ws, l), PLE, PLE}; pg8::StaticOrder S; S.init(MPR, DM, F.G, F.bx); EpiPP E{F.PPB()}; pg8::gemm_phase<EpiPP, true>(F.lds, F.tid, g, S, E); }
            asm volatile("s_waitcnt vmcnt(0)" ::: "memory"); __syncthreads();
            FRESH();
            { pg8::Gemm g{F.HB2(), w_g_t(ws, l), DM, DM}; pg8::StaticOrder S; S.init(MPR, DM, F.G, F.bx); EpiGate E{F.out, F.HB(), F.PPB(), F.SSQ_PLE(), F.SSQ_MIX()}; pg8::gemm_phase<EpiGate, true>(F.lds, F.tid, g, S, E); } FRESH(); sample_p6(F, l, F.G - 1 - F.bx); } break;
        default: FRESH();
#ifdef DBG_SELF
            { const GAS float* t1 = (const GAS float*)(F.ws + WS_RT); const GAS float* t2 = t1 + (size_t)8192 * DM + 131072; unsigned cnt = 0;
              for (size_t e = (size_t)F.bx * 512 + F.tid; e < (size_t)8192 * DM; e += (size_t)F.G * 512) cnt += (t1[e] != t2[e]) ? 1u : 0u;
              cnt = (unsigned)wave_sum((float)cnt);
              if (F.lane == 0) F.out[(size_t)(F.bx * 8 + F.wave) * DM] = 1000.f * (float)cnt; }
            break;
#endif
#ifdef DBG_CK
            { GAS float* yo = F.out + (size_t)MPR * DM;
              const int gw = F.bx * 8 + F.wave, NGW = F.G * 8;
              for (int it = gw; it < 128 * (24 + 16 + 1); it += NGW) { const int blk = it % 128, g = it / 128; float sacc = 0.f;
#ifdef DBG_CK2
                  if (g < 12) { for (int e = F.lane; e < 128 * 64; e += 64) sacc += fabsf(bf2f(F.XA()[(size_t)(blk * 128 + (e >> 6)) * 768 + g * 64 + (e & 63)])); }
                  else if (g < 20) { for (int e = F.lane; e < 128 * 64; e += 64) sacc += fabsf(bf2f(F.BIG()[(size_t)(blk * 128 + (e >> 6)) * NPJ + PC_BZ + (g - 12) * 64 + (e & 63)])); }
                  else if (g < 21) { for (int e = F.lane; e < 128 * 8; e += 64) sacc += fabsf(F.DT()[(size_t)blk * 128 * 8 + e]); }
                  else if (g < 24) { }
#else
                  if (g < 24) { for (int e = F.lane; e < 128 * 64; e += 64) sacc += fabsf(bf2f(F.BIG()[(size_t)(blk * 128 + (e >> 6)) * NPJ + g * 64 + (e & 63)])); }
#endif
                  else if (g < 40) { for (int e = F.lane; e < 128 * 64; e += 64) sacc += fabsf(F.out[(size_t)(blk * 128 + (e >> 6)) * DM + (g - 24) * 64 + (e & 63)]); }
                  else { for (int e = F.lane; e < 128 * 16; e += 64) sacc += fabsf(F.SSDP()[(size_t)blk * 128 * 16 + e]); }
                  sacc = wave_sum(sacc); if (F.lane == 0) yo[it] = (g >= DBG_CK_LO && g < DBG_CK_HI) ? sacc : 0.f; } }
            break;
#endif
#ifdef DBG_COPY
            for (int e = F.bx * 512 + F.tid; e < 128 * DM; e += F.G * 512) F.out[(size_t)MPR * DM + e] = F.out[(size_t)DBG_COPY * DM + e];
            break;
#endif
#ifdef DBG_CUT
            { const int gw = F.bx * 8 + F.wave, NGW = F.G * 8;
              for (int m = gw; m < MREAL; m += NGW) { float s0 = 0.f, s1 = 0.f, s2 = 0.f;
                  const GAS bf16* b = F.BIG() + (size_t)m * NPJ; for (int c = F.lane; c < NPJ; c += 64) s0 += fabsf(bf2f(b[c]));
                  const GAS bf16* hb = F.HB() + (size_t)m * DM; for (int c = F.lane; c < DM; c += 64) s1 += fabsf(bf2f(hb[c]));
                  const GAS bf16* h2 = F.HB2() + (size_t)m * DM; for (int c = F.lane; c < DM; c += 64) s2 += fabsf(bf2f(h2[c]));
                  s0 = wave_sum(s0); s1 = wave_sum(s1); s2 = wave_sum(s2);
                  float s3 = 0.f, s4 = 0.f; if (m < 1024) { const GAS float* si = F.in[I_SSS] + ((size_t)(1024 + m)) * 8192; for (int c = F.lane; c < 8192; c += 64) s3 += fabsf(si[c]);
                      const GAS float* s0i = F.in[I_SSS] + ((size_t)m) * 8192; for (int c = F.lane; c < 8192; c += 64) s4 += fabsf(s0i[c]); }
                  s3 = wave_sum(s3); s4 = wave_sum(s4);
                  if (F.lane == 0) { GAS float* o = F.out + (size_t)m * DM; o[8] = s3; o[9] = s4; if (m < N_IN * 4) o[10] = ((GAS float*)(F.ws + 65536))[m]; o[0] = s0; o[1] = s1; o[2] = s2; o[3] = F.DT()[(size_t)m * 8 + 3]; o[4] = F.SSQ_MIX()[(size_t)m * 16 + 5]; o[5] = F.SSQ_FFN()[(size_t)m * 16 + 5]; o[6] = F.SSQ_PLE()[(size_t)m * 16 + 5]; o[7] = F.SSDP()[(size_t)m * 16 + 5]; } } }
#else
#ifndef DBG_NOFINAL
            final_phase(F);
#endif
#ifdef DBG_SANOUT
            asm volatile("s_waitcnt vmcnt(0)" ::: "memory"); { XcdBarrier b3 = bar; xcd_barrier(b3, F.tid); }
            for (size_t e = (size_t)F.bx * 512 + F.tid; e < O_END; e += (size_t)F.G * 512) { const float v = F.out[e]; if (!(fabsf(v) < 1e30f)) F.out[e] = 12345.f; }
#endif
#endif
            break;
        }
#ifdef DBG_REPEAT_K
        }
#endif
    }
}

extern "C" void kernel_launch(void* const* d_in, const int* in_sizes, int n_in, void* d_out, int out_size, void* d_ws, size_t ws_size, hipStream_t stream) {
    static int grid = 0;
    if (grid == 0) {
        if (n_in != N_IN || (size_t)out_size != O_END || ws_size < WS_END) { fprintf(stderr, "kernel_launch: unexpected shapes: n_in %d out %d ws %zu (need %zu)\n", n_in, out_size, ws_size, (size_t)WS_END); grid = -1; return; }
        int dev = 0, cus = 0, per_cu = 0;
        if (hipGetDevice(&dev) != hipSuccess || hipDeviceGetAttribute(&cus, hipDeviceAttributeMultiprocessorCount, dev) != hipSuccess) { grid = -1; return; }
        if (hipFuncSetAttribute((const void*)fwd_kernel, hipFuncAttributeMaxDynamicSharedMemorySize, LDS_BYTES) != hipSuccess) { fprintf(stderr, "kernel_launch: hipFuncSetAttribute failed\n"); grid = -1; return; }
        if (hipOccupancyMaxActiveBlocksPerMultiprocessor(&per_cu, (const void*)fwd_kernel, 512, LDS_BYTES) != hipSuccess || per_cu < 1) { fprintf(stderr, "kernel_launch: occupancy query says %d blocks per CU\n", per_cu); (void)hipGetLastError(); grid = -1; return; }
        grid = cus;
        if (grid > 256) grid = 256;
    }
    if (grid < 0) return;
    if (hipMemsetAsync((char*)d_ws + WS_CTL, 0, CTL_ZERO_BYTES, stream) != hipSuccess) return;
#ifdef DBG_FILLOUT
    (void)hipMemsetAsync(d_out, 0, (size_t)O_END * 4, stream);
#endif
#ifdef DBG_FILL
    (void)hipMemsetAsync((char*)d_ws + CTL_ZERO_BYTES, DBG_FILL, WS_END - CTL_ZERO_BYTES, stream);
#endif
    Args a{};
    for (int i = 0; i < N_IN; ++i) a.in[i] = (const float*)d_in[i];
    a.out = (float*)d_out; a.ws = (unsigned char*)d_ws;
    if (MK_N_LAUNCHES == 1) { a.ph_lo = 0; a.ph_hi = N_PHASES; a.li = 0; hipLaunchKernelGGL(fwd_kernel, dim3(grid), dim3(512), LDS_BYTES, stream, a); }
    else for (int p = 0; p < N_PHASES + DBG_EXTRA_PH; ++p) { a.ph_lo = p; a.ph_hi = p + 1; a.li = p; hipLaunchKernelGGL(fwd_kernel, dim3(grid), dim3(512), LDS_BYTES, stream, a); }
}
```

```cpp
#include <hip/hip_runtime.h>
#include <cstdio>
#include <cstdint>

#define LAS __attribute__((address_space(3)))
#define GAS __attribute__((address_space(1)))
typedef unsigned short bf16;
typedef short bf16x8 __attribute__((ext_vector_type(8)));
typedef float f32x4 __attribute__((ext_vector_type(4)));
typedef float f32x16 __attribute__((ext_vector_type(16)));
typedef unsigned u32x4 __attribute__((ext_vector_type(4)));
typedef unsigned u32x2 __attribute__((ext_vector_type(2)));
typedef GAS unsigned gu32;

#ifndef MK_N_LAUNCHES
#define MK_N_LAUNCHES 1
#endif

constexpr int DM = 1024, NBATCH = 8, SEQ = 2048, MPR = NBATCH * SEQ, MSM = 128, MREAL = MPR + MSM, MP = 16640  ;
constexpr int NPJ = 4352, NPJP = 4608, DFF = 4096, PLE = 256, DMIX = 1536, NL = 2, DIN = 4360;
constexpr int PC_XS = 0, PC_AX = 512, PC_CQ = 1024, PC_B = 1536, PC_C = 1664, PC_AG = 1792, PC_BZ = 2304, PC_CF = 2816, PC_CI = 3328, PC_CG = 3840;
constexpr float EPS = 1e-6f;
enum { I_XP = 0, I_XS, I_SRC, I_SRH, I_SSC, I_SSS, I_SHG, I_PP, I_PS, I_NMIX, I_WIN, I_CAW, I_CAB, I_WA, I_BA, I_WX, I_BX, I_LAM, I_CBW, I_CBB, I_DTB, I_ALOG, I_SSD_D, I_SNORM,
       I_HLB, I_HNORM, I_WOUT, I_NFFN, I_WUP, I_WDN, I_NPLE, I_WG, I_WPJ, I_NFIN, N_IN };
constexpr size_t O_Y = 0, O_RCP = (size_t)MREAL * DM, O_RHP = O_RCP + 2 * 8 * 3 * 512, O_SCP = O_RHP + 2 * 8 * 512, O_SSP = O_SCP + 2 * 8 * 3 * 768, O_HSP = O_SSP + 2 * 8 * 8 * 64 * 128,
                 O_RCS = O_HSP + 2 * 8 * 8 * 64 * 64, O_RHS = O_RCS + 2 * 128 * 3 * 512, O_SCS = O_RHS + 2 * 128 * 512, O_SSS = O_SCS + 2 * 128 * 3 * 768, O_HSS = O_SSS + (size_t)2 * 128 * 8 * 64 * 128,
                 O_END = O_HSS + (size_t)2 * 128 * 8 * 64 * 64;
static_assert(O_END == 44830720, "output size");

constexpr size_t MiB = 1u << 20;
constexpr size_t WS_CTL = 0, CTL_ZERO_BYTES = 1 * MiB;
constexpr size_t WS_WIN = 1 * MiB, WS_WOUT = 19 * MiB, WS_WUP = 25 * MiB, WS_WDN = 41 * MiB, WS_WG = 57 * MiB, WS_WPJ = 61 * MiB, WS_WAT = 62 * MiB, WS_LBS = 62 * MiB + 512 * 1024;
constexpr size_t KiB64 = 65536;
constexpr size_t WS_PB = 63 * MiB, WS_HB = WS_PB + 132 * KiB64  , WS_BIG = WS_HB + 520 * KiB64  , WS_RT = WS_BIG + 2211 * KiB64  ;
constexpr size_t WS_LA = WS_RT, WS_BB = WS_RT + 16 * MiB, WS_XA = WS_RT + 32 * MiB, WS_PPB = WS_RT, WS_HB2 = WS_RT + 520 * KiB64, WS_TS = WS_RT + 56 * MiB  ;
constexpr size_t WS_DT = WS_RT + 1040 * KiB64  , WS_SSQ_MIX = WS_DT + 12 * KiB64, WS_SSQ_FFN = WS_SSQ_MIX + 17 * KiB64, WS_SSQ_PLE = WS_SSQ_FFN + 17 * KiB64, WS_SSDP = WS_SSQ_PLE + 17 * KiB64, WS_END = WS_SSDP + 17 * KiB64;
static_assert(WS_PB + (size_t)MP * PLE * 2 <= WS_HB && WS_HB + (size_t)MP * DM * 2 <= WS_BIG && WS_BIG + (size_t)MP * NPJ * 2 <= WS_RT && WS_XA + (size_t)MPR * 768 * 2 <= WS_DT && WS_PPB + (size_t)MP * DM * 2 <= WS_HB2 &&
              WS_HB2 + (size_t)MP * DM * 2 <= WS_DT && WS_DT + (size_t)MP * 8 * 4 <= WS_SSQ_MIX && (size_t)MP * 16 * 4 <= 17 * KiB64 && WS_END <= 313 * MiB, "ws map");
constexpr int CW_TMO = 0, CW_BAR = 4096;

constexpr int SCR_BYTES = 147456, LDSCTL_OFF = SCR_BYTES, LDS_BYTES = SCR_BYTES + 1024;

typedef float f32x2v_ __attribute__((ext_vector_type(2))); typedef __bf16 bf16x2v_ __attribute__((ext_vector_type(2)));
__device__ __forceinline__ unsigned pk2(float lo, float hi) { const f32x2v_ v = {lo, hi}; return __builtin_bit_cast(unsigned, __builtin_convertvector(v, bf16x2v_)); }
__device__ __forceinline__ bf16 f2bf(float f) { return (bf16)(pk2(f, 0.f) & 0xffffu); }
__device__ __forceinline__ float bf2f(bf16 b) { return __uint_as_float(((unsigned)b) << 16); }
__device__ __forceinline__ float bflo(unsigned w) { return __uint_as_float(w << 16); }
__device__ __forceinline__ float bfhi(unsigned w) { return __uint_as_float(w & 0xffff0000u); }
__device__ __forceinline__ float fexp(float x) { return __builtin_amdgcn_exp2f(x * 1.44269504089f); }
__device__ __forceinline__ float frcp(float x) { return __builtin_amdgcn_rcpf(x); }
__device__ __forceinline__ float fsigmoid(float x) { return frcp(1.f + fexp(-x)); }
__device__ __forceinline__ float fsilu(float x) { return x * fsigmoid(x); }
__device__ __forceinline__ float fgelu(float x) { const float u = x + 0.044715f * x * x * x; return x * frcp(1.f + fexp(-1.5957691216f * u)); }
__device__ __forceinline__ float flog(float x) { return __builtin_amdgcn_logf(x) * 0.69314718056f; }
__device__ __forceinline__ float fsoftplus(float x) {
    if (x > 20.f) return x;
    const float e = fexp(x);
    if (e < 0.05f) return e * (1.f - e * (0.5f - e * (0.33333333f - e * (0.25f - 0.2f * e))));
    return flog(1.f + e);
}
__device__ __forceinline__ float fnegexpm1(float x) {
    if (x > -0.5f && x < 0.5f) return -(x * (1.f + x * 0.5f * (1.f + x * 0.33333333f * (1.f + x * 0.25f * (1.f + x * 0.2f * (1.f + x * 0.16666667f))))));
    return 1.f - fexp(x);
}
template <int X> __device__ __forceinline__ float swz_xor(float v) { return __int_as_float(__builtin_amdgcn_ds_swizzle(__float_as_int(v), (X << 10) | 0x1f)); }
__device__ __forceinline__ float sum_halves(float v) {
    const unsigned u = __float_as_uint(v); auto r = __builtin_amdgcn_permlane32_swap(u, u, false, false); return __uint_as_float(r[0]) + __uint_as_float(r[1]); }
template <int CTRL> __device__ __forceinline__ float dpp_f(float v) { return __int_as_float(__builtin_amdgcn_update_dpp(0, __float_as_int(v), CTRL, 0xF, 0xF, true)); }
__device__ __forceinline__ float sum16r(float v) {
    v += dpp_f<0xB1>(v); v += dpp_f<0x4E>(v); v += dpp_f<0x141>(v); v += dpp_f<0x140>(v); return v; }
__device__ __forceinline__ float sum32(float v) { v = sum16r(v); v += swz_xor<16>(v); return v; }
__device__ __forceinline__ float wave_sum(float v) { return sum_halves(sum32(v)); }
__device__ __forceinline__ float bperm(float v, int srclane) { return __int_as_float(__builtin_amdgcn_ds_bpermute(srclane << 2, __float_as_int(v))); }
__device__ __forceinline__ f32x16 mfma32(bf16x8 a, bf16x8 b, f32x16 c) { return __builtin_amdgcn_mfma_f32_32x32x16_bf16(a, b, c, 0, 0, 0); }
__device__ __forceinline__ int rowoff(int reg, int hf) { return (reg & 3) + 8 * (reg >> 2) + 4 * hf; }
#ifndef DBG_V
#define DBG_V 0
#endif
#if DBG_V == 3
#define WG_BARRIER() do { asm volatile("s_waitcnt vmcnt(0) lgkmcnt(0)" ::: "memory"); __syncthreads(); } while (0)
#else
#define WG_BARRIER() __syncthreads()
#endif

namespace pg8 {
constexpr int BM = 256, BK = 64, HALF = 128, HTB = HALF * BK * 2, STAGE_BYTES = 8 * HTB, NXCD = 8, WGM = 8;
__host__ __device__ __forceinline__ int lds_byte(int r, int c) { const int st = (r >> 4) * 2 + (c >> 5), rr = r & 15, cc = c & 31, ob = rr * 64 + cc * 2; return st * 1024 + (ob ^ (((ob >> 9) & 1) << 5)); }
__host__ __device__ __forceinline__ void stage_rc(int b, int& R, int& C) { const int st = b / 1024, sb = b % 1024, swz = sb ^ (((sb >> 9) & 1) << 5); R = (st >> 1) * 16 + swz / 64; C = (st & 1) * 32 + (swz % 64) / 2; }
__host__ __device__ __forceinline__ int perm32(int rho) { const int n = rho >> 4, i = rho & 15; return 8 * (i >> 2) + 4 * n + (i & 3); }
struct Unit { int pm, pn; };
struct Gemm { const GAS bf16* A; const GAS bf16* Bt; int lda, K; };
struct StaticOrder {
    int nM, nN, nwg, G, c;
    __device__ void init(int M, int N, int G_, int c_) { nM = M / BM; nN = N / BM; nwg = nM * nN; G = G_; c = c_; }
    __device__ bool next(int i, Unit& u) const {
        const long L = (long)i * G + c; if (L >= nwg) return false;
        int wgid = (int)L; { const int q = nwg / NXCD, r = nwg % NXCD, xcd = wgid % NXCD, off = wgid / NXCD; wgid = (xcd < r ? xcd * (q + 1) : r * (q + 1) + (xcd - r) * q) + off; }
        const int nig = WGM * nN, gid = wgid / nig, fm = gid * WGM, gsz = (nM - fm) < WGM ? (nM - fm) : WGM;
        u.pm = fm + ((wgid % nig) % gsz); u.pn = (wgid % nig) / gsz; return true;
    }
};
typedef f32x4 Acc[2][2][4][2];

template <class Epi, bool ALIGN_EPI>
__device__ __forceinline__ void gemm_phase(LAS unsigned char* lds, const int tid, const Gemm g, const StaticOrder& S, const Epi& E) {
    const int wid = __builtin_amdgcn_readfirstlane(tid >> 6), lane = tid & 63, wr = wid >> 2, wc = wid & 3, fr = lane & 15, fq = lane >> 4;
    const int K = g.K, nt = K / BK, lda = g.lda;
    unsigned voffA[2], voffB[2];
#pragma unroll
    for (int i = 0; i < 2; ++i) { int R, C; stage_rc(tid * 16 + i * 8192, R, C); const int Rb = Epi::PERM ? ((R & ~31) + perm32(R & 31)) : R;
        voffA[i] = (unsigned)(R * lda + C) * 2u; voffB[i] = (unsigned)(Rb * K + C) * 2u; }
    const size_t kstep = (size_t)(BK * 2);
    const size_t hA = (size_t)HALF * lda * 2, hB = (size_t)HALF * K * 2, tA = 2 * hA, tB = 2 * hB;
    const unsigned ldsw = (unsigned)wid * 1024u;
    const int aoff = lds_byte(wr * 64 + fr, fq * 8), boff = lds_byte(wc * 32 + fr, fq * 8);
#define PG8_SA(b, h) (((b) * 2 + (h)) * HTB)
#define PG8_SB(b, h) ((4 + (b) * 2 + (h)) * HTB)
#define PG8_STAGE(bufoff, gbase, voff) do { _Pragma("unroll") for (int _i = 0; _i < 2; ++_i) \
        __builtin_amdgcn_global_load_lds((const GAS unsigned*)((const GAS char*)(gbase) + (voff)[_i]), (LAS unsigned*)(lds + (bufoff) + ldsw + _i * 8192), 16, 0, 0); } while (0)
#define PG8_LDA(dst, b, h) do { _Pragma("unroll") for (int m = 0; m < 4; ++m) _Pragma("unroll") for (int k = 0; k < 2; ++k) dst[m][k] = *(const LAS bf16x8*)(lds + PG8_SA(b, h) + aoff + m * 2048 + k * 1024); } while (0)
#define PG8_LDB(dst, b, h) do { _Pragma("unroll") for (int n = 0; n < 2; ++n) _Pragma("unroll") for (int k = 0; k < 2; ++k) dst[n][k] = *(const LAS bf16x8*)(lds + PG8_SB(b, h) + boff + n * 2048 + k * 1024); } while (0)
#define PG8_MMA(ai, bj, At, Bt) do { __builtin_amdgcn_s_setprio(1); _Pragma("unroll") for (int m = 0; m < 4; ++m) _Pragma("unroll") for (int n = 0; n < 2; ++n) _Pragma("unroll") for (int k = 0; k < 2; ++k) \
        acc[ai][bj][m][n] = __builtin_amdgcn_mfma_f32_16x16x32_bf16(Bt[n][k], At[m][k], acc[ai][bj][m][n], 0, 0, 0); __builtin_amdgcn_s_setprio(0); } while (0)
#define PG8_WAIT_V(n) asm volatile("s_waitcnt vmcnt(" #n ")" ::: "memory")
#define PG8_WAIT_L(n) asm volatile("s_waitcnt lgkmcnt(" #n ")" ::: "memory")
#define PG8_BAR __builtin_amdgcn_s_barrier()
#define PG8_SCHED __builtin_amdgcn_sched_barrier(0)
    Unit cur, nxt; int ui = 0;
    if (!S.next(0, cur)) return;
    f32x4 acc[2][2][4][2];
#pragma unroll
    for (int a = 0; a < 2; ++a)
#pragma unroll
        for (int b = 0; b < 2; ++b)
#pragma unroll
            for (int m = 0; m < 4; ++m)
#pragma unroll
                for (int n = 0; n < 2; ++n) acc[a][b][m][n] = (f32x4){0.f, 0.f, 0.f, 0.f};
    bf16x8 At[4][2], B0[2][2], B1[2][2];
    const GAS char* cA = (const GAS char*)g.A + (size_t)cur.pm * tA; const GAS char* cB = (const GAS char*)g.Bt + (size_t)cur.pn * tB;
    PG8_STAGE(PG8_SB(0, 0), cB, voffB); PG8_STAGE(PG8_SB(0, 1), cB + hB, voffB); PG8_STAGE(PG8_SA(0, 0), cA, voffA); PG8_STAGE(PG8_SA(0, 1), cA + hA, voffA);
    if (wr == 1) PG8_BAR;
    PG8_WAIT_V(2); PG8_BAR;
    PG8_STAGE(PG8_SB(1, 0), cB + kstep, voffB); PG8_STAGE(PG8_SA(1, 0), cA + kstep, voffA); PG8_STAGE(PG8_SB(1, 1), cB + hB + kstep, voffB);
    PG8_WAIT_V(6); PG8_BAR;
    for (;;) {
        const bool has_next = S.next(ui + 1, nxt);
        const GAS char* nA = has_next ? (const GAS char*)g.A + (size_t)nxt.pm * tA : cA; const GAS char* nB = has_next ? (const GAS char*)g.Bt + (size_t)nxt.pn * tB : cB;
        for (int t = 0; t < nt; t += 2) {
            const bool last = (t == nt - 2);
            const GAS char* a1 = cA + (size_t)(t + 1) * kstep;
            const GAS char* a2 = last ? nA : cA + (size_t)(t + 2) * kstep; const GAS char* b2 = last ? nB : cB + (size_t)(t + 2) * kstep;
            const GAS char* a3 = a2 + kstep; const GAS char* b3 = b2 + kstep;
            if constexpr (Epi::MIDK > 0) { if (t == Epi::MIDK) E.mid(acc, cur, wr, wc, fr, fq); }
            PG8_LDB(B0, 0, 0); PG8_LDB(B1, 0, 1); PG8_SCHED; PG8_LDA(At, 0, 0); PG8_STAGE(PG8_SA(1, 1), a1 + hA, voffA);
            PG8_WAIT_V(8); PG8_WAIT_L(0); PG8_BAR; PG8_MMA(0, 0, At, B0); PG8_MMA(0, 1, At, B1); PG8_BAR; PG8_SCHED;
            PG8_LDA(At, 0, 1); PG8_STAGE(PG8_SB(0, 0), b2, voffB); PG8_STAGE(PG8_SB(0, 1), b2 + hB, voffB); PG8_STAGE(PG8_SA(0, 0), a2, voffA);
            PG8_WAIT_V(8); PG8_WAIT_L(0); PG8_BAR; PG8_MMA(1, 0, At, B0); PG8_MMA(1, 1, At, B1); PG8_BAR; PG8_SCHED;
            PG8_LDB(B0, 1, 0); PG8_LDB(B1, 1, 1); PG8_SCHED; PG8_LDA(At, 1, 0); PG8_STAGE(PG8_SA(0, 1), a2 + hA, voffA);
            PG8_WAIT_V(8); PG8_WAIT_L(0); PG8_BAR; PG8_MMA(0, 0, At, B0); PG8_MMA(0, 1, At, B1); PG8_BAR; PG8_SCHED;
            PG8_LDA(At, 1, 1); PG8_STAGE(PG8_SB(1, 0), b3, voffB); PG8_STAGE(PG8_SB(1, 1), b3 + hB, voffB); PG8_STAGE(PG8_SA(1, 0), a3, voffA);
            PG8_WAIT_V(8); PG8_WAIT_L(0); PG8_BAR; PG8_MMA(1, 0, At, B0); PG8_MMA(1, 1, At, B1); PG8_BAR; PG8_SCHED;
        }
        if constexpr (ALIGN_EPI) { if (wr == 0) PG8_BAR; }
        E(acc, cur, wr, wc, fr, fq);
        if (!has_next) break;
#pragma unroll
        for (int a = 0; a < 2; ++a)
#pragma unroll
            for (int b = 0; b < 2; ++b)
#pragma unroll
                for (int m = 0; m < 4; ++m)
#pragma unroll
                    for (int n = 0; n < 2; ++n) acc[a][b][m][n] = (f32x4){0.f, 0.f, 0.f, 0.f};
        cur = nxt; cA = nA; cB = nB; ++ui;
        if constexpr (ALIGN_EPI) { if (wr == 1) PG8_BAR; }
    }
    PG8_WAIT_V(0);
    if constexpr (!ALIGN_EPI) { if (wr == 0) PG8_BAR; }
    PG8_BAR;
#undef PG8_SA
#undef PG8_SB
#undef PG8_STAGE
#undef PG8_LDA
#undef PG8_LDB
#undef PG8_MMA
#undef PG8_WAIT_V
#undef PG8_WAIT_L
#undef PG8_BAR
#undef PG8_SCHED
}
}
using pg8::Unit; using pg8::Acc; using pg8::BM; using pg8::HALF;

__device__ __forceinline__ float rstd16(const GAS float* ssq, int row) {
    const GAS f32x4* p = (const GAS f32x4*)(ssq + (size_t)row * 16); const f32x4 a = p[0], b = p[1], c = p[2], d = p[3];
    const float s = ((a[0] + a[1]) + (a[2] + a[3])) + ((b[0] + b[1]) + (b[2] + b[3])) + ((c[0] + c[1]) + (c[2] + c[3])) + ((d[0] + d[1]) + (d[2] + d[3]));
    return __builtin_amdgcn_rsqf(s * (1.f / DM) + EPS);
}
template <int MODE> __device__ __forceinline__ float act1(float v, float lb) {
    if (MODE == 1) return fsilu(v);
    if (MODE == 2) return fgelu(v);
    if (MODE == 3) { const float g = lb + (1.f - lb) * fsigmoid(v); return fmaxf(flog(g), -30.f); }
    return v;
}
struct EpiProj {
    static constexpr bool PERM = true; static constexpr int MIDK = 0;
    GAS bf16* P; GAS float* DT; const GAS float* ssq; const GAS float* lbs;
    __device__ __forceinline__ void mid(Acc&, const Unit&, int, int, int, int) const {}
    template <int MODE> __device__ __forceinline__ void body(const Acc& acc, const Unit& u, int wr, int wc, int fr, int fq) const {
        const int row0 = u.pm * BM + wr * 64 + fr, col0 = u.pn * BM + wc * 32 + 8 * fq;
        f32x4 lb[2][2];
#pragma unroll
        for (int bj = 0; bj < 2; ++bj)
#pragma unroll
            for (int n = 0; n < 2; ++n) lb[bj][n] = (MODE == 3) ? *(const GAS f32x4*)(lbs + (col0 - PC_CF) + bj * HALF + 4 * n) : (f32x4){0.f, 0.f, 0.f, 0.f};
#pragma unroll
        for (int ai = 0; ai < 2; ++ai)
#pragma unroll
            for (int m = 0; m < 4; ++m) { const int row = row0 + ai * HALF + m * 16; const float rs = rstd16(ssq, row); GAS bf16* rowp = P + (size_t)row * NPJ + col0;
#pragma unroll
                for (int bj = 0; bj < 2; ++bj) { const f32x4 v0 = acc[ai][bj][m][0] * rs, v1 = acc[ai][bj][m][1] * rs; u32x4 w;
                    w.x = pk2(act1<MODE>(v0[0], lb[bj][0][0]), act1<MODE>(v0[1], lb[bj][0][1])); w.y = pk2(act1<MODE>(v0[2], lb[bj][0][2]), act1<MODE>(v0[3], lb[bj][0][3]));
                    w.z = pk2(act1<MODE>(v1[0], lb[bj][1][0]), act1<MODE>(v1[1], lb[bj][1][1])); w.w = pk2(act1<MODE>(v1[2], lb[bj][1][2]), act1<MODE>(v1[3], lb[bj][1][3]));
                    *(GAS u32x4*)(rowp + bj * HALF) = w; } }
    }
    __device__ __forceinline__ void operator()(const Acc& acc, const Unit& u, int wr, int wc, int fr, int fq) const {
        const int pn = u.pn;
        if (pn == 17) {
            if (wc == 0 && fq == 0) {
#pragma unroll
                for (int ai = 0; ai < 2; ++ai)
#pragma unroll
                    for (int m = 0; m < 4; ++m) { const int row = u.pm * BM + wr * 64 + fr + ai * HALF + m * 16; const float rs = rstd16(ssq, row);
                        *(GAS f32x4*)(DT + (size_t)row * 8) = acc[ai][0][m][0] * rs; *(GAS f32x4*)(DT + (size_t)row * 8 + 4) = acc[ai][0][m][1] * rs; }
            }
            return;
        }
        if (pn == 4 || pn == 5 || pn == 9 || pn == 10 || pn == 15 || pn == 16) body<1>(acc, u, wr, wc, fr, fq);
        else if (pn == 7 || pn == 8) body<2>(acc, u, wr, wc, fr, fq);
        else if (pn == 11 || pn == 12) body<3>(acc, u, wr, wc, fr, fq);
        else body<0>(acc, u, wr, wc, fr, fq);
    }
};
template <bool MID> struct EpiRes {
    static constexpr bool PERM = false; static constexpr int MIDK = MID ? 8 : 0;
    const GAS float* basep; const GAS float* bases; GAS float* hout; GAS bf16* hb; GAS float* ssq; const GAS float* ssdp;
    __device__ __forceinline__ void mid(Acc& acc, const Unit& u, int wr, int wc, int fr, int fq) const {
#pragma unroll
        for (int ai = 0; ai < 2; ++ai)
#pragma unroll
            for (int m = 0; m < 4; ++m) { const int row = u.pm * BM + wr * 64 + fr + ai * HALF + m * 16;
                const GAS f32x4* p = (const GAS f32x4*)(ssdp + (size_t)row * 16); const f32x4 a = p[0], b = p[1], c = p[2], d = p[3];
                const float s = ((a[0] + a[1]) + (a[2] + a[3])) + ((b[0] + b[1]) + (b[2] + b[3])) + ((c[0] + c[1]) + (c[2] + c[3])) + ((d[0] + d[1]) + (d[2] + d[3]));
                const float rs = __builtin_amdgcn_rsqf(s * (1.f / 512.f) + EPS);
#pragma unroll
                for (int bj = 0; bj < 2; ++bj)
#pragma unroll
                    for (int n = 0; n < 2; ++n) acc[ai][bj][m][n] = acc[ai][bj][m][n] * rs; }
    }
    __device__ __forceinline__ void operator()(const Acc& acc, const Unit& u, int wr, int wc, int fr, int fq) const {
        const int row0 = u.pm * BM + wr * 64 + fr, col0 = u.pn * BM + wc * 32 + 4 * fq;
        const GAS float* base = (u.pm < MPR / BM) ? basep : bases;
#pragma unroll
        for (int ai = 0; ai < 2; ++ai)
#pragma unroll
            for (int m = 0; m < 4; ++m) { const int row = row0 + ai * HALF + m * 16; const size_t off = (size_t)row * DM + col0; float ss = 0.f;
                if (row < MREAL) {
#pragma unroll
                    for (int bj = 0; bj < 2; ++bj)
#pragma unroll
                        for (int n = 0; n < 2; ++n) { const f32x4 v = *(const GAS f32x4*)(base + off + bj * HALF + n * 16) + acc[ai][bj][m][n];
                            *(GAS f32x4*)(hout + off + bj * HALF + n * 16) = v; u32x2 w; w.x = pk2(v[0], v[1]); w.y = pk2(v[2], v[3]); *(GAS u32x2*)(hb + off + bj * HALF + n * 16) = w;
                            ss += (v[0] * v[0] + v[1] * v[1]) + (v[2] * v[2] + v[3] * v[3]); }
                }
                ss += swz_xor<16>(ss); ss = sum_halves(ss);
                if (fq == 0) ssq[(size_t)row * 16 + u.pn * 4 + wc] = ss;
                asm volatile("" ::: "memory"); }
    }
};
struct EpiDbg {
    static constexpr bool PERM = false; static constexpr int MIDK = 8;
    const GAS float* basep; GAS float* hout; const GAS float* ssdp;
    __device__ __forceinline__ void mid(Acc& acc, const Unit& u, int wr, int wc, int fr, int fq) const {
#pragma unroll
        for (int ai = 0; ai < 2; ++ai)
#pragma unroll
            for (int m = 0; m < 4; ++m) { const int row = u.pm * BM + wr * 64 + fr + ai * HALF + m * 16;
                const GAS f32x4* p = (const GAS f32x4*)(ssdp + (size_t)row * 16); const f32x4 a = p[0], b = p[1], c = p[2], d = p[3];
                const float s = ((a[0] + a[1]) + (a[2] + a[3])) + ((b[0] + b[1]) + (b[2] + b[3])) + ((c[0] + c[1]) + (c[2] + c[3])) + ((d[0] + d[1]) + (d[2] + d[3]));
                const float rs = __builtin_amdgcn_rsqf(s * (1.f / 512.f) + EPS);
#pragma unroll
                for (int bj = 0; bj < 2; ++bj)
#pragma unroll
                    for (int n = 0; n < 2; ++n) acc[ai][bj][m][n] = acc[ai][bj][m][n] * rs; }
    }
    __device__ __forceinline__ void operator()(const Acc& acc, const Unit& u, int wr, int wc, int fr, int fq) const {
        const int row0 = u.pm * BM + wr * 64 + fr, col0 = u.pn * BM + wc * 32 + 4 * fq;
#pragma unroll
        for (int ai = 0; ai < 2; ++ai)
#pragma unroll
            for (int m = 0; m < 4; ++m) { const int row = row0 + ai * HALF + m * 16; const size_t off = (size_t)row * DM + col0;
#pragma unroll
                for (int bj = 0; bj < 2; ++bj)
#pragma unroll
                    for (int n = 0; n < 2; ++n) { const f32x4 v = *(const GAS f32x4*)(basep + off + bj * HALF + n * 16) + acc[ai][bj][m][n]; *(GAS f32x4*)(hout + off + bj * HALF + n * 16) = v; }
                asm volatile("" ::: "memory"); }
    }
};
struct EpiUp {
    static constexpr bool PERM = true; static constexpr int MIDK = 0;
    GAS bf16* Z; const GAS float* ssq;
    __device__ __forceinline__ void mid(Acc&, const Unit&, int, int, int, int) const {}
    __device__ __forceinline__ void operator()(const Acc& acc, const Unit& u, int wr, int wc, int fr, int fq) const {
        const int row0 = u.pm * BM + wr * 64 + fr, col0 = u.pn * BM + wc * 32 + 8 * fq;
#pragma unroll
        for (int ai = 0; ai < 2; ++ai)
#pragma unroll
            for (int m = 0; m < 4; ++m) { const int row = row0 + ai * HALF + m * 16; const float rs = rstd16(ssq, row); GAS bf16* rowp = Z + (size_t)row * DFF + col0;
#pragma unroll
                for (int bj = 0; bj < 2; ++bj) { f32x4 v0 = acc[ai][bj][m][0] * rs, v1 = acc[ai][bj][m][1] * rs;
#pragma unroll
                    for (int i = 0; i < 4; ++i) { const float a = fmaxf(v0[i], 0.f), b = fmaxf(v1[i], 0.f); v0[i] = a * a; v1[i] = b * b; }
                    u32x4 w; w.x = pk2(v0[0], v0[1]); w.y = pk2(v0[2], v0[3]); w.z = pk2(v1[0], v1[1]); w.w = pk2(v1[2], v1[3]); *(GAS u32x4*)(rowp + bj * HALF) = w; } }
    }
};
struct EpiPP {
    static constexpr bool PERM = false; static constexpr int MIDK = 0;
    GAS bf16* PPB;
    __device__ __forceinline__ void mid(Acc&, const Unit&, int, int, int, int) const {}
    __device__ __forceinline__ void operator()(const Acc& acc, const Unit& u, int wr, int wc, int fr, int fq) const {
        const int row0 = u.pm * BM + wr * 64 + fr, col0 = u.pn * BM + wc * 32 + 4 * fq;
#pragma unroll
        for (int ai = 0; ai < 2; ++ai)
#pragma unroll
            for (int m = 0; m < 4; ++m) { const size_t off = (size_t)(row0 + ai * HALF + m * 16) * DM + col0;
#pragma unroll
                for (int bj = 0; bj < 2; ++bj)
#pragma unroll
                    for (int n = 0; n < 2; ++n) { const f32x4 v = acc[ai][bj][m][n]; u32x2 w; w.x = pk2(v[0], v[1]); w.y = pk2(v[2], v[3]); *(GAS u32x2*)(PPB + off + bj * HALF + n * 16) = w; } }
    }
};
struct EpiGate {
    static constexpr bool PERM = false; static constexpr int MIDK = 0;
    GAS float* h; GAS bf16* hb; const GAS bf16* PPB; const GAS float* ssq_in; GAS float* ssq_out;
    __device__ __forceinline__ void mid(Acc&, const Unit&, int, int, int, int) const {}
    __device__ __forceinline__ void operator()(const Acc& acc, const Unit& u, int wr, int wc, int fr, int fq) const {
        const int row0 = u.pm * BM + wr * 64 + fr, col0 = u.pn * BM + wc * 32 + 4 * fq;
#pragma unroll
        for (int ai = 0; ai < 2; ++ai)
#pragma unroll
            for (int m = 0; m < 4; ++m) { const int row = row0 + ai * HALF + m * 16; const size_t off = (size_t)row * DM + col0; float ss = 0.f;
                if (row < MREAL) { const float rs = rstd16(ssq_in, row);
#pragma unroll
                    for (int bj = 0; bj < 2; ++bj)
#pragma unroll
                        for (int n = 0; n < 2; ++n) { const f32x4 a = acc[ai][bj][m][n] * rs; const u32x2 pw = *(const GAS u32x2*)(PPB + off + bj * HALF + n * 16);
                            f32x4 v = *(const GAS f32x4*)(h + off + bj * HALF + n * 16);
                            v[0] += fsigmoid(a[0]) * bflo(pw.x); v[1] += fsigmoid(a[1]) * bfhi(pw.x); v[2] += fsigmoid(a[2]) * bflo(pw.y); v[3] += fsigmoid(a[3]) * bfhi(pw.y);
                            *(GAS f32x4*)(h + off + bj * HALF + n * 16) = v; u32x2 w; w.x = pk2(v[0], v[1]); w.y = pk2(v[2], v[3]); *(GAS u32x2*)(hb + off + bj * HALF + n * 16) = w;
                            ss += (v[0] * v[0] + v[1] * v[1]) + (v[2] * v[2] + v[3] * v[3]); }
                }
                ss += swz_xor<16>(ss); ss = sum_halves(ss);
                if (fq == 0) ssq_out[(size_t)row * 16 + u.pn * 4 + wc] = ss;
                asm volatile("" ::: "memory"); }
    }
};

#define RLX_AGENT __ATOMIC_RELAXED, __HIP_MEMORY_SCOPE_AGENT
#define XB_TMO      128
#define XB_XCNT(j)  (256  + 64 * (j))
#define XB_XSUB(j)  (1280 + 64 * (j))
#define XB_XGEN(j)  (2304 + 64 * (j))
#define XB_TOP      3328
#define XB_TOPGEN   3392
#define XCD_BAR_WORDS 3456
#define XB_SPIN_CAP (1u << 20)
__device__ __forceinline__ unsigned xb_ld(GAS unsigned* p)              { return __hip_atomic_load(p, __ATOMIC_RELAXED, __HIP_MEMORY_SCOPE_AGENT); }
__device__ __forceinline__ unsigned xb_add(GAS unsigned* p, unsigned v) { return __hip_atomic_fetch_add(p, v, __ATOMIC_RELAXED, __HIP_MEMORY_SCOPE_AGENT); }
__device__ __forceinline__ unsigned xb_xcc_id() { return (unsigned)__builtin_amdgcn_s_getreg((3 << 11) | 20) & 0xFu; }
#define XB_SPIN(cond, bar) do { unsigned _sp = 0; while (cond) { __builtin_amdgcn_s_sleep(1); \
    if ((++_sp & 255u) == 0u) { if (xb_ld(&(bar)[XB_TMO])) break; if (_sp > XB_SPIN_CAP) { (void)xb_add(&(bar)[XB_TMO], 1u); break; } } } } while (0)
struct XcdBarrier { GAS unsigned* bar; unsigned x; volatile LAS unsigned* st; };
__device__ __forceinline__ XcdBarrier xcd_barrier_post(GAS unsigned* bar, volatile LAS unsigned* st) {
    XcdBarrier b; b.bar = bar; b.x = xb_xcc_id(); b.st = st;
    if (threadIdx.x == 0) (void)xb_add(&bar[XB_XCNT(b.x)], 1u);
    return b;
}
__device__ __forceinline__ void xcd_barrier_complete(GAS unsigned* bar, unsigned x, unsigned& nloc, unsigned& nx) {
    const unsigned G = gridDim.x * gridDim.y * gridDim.z;
    unsigned sum, cnt, mine, sp = 0u;
    for (;;) {
        sum = 0u; cnt = 0u; mine = 0u;
#pragma unroll
        for (unsigned j = 0; j < 16; ++j) { const unsigned c = xb_ld(&bar[XB_XCNT(j)]); sum += c; cnt += (c > 0u) ? 1u : 0u; mine = (j == x) ? c : mine; }
        if (sum == G) break;
        __builtin_amdgcn_s_sleep(1);
        if ((++sp & 255u) == 0u) { if (xb_ld(&bar[XB_TMO])) break; if (sp > XB_SPIN_CAP) { (void)xb_add(&bar[XB_TMO], 1u); break; } }
    }
    nloc = mine > 0u ? mine : 1u; nx = cnt > 0u ? cnt : 1u;
}
__device__ __forceinline__ void xcd_barrier(const XcdBarrier& b, const int tid) {
    asm volatile("s_waitcnt vmcnt(0)" ::: "memory");
    __syncthreads();
    if (tid == 0) {
        GAS unsigned* bar = b.bar;
        __builtin_amdgcn_s_waitcnt(0);
        unsigned nloc = b.st[0], nx = b.st[1];
        if (nloc == 0u) { xcd_barrier_complete(bar, b.x, nloc, nx); b.st[0] = nloc; b.st[1] = nx; }
        const unsigned old = xb_add(&bar[XB_XSUB(b.x)], 1u);
        const unsigned gen = old / nloc;
        if (old + 1u == (gen + 1u) * nloc) {
            __builtin_amdgcn_fence(__ATOMIC_RELEASE, "agent");
            asm volatile("s_waitcnt vmcnt(0)" ::: "memory");
            const unsigned og = xb_add(&bar[XB_TOP], 1u);
            const unsigned tg = og / nx;
            if (og + 1u == (tg + 1u) * nx) xb_add(&bar[XB_TOPGEN], 1u);
            else XB_SPIN(xb_ld(&bar[XB_TOPGEN]) == tg, bar);
            __builtin_amdgcn_fence(__ATOMIC_ACQUIRE, "agent");
            xb_add(&bar[XB_XGEN(b.x)], 1u);
            asm volatile("s_waitcnt vmcnt(0)" ::: "memory");
        } else {
            XB_SPIN(xb_ld(&bar[XB_XGEN(b.x)]) == gen, bar);
            __builtin_amdgcn_fence(__ATOMIC_ACQUIRE, "agent");
            asm volatile("s_waitcnt vmcnt(0)" ::: "memory");
        }
    }
    __syncthreads();
}

struct Frame {
    LAS unsigned char* lds;
    int tid, lane, wave, G, bx;
    const LAS unsigned long long* intab;
    struct InAcc { const LAS unsigned long long* t; __device__ __forceinline__ const GAS float* operator[](int i) const { const unsigned long long v = t[i];
        const unsigned lo = __builtin_amdgcn_readfirstlane((unsigned)v), hi = __builtin_amdgcn_readfirstlane((unsigned)(v >> 32)); return (const GAS float*)(((unsigned long long)hi << 32) | lo); } } in;
    GAS float* out; GAS unsigned char* ws;
#define FPTR(name, type, off) __device__ __forceinline__ GAS type* name() const { return (GAS type*)(ws + (off)); }
    FPTR(BIG, bf16, WS_BIG) FPTR(HB, bf16, WS_HB) FPTR(HB2, bf16, WS_HB2) FPTR(PB, bf16, WS_PB) FPTR(LA, bf16, WS_LA) FPTR(BB, bf16, WS_BB) FPTR(XA, bf16, WS_XA) FPTR(TS, float, WS_TS) FPTR(PPB, bf16, WS_PPB)
    FPTR(DT, float, WS_DT) FPTR(SSQ_MIX, float, WS_SSQ_MIX) FPTR(SSQ_FFN, float, WS_SSQ_FFN) FPTR(SSQ_PLE, float, WS_SSQ_PLE) FPTR(SSDP, float, WS_SSDP) FPTR(LBS, float, WS_LBS) FPTR(WAT, bf16, WS_WAT)
#undef FPTR
};
__device__ __forceinline__ GAS bf16* w_in_t(GAS unsigned char* ws, int l) { return (GAS bf16*)(ws + WS_WIN) + (size_t)l * NPJP * DM; }
__device__ __forceinline__ GAS bf16* w_out_t(GAS unsigned char* ws, int l) { return (GAS bf16*)(ws + WS_WOUT) + (size_t)l * DM * DMIX; }
__device__ __forceinline__ GAS bf16* w_up_t(GAS unsigned char* ws, int l) { return (GAS bf16*)(ws + WS_WUP) + (size_t)l * DFF * DM; }
__device__ __forceinline__ GAS bf16* w_dn_t(GAS unsigned char* ws, int l) { return (GAS bf16*)(ws + WS_WDN) + (size_t)l * DM * DFF; }
__device__ __forceinline__ GAS bf16* w_g_t(GAS unsigned char* ws, int l) { return (GAS bf16*)(ws + WS_WG) + (size_t)l * DM * DM; }
__device__ __forceinline__ GAS bf16* w_pj_t(GAS unsigned char* ws, int l) { return (GAS bf16*)(ws + WS_WPJ) + (size_t)l * DM * PLE; }

__device__ __forceinline__ int win_src(int n0) {
    if (n0 < 512) return 1536 + n0;
    if (n0 < 1024) return n0 - 512;
    if (n0 < 1536) return 2312 + (n0 - 1024);
    if (n0 < 1792) return 2048 + (n0 - 1536);
    if (n0 < 2304) return 512 + (n0 - 1792);
    if (n0 < 2816) return 1024 + (n0 - 2304);
    if (n0 < 3328) return 2824 + (n0 - 2816);
    if (n0 < 3840) return 3336 + (n0 - 3328);
    if (n0 < 4352) return 3848 + (n0 - 3840);
    return 2304 + (n0 - 4352);
}
__device__ __forceinline__ void p0_item(const GAS float* W, int ldw, GAS bf16* WT, int K, int N, int mode, const GAS float* ks, LAS float* scr, int item, int lane) {
    const int nblk = N / 32, kb = item / nblk, nb = item % nblk, k0 = 64 * kb, n0 = 32 * nb;
    int sn0 = n0, nvalid = 32;
    if (mode == 1) { sn0 = win_src(n0); if (n0 >= NPJ) nvalid = (n0 == NPJ) ? 8 : 0; }
#pragma unroll 8
    for (int i = 0; i < 32; ++i) { const int kk = 2 * i + (lane >> 5), k = k0 + kk; int sk = k; float sc = 1.f;
        if (mode == 2) { sk = (k < 512) ? 512 + k : (k < 1024 ? k - 512 : k); if (k < 512) sc = ks[k]; } else if (ks) sc = ks[k];
        float v = 0.f; if ((lane & 31) < nvalid) v = W[(size_t)sk * ldw + sn0 + (lane & 31)];
        scr[kk * 33 + (lane & 31)] = v * sc; }
    asm volatile("s_waitcnt lgkmcnt(0)" ::: "memory");
    const int c = lane & 7;
#pragma unroll
    for (int j = 0; j < 4; ++j) { const int n = (lane >> 3) + 8 * j; const LAS float* s = scr + (8 * c) * 33 + n;
        u32x4 o; o.x = pk2(s[0 * 33], s[1 * 33]); o.y = pk2(s[2 * 33], s[3 * 33]); o.z = pk2(s[4 * 33], s[5 * 33]); o.w = pk2(s[6 * 33], s[7 * 33]);
        *(GAS u32x4*)(WT + (size_t)(n0 + n) * K + k0 + 8 * c) = o; }
    asm volatile("s_waitcnt lgkmcnt(0)" ::: "memory");
}
__device__ __forceinline__ void p0_prologue(Frame& F) {
    LAS float* scr = (LAS float*)(F.lds + F.wave * 16384);
    const int gw = F.bx * 8 + F.wave, NGW = F.G * 8;
    constexpr int I_IN = (DM / 64) * (NPJP / 32), I_OUT = (DMIX / 64) * (DM / 32), I_UP = (DM / 64) * (DFF / 32), I_DN = (DFF / 64) * (DM / 32), I_G = (DM / 64) * (DM / 32), I_PJ = (PLE / 64) * (DM / 32);
    constexpr int PER_L = I_IN + I_OUT + I_UP + I_DN + I_G + I_PJ;
    for (int it = gw; it < NL * PER_L; it += NGW) {
        const int l = it / PER_L; int r = it % PER_L;
        if (r < I_IN) { p0_item(F.in[I_WIN] + (size_t)l * DM * DIN, DIN, w_in_t(F.ws, l), DM, NPJP, 1, F.in[I_NMIX] + l * DM, scr, r, F.lane); continue; } r -= I_IN;
        if (r < I_OUT) { p0_item(F.in[I_WOUT] + (size_t)l * DMIX * DM, DM, w_out_t(F.ws, l), DMIX, DM, 2, F.in[I_SNORM] + l * 512, scr, r, F.lane); continue; } r -= I_OUT;
        if (r < I_UP) { p0_item(F.in[I_WUP] + (size_t)l * DM * DFF, DFF, w_up_t(F.ws, l), DM, DFF, 0, F.in[I_NFFN] + l * DM, scr, r, F.lane); continue; } r -= I_UP;
        if (r < I_DN) { p0_item(F.in[I_WDN] + (size_t)l * DFF * DM, DM, w_dn_t(F.ws, l), DFF, DM, 0, nullptr, scr, r, F.lane); continue; } r -= I_DN;
        if (r < I_G) { p0_item(F.in[I_WG] + (size_t)l * DM * DM, DM, w_g_t(F.ws, l), DM, DM, 0, F.in[I_NPLE] + l * DM, scr, r, F.lane); continue; } r -= I_G;
        p0_item(F.in[I_WPJ] + (size_t)l * PLE * DM, DM, w_pj_t(F.ws, l), PLE, DM, 0, nullptr, scr, r, F.lane);
    }
    for (int m = gw; m < MREAL; m += NGW) {
        const GAS float* xr = (m < MPR) ? F.in[I_XP] + (size_t)m * DM : F.in[I_XS] + (size_t)(m - MPR) * DM;
        f32x4 v[4]; float s = 0.f;
#pragma unroll
        for (int j = 0; j < 4; ++j) { v[j] = ((const GAS f32x4*)xr)[F.lane + 64 * j]; s += (v[j][0] * v[j][0] + v[j][1] * v[j][1]) + (v[j][2] * v[j][2] + v[j][3] * v[j][3]); }
        s = wave_sum(s);
#pragma unroll
        for (int j = 0; j < 4; ++j) { u32x2 w; w.x = pk2(v[j][0], v[j][1]); w.y = pk2(v[j][2], v[j][3]); ((GAS u32x2*)(F.HB() + (size_t)m * DM))[F.lane + 64 * j] = w; }
        if (F.lane < 16) F.SSQ_MIX()[(size_t)m * 16 + F.lane] = (F.lane == 0) ? s : 0.f;
    }
    const int gt = F.bx * 512 + F.tid, NGT = F.G * 512;
    for (int e = gt; e < NL * 2 * 8 * 64 * 64; e += NGT) { const int i = e & 63, j = (e >> 6) & 63, h = (e >> 12) & 7, g = (e >> 15) & 1, l = e >> 16;
        F.WAT()[e] = f2bf(F.in[g ? I_WX : I_WA][(((size_t)l * 8 + h) * 64 + i) * 64 + j]); }
    for (int e = gt; e < NL * 512; e += NGT) { const int l = e / 512, c = e % 512;
        float mx = -1e30f; for (int q = 0; q < NL; ++q) mx = fmaxf(mx, F.in[I_HLB][q * 512 + c]);
        float den = 0.f, cs = 0.f, c0 = 0.f; for (int q = 0; q < NL; ++q) den += __expf(F.in[I_HLB][q * 512 + c] - mx);
        for (int q = 0; q <= l; ++q) { const float p = __expf(F.in[I_HLB][q * 512 + c] - mx) / den; cs += p; if (q == 0) c0 = p; }
        F.LBS()[e] = cs - c0; }
}

__device__ __forceinline__ void p2a_rg_item(Frame& F, int l, int item) {
    const int tt = item >> 3, h = item & 7, row0 = tt * 32, lane = F.lane, r = lane & 31, hf = lane >> 5;
    LAS float* xt = (LAS float*)(F.lds + F.wave * 8704);
    const int gc = 64 * h + lane;
    const GAS float* cw = F.in[I_CAW] + l * 4 * 512; const float w0 = cw[gc], w1 = cw[512 + gc], w2 = cw[1024 + gc], w3 = cw[1536 + gc], cb = F.in[I_CAB][l * 512 + gc];
    const GAS bf16* ax = F.BIG() + (size_t)row0 * NPJ + PC_AX + gc;
    const bool first = (row0 % SEQ) == 0;
    float p3 = 0.f, p2 = 0.f, p1 = 0.f;
    if (!first) { p3 = bf2f(ax[-3 * NPJ]); p2 = bf2f(ax[-2 * NPJ]); p1 = bf2f(ax[-1 * NPJ]); }
#pragma unroll 8
    for (int t = 0; t < 32; ++t) { const float cur = bf2f(ax[(size_t)t * NPJ]); xt[t * 68 + lane] = w0 * p3 + w1 * p2 + w2 * p1 + w3 * cur + cb; p3 = p2; p2 = p1; p1 = cur; }
    if ((row0 + 32) % SEQ == 0) { const int b = row0 / SEQ; GAS float* o = F.out + O_RCP + ((size_t)(l * 8 + b) * 3) * 512 + gc; o[0] = p3; o[512] = p2; o[1024] = p1; }
    bf16x8 af[4];
#pragma unroll
    for (int s = 0; s < 4; ++s) { const f32x4 a = *(const LAS f32x4*)(xt + r * 68 + 16 * s + 8 * hf), b = *(const LAS f32x4*)(xt + r * 68 + 16 * s + 8 * hf + 4);
        u32x4 w; w.x = pk2(a[0], a[1]); w.y = pk2(a[2], a[3]); w.z = pk2(b[0], b[1]); w.w = pk2(b[2], b[3]); af[s] = __builtin_bit_cast(bf16x8, w); }
#pragma unroll
    for (int jb = 0; jb < 2; ++jb) {
        f32x16 ar, ai;
#pragma unroll
        for (int q = 0; q < 16; ++q) { ar[q] = 0.f; ai[q] = 0.f; }
        const GAS bf16* wr_ = F.WAT() + ((((size_t)l * 2 + 0) * 8 + h) * 64 + 32 * jb + r) * 64 + 8 * hf;
        const GAS bf16* wi_ = F.WAT() + ((((size_t)l * 2 + 1) * 8 + h) * 64 + 32 * jb + r) * 64 + 8 * hf;
#pragma unroll
        for (int s = 0; s < 4; ++s) { const bf16x8 br = *(const GAS bf16x8*)(wr_ + 16 * s), bi = *(const GAS bf16x8*)(wi_ + 16 * s); ar = mfma32(af[s], br, ar); ai = mfma32(af[s], bi, ai); }
        const int j = 32 * jb + r, gj = 64 * h + j;
        const float ba = F.in[I_BA][l * 512 + gj], bx = F.in[I_BX][l * 512 + gj], c8 = -8.f * fsoftplus(-F.in[I_LAM][l * 512 + gj]);
        bf16 labs[16], bvbs[16];
#pragma unroll
        for (int q = 0; q < 16; ++q) { const int t = rowoff(q, hf); const float rr = fsigmoid(ar[q] + ba), ii = fsigmoid(ai[q] + bx), la = c8 * rr;
            float mult = __builtin_amdgcn_sqrtf(fmaxf(fnegexpm1(2.f * la), 0.f)); if (((row0 + t) % SEQ) == 0) mult = 1.f;
            const float bv = mult * ii * xt[t * 68 + j]; const bf16 lab = f2bf(la), bvb = f2bf(bv); labs[q] = lab; bvbs[q] = bvb;
            ar[q] = fexp(bf2f(lab)); ai[q] = bf2f(bvb); }
#pragma unroll
        for (int k = 0; k < 4; ++k) { const size_t o = (((size_t)tt * 4 + k) * 512 + gj) * 8 + 4 * hf;
            u32x2 wl, wb; wl.x = labs[4 * k] | ((unsigned)labs[4 * k + 1] << 16); wl.y = labs[4 * k + 2] | ((unsigned)labs[4 * k + 3] << 16); wb.x = bvbs[4 * k] | ((unsigned)bvbs[4 * k + 1] << 16); wb.y = bvbs[4 * k + 2] | ((unsigned)bvbs[4 * k + 3] << 16);
            *(GAS u32x2*)(F.LA() + o) = wl; *(GAS u32x2*)(F.BB() + o) = wb; }
        float gA[4], gB[4];
#pragma unroll
        for (int k = 0; k < 4; ++k) { float A_ = 1.f, B_ = 0.f;
#pragma unroll
            for (int i = 0; i < 4; ++i) { B_ = ar[4 * k + i] * B_ + ai[4 * k + i]; A_ *= ar[4 * k + i]; }
            gA[k] = A_; gB[k] = B_; }
        float A_ = 1.f, B_ = 0.f;
#pragma unroll
        for (int k = 0; k < 4; ++k) { const unsigned ua = __float_as_uint(gA[k]), ub = __float_as_uint(gB[k]);
            auto ra = __builtin_amdgcn_permlane32_swap(ua, ua, false, false); auto rb_ = __builtin_amdgcn_permlane32_swap(ub, ub, false, false);
            const float loA = __uint_as_float(ra[0]), hiA = __uint_as_float(ra[1]), loB = __uint_as_float(rb_[0]), hiB = __uint_as_float(rb_[1]);
            B_ = loA * B_ + loB; A_ *= loA; B_ = hiA * B_ + hiB; A_ *= hiA; }
        if (hf == 0) { typedef float f32x2t __attribute__((ext_vector_type(2))); *(GAS f32x2t*)(F.TS() + ((size_t)tt * 512 + gj) * 2) = (f32x2t){A_, B_}; }
    }
}
__device__ __forceinline__ void p2a_conv_item(Frame& F, int l, int item) {
    const int tt = item / 3, g = item % 3, row0 = tt * 32, ch = 256 * g + 4 * F.lane, col = ch < 512 ? PC_XS + ch : PC_B + (ch - 512);
    const GAS float* cw = F.in[I_CBW] + l * 4 * 768 + ch; const f32x4 w0 = *(const GAS f32x4*)cw, w1 = *(const GAS f32x4*)(cw + 768), w2 = *(const GAS f32x4*)(cw + 1536), w3 = *(const GAS f32x4*)(cw + 2304), cb = *(const GAS f32x4*)(F.in[I_CBB] + l * 768 + ch);
    const GAS bf16* src = F.BIG() + (size_t)row0 * NPJ + col;
    const bool first = (row0 % SEQ) == 0;
    f32x4 p3 = {0.f, 0.f, 0.f, 0.f}, p2 = p3, p1 = p3;
    auto ld4 = [](const GAS bf16* p) { const u32x2 w = *(const GAS u32x2*)p; return (f32x4){bflo(w.x), bfhi(w.x), bflo(w.y), bfhi(w.y)}; };
    if (!first) { p3 = ld4(src - 3 * NPJ); p2 = ld4(src - 2 * NPJ); p1 = ld4(src - NPJ); }
#pragma unroll 4
    for (int t = 0; t < 32; ++t) { const f32x4 cur = ld4(src + (size_t)t * NPJ); const f32x4 y = w0 * p3 + w1 * p2 + w2 * p1 + w3 * cur + cb;
        u32x2 w; w.x = pk2(fsilu(y[0]), fsilu(y[1])); w.y = pk2(fsilu(y[2]), fsilu(y[3])); *(GAS u32x2*)(F.XA() + (size_t)(row0 + t) * 768 + ch) = w; p3 = p2; p2 = p1; p1 = cur; }
    if ((row0 + 32) % SEQ == 0) { const int b = row0 / SEQ; GAS float* o = F.out + O_SCP + ((size_t)(l * 8 + b) * 3) * 768 + ch; *(GAS f32x4*)o = p3; *(GAS f32x4*)(o + 768) = p2; *(GAS f32x4*)(o + 1536) = p1; }
}
__device__ __forceinline__ void p2a_pb_item(Frame& F, int l, int item) {
#pragma unroll
    for (int rr = 0; rr < 8; ++rr) { const int row = 8 * item + rr;
        if (row < MREAL) { const GAS float* s = (row < MPR) ? F.in[I_PP] + ((size_t)l * MPR + row) * PLE : F.in[I_PS] + ((size_t)l * MSM + row - MPR) * PLE;
            const f32x4 v = ((const GAS f32x4*)s)[F.lane]; u32x2 w; w.x = pk2(v[0], v[1]); w.y = pk2(v[2], v[3]); ((GAS u32x2*)(F.PB() + (size_t)row * PLE))[F.lane] = w; } }
}

__device__ __forceinline__ void smp_rg_item(Frame& F, int l, int i, int hh) {
    const int lane = F.lane, c = 64 * hh + lane; const size_t row = (size_t)MPR + i; GAS bf16* pr = F.BIG() + row * NPJ;
    LAS float* sx = (LAS float*)(F.lds + F.wave * 8704);
    const GAS float* st = F.in[I_SRC] + ((size_t)(l * MSM + i) * 3) * 512 + c; const float b0 = st[0], b1 = st[512], b2 = st[1024], cur = bf2f(pr[PC_AX + c]);
    const GAS float* cw = F.in[I_CAW] + l * 4 * 512; const float xa = cw[c] * b0 + cw[512 + c] * b1 + cw[1024 + c] * b2 + cw[1536 + c] * cur + F.in[I_CAB][l * 512 + c];
    { GAS float* o = F.out + O_RCS + ((size_t)(l * MSM + i) * 3) * 512 + c; o[0] = b1; o[512] = b2; o[1024] = cur; }
    sx[lane] = xa;
    const GAS float* wa = F.in[I_WA] + ((size_t)(l * 8 + hh) * 64) * 64 + lane; const GAS float* wx = F.in[I_WX] + ((size_t)(l * 8 + hh) * 64) * 64 + lane;
    const float h0 = F.in[I_SRH][(size_t)(l * MSM + i) * 512 + c], ga = bf2f(pr[PC_AG + c]);
    float ar = 0.f, ai = 0.f;
#pragma nounroll
    for (int hb_ = 0; hb_ < 4; ++hb_) { float wv[16], xv[16];
#pragma unroll
        for (int q = 0; q < 16; ++q) { wv[q] = wa[(16 * hb_ + q) * 64]; xv[q] = wx[(16 * hb_ + q) * 64]; }
#pragma unroll
        for (int q = 0; q < 16; ++q) { const float x = sx[16 * hb_ + q]; ar += x * wv[q]; ai += x * xv[q]; } }
    const float rr = fsigmoid(ar + F.in[I_BA][l * 512 + c]), ii = fsigmoid(ai + F.in[I_BX][l * 512 + c]), la = -8.f * fsoftplus(-F.in[I_LAM][l * 512 + c]) * rr;
    const float a = fexp(la), mult = __builtin_amdgcn_sqrtf(fmaxf(fnegexpm1(2.f * la), 0.f));
    const float hn = a * h0 + mult * ii * xa;
    F.out[O_RHS + (size_t)(l * MSM + i) * 512 + c] = hn; pr[PC_AX + c] = f2bf(hn * ga);
}
__device__ __forceinline__ float smp_conv_b(Frame& F, int l, int i, int ch, const GAS bf16* pr, bool wr) {
    const int col = ch < 512 ? PC_XS + ch : PC_B + (ch - 512);
    const GAS float* st = F.in[I_SSC] + ((size_t)(l * MSM + i) * 3) * 768 + ch; const float b0 = st[0], b1 = st[768], b2 = st[1536], cur = bf2f(pr[col]);
    const GAS float* cw = F.in[I_CBW] + l * 4 * 768;
    if (wr) { GAS float* o = F.out + O_SCS + ((size_t)(l * MSM + i) * 3) * 768 + ch; o[0] = b1; o[768] = b2; o[1536] = cur; }
    return fsilu(cw[ch] * b0 + cw[768 + ch] * b1 + cw[1536 + ch] * b2 + cw[2304 + ch] * cur + F.in[I_CBB][l * 768 + ch]);
}
__device__ __forceinline__ void smp_ssd_item(Frame& F, int l, int i, int hh) {
    const int lane = F.lane, half = lane >> 5, ln = lane & 31, n0 = 4 * ln; const size_t row = (size_t)MPR + i; GAS bf16* pr = F.BIG() + row * NPJ;
    LAS float* sX = (LAS float*)(F.lds + F.wave * 8704); LAS float* sB = sX + 64; LAS float* sC = sB + 128; LAS float* sY = sC + 128;
    const float zg = bf2f(pr[PC_BZ + 64 * hh + lane]);
    const float xh = smp_conv_b(F, l, i, 64 * hh + lane, pr, true);
    const float bq0 = smp_conv_b(F, l, i, 512 + lane, pr, hh == 0), bq1 = smp_conv_b(F, l, i, 576 + lane, pr, hh == 0), cq0 = smp_conv_b(F, l, i, 640 + lane, pr, hh == 0), cq1 = smp_conv_b(F, l, i, 704 + lane, pr, hh == 0);
    sX[lane] = xh; sB[lane] = bq0; sB[64 + lane] = bq1; sC[lane] = cq0; sC[64 + lane] = cq1;
    const float dtv = fsoftplus(F.DT()[row * 8 + hh] + F.in[I_DTB][l * 8 + hh]), dA = fexp(-dtv * __expf(F.in[I_ALOG][l * 8 + hh])), Dh = F.in[I_SSD_D][l * 8 + hh];
    const f32x4 Bn = *(const LAS f32x4*)(sB + n0), Cn = *(const LAS f32x4*)(sC + n0);
    const GAS float* sin_ = F.in[I_SSS] + (((size_t)(l * MSM + i) * 8 + hh) * 64) * 128; GAS float* sout = F.out + O_SSS + (((size_t)(l * MSM + i) * 8 + hh) * 64) * 128;
#pragma nounroll
    for (int hb_ = 0; hb_ < 2; ++hb_) { f32x4 sv[16];
#pragma unroll
        for (int k = 0; k < 16; ++k) sv[k] = *(const GAS f32x4*)(sin_ + (2 * (16 * hb_ + k) + half) * 128 + n0);
#pragma unroll
        for (int k = 0; k < 16; ++k) { const int p = 2 * (16 * hb_ + k) + half; const float xv = sX[p], xdt = dtv * xv;
            const f32x4 sn = sv[k] * dA + Bn * xdt; *(GAS f32x4*)(sout + p * 128 + n0) = sn;
            float yv = (Cn[0] * sn[0] + Cn[1] * sn[1]) + (Cn[2] * sn[2] + Cn[3] * sn[3]);
            yv = sum32(yv);
            if (ln == 0) sY[p] = yv + Dh * xv; } }
    const float yg = sY[lane] * zg; pr[PC_XS + 64 * hh + lane] = f2bf(yg);
    const float ssq = wave_sum(yg * yg);
    if (lane == 0) { F.SSDP()[row * 16 + 2 * hh] = ssq; F.SSDP()[row * 16 + 2 * hh + 1] = 0.f; }
}
__device__ __forceinline__ void smp_hg_item(Frame& F, int l, int i, int hh) {
    const int lane = F.lane; const size_t row = (size_t)MPR + i; GAS bf16* pr = F.BIG() + row * NPJ;
    LAS float* sQ = (LAS float*)(F.lds + F.wave * 8704); LAS float* sFd = sQ + 64; LAS float* sK = sFd + 64;
    const float lf = bf2f(pr[PC_CF + 64 * hh + lane]), vv = bf2f(pr[PC_CI + 64 * hh + lane]), gz = bf2f(pr[PC_CG + 64 * hh + lane]);
    sQ[lane] = bf2f(pr[PC_CQ + 64 * hh + lane]); sFd[lane] = fexp(lf); sK[lane] = fnegexpm1(lf);
    const GAS float* sin_ = F.in[I_SHG] + (((size_t)(l * MSM + i) * 8 + hh) * 64) * 64 + lane; GAS float* sout = F.out + O_HSS + (((size_t)(l * MSM + i) * 8 + hh) * 64) * 64 + lane;
    float o = 0.f;
#pragma nounroll
    for (int hb_ = 0; hb_ < 2; ++hb_) { float sv[32];
#pragma unroll
        for (int k = 0; k < 32; ++k) sv[k] = sin_[(32 * hb_ + k) * 64];
#pragma unroll
        for (int k = 0; k < 32; ++k) { const int dd = 32 * hb_ + k; const float sn = sFd[dd] * sv[k] + sK[dd] * vv; sout[dd * 64] = sn; o += sQ[dd] * sn; } }
    const float ss = wave_sum(o * o); const float rs = __builtin_amdgcn_rsqf(ss * (1.f / 64.f) + EPS);
    pr[PC_CQ + 64 * hh + lane] = f2bf(o * rs * F.in[I_HNORM][l * 64 + lane] * gz);
}
__device__ __forceinline__ void p2a_phase(Frame& F, int l) {
    const int gw = F.bx * 8 + F.wave, NGW = F.G * 8;
    constexpr int N_RG = (MPR / 32) * 8, N_CV = (MPR / 32) * 3, N_PB = MP / 8, N_SM = MSM * 8 * 3;
#pragma nounroll
    for (int it = gw; it < N_SM + N_RG + N_CV + N_PB; it += NGW) {
        if (it < N_SM) { const int m3 = it % 3, th = it / 3, hh = th & 7, i = th >> 3;
            if (m3 == 0) smp_ssd_item(F, l, i, hh); else if (m3 == 1) smp_hg_item(F, l, i, hh); else smp_rg_item(F, l, i, hh); }
        else if (it < N_SM + N_RG) p2a_rg_item(F, l, it - N_SM);
        else if (it < N_SM + N_RG + N_CV) p2a_conv_item(F, l, it - N_SM - N_RG);
        else p2a_pb_item(F, l, it - N_SM - N_RG - N_CV);
    }
}

__device__ __forceinline__ void rg_scan_role(Frame& F, int l, int rid) {
    const int b = rid >> 3, h = rid & 7, lane = F.lane, w = F.wave, gj = 64 * h + lane;
    LAS float* sA = (LAS float*)F.lds; LAS float* sB = sA + 512;
    const size_t rb = (size_t)b * SEQ + 256 * w;
    const GAS bf16* la = F.LA() + rb * 512 + gj; const GAS bf16* bb = F.BB() + rb * 512 + gj;
    float A = 1.f, B = 0.f;
#pragma nounroll
    for (int t = 0; t < 256; t += 8) { float av[8], bv[8];
#pragma unroll
        for (int k = 0; k < 8; ++k) { av[k] = bf2f(la[(size_t)(t + k) * 512]); bv[k] = bf2f(bb[(size_t)(t + k) * 512]); }
#pragma unroll
        for (int k = 0; k < 8; ++k) { const float a = fexp(av[k]); B = a * B + bv[k]; A *= a; } }
    sA[w * 64 + lane] = A; sB[w * 64 + lane] = B;
    WG_BARRIER();
    float hh = 0.f;
    for (int q = 0; q < w; ++q) hh = sA[q * 64 + lane] * hh + sB[q * 64 + lane];
    GAS bf16* pr = F.BIG() + rb * NPJ;
#pragma nounroll
    for (int t = 0; t < 256; t += 8) { float av[8], bv[8], gv[8];
#pragma unroll
        for (int k = 0; k < 8; ++k) { av[k] = bf2f(la[(size_t)(t + k) * 512]); bv[k] = bf2f(bb[(size_t)(t + k) * 512]); gv[k] = bf2f(pr[(size_t)(t + k) * NPJ + PC_AG + gj]); }
#pragma unroll
        for (int k = 0; k < 8; ++k) { hh = fexp(av[k]) * hh + bv[k]; pr[(size_t)(t + k) * NPJ + PC_AX + gj] = f2bf(hh * gv[k]); } }
    if (w == 7) F.out[O_RHP + (size_t)(l * 8 + b) * 512 + gj] = hh;
    WG_BARRIER();
}

__device__ __forceinline__ void rg_apply_role(Frame& F, int l, int rid, int nrole) {
    typedef float f32x2t __attribute__((ext_vector_type(2)));
#pragma nounroll
    for (int bh = rid; bh < 64; bh += nrole) { const int b = bh >> 3, h = bh & 7, lane = F.lane, w = F.wave, gj = 64 * h + lane;
        float hh = 0.f;
        for (int q0 = 0; q0 < 8 * w; q0 += 8) { f32x2t ab[8];
#pragma unroll
            for (int k = 0; k < 8; ++k) ab[k] = *(const GAS f32x2t*)(F.TS() + ((size_t)(64 * b + q0 + k) * 512 + gj) * 2);
#pragma unroll
            for (int k = 0; k < 8; ++k) hh = ab[k].x * hh + ab[k].y; }
        const size_t rb = (size_t)b * SEQ + 256 * w;
        GAS bf16* pr = F.BIG() + rb * NPJ;
#define RG_LOAD(LW, BW, GV, T0) do { const size_t to_ = (((rb + (T0)) >> 5) * 4 * 512 + gj) * 8; \
            _Pragma("unroll") for (int g = 0; g < 4; ++g) { LW[g] = *(const GAS u32x4*)(F.LA() + to_ + (size_t)g * 512 * 8); BW[g] = *(const GAS u32x4*)(F.BB() + to_ + (size_t)g * 512 * 8); } \
            _Pragma("unroll") for (int k = 0; k < 32; ++k) GV[k] = pr[(size_t)((T0) + k) * NPJ + PC_AG + gj]; } while (0)
#define RG_RUN(LW, BW, GV, T0) do { float yv_[32]; \
            _Pragma("unroll") for (int g = 0; g < 4; ++g) { const unsigned lws[4] = {LW[g].x, LW[g].y, LW[g].z, LW[g].w}, bws[4] = {BW[g].x, BW[g].y, BW[g].z, BW[g].w}; \
                _Pragma("unroll") for (int j = 0; j < 4; ++j) { hh = fexp(bflo(lws[j])) * hh + bflo(bws[j]); yv_[8 * g + 2 * j] = hh * bf2f(GV[8 * g + 2 * j]); hh = fexp(bfhi(lws[j])) * hh + bfhi(bws[j]); yv_[8 * g + 2 * j + 1] = hh * bf2f(GV[8 * g + 2 * j + 1]); } } \
            _Pragma("unroll") for (int k = 0; k < 32; ++k) pr[(size_t)((T0) + k) * NPJ + PC_AX + gj] = f2bf(yv_[k]); } while (0)
        u32x4 lwA[4], bwA[4], lwB[4], bwB[4]; bf16 gvA[32], gvB[32];
        RG_LOAD(lwA, bwA, gvA, 0);
#pragma nounroll
        for (int t0 = 0; t0 < 256; t0 += 64) {
            RG_LOAD(lwB, bwB, gvB, t0 + 32);
            RG_RUN(lwA, bwA, gvA, t0);
            if (t0 + 64 < 256) RG_LOAD(lwA, bwA, gvA, t0 + 64);
            RG_RUN(lwB, bwB, gvB, t0 + 32);
        }
#undef RG_LOAD
#undef RG_RUN
        if (w == 7) F.out[O_RHP + (size_t)(l * 8 + b) * 512 + gj] = hh; }
}

constexpr int SLD = 136;
__device__ __forceinline__ void ssd_role(Frame& F, int l, int rid) {
    const int b = rid >> 3, h = rid & 7, tid = F.tid, lane = F.lane, w = F.wave, r = lane & 31, hf = lane >> 5;
    LAS bf16* sC = (LAS bf16*)F.lds; LAS bf16* sBG = sC + 128 * SLD; LAS bf16* sBw = sBG + 128 * SLD; LAS bf16* sXT = sBw + 128 * SLD; LAS bf16* sS = sXT + 64 * SLD;
    LAS float* sCum = (LAS float*)(sS + 64 * SLD); LAS float* sDt = sCum + 128; LAS float* sW = sDt + 128; LAS float* sEc = sW + 128; LAS float* sTmp = sEc + 128;
    const float a_neg = -__expf(F.in[I_ALOG][l * 8 + h]), dtb = F.in[I_DTB][l * 8 + h], Dh = F.in[I_SSD_D][l * 8 + h];
    f32x16 accS;
#ifdef DBG_SSD2
    unsigned mism = 0;
#pragma nounroll
    for (int rep = 0; rep < 2; ++rep) {
#endif
#pragma unroll
    for (int q = 0; q < 16; ++q) accS[q] = 0.f;
    for (int e = tid; e < 64 * SLD; e += 512) sS[e] = 0;
    WG_BARRIER();
#pragma nounroll
    for (int c = 0; c < 16; ++c) {
        const size_t row0 = (size_t)b * SEQ + 128 * c;
#pragma unroll
        for (int i = 0; i < 4; ++i) { const int rr = (tid >> 4) + 32 * i, ck = tid & 15; const GAS bf16* src = F.XA() + (row0 + rr) * 768 + 512 + 8 * ck;
            *(LAS u32x4*)(sBG + rr * SLD + 8 * ck) = *(const GAS u32x4*)src; *(LAS u32x4*)(sC + rr * SLD + 8 * ck) = *(const GAS u32x4*)(src + 128); }
        if (w == 0) { const int t0 = 2 * lane; const float d0 = fsoftplus(F.DT()[(row0 + t0) * 8 + h] + dtb), d1 = fsoftplus(F.DT()[(row0 + t0 + 1) * 8 + h] + dtb);
            const float a0 = d0 * a_neg, a1 = d1 * a_neg; float s = a0 + a1;
#pragma unroll
            for (int o = 1; o < 64; o <<= 1) { const float v = bperm(s, lane - o); if (lane >= o) s += v; }
            const float c1 = s, c0 = s - a1, last = __int_as_float(__builtin_amdgcn_readlane(__float_as_int(s), 63));
            sCum[t0] = c0; sCum[t0 + 1] = c1; sEc[t0] = fexp(c0); sEc[t0 + 1] = fexp(c1); sW[t0] = fexp(last - c0) * d0; sW[t0 + 1] = fexp(last - c1) * d1; sDt[t0] = d0; sDt[t0 + 1] = d1;
            if (lane == 0) sTmp[0] = fexp(last); }
        WG_BARRIER();
        { const int s = tid & 127, pg = tid >> 7; const GAS bf16* src = F.XA() + (row0 + s) * 768;
            const u32x4 x0 = *(const GAS u32x4*)(src + 64 * h + 16 * pg), x1 = *(const GAS u32x4*)(src + 64 * h + 16 * pg + 8);
            const unsigned xw[8] = {x0.x, x0.y, x0.z, x0.w, x1.x, x1.y, x1.z, x1.w};
#pragma unroll
            for (int j = 0; j < 8; ++j) { sXT[(16 * pg + 2 * j) * SLD + s] = (bf16)(xw[j] & 0xffffu); sXT[(16 * pg + 2 * j + 1) * SLD + s] = (bf16)(xw[j] >> 16); }
            const float ws = sW[s];
#pragma unroll
            for (int q4 = 0; q4 < 4; ++q4) { const u32x4 bq = *(const GAS u32x4*)(src + 512 + 32 * pg + 8 * q4); const unsigned bw[4] = {bq.x, bq.y, bq.z, bq.w};
#pragma unroll
                for (int j = 0; j < 4; ++j) { const int n = 32 * pg + 8 * q4 + 2 * j; sBw[n * SLD + s] = f2bf(bflo(bw[j]) * ws); sBw[(n + 1) * SLD + s] = f2bf(bfhi(bw[j]) * ws); } } }
#if DBG_V == 1
        WG_BARRIER();
#endif
        f32x16 cbv[2];
#pragma unroll
        for (int q = 0; q < 2; ++q) { const int blk = 2 * w + q, tb = blk >> 2, sb = blk & 3; f32x16 a_;
#pragma unroll
            for (int z = 0; z < 16; ++z) a_[z] = 0.f;
            if (sb <= tb) {
#pragma unroll
                for (int ks = 0; ks < 8; ++ks) { const bf16x8 a = *(const LAS bf16x8*)(sC + (32 * tb + r) * SLD + 16 * ks + 8 * hf), bb = *(const LAS bf16x8*)(sBG + (32 * sb + r) * SLD + 16 * ks + 8 * hf); a_ = mfma32(a, bb, a_); } }
            cbv[q] = a_; }
        const int tby = w >> 1, pb = w & 1;
        f32x16 y;
#pragma unroll
        for (int z = 0; z < 16; ++z) y[z] = 0.f;
#pragma unroll
        for (int ks = 0; ks < 8; ++ks) { const bf16x8 a = *(const LAS bf16x8*)(sC + (32 * tby + r) * SLD + 16 * ks + 8 * hf), bs = *(const LAS bf16x8*)(sS + (32 * pb + r) * SLD + 16 * ks + 8 * hf); y = mfma32(a, bs, y); }
        WG_BARRIER();
#pragma unroll
        for (int q = 0; q < 2; ++q) { const int blk = 2 * w + q, tb = blk >> 2, sb = blk & 3;
            if (sb <= tb) { const int s_ = 32 * sb + r; const float cs = sCum[s_], ds = sDt[s_];
#pragma unroll
                for (int z = 0; z < 16; ++z) { const int t = 32 * tb + rowoff(z, hf); const float gv = (s_ <= t) ? cbv[q][z] * fexp(sCum[t] - cs) * ds : 0.f; sBG[t * SLD + s_] = f2bf(gv); } } }
#pragma unroll
        for (int z = 0; z < 16; ++z) y[z] *= sEc[32 * tby + rowoff(z, hf)];
        WG_BARRIER();
        for (int ks = 0; ks < 2 * (tby + 1); ++ks) { const bf16x8 a = *(const LAS bf16x8*)(sBG + (32 * tby + r) * SLD + 16 * ks + 8 * hf), bx = *(const LAS bf16x8*)(sXT + (32 * pb + r) * SLD + 16 * ks + 8 * hf); y = mfma32(a, bx, y); }
        { const int p = 32 * pb + r, col = 64 * h + p;
#pragma unroll
            for (int z = 0; z < 16; ++z) { const int t = 32 * tby + rowoff(z, hf); GAS bf16* pr = F.BIG() + (row0 + t) * NPJ;
                const float yv = y[z] + Dh * bf2f(sXT[p * SLD + t]); const float yg = yv * bf2f(pr[PC_BZ + col]);
#ifdef DBG_SSD2
                if (rep == 1) { if (l == 1 && pr[PC_XS + col] != f2bf(yg)) ++mism; } else
#endif
                pr[PC_XS + col] = f2bf(yg);
                const float ss = sum32(yg * yg);
                if (r == 0) F.SSDP()[(row0 + t) * 16 + 2 * h + pb] = ss; } }
#if DBG_V == 2
        WG_BARRIER();
#endif
        { const int pbs = w >> 2, nb = w & 3; const float dec = sTmp[0];
#pragma unroll
            for (int z = 0; z < 16; ++z) accS[z] *= dec;
#pragma unroll
            for (int ks = 0; ks < 8; ++ks) { const bf16x8 a = *(const LAS bf16x8*)(sXT + (32 * pbs + r) * SLD + 16 * ks + 8 * hf), bw = *(const LAS bf16x8*)(sBw + (32 * nb + r) * SLD + 16 * ks + 8 * hf); accS = mfma32(a, bw, accS); }
#pragma unroll
            for (int z = 0; z < 16; ++z) sS[(32 * pbs + rowoff(z, hf)) * SLD + 32 * nb + r] = f2bf(accS[z]); }
        WG_BARRIER();
    }
#ifdef DBG_SSD2
    }
    { const float mt = wave_sum((float)mism); if (lane == 0 && l == 1) F.out[(size_t)(16000 + rid * 8 + w) * DM] = 1000.f * mt; }
#endif
    { const int pbs = w >> 2, nb = w & 3; GAS float* o = F.out + O_SSP + ((size_t)(l * 8 + b) * 8 + h) * 64 * 128;
#pragma unroll
        for (int z = 0; z < 16; ++z) o[(32 * pbs + rowoff(z, hf)) * 128 + 32 * nb + r] = accS[z]; }
}


__device__ __forceinline__ void ssd_role2(Frame& F, int l, int rid) {
    const int b = rid >> 4, h = (rid >> 1) & 7, ph = rid & 1, tid = F.tid, lane = F.lane, w = F.wave, r = lane & 31, hf = lane >> 5;
    LAS bf16* sC = (LAS bf16*)F.lds; LAS bf16* sBG = sC + 128 * SLD; LAS bf16* sBw = sBG + 128 * SLD; LAS bf16* sXT = sBw + 128 * SLD; LAS bf16* sS = sXT + 32 * SLD;
    LAS float* sCum = (LAS float*)(sS + 32 * SLD); LAS float* sDt = sCum + 128; LAS float* sW = sDt + 128; LAS float* sEc = sW + 128; LAS float* sTmp = sEc + 128; LAS float* sYo = sTmp + 16;
    const float a_neg = -__expf(F.in[I_ALOG][l * 8 + h]), dtb = F.in[I_DTB][l * 8 + h], Dh = F.in[I_SSD_D][l * 8 + h];
    const int pcol = 64 * h + 32 * ph;
    f32x16 accS;
#pragma unroll
    for (int q = 0; q < 16; ++q) accS[q] = 0.f;
    for (int e = tid; e < 32 * SLD; e += 512) sS[e] = 0;
    u32x4 rx, rbq[4], rzv; float rd0 = 0.f, rd1 = 0.f;
    const int s_ = tid & 127, pg = tid >> 7, ot = tid >> 2, ock = tid & 3;
#define SSD_LOAD(ROW0) do { \
        { const GAS bf16* src = F.XA() + ((ROW0) + s_) * 768; rx = *(const GAS u32x4*)(src + pcol + 8 * pg); _Pragma("unroll") for (int q4 = 0; q4 < 4; ++q4) rbq[q4] = *(const GAS u32x4*)(src + 512 + 32 * pg + 8 * q4); } \
        rzv = *(const GAS u32x4*)(F.BIG() + ((ROW0) + ot) * NPJ + PC_BZ + pcol + 8 * ock); \
        if (w == 0) { rd0 = F.DT()[((ROW0) + 2 * lane) * 8 + h]; rd1 = F.DT()[((ROW0) + 2 * lane + 1) * 8 + h]; } } while (0)
    SSD_LOAD((size_t)b * SEQ);
    WG_BARRIER();
#pragma nounroll
    for (int c = 0; c < 16; ++c) {
        const size_t row0 = (size_t)b * SEQ + 128 * c;
#pragma unroll
        for (int i = 0; i < 4; ++i) { const int rr = (tid >> 4) + 32 * i, ck = tid & 15; const GAS bf16* src = F.XA() + (row0 + rr) * 768 + 512 + 8 * ck;
            *(LAS u32x4*)(sBG + rr * SLD + 8 * ck) = *(const GAS u32x4*)src; *(LAS u32x4*)(sC + rr * SLD + 8 * ck) = *(const GAS u32x4*)(src + 128); }
        if (w == 0) { const int t0 = 2 * lane; const float d0 = fsoftplus(rd0 + dtb), d1 = fsoftplus(rd1 + dtb);
            const float a0 = d0 * a_neg, a1 = d1 * a_neg; float sc_ = a0 + a1;
#pragma unroll
            for (int o = 1; o < 64; o <<= 1) { const float v = bperm(sc_, lane - o); if (lane >= o) sc_ += v; }
            const float c1 = sc_, c0 = sc_ - a1, last = __int_as_float(__builtin_amdgcn_readlane(__float_as_int(sc_), 63));
            sCum[t0] = c0; sCum[t0 + 1] = c1; sEc[t0] = fexp(c0); sEc[t0 + 1] = fexp(c1); sW[t0] = fexp(last - c0) * d0; sW[t0 + 1] = fexp(last - c1) * d1; sDt[t0] = d0; sDt[t0 + 1] = d1;
            if (lane == 0) sTmp[0] = fexp(last); }
        WG_BARRIER();
        { const unsigned xw[4] = {rx.x, rx.y, rx.z, rx.w};
#pragma unroll
            for (int j = 0; j < 4; ++j) { sXT[(8 * pg + 2 * j) * SLD + s_] = (bf16)(xw[j] & 0xffffu); sXT[(8 * pg + 2 * j + 1) * SLD + s_] = (bf16)(xw[j] >> 16); }
            const float ws_ = sW[s_];
#pragma unroll
            for (int q4 = 0; q4 < 4; ++q4) { const unsigned bw[4] = {rbq[q4].x, rbq[q4].y, rbq[q4].z, rbq[q4].w};
#pragma unroll
                for (int j = 0; j < 4; ++j) { const int n = 32 * pg + 8 * q4 + 2 * j; sBw[n * SLD + s_] = f2bf(bflo(bw[j]) * ws_); sBw[(n + 1) * SLD + s_] = f2bf(bfhi(bw[j]) * ws_); } } }
        const u32x4 zcur = rzv;
        if (c + 1 < 16) SSD_LOAD(row0 + 128);
        f32x16 cbv[2];
#pragma unroll
        for (int q = 0; q < 2; ++q) { const int blk = 2 * w + q, tb = blk >> 2, sb = blk & 3; f32x16 a_;
#pragma unroll
            for (int z = 0; z < 16; ++z) a_[z] = 0.f;
            if (sb <= tb) {
#pragma unroll
                for (int ks = 0; ks < 8; ++ks) { const bf16x8 a = *(const LAS bf16x8*)(sC + (32 * tb + r) * SLD + 16 * ks + 8 * hf), bb = *(const LAS bf16x8*)(sBG + (32 * sb + r) * SLD + 16 * ks + 8 * hf); a_ = mfma32(a, bb, a_); } }
            cbv[q] = a_; }
        f32x16 y;
#pragma unroll
        for (int z = 0; z < 16; ++z) y[z] = 0.f;
        if (w < 4) {
#pragma unroll
            for (int ks = 0; ks < 8; ++ks) { const bf16x8 a = *(const LAS bf16x8*)(sC + (32 * w + r) * SLD + 16 * ks + 8 * hf), bs = *(const LAS bf16x8*)(sS + r * SLD + 16 * ks + 8 * hf); y = mfma32(a, bs, y); } }
        WG_BARRIER();
#pragma unroll
        for (int q = 0; q < 2; ++q) { const int blk = 2 * w + q, tb = blk >> 2, sb = blk & 3;
            if (sb <= tb) { const int sq = 32 * sb + r; const float cs = sCum[sq], ds = sDt[sq];
#pragma unroll
                for (int z = 0; z < 16; ++z) { const int t = 32 * tb + rowoff(z, hf); const float gv = (sq <= t) ? cbv[q][z] * fexp(sCum[t] - cs) * ds : 0.f; sBG[t * SLD + sq] = f2bf(gv); } } }
        if (w < 4) {
#pragma unroll
            for (int z = 0; z < 16; ++z) y[z] *= sEc[32 * w + rowoff(z, hf)]; }
        WG_BARRIER();
        if (w < 4) {
            for (int ks = 0; ks < 2 * (w + 1); ++ks) { const bf16x8 a = *(const LAS bf16x8*)(sBG + (32 * w + r) * SLD + 16 * ks + 8 * hf), bx = *(const LAS bf16x8*)(sXT + r * SLD + 16 * ks + 8 * hf); y = mfma32(a, bx, y); }
#pragma unroll
            for (int z = 0; z < 16; ++z) { const int t = 32 * w + rowoff(z, hf); sYo[t * 36 + r] = y[z] + Dh * bf2f(sXT[r * SLD + t]); }
        } else { const int nb = w - 4; const float dec = sTmp[0];
#pragma unroll
            for (int z = 0; z < 16; ++z) accS[z] *= dec;
#pragma unroll
            for (int ks = 0; ks < 8; ++ks) { const bf16x8 a = *(const LAS bf16x8*)(sXT + r * SLD + 16 * ks + 8 * hf), bw = *(const LAS bf16x8*)(sBw + (32 * nb + r) * SLD + 16 * ks + 8 * hf); accS = mfma32(a, bw, accS); }
#pragma unroll
            for (int z = 0; z < 16; ++z) sS[rowoff(z, hf) * SLD + 32 * nb + r] = f2bf(accS[z]); }
        WG_BARRIER();
        { const f32x4 ya = *(const LAS f32x4*)(sYo + ot * 36 + 8 * ock), yb = *(const LAS f32x4*)(sYo + ot * 36 + 8 * ock + 4);
            const float g0 = ya[0] * bflo(zcur.x), g1 = ya[1] * bfhi(zcur.x), g2 = ya[2] * bflo(zcur.y), g3 = ya[3] * bfhi(zcur.y), g4 = yb[0] * bflo(zcur.z), g5 = yb[1] * bfhi(zcur.z), g6 = yb[2] * bflo(zcur.w), g7 = yb[3] * bfhi(zcur.w);
            u32x4 ow; ow.x = pk2(g0, g1); ow.y = pk2(g2, g3); ow.z = pk2(g4, g5); ow.w = pk2(g6, g7);
            *(GAS u32x4*)(F.BIG() + (row0 + ot) * NPJ + PC_XS + pcol + 8 * ock) = ow;
            float ss = ((g0 * g0 + g1 * g1) + (g2 * g2 + g3 * g3)) + ((g4 * g4 + g5 * g5) + (g6 * g6 + g7 * g7));
            ss += dpp_f<0xB1>(ss); ss += dpp_f<0x4E>(ss);
            if (ock == 0) F.SSDP()[(row0 + ot) * 16 + 2 * h + ph] = ss; }
    }
#undef SSD_LOAD
    if (w >= 4) { const int nb = w - 4; GAS float* o = F.out + O_SSP + ((size_t)(l * 8 + b) * 8 + h) * 64 * 128;
#pragma unroll
        for (int z = 0; z < 16; ++z) o[(32 * ph + rowoff(z, hf)) * 128 + 32 * nb + r] = accS[z]; }
    WG_BARRIER();
}

constexpr int HLD = 72;
template <bool DRY> __device__ __forceinline__ void hgrn_role(Frame& F, int l, int rid) {
    const int b = rid >> 3, h = rid & 7, tid = F.tid, lane = F.lane, w = F.wave, r = lane & 31, hf = lane >> 5;
    LAS bf16* sQe = (LAS bf16*)F.lds; LAS bf16* sKe = sQe + 64 * HLD; LAS bf16* sQb = sKe + 64 * HLD; LAS bf16* sKdT = sQb + 64 * HLD; LAS bf16* sVT = sKdT + 64 * HLD; LAS bf16* sAtt = sVT + 64 * HLD; LAS bf16* sST = sAtt + 64 * HLD;
    LAS float* sO = (LAS float*)(sST + 64 * HLD); LAS float* sPart = sO + 64 * 68; LAS float* sBl = sPart + 512;
    f32x16 accS;
#pragma unroll
    for (int q = 0; q < 16; ++q) accS[q] = 0.f;
    for (int e = tid; e < 64 * HLD; e += 512) sST[e] = 0;
    WG_BARRIER();
    const int d = lane, col = 64 * h + d;
    bf16 rq[8], rlf[8], rv[8]; u32x4 rgz;
#define HG_LOAD(ROW0) do { _Pragma("unroll") for (int i = 0; i < 8; ++i) { const GAS bf16* pr_ = F.BIG() + ((ROW0) + 8 * w + i) * NPJ; rq[i] = pr_[PC_CQ + col]; rlf[i] = pr_[PC_CF + col]; rv[i] = pr_[PC_CI + col]; } \
        rgz = *(const GAS u32x4*)(F.BIG() + ((ROW0) + (tid >> 3)) * NPJ + PC_CG + 64 * h + 8 * (tid & 7)); } while (0)
    HG_LOAD((size_t)b * SEQ);
#pragma nounroll
    for (int c = 0; c < 32; ++c) {
        const size_t row0 = (size_t)b * SEQ + 64 * c;
        float q[8], lf[8], v[8], bc[8];
#pragma unroll
        for (int i = 0; i < 8; ++i) { q[i] = bf2f(rq[i]); lf[i] = bf2f(rlf[i]); v[i] = bf2f(rv[i]); }
        const u32x4 gz = rgz;
        if (c + 1 < 32) HG_LOAD(row0 + 64);
        float run = 0.f;
#pragma unroll
        for (int i = 0; i < 8; ++i) { run += lf[i]; bc[i] = run; }
        sPart[w * 64 + d] = run;
        WG_BARRIER();
        float pre = 0.f, bm = 0.f, bl = 0.f;
#pragma unroll
        for (int q8 = 0; q8 < 8; ++q8) { const float pv = sPart[q8 * 64 + d]; if (q8 < w) pre += pv; if (q8 < 4) bm += pv; bl += pv; }
        unsigned kdw[4], vw[4];
#pragma unroll
        for (int i = 0; i < 8; i += 2) { float kd2[2];
#pragma unroll
            for (int u = 0; u < 2; ++u) { const int ii = i + u; const float bt = pre + bc[ii]; const float k = fnegexpm1(lf[ii]);
                const float e1 = fexp(fminf(fmaxf(bt - bm, -80.f), 80.f)), e2 = fexp(fminf(fmaxf(bm - bt, -80.f), 80.f));
                const int t = 8 * w + ii; sQe[t * HLD + d] = f2bf(q[ii] * e1); sKe[t * HLD + d] = f2bf(k * e2); sQb[t * HLD + d] = f2bf(q[ii] * fexp(bt)); kd2[u] = k * fexp(bl - bt); }
            kdw[i >> 1] = pk2(kd2[0], kd2[1]); vw[i >> 1] = pk2(v[i], v[i + 1]); }
        *(LAS u32x4*)(sKdT + d * HLD + 8 * w) = (u32x4){kdw[0], kdw[1], kdw[2], kdw[3]};
        *(LAS u32x4*)(sVT + d * HLD + 8 * w) = (u32x4){vw[0], vw[1], vw[2], vw[3]};
        if (w == 0) sBl[d] = fexp(bl);
        WG_BARRIER();
        f32x16 o;
#pragma unroll
        for (int z = 0; z < 16; ++z) o[z] = 0.f;
        const int tb = (w >> 1) & 1, eb = w & 1;
        if (w < 4) {
#pragma unroll
            for (int ks = 0; ks < 4; ++ks) { const bf16x8 a = *(const LAS bf16x8*)(sQb + (32 * tb + r) * HLD + 16 * ks + 8 * hf), bs = *(const LAS bf16x8*)(sST + (32 * eb + r) * HLD + 16 * ks + 8 * hf); o = mfma32(a, bs, o); }
        } else if (w < 7) { const int blk = w - 4, tba = blk == 0 ? 0 : 1, sba = blk == 2 ? 1 : 0;
#pragma unroll
            for (int ks = 0; ks < 4; ++ks) { const bf16x8 a = *(const LAS bf16x8*)(sQe + (32 * tba + r) * HLD + 16 * ks + 8 * hf), bk = *(const LAS bf16x8*)(sKe + (32 * sba + r) * HLD + 16 * ks + 8 * hf); o = mfma32(a, bk, o); }
#pragma unroll
            for (int z = 0; z < 16; ++z) { const int t = 32 * tba + rowoff(z, hf), s_ = 32 * sba + r; sAtt[t * HLD + s_] = f2bf((s_ <= t) ? o[z] : 0.f); }
        }
        WG_BARRIER();
        if (w < 4) {
            for (int ks = 0; ks < 2 * (tb + 1); ++ks) { const bf16x8 a = *(const LAS bf16x8*)(sAtt + (32 * tb + r) * HLD + 16 * ks + 8 * hf), bv = *(const LAS bf16x8*)(sVT + (32 * eb + r) * HLD + 16 * ks + 8 * hf); o = mfma32(a, bv, o); }
#pragma unroll
            for (int z = 0; z < 16; ++z) sO[(32 * tb + rowoff(z, hf)) * 68 + 32 * eb + r] = o[z];
        } else { const int db = (w >> 1) & 1;
#pragma unroll
            for (int z = 0; z < 16; ++z) accS[z] *= sBl[32 * db + rowoff(z, hf)];
#pragma unroll
            for (int ks = 0; ks < 4; ++ks) { const bf16x8 a = *(const LAS bf16x8*)(sKdT + (32 * db + r) * HLD + 16 * ks + 8 * hf), bv = *(const LAS bf16x8*)(sVT + (32 * eb + r) * HLD + 16 * ks + 8 * hf); accS = mfma32(a, bv, accS); }
#pragma unroll
            for (int z = 0; z < 16; ++z) sST[(32 * eb + r) * HLD + 32 * db + rowoff(z, hf)] = f2bf(accS[z]);
        }
        WG_BARRIER();
        { const int t = tid >> 3, eg = tid & 7; const f32x4 o0 = *(const LAS f32x4*)(sO + t * 68 + 8 * eg), o1 = *(const LAS f32x4*)(sO + t * 68 + 8 * eg + 4);
            float ss = (o0[0] * o0[0] + o0[1] * o0[1]) + (o0[2] * o0[2] + o0[3] * o0[3]) + (o1[0] * o1[0] + o1[1] * o1[1]) + (o1[2] * o1[2] + o1[3] * o1[3]);
            ss += swz_xor<1>(ss); ss += swz_xor<2>(ss); ss += swz_xor<4>(ss);
            const float rs = __builtin_amdgcn_rsqf(ss * (1.f / 64.f) + EPS);
            GAS bf16* pr = F.BIG() + (row0 + t) * NPJ;
            const f32x4 n0 = *(const GAS f32x4*)(F.in[I_HNORM] + l * 64 + 8 * eg), n1 = *(const GAS f32x4*)(F.in[I_HNORM] + l * 64 + 8 * eg + 4);
            u32x4 ow; ow.x = pk2(o0[0] * rs * n0[0] * bflo(gz.x), o0[1] * rs * n0[1] * bfhi(gz.x)); ow.y = pk2(o0[2] * rs * n0[2] * bflo(gz.y), o0[3] * rs * n0[3] * bfhi(gz.y));
            ow.z = pk2(o1[0] * rs * n1[0] * bflo(gz.z), o1[1] * rs * n1[1] * bfhi(gz.z)); ow.w = pk2(o1[2] * rs * n1[2] * bflo(gz.w), o1[3] * rs * n1[3] * bfhi(gz.w));
            if (DRY) *(GAS u32x4*)(F.HB() + (size_t)(row0 + t) * DM + 64 * h + 8 * eg) = ow; else *(GAS u32x4*)(pr + PC_CQ + 64 * h + 8 * eg) = ow; }
    }
    if (w >= 4 && !DRY) { const int db = (w >> 1) & 1, eb = w & 1; GAS float* o = F.out + O_HSP + ((size_t)(l * 8 + b) * 8 + h) * 64 * 64;
#pragma unroll
        for (int z = 0; z < 16; ++z) o[(32 * db + rowoff(z, hf)) * 64 + 32 * eb + r] = accS[z]; }
    WG_BARRIER();
}

#ifndef SAMPLE_MASK
#define SAMPLE_MASK 7
#endif
template <bool DRY> __device__ __forceinline__ void sample_role(Frame& F, int l, int rid, int nrole) {
    const int tid = F.tid, lane = F.lane, w = F.wave;
    LAS float* sXa = (LAS float*)F.lds; LAS float* sX = sXa + 512; LAS float* sQ = sX + 768; LAS float* sFd = sQ + 512; LAS float* sK = sFd + 512; LAS float* sDt = sK + 512; LAS float* sY = sDt + 32;
#pragma nounroll
    for (int i = rid; i < MSM; i += nrole) { const size_t row = (size_t)MPR + i; GAS bf16* pr = F.BIG() + row * NPJ;
        { const int c = tid; const GAS float* st = F.in[I_SRC] + ((size_t)(l * MSM + i) * 3) * 512 + c; const float b0 = st[0], b1 = st[512], b2 = st[1024], cur = bf2f(pr[PC_AX + c]);
            const GAS float* cw = F.in[I_CAW] + l * 4 * 512; sXa[c] = cw[c] * b0 + cw[512 + c] * b1 + cw[1024 + c] * b2 + cw[1536 + c] * cur + F.in[I_CAB][l * 512 + c];
            GAS float* o = F.out + O_RCS + ((size_t)(l * MSM + i) * 3) * 512 + c; o[0] = b1; o[512] = b2; o[1024] = cur; }
        for (int ch = tid; ch < 768; ch += 512) { const int col = ch < 512 ? PC_XS + ch : PC_B + (ch - 512);
            const GAS float* st = F.in[I_SSC] + ((size_t)(l * MSM + i) * 3) * 768 + ch; const float b0 = st[0], b1 = st[768], b2 = st[1536], cur = bf2f(pr[col]);
            const GAS float* cw = F.in[I_CBW] + l * 4 * 768; sX[ch] = fsilu(cw[ch] * b0 + cw[768 + ch] * b1 + cw[1536 + ch] * b2 + cw[2304 + ch] * cur + F.in[I_CBB][l * 768 + ch]);
            GAS float* o = F.out + O_SCS + ((size_t)(l * MSM + i) * 3) * 768 + ch; o[0] = b1; o[768] = b2; o[1536] = cur; }
        { const int c = tid; sQ[c] = bf2f(pr[PC_CQ + c]); const float lf = bf2f(pr[PC_CF + c]); sFd[c] = fexp(lf); sK[c] = fnegexpm1(lf); }
        if (tid < 8) { const float dtv = fsoftplus(F.DT()[row * 8 + tid] + F.in[I_DTB][l * 8 + tid]); sDt[tid] = dtv; sDt[8 + tid] = fexp(-dtv * __expf(F.in[I_ALOG][l * 8 + tid])); }
        WG_BARRIER();
        if (SAMPLE_MASK & 1) { const int c = tid, hh = c >> 6, j = c & 63; const GAS float* wa = F.in[I_WA] + ((size_t)(l * 8 + hh) * 64) * 64 + j; const GAS float* wx = F.in[I_WX] + ((size_t)(l * 8 + hh) * 64) * 64 + j;
            float ar = 0.f, ai = 0.f;
#pragma unroll 32
            for (int q = 0; q < 64; ++q) { const float xv = sXa[64 * hh + q]; ar += xv * wa[q * 64]; ai += xv * wx[q * 64]; }
            const float rr = fsigmoid(ar + F.in[I_BA][l * 512 + c]), ii = fsigmoid(ai + F.in[I_BX][l * 512 + c]), la = -8.f * fsoftplus(-F.in[I_LAM][l * 512 + c]) * rr;
            const float a = fexp(la), mult = __builtin_amdgcn_sqrtf(fmaxf(fnegexpm1(2.f * la), 0.f));
            const float hn = a * F.in[I_SRH][(size_t)(l * MSM + i) * 512 + c] + mult * ii * sXa[c];
            F.out[O_RHS + (size_t)(l * MSM + i) * 512 + c] = hn; if (!DRY) pr[PC_AX + c] = f2bf(hn * bf2f(pr[PC_AG + c])); }
#ifdef DBG_BAR
        asm volatile("s_waitcnt vmcnt(0) lgkmcnt(0)" ::: "memory");
#endif
        if (SAMPLE_MASK & 2) { const int hh = w, half = lane >> 5, ln = lane & 31, n0 = 4 * ln; const float dA = sDt[8 + hh], dtv = sDt[hh], Dh = F.in[I_SSD_D][l * 8 + hh];
            const f32x4 Bn = *(const LAS f32x4*)(sX + 512 + n0), Cn = *(const LAS f32x4*)(sX + 640 + n0);
            const GAS float* sin_ = F.in[I_SSS] + (((size_t)(l * MSM + i) * 8 + hh) * 64) * 128; GAS float* sout = F.out + O_SSS + (((size_t)(l * MSM + i) * 8 + hh) * 64) * 128;
#pragma unroll
            for (int hb_ = 0; hb_ < 2; ++hb_) { f32x4 sv[16];
#pragma unroll
                for (int k = 0; k < 16; ++k) sv[k] = *(const GAS f32x4*)(sin_ + (2 * (16 * hb_ + k) + half) * 128 + n0);
#pragma unroll
                for (int k = 0; k < 16; ++k) { const int p = 2 * (16 * hb_ + k) + half; const float xv = sX[64 * hh + p], xdt = dtv * xv;
                    const f32x4 sn = sv[k] * dA + Bn * xdt; *(GAS f32x4*)(sout + p * 128 + n0) = sn;
                    float yv = (Cn[0] * sn[0] + Cn[1] * sn[1]) + (Cn[2] * sn[2] + Cn[3] * sn[3]);
                    yv = sum32(yv);
                    if (ln == 0) sY[64 * hh + p] = yv + Dh * xv; } }
            { const float yg = sY[64 * hh + lane] * bf2f(pr[PC_BZ + 64 * hh + lane]); if (!DRY) pr[PC_XS + 64 * hh + lane] = f2bf(yg);
              const float ssq = wave_sum(yg * yg);
#ifdef DBG_YG
              if (l == 1) { F.out[(size_t)i * DM + 64 * hh + lane] = yg; F.out[(size_t)(128 + i) * DM + 64 * hh + lane] = bf2f(pr[PC_BZ + 64 * hh + lane]); F.out[(size_t)(256 + i) * DM + 64 * hh + lane] = sY[64 * hh + lane]; F.out[(size_t)(384 + i) * DM + 64 * hh + lane] = ssq; }
#endif
              if (lane == 0) { F.SSDP()[row * 16 + 2 * hh] = ssq; F.SSDP()[row * 16 + 2 * hh + 1] = 0.f; } } }
        if (SAMPLE_MASK & 4) { const int hh = w, e = lane; const float vv = bf2f(pr[PC_CI + 64 * hh + e]);
            const GAS float* sin_ = F.in[I_SHG] + (((size_t)(l * MSM + i) * 8 + hh) * 64) * 64 + e; GAS float* sout = F.out + O_HSS + (((size_t)(l * MSM + i) * 8 + hh) * 64) * 64 + e;
            float o = 0.f;
#pragma unroll
            for (int hb_ = 0; hb_ < 2; ++hb_) { float sv[32];
#pragma unroll
                for (int k = 0; k < 32; ++k) sv[k] = sin_[(32 * hb_ + k) * 64];
#pragma unroll
                for (int k = 0; k < 32; ++k) { const int dd = 32 * hb_ + k; const float sn = sFd[64 * hh + dd] * sv[k] + sK[64 * hh + dd] * vv; sout[dd * 64] = sn; o += sQ[64 * hh + dd] * sn; } }
            const float ss = wave_sum(o * o); const float rs = __builtin_amdgcn_rsqf(ss * (1.f / 64.f) + EPS);
            if (!DRY) pr[PC_CQ + 64 * hh + e] = f2bf(o * rs * F.in[I_HNORM][l * 64 + e] * bf2f(pr[PC_CG + 64 * hh + e])); }
        WG_BARRIER();
    }
}
__device__ __forceinline__ void p2b_phase(Frame& F, int l) {
    constexpr int N_SSD = 128, N_HG = 64, N_SMP = 0, N_RGA = 64;
#pragma nounroll
    for (int rid = F.bx; rid < 256; rid += F.G) {
#define RFRESH() do { int z_ = 0; asm volatile("" : "+v"(z_)); F.lane = __builtin_amdgcn_mbcnt_hi(~0u, __builtin_amdgcn_mbcnt_lo(~0u, z_)); F.tid = F.wave * 64 + F.lane; } while (0)
        const int kind = rid < N_SSD ? 0 : (rid < N_SSD + N_HG ? 1 : (rid < N_SSD + N_HG + N_SMP ? 2 : 3));
        switch (kind) {
        case 0: RFRESH(); ssd_role2(F, l, rid);
#ifdef DBG_REPEAT_SSD
            ssd_role2(F, l, rid);
#endif
            break;
        case 1:
#ifdef DBG_REPEAT_HG
            hgrn_role<true>(F, l, rid - N_SSD);
#endif
            RFRESH(); hgrn_role<false>(F, l, rid - N_SSD); break;
        case 2: break;
        default: RFRESH(); rg_apply_role(F, l, rid - N_SSD - N_HG - N_SMP, N_RGA);
#ifdef DBG_REPEAT_RG
            rg_apply_role(F, l, rid - N_SSD - N_HG - N_SMP, N_RGA);
#endif
            break;
        }
    }
}


__device__ __forceinline__ f32x4 sgemm_tile(Frame& F, const GAS bf16* A, int lda, const GAS bf16* Bt, int ldb, int kbeg, int klen, int rb, int cg) {
    const int lane = F.lane, w = F.wave, r = lane & 31, hf = lane >> 5, kw = klen >> 3;
    const GAS bf16* ap = A + (size_t)(MPR + 32 * rb + r) * lda + kbeg + w * kw + 8 * hf;
    const GAS bf16* bp0 = Bt + (size_t)(64 * cg + r) * ldb + kbeg + w * kw + 8 * hf; const GAS bf16* bp1 = bp0 + (size_t)32 * ldb;
    f32x16 a0, a1;
#pragma unroll
    for (int q = 0; q < 16; ++q) { a0[q] = 0.f; a1[q] = 0.f; }
#pragma unroll 4
    for (int k = 0; k < kw; k += 16) { const bf16x8 af = *(const GAS bf16x8*)(ap + k), b0 = *(const GAS bf16x8*)(bp0 + k), b1 = *(const GAS bf16x8*)(bp1 + k); a0 = mfma32(af, b0, a0); a1 = mfma32(af, b1, a1); }
    LAS float* part = (LAS float*)F.lds + w * 2048;
#pragma unroll
    for (int q = 0; q < 16; ++q) { const int row = rowoff(q, hf); part[row * 64 + r] = a0[q]; part[row * 64 + 32 + r] = a1[q]; }
    WG_BARRIER();
    const LAS float* pr_ = (const LAS float*)F.lds + (F.tid >> 4) * 64 + 4 * (F.tid & 15);
    f32x4 v = *(const LAS f32x4*)pr_;
#pragma unroll
    for (int q = 1; q < 8; ++q) v = v + *(const LAS f32x4*)(pr_ + q * 2048);
    WG_BARRIER();
    return v;
}
__device__ __forceinline__ float sum16(float v) { return sum16r(v); }
__device__ __forceinline__ void store_bf4(GAS bf16* p, f32x4 v) { u32x2 w; w.x = pk2(v[0], v[1]); w.y = pk2(v[2], v[3]); *(GAS u32x2*)p = w; }
template <int MODE> __device__ __forceinline__ f32x4 act4(f32x4 v, f32x4 lb) { return (f32x4){act1<MODE>(v[0], lb[0]), act1<MODE>(v[1], lb[1]), act1<MODE>(v[2], lb[2]), act1<MODE>(v[3], lb[3])}; }
__device__ __forceinline__ void sample_p1(Frame& F, int l, int u0) {
    for (int u = u0; u < 4 * (NPJP / 64); u += F.G) { const int rb = u & 3, cg = u >> 2;
        if (64 * cg >= NPJ + 64) continue;
        const f32x4 v = sgemm_tile(F, F.HB(), DM, w_in_t(F.ws, l), DM, 0, DM, rb, cg);
        const int row = MPR + 32 * rb + (F.tid >> 4), col = 64 * cg + 4 * (F.tid & 15); const float rs = rstd16(F.SSQ_MIX(), row); const f32x4 x = v * rs;
        if (col >= NPJ) { if (col < NPJ + 8) *(GAS f32x4*)(F.DT() + (size_t)row * 8 + (col - NPJ)) = x; continue; }
        const int pn = col >> 8; f32x4 o;
        if (pn == 4 || pn == 5 || pn == 9 || pn == 10 || pn == 15 || pn == 16) o = act4<1>(x, x);
        else if (pn == 7 || pn == 8) o = act4<2>(x, x);
        else if (pn == 11 || pn == 12) o = act4<3>(x, *(const GAS f32x4*)(F.LBS() + l * 512 + (col - PC_CF)));
        else o = x;
        store_bf4(F.BIG() + (size_t)row * NPJ + col, o); }
}
__device__ __forceinline__ void sample_p3(Frame& F, int l, int u0) {
    for (int u = u0; u < 4 * (DM / 64); u += F.G) { const int rb = u & 3, cg = u >> 2;
        const f32x4 vb = sgemm_tile(F, F.BIG(), NPJ, w_out_t(F.ws, l), DMIX, 0, 512, rb, cg);
        const f32x4 va = sgemm_tile(F, F.BIG(), NPJ, w_out_t(F.ws, l), DMIX, 512, 1024, rb, cg);
        const int row = MPR + 32 * rb + (F.tid >> 4), col = 64 * cg + 4 * (F.tid & 15);
        const GAS f32x4* p = (const GAS f32x4*)(F.SSDP() + (size_t)row * 16); const f32x4 a = p[0], b = p[1], c = p[2], d = p[3];
        const float sb = ((a[0] + a[1]) + (a[2] + a[3])) + ((b[0] + b[1]) + (b[2] + b[3])) + ((c[0] + c[1]) + (c[2] + c[3])) + ((d[0] + d[1]) + (d[2] + d[3]));
        const float rsb = __builtin_amdgcn_rsqf(sb * (1.f / 512.f) + EPS);
        const GAS float* base = (l == 0) ? F.in[I_XS] + (size_t)(row - MPR) * DM + col : F.out + (size_t)row * DM + col;
        const f32x4 h = *(const GAS f32x4*)base + vb * rsb + va;
        *(GAS f32x4*)(F.out + (size_t)row * DM + col) = h; store_bf4(F.HB() + (size_t)row * DM + col, h);
        const float ss = sum16((h[0] * h[0] + h[1] * h[1]) + (h[2] * h[2] + h[3] * h[3]));
        if ((F.tid & 15) == 0) F.SSQ_FFN()[(size_t)row * 16 + cg] = ss; }
}
__device__ __forceinline__ void sample_p4(Frame& F, int l, int u0) {
    for (int u = u0; u < 4 * (DFF / 64); u += F.G) { const int rb = u & 3, cg = u >> 2;
        const f32x4 v = sgemm_tile(F, F.HB(), DM, w_up_t(F.ws, l), DM, 0, DM, rb, cg);
        const int row = MPR + 32 * rb + (F.tid >> 4), col = 64 * cg + 4 * (F.tid & 15); const float rs = rstd16(F.SSQ_FFN(), row);
        f32x4 x = v * rs;
#pragma unroll
        for (int i = 0; i < 4; ++i) { const float t_ = fmaxf(x[i], 0.f); x[i] = t_ * t_; }
        store_bf4(F.BIG() + (size_t)row * DFF + col, x); }
}
__device__ __forceinline__ void sample_p5(Frame& F, int l, int u0) {
    for (int u = u0; u < 4 * (DM / 64); u += F.G) { const int rb = u & 3, cg = u >> 2;
#ifdef DBG_TAIL2
        (void)sgemm_tile(F, F.BIG(), DFF, w_dn_t(F.ws, l), DFF, 0, DFF, rb, cg);
#endif
        const f32x4 v = sgemm_tile(F, F.BIG(), DFF, w_dn_t(F.ws, l), DFF, 0, DFF, rb, cg);
        const int row = MPR + 32 * rb + (F.tid >> 4), col = 64 * cg + 4 * (F.tid & 15);
        const f32x4 h = *(const GAS f32x4*)(F.out + (size_t)row * DM + col) + v;
        *(GAS f32x4*)(F.out + (size_t)row * DM + col) = h; store_bf4(F.HB2() + (size_t)row * DM + col, h);
        const float ss = sum16((h[0] * h[0] + h[1] * h[1]) + (h[2] * h[2] + h[3] * h[3]));
        if ((F.tid & 15) == 0) F.SSQ_PLE()[(size_t)row * 16 + cg] = ss; }
}
__device__ __forceinline__ void sample_p6(Frame& F, int l, int u0) {
    for (int u = u0; u < 4 * (DM / 64); u += F.G) { const int rb = u & 3, cg = u >> 2;
        const f32x4 pp = sgemm_tile(F, F.PB(), PLE, w_pj_t(F.ws, l), PLE, 0, PLE, rb, cg);
        const f32x4 g = sgemm_tile(F, F.HB2(), DM, w_g_t(F.ws, l), DM, 0, DM, rb, cg);
        const int row = MPR + 32 * rb + (F.tid >> 4), col = 64 * cg + 4 * (F.tid & 15); const float rs = rstd16(F.SSQ_PLE(), row);
        f32x4 h = *(const GAS f32x4*)(F.out + (size_t)row * DM + col);
#pragma unroll
        for (int i = 0; i < 4; ++i) h[i] += fsigmoid(g[i] * rs) * pp[i];
        *(GAS f32x4*)(F.out + (size_t)row * DM + col) = h; store_bf4(F.HB() + (size_t)row * DM + col, h);
        const float ss = sum16((h[0] * h[0] + h[1] * h[1]) + (h[2] * h[2] + h[3] * h[3]));
        if ((F.tid & 15) == 0) F.SSQ_MIX()[(size_t)row * 16 + cg] = ss; }
}

__device__ __forceinline__ void final_phase(Frame& F) {
    const int gw = F.bx * 8 + F.wave, NGW = F.G * 8;
    for (int m = gw; m < MREAL; m += NGW) { const float rs = rstd16(F.SSQ_MIX(), m); GAS f32x4* hr = (GAS f32x4*)(F.out + (size_t)m * DM);
#pragma unroll
        for (int j = 0; j < 4; ++j) { const f32x4 g = ((const GAS f32x4*)F.in[I_NFIN])[F.lane + 64 * j]; hr[F.lane + 64 * j] = hr[F.lane + 64 * j] * rs * g; } }
}

struct Args { const float* in[N_IN]; float* out; unsigned char* ws; int ph_lo, ph_hi, li, pad; };
constexpr int N_PHASES = 16;
#ifdef DBG_OUTMASK
#define DBG_EXTRA_PH 1
#else
#define DBG_EXTRA_PH 0
#endif

__global__ void __launch_bounds__(512, 2) fwd_kernel(Args args) {
    extern __shared__ __attribute__((aligned(16))) unsigned char lds_raw[];
    volatile LAS unsigned* MISC = (volatile LAS unsigned*)((LAS unsigned char*)lds_raw + LDSCTL_OFF);
    for (int u = threadIdx.x; u < (LDS_BYTES - LDSCTL_OFF) / 4; u += 512) MISC[u] = 0u;
    __syncthreads();
    if (threadIdx.x < N_IN) ((LAS unsigned long long*)((LAS unsigned char*)lds_raw + LDSCTL_OFF + 256))[threadIdx.x] = (unsigned long long)args.in[threadIdx.x];
    __syncthreads();
    XcdBarrier bar; bar.bar = (GAS unsigned*)(args.ws + WS_CTL) + CW_BAR; bar.x = 0; bar.st = nullptr;
    if (MK_N_LAUNCHES == 1) bar = xcd_barrier_post((GAS unsigned*)(args.ws + WS_CTL) + CW_BAR, MISC + 8);
    const int lo = args.ph_lo, hi = args.ph_hi;
#ifndef PHASE_MASK
#define PHASE_MASK 0xFFFFu
#endif
    const int wave0 = __builtin_amdgcn_readfirstlane(threadIdx.x >> 6);
#pragma nounroll
    for (int ph = lo; ph < hi; ++ph) {
        if (ph > lo) { XcdBarrier b2 = bar; int w_ = wave0, z_ = 0; asm volatile("" : "+s"(b2.bar), "+s"(b2.x), "+s"(w_), "+v"(z_)); xcd_barrier(b2, w_ * 64 + (int)__builtin_amdgcn_mbcnt_hi(~0u, __builtin_amdgcn_mbcnt_lo(~0u, z_))); }
        Frame F;
        F.lds = (LAS unsigned char*)lds_raw;
        int wv_ = wave0, g_ = gridDim.x, b_ = blockIdx.x; GAS unsigned char* ws = (GAS unsigned char*)args.ws;
        asm volatile("" : "+s"(wv_), "+s"(g_), "+s"(b_), "+s"(ws));
        F.wave = wv_; F.G = g_; F.bx = b_;
#define FRESH() do { int z_ = 0; asm volatile("" : "+v"(z_)); F.lane = __builtin_amdgcn_mbcnt_hi(~0u, __builtin_amdgcn_mbcnt_lo(~0u, z_)); F.tid = F.wave * 64 + F.lane; } while (0)
        GAS float* out_ = (GAS float*)args.out; asm volatile("" : "+s"(out_));
        F.intab = (const LAS unsigned long long*)((LAS unsigned char*)lds_raw + LDSCTL_OFF + 256); F.in.t = F.intab; F.out = out_; F.ws = ws;
#ifdef DBG_OUTMASK
        if (ph == 16) {
            const size_t offs[13] = {0, (size_t)MPR * DM, O_RCP, O_RHP, O_SCP, O_SSP, O_HSP, O_RCS, O_RHS, O_SCS, O_SSS, O_HSS, O_END};
            int z2_ = 0; asm volatile("" : "+v"(z2_)); const int ln_ = __builtin_amdgcn_mbcnt_hi(~0u, __builtin_amdgcn_mbcnt_lo(~0u, z2_));
            for (int o_ = 0; o_ < 12; ++o_) { const float sc_ = ((DBG_OUTMASK >> o_) & 1) ? DBG_OUTSCALE : 0.f;
                for (size_t e = offs[o_] + (size_t)F.bx * 512 + F.wave * 64 + ln_; e < offs[o_ + 1]; e += (size_t)F.G * 512) F.out[e] = F.out[e] * sc_; }
            continue; }
#endif
        const int l = (ph - 1) / 7; const int k = (ph == 0) ? 0 : (ph == 15 ? 8 : 1 + (ph - 1) % 7);
        if (!((PHASE_MASK >> k) & 1u)) continue;
#ifdef DBG_CUT
        if (ph > DBG_CUT && ph != 15) continue;
#endif
#ifdef DBG_CUT2
        if (ph > DBG_CUT2) continue;
#endif
#ifdef DBG_REPEAT_K
        for (int rep_ = 0; rep_ < ((k == DBG_REPEAT_K) ? 2 : 1); ++rep_) {
        if (rep_) { XcdBarrier b4 = bar; int w4_ = wave0, z4_ = 0; asm volatile("" : "+s"(b4.bar), "+s"(b4.x), "+s"(w4_), "+v"(z4_)); xcd_barrier(b4, w4_ * 64 + (int)__builtin_amdgcn_mbcnt_hi(~0u, __builtin_amdgcn_mbcnt_lo(~0u, z4_))); }
#endif
        switch (k) {
        case 0: FRESH(); p0_prologue(F);
#ifdef DBG_CUT
            { const int sizes[N_IN] = {16777216,131072,393216,131072,589824,16777216,8388608,8388608,65536,2048,8929280,4096,1024,65536,1024,65536,1024,1024,6144,1536,16,16,16,1024,1024,128,3145728,2048,8388608,8388608,2048,2097152,524288,1024};
              for (int t = F.bx; t < N_IN * 4; t += F.G) { const int ti = t >> 2, part = t & 3; const int n = sizes[ti]; const int q0 = (int)((long)n * part / 4), q1 = (int)((long)n * (part + 1) / 4);
                  const GAS float* p = F.in[ti]; float sacc = 0.f; for (int e = q0 + F.tid; e < q1; e += 512) sacc += fabsf(p[e]);
                  sacc = wave_sum(sacc); if (F.lane == 0) __hip_atomic_fetch_add((GAS float*)(F.ws + 65536) + t, sacc, __ATOMIC_RELAXED, __HIP_MEMORY_SCOPE_AGENT); } }
#endif
            break;
        case 1: {
            FRESH();
            pg8::Gemm g{F.HB(), w_in_t(ws, l), DM, DM}; pg8::StaticOrder S; S.init(MPR, NPJP, F.G, F.bx);
            EpiProj E{F.BIG(), F.DT(), F.SSQ_MIX(), F.LBS() + l * 512};
            pg8::gemm_phase<EpiProj, true>(F.lds, F.tid, g, S, E); FRESH(); sample_p1(F, l, F.G - 1 - F.bx); } break;
        case 2: FRESH(); p2a_phase(F, l); break;
        case 3: FRESH(); p2b_phase(F, l); break;
        case 4: {
            FRESH();
#ifdef DBG_DRY3
            { pg8::Gemm g{F.BIG(), w_out_t(ws, l), NPJ, DMIX}; pg8::StaticOrder S; S.init(MPR, DM, F.G, F.bx); EpiPP E{F.PPB()}; pg8::gemm_phase<EpiPP, true>(F.lds, F.tid, g, S, E); asm volatile("s_waitcnt vmcnt(0)" ::: "memory"); __syncthreads(); FRESH(); }
#endif
#ifdef DBG_SELF
            if (l == 1) {
                for (int rep = 0; rep < 2; ++rep) {
                    FRESH();
                    pg8::Gemm g{F.BIG(), w_out_t(ws, l), NPJ, DMIX}; pg8::StaticOrder S; S.init(8192, DM, F.G, F.bx);
                    EpiDbg E{F.out, (GAS float*)(F.ws + WS_RT) + (size_t)rep * 8192 * DM + (rep ? 131072 : 0), F.SSDP()};
                    pg8::gemm_phase<EpiDbg, true>(F.lds, F.tid, g, S, E);
                    asm volatile("s_waitcnt vmcnt(0)" ::: "memory"); __syncthreads();
                }
                break; }
#endif
#ifdef DBG_RD
            if (l == 1) { if (F.bx < 4) { for (int e = F.tid; e < 128 * 1536; e += 512) { const int r_ = e / 1536, c_ = e % 1536;
                    F.out[(size_t)(F.bx * 256 + 2 * r_ + (c_ >> 10)) * DM + (c_ & 1023)] = bf2f(F.BIG()[(size_t)(MPR + r_) * NPJ + c_]); }
                  for (int e = F.tid; e < 128 * 16; e += 512) F.out[(size_t)(1024 + F.bx * 2) * DM + e] = F.SSDP()[(size_t)MPR * 16 + e]; }
                break; }
#endif
            pg8::Gemm g{F.BIG(), w_out_t(ws, l), NPJ, DMIX}; pg8::StaticOrder S; S.init(MPR, DM, F.G, F.bx);
            const GAS float* bp = (l == 0) ? F.in[I_XP] : F.out; const GAS float* bs = (l == 0) ? F.in[I_XS] - (size_t)MPR * DM : F.out;
            EpiRes<true> E{bp, bs, F.out, F.HB(), F.SSQ_FFN(), F.SSDP()};
            pg8::gemm_phase<EpiRes<true>, true>(F.lds, F.tid, g, S, E); FRESH(); sample_p3(F, l, F.G - 1 - F.bx); } break;
        case 5: {
            FRESH();
            pg8::Gemm g{F.HB(), w_up_t(ws, l), DM, DM}; pg8::StaticOrder S; S.init(MPR, DFF, F.G, F.bx);
            EpiUp E{F.BIG(), F.SSQ_FFN()};
            pg8::gemm_phase<EpiUp, true>(F.lds, F.tid, g, S, E); FRESH(); sample_p4(F, l, F.G - 1 - F.bx); } break;
        case 6: {
            FRESH();
#ifdef DBG_DRY5
            { pg8::Gemm g{F.BIG(), w_dn_t(ws, l), DFF, DFF}; pg8::StaticOrder S; S.init(MPR, DM, F.G, F.bx); EpiPP E{F.PPB()}; pg8::gemm_phase<EpiPP, true>(F.lds, F.tid, g, S, E); asm volatile("s_waitcnt vmcnt(0)" ::: "memory"); __syncthreads(); FRESH(); }
#endif
            pg8::Gemm g{F.BIG(), w_dn_t(ws, l), DFF, DFF}; pg8::StaticOrder S; S.init(MPR, DM, F.G, F.bx);
            EpiRes<false> E{F.out, F.out, F.out, F.HB2(), F.SSQ_PLE(), nullptr};
            pg8::gemm_phase<EpiRes<false>, true>(F.lds, F.tid, g, S, E); FRESH(); sample_p5(F, l, F.G - 1 - F.bx); } break;
        case 7: {
            FRESH();
            { pg8::Gemm g{F.PB(), w_pj_t(ws, l), PLE, PLE}; pg8::StaticOrder S; S.init(MPR, DM, F.G, F.bx); EpiPP E{F.PPB()}; pg8::gemm_phase<EpiPP, true>(F.lds, F.tid, g, S, E); }
            asm volatile("s_waitcnt vmcnt(0)" ::: "memory"); __syncthreads();
            FRESH();
            { pg8::Gemm g{F.HB2(), w_g_t(ws, l), DM, DM}; pg8::StaticOrder S; S.init(MPR, DM, F.G, F.bx); EpiGate E{F.out, F.HB(), F.PPB(), F.SSQ_PLE(), F.SSQ_MIX()}; pg8::gemm_phase<EpiGate, true>(F.lds, F.tid, g, S, E); } FRESH(); sample_p6(F, l, F.G - 1 - F.bx); } break;
        default: FRESH();
#ifdef DBG_SELF
            { const GAS float* t1 = (const GAS float*)(F.ws + WS_RT); const GAS float* t2 = t1 + (size_t)8192 * DM + 131072; unsigned cnt = 0;
              for (size_t e = (size_t)F.bx * 512 + F.tid; e < (size_t)8192 * DM; e += (size_t)F.G * 512) cnt += (t1[e] != t2[e]) ? 1u : 0u;
              cnt = (unsigned)wave_sum((float)cnt);
              if (F.lane == 0) F.out[(size_t)(F.bx * 8 + F.wave) * DM] = 1000.f * (float)cnt; }
            break;
#endif
#ifdef DBG_CK
            { GAS float* yo = F.out + (size_t)MPR * DM;
              const int gw = F.bx * 8 + F.wave, NGW = F.G * 8;
              for (int it = gw; it < 128 * (24 + 16 + 1); it += NGW) { const int blk = it % 128, g = it / 128; float sacc = 0.f;
#ifdef DBG_CK2
                  if (g < 12) { for (int e = F.lane; e < 128 * 64; e += 64) sacc += fabsf(bf2f(F.XA()[(size_t)(blk * 128 + (e >> 6)) * 768 + g * 64 + (e & 63)])); }
                  else if (g < 20) { for (int e = F.lane; e < 128 * 64; e += 64) sacc += fabsf(bf2f(F.BIG()[(size_t)(blk * 128 + (e >> 6)) * NPJ + PC_BZ + (g - 12) * 64 + (e & 63)])); }
                  else if (g < 21) { for (int e = F.lane; e < 128 * 8; e += 64) sacc += fabsf(F.DT()[(size_t)blk * 128 * 8 + e]); }
                  else if (g < 24) { }
#else
                  if (g < 24) { for (int e = F.lane; e < 128 * 64; e += 64) sacc += fabsf(bf2f(F.BIG()[(size_t)(blk * 128 + (e >> 6)) * NPJ + g * 64 + (e & 63)])); }
#endif
                  else if (g < 40) { for (int e = F.lane; e < 128 * 64; e += 64) sacc += fabsf(F.out[(size_t)(blk * 128 + (e >> 6)) * DM + (g - 24) * 64 + (e & 63)]); }
                  else { for (int e = F.lane; e < 128 * 16; e += 64) sacc += fabsf(F.SSDP()[(size_t)blk * 128 * 16 + e]); }
                  sacc = wave_sum(sacc); if (F.lane == 0) yo[it] = (g >= DBG_CK_LO && g < DBG_CK_HI) ? sacc : 0.f; } }
            break;
#endif
#ifdef DBG_COPY
            for (int e = F.bx * 512 + F.tid; e < 128 * DM; e += F.G * 512) F.out[(size_t)MPR * DM + e] = F.out[(size_t)DBG_COPY * DM + e];
            break;
#endif
#ifdef DBG_CUT
            { const int gw = F.bx * 8 + F.wave, NGW = F.G * 8;
              for (int m = gw; m < MREAL; m += NGW) { float s0 = 0.f, s1 = 0.f, s2 = 0.f;
                  const GAS bf16* b = F.BIG() + (size_t)m * NPJ; for (int c = F.lane; c < NPJ; c += 64) s0 += fabsf(bf2f(b[c]));
                  const GAS bf16* hb = F.HB() + (size_t)m * DM; for (int c = F.lane; c < DM; c += 64) s1 += fabsf(bf2f(hb[c]));
                  const GAS bf16* h2 = F.HB2() + (size_t)m * DM; for (int c = F.lane; c < DM; c += 64) s2 += fabsf(bf2f(h2[c]));
                  s0 = wave_sum(s0); s1 = wave_sum(s1); s2 = wave_sum(s2);
                  float s3 = 0.f, s4 = 0.f; if (m < 1024) { const GAS float* si = F.in[I_SSS] + ((size_t)(1024 + m)) * 8192; for (int c = F.lane; c < 8192; c += 64) s3 += fabsf(si[c]);
                      const GAS float* s0i = F.in[I_SSS] + ((size_t)m) * 8192; for (int c = F.lane; c < 8192; c += 64) s4 += fabsf(s0i[c]); }
                  s3 = wave_sum(s3); s4 = wave_sum(s4);
                  if (F.lane == 0) { GAS float* o = F.out + (size_t)m * DM; o[8] = s3; o[9] = s4; if (m < N_IN * 4) o[10] = ((GAS float*)(F.ws + 65536))[m]; o[0] = s0; o[1] = s1; o[2] = s2; o[3] = F.DT()[(size_t)m * 8 + 3]; o[4] = F.SSQ_MIX()[(size_t)m * 16 + 5]; o[5] = F.SSQ_FFN()[(size_t)m * 16 + 5]; o[6] = F.SSQ_PLE()[(size_t)m * 16 + 5]; o[7] = F.SSDP()[(size_t)m * 16 + 5]; } } }
#else
#ifndef DBG_NOFINAL
            final_phase(F);
#endif
#ifdef DBG_SANOUT
            asm volatile("s_waitcnt vmcnt(0)" ::: "memory"); { XcdBarrier b3 = bar; xcd_barrier(b3, F.tid); }
            for (size_t e = (size_t)F.bx * 512 + F.tid; e < O_END; e += (size_t)F.G * 512) { const float v = F.out[e]; if (!(fabsf(v) < 1e30f)) F.out[e] = 12345.f; }
#endif
#endif
            break;
        }
#ifdef DBG_REPEAT_K
        }
#endif
    }
}

extern "C" void kernel_launch(void* const* d_in, const int* in_sizes, int n_in, void* d_out, int out_size, void* d_ws, size_t ws_size, hipStream_t stream) {
    static int grid = 0;
    if (grid == 0) {
        if (n_in != N_IN || (size_t)out_size != O_END || ws_size < WS_END) { fprintf(stderr, "kernel_launch: unexpected shapes: n_in %d out %d ws %zu (need %zu)\n", n_in, out_size, ws_size, (size_t)WS_END); grid = -1; return; }
        int dev = 0, cus = 0, per_cu = 0;
        if (hipGetDevice(&dev) != hipSuccess || hipDeviceGetAttribute(&cus, hipDeviceAttributeMultiprocessorCount, dev) != hipSuccess) { grid = -1; return; }
        if (hipFuncSetAttribute((const void*)fwd_kernel, hipFuncAttributeMaxDynamicSharedMemorySize, LDS_BYTES) != hipSuccess) { fprintf(stderr, "kernel_launch: hipFuncSetAttribute failed\n"); grid = -1; return; }
        if (hipOccupancyMaxActiveBlocksPerMultiprocessor(&per_cu, (const void*)fwd_kernel, 512, LDS_BYTES) != hipSuccess || per_cu < 1) { fprintf(stderr, "kernel_launch: occupancy query says %d blocks per CU\n", per_cu); (void)hipGetLastError(); grid = -1; return; }
        grid = cus;
        if (grid > 256) grid = 256;
    }
    if (grid < 0) return;
    if (hipMemsetAsync((char*)d_ws + WS_CTL, 0, CTL_ZERO_BYTES, stream) != hipSuccess) return;
#ifdef DBG_FILLOUT
    (void)hipMemsetAsync(d_out, 0, (size_t)O_END * 4, stream);
#endif
#ifdef DBG_FILL
    (void)hipMemsetAsync((char*)d_ws + CTL_ZERO_BYTES, DBG_FILL, WS_END - CTL_ZERO_BYTES, stream);
#endif
    Args a{};
    for (int i = 0; i < N_IN; ++i) a.in[i] = (const float*)d_in[i];
    a.out = (float*)d_out; a.ws = (unsigned char*)d_ws;
    if (MK_N_LAUNCHES == 1) { a.ph_lo = 0; a.ph_hi = N_PHASES; a.li = 0; hipLaunchKernelGGL(fwd_kernel, dim3(grid), dim3(512), LDS_BYTES, stream, a); }
    else for (int p = 0; p < N_PHASES + DBG_EXTRA_PH; ++p) { a.ph_lo = p; a.ph_hi = p + 1; a.li = p; hipLaunchKernelGGL(fwd_kernel, dim3(grid), dim3(512), LDS_BYTES, stream, a); }
}
```

```cpp
#include <hip/hip_runtime.h>
#include <cstdio>
#include <cstdint>

#define LAS __attribute__((address_space(3)))
#define GAS __attribute__((address_space(1)))
typedef unsigned short bf16;
typedef short bf16x8 __attribute__((ext_vector_type(8)));
typedef float f32x4 __attribute__((ext_vector_type(4)));
typedef float f32x16 __attribute__((ext_vector_type(16)));
typedef unsigned u32x4 __attribute__((ext_vector_type(4)));
typedef unsigned u32x2 __attribute__((ext_vector_type(2)));
typedef GAS unsigned gu32;

#ifndef MK_N_LAUNCHES
#define MK_N_LAUNCHES 1
#endif

constexpr int DM = 1024, NBATCH = 8, SEQ = 2048, MPR = NBATCH * SEQ, MSM = 128, MREAL = MPR + MSM, MP = 16640  ;
constexpr int NPJ = 4352, NPJP = 4608, DFF = 4096, PLE = 256, DMIX = 1536, NL = 2, DIN = 4360;
constexpr int PC_XS = 0, PC_AX = 512, PC_CQ = 1024, PC_B = 1536, PC_C = 1664, PC_AG = 1792, PC_BZ = 2304, PC_CF = 2816, PC_CI = 3328, PC_CG = 3840;
constexpr float EPS = 1e-6f;
enum { I_XP = 0, I_XS, I_SRC, I_SRH, I_SSC, I_SSS, I_SHG, I_PP, I_PS, I_NMIX, I_WIN, I_CAW, I_CAB, I_WA, I_BA, I_WX, I_BX, I_LAM, I_CBW, I_CBB, I_DTB, I_ALOG, I_SSD_D, I_SNORM,
       I_HLB, I_HNORM, I_WOUT, I_NFFN, I_WUP, I_WDN, I_NPLE, I_WG, I_WPJ, I_NFIN, N_IN };
constexpr size_t O_Y = 0, O_RCP = (size_t)MREAL * DM, O_RHP = O_RCP + 2 * 8 * 3 * 512, O_SCP = O_RHP + 2 * 8 * 512, O_SSP = O_SCP + 2 * 8 * 3 * 768, O_HSP = O_SSP + 2 * 8 * 8 * 64 * 128,
                 O_RCS = O_HSP + 2 * 8 * 8 * 64 * 64, O_RHS = O_RCS + 2 * 128 * 3 * 512, O_SCS = O_RHS + 2 * 128 * 512, O_SSS = O_SCS + 2 * 128 * 3 * 768, O_HSS = O_SSS + (size_t)2 * 128 * 8 * 64 * 128,
                 O_END = O_HSS + (size_t)2 * 128 * 8 * 64 * 64;
static_assert(O_END == 44830720, "output size");

constexpr size_t MiB = 1u << 20;
constexpr size_t WS_CTL = 0, CTL_ZERO_BYTES = 1 * MiB;
constexpr size_t WS_WIN = 1 * MiB, WS_WOUT = 19 * MiB, WS_WUP = 25 * MiB, WS_WDN = 41 * MiB, WS_WG = 57 * MiB, WS_WPJ = 61 * MiB, WS_WAT = 62 * MiB, WS_LBS = 62 * MiB + 512 * 1024;
constexpr size_t KiB64 = 65536;
constexpr size_t WS_PB = 63 * MiB, WS_HB = WS_PB + 132 * KiB64  , WS_BIG = WS_HB + 520 * KiB64  , WS_RT = WS_BIG + 2211 * KiB64  ;
constexpr size_t WS_LA = WS_RT, WS_BB = WS_RT + 16 * MiB, WS_XA = WS_RT + 32 * MiB, WS_PPB = WS_RT, WS_HB2 = WS_RT + 520 * KiB64, WS_TS = WS_RT + 56 * MiB  ;
constexpr size_t WS_DT = WS_RT + 1040 * KiB64  , WS_SSQ_MIX = WS_DT + 12 * KiB64, WS_SSQ_FFN = WS_SSQ_MIX + 17 * KiB64, WS_SSQ_PLE = WS_SSQ_FFN + 17 * KiB64, WS_SSDP = WS_SSQ_PLE + 17 * KiB64, WS_END = WS_SSDP + 17 * KiB64;
static_assert(WS_PB + (size_t)MP * PLE * 2 <= WS_HB && WS_HB + (size_t)MP * DM * 2 <= WS_BIG && WS_BIG + (size_t)MP * NPJ * 2 <= WS_RT && WS_XA + (size_t)MPR * 768 * 2 <= WS_DT && WS_PPB + (size_t)MP * DM * 2 <= WS_HB2 &&
              WS_HB2 + (size_t)MP * DM * 2 <= WS_DT && WS_DT + (size_t)MP * 8 * 4 <= WS_SSQ_MIX && (size_t)MP * 16 * 4 <= 17 * KiB64 && WS_END <= 313 * MiB, "ws map");
constexpr int CW_TMO = 0, CW_BAR = 4096;

constexpr int SCR_BYTES = 147456, LDSCTL_OFF = SCR_BYTES, LDS_BYTES = SCR_BYTES + 1024;

typedef float f32x2v_ __attribute__((ext_vector_type(2))); typedef __bf16 bf16x2v_ __attribute__((ext_vector_type(2)));
__device__ __forceinline__ unsigned pk2(float lo, float hi) { const f32x2v_ v = {lo, hi}; return __builtin_bit_cast(unsigned, __builtin_convertvector(v, bf16x2v_)); }
__device__ __forceinline__ bf16 f2bf(float f) { return (bf16)(pk2(f, 0.f) & 0xffffu); }
__device__ __forceinline__ float bf2f(bf16 b) { return __uint_as_float(((unsigned)b) << 16); }
__device__ __forceinline__ float bflo(unsigned w) { return __uint_as_float(w << 16); }
__device__ __forceinline__ float bfhi(unsigned w) { return __uint_as_float(w & 0xffff0000u); }
__device__ __forceinline__ float fexp(float x) { return __builtin_amdgcn_exp2f(x * 1.44269504089f); }
__device__ __forceinline__ float frcp(float x) { return __builtin_amdgcn_rcpf(x); }
__device__ __forceinline__ float fsigmoid(float x) { return frcp(1.f + fexp(-x)); }
__device__ __forceinline__ float fsilu(float x) { return x * fsigmoid(x); }
__device__ __forceinline__ float fgelu(float x) { const float u = x + 0.044715f * x * x * x; return x * frcp(1.f + fexp(-1.5957691216f * u)); }
__device__ __forceinline__ float flog(float x) { return __builtin_amdgcn_logf(x) * 0.69314718056f; }
__device__ __forceinline__ float fsoftplus(float x) {
    if (x > 20.f) return x;
    const float e = fexp(x);
    if (e < 0.05f) return e * (1.f - e * (0.5f - e * (0.33333333f - e * (0.25f - 0.2f * e))));
    return flog(1.f + e);
}
__device__ __forceinline__ float fnegexpm1(float x) {
    if (x > -0.5f && x < 0.5f) return -(x * (1.f + x * 0.5f * (1.f + x * 0.33333333f * (1.f + x * 0.25f * (1.f + x * 0.2f * (1.f + x * 0.16666667f))))));
    return 1.f - fexp(x);
}
template <int X> __device__ __forceinline__ float swz_xor(float v) { return __int_as_float(__builtin_amdgcn_ds_swizzle(__float_as_int(v), (X << 10) | 0x1f)); }
__device__ __forceinline__ float sum_halves(float v) {
    const unsigned u = __float_as_uint(v); auto r = __builtin_amdgcn_permlane32_swap(u, u, false, false); return __uint_as_float(r[0]) + __uint_as_float(r[1]); }
template <int CTRL> __device__ __forceinline__ float dpp_f(float v) { return __int_as_float(__builtin_amdgcn_update_dpp(0, __float_as_int(v), CTRL, 0xF, 0xF, true)); }
__device__ __forceinline__ float sum16r(float v) {
    v += dpp_f<0xB1>(v); v += dpp_f<0x4E>(v); v += dpp_f<0x141>(v); v += dpp_f<0x140>(v); return v; }
__device__ __forceinline__ float sum32(float v) { v = sum16r(v); v += swz_xor<16>(v); return v; }
__device__ __forceinline__ float wave_sum(float v) { return sum_halves(sum32(v)); }
__device__ __forceinline__ float bperm(float v, int srclane) { return __int_as_float(__builtin_amdgcn_ds_bpermute(srclane << 2, __float_as_int(v))); }
__device__ __forceinline__ f32x16 mfma32(bf16x8 a, bf16x8 b, f32x16 c) { return __builtin_amdgcn_mfma_f32_32x32x16_bf16(a, b, c, 0, 0, 0); }
__device__ __forceinline__ int rowoff(int reg, int hf) { return (reg & 3) + 8 * (reg >> 2) + 4 * hf; }
#ifndef DBG_V
#define DBG_V 0
#endif
#if DBG_V == 3
#define WG_BARRIER() do { asm volatile("s_waitcnt vmcnt(0) lgkmcnt(0)" ::: "memory"); __syncthreads(); } while (0)
#else
#define WG_BARRIER() __syncthreads()
#endif

namespace pg8 {
constexpr int BM = 256, BK = 64, HALF = 128, HTB = HALF * BK * 2, STAGE_BYTES = 8 * HTB, NXCD = 8, WGM = 8;
__host__ __device__ __forceinline__ int lds_byte(int r, int c) { const int st = (r >> 4) * 2 + (c >> 5), rr = r & 15, cc = c & 31, ob = rr * 64 + cc * 2; return st * 1024 + (ob ^ (((ob >> 9) & 1) << 5)); }
__host__ __device__ __forceinline__ void stage_rc(int b, int& R, int& C) { const int st = b / 1024, sb = b % 1024, swz = sb ^ (((sb >> 9) & 1) << 5); R = (st >> 1) * 16 + swz / 64; C = (st & 1) * 32 + (swz % 64) / 2; }
__host__ __device__ __forceinline__ int perm32(int rho) { const int n = rho >> 4, i = rho & 15; return 8 * (i >> 2) + 4 * n + (i & 3); }
struct Unit { int pm, pn; };
struct Gemm { const GAS bf16* A; const GAS bf16* Bt; int lda, K; };
struct StaticOrder {
    int nM, nN, nwg, G, c;
    __device__ void init(int M, int N, int G_, int c_) { nM = M / BM; nN = N / BM; nwg = nM * nN; G = G_; c = c_; }
    __device__ bool next(int i, Unit& u) const {
        const long L = (long)i * G + c; if (L >= nwg) return false;
        int wgid = (int)L; { const int q = nwg / NXCD, r = nwg % NXCD, xcd = wgid % NXCD, off = wgid / NXCD; wgid = (xcd < r ? xcd * (q + 1) : r * (q + 1) + (xcd - r) * q) + off; }
        const int nig = WGM * nN, gid = wgid / nig, fm = gid * WGM, gsz = (nM - fm) < WGM ? (nM - fm) : WGM;
        u.pm = fm + ((wgid % nig) % gsz); u.pn = (wgid % nig) / gsz; return true;
    }
};
typedef f32x4 Acc[2][2][4][2];

template <class Epi, bool ALIGN_EPI>
__device__ __forceinline__ void gemm_phase(LAS unsigned char* lds, const int tid, const Gemm g, const StaticOrder& S, const Epi& E) {
    const int wid = __builtin_amdgcn_readfirstlane(tid >> 6), lane = tid & 63, wr = wid >> 2, wc = wid & 3, fr = lane & 15, fq = lane >> 4;
    const int K = g.K, nt = K / BK, lda = g.lda;
    unsigned voffA[2], voffB[2];
#pragma unroll
    for (int i = 0; i < 2; ++i) { int R, C; stage_rc(tid * 16 + i * 8192, R, C); const int Rb = Epi::PERM ? ((R & ~31) + perm32(R & 31)) : R;
        voffA[i] = (unsigned)(R * lda + C) * 2u; voffB[i] = (unsigned)(Rb * K + C) * 2u; }
    const size_t kstep = (size_t)(BK * 2);
    const size_t hA = (size_t)HALF * lda * 2, hB = (size_t)HALF * K * 2, tA = 2 * hA, tB = 2 * hB;
    const unsigned ldsw = (unsigned)wid * 1024u;
    const int aoff = lds_byte(wr * 64 + fr, fq * 8), boff = lds_byte(wc * 32 + fr, fq * 8);
#define PG8_SA(b, h) (((b) * 2 + (h)) * HTB)
#define PG8_SB(b, h) ((4 + (b) * 2 + (h)) * HTB)
#define PG8_STAGE(bufoff, gbase, voff) do { _Pragma("unroll") for (int _i = 0; _i < 2; ++_i) \
        __builtin_amdgcn_global_load_lds((const GAS unsigned*)((const GAS char*)(gbase) + (voff)[_i]), (LAS unsigned*)(lds + (bufoff) + ldsw + _i * 8192), 16, 0, 0); } while (0)
#define PG8_LDA(dst, b, h) do { _Pragma("unroll") for (int m = 0; m < 4; ++m) _Pragma("unroll") for (int k = 0; k < 2; ++k) dst[m][k] = *(const LAS bf16x8*)(lds + PG8_SA(b, h) + aoff + m * 2048 + k * 1024); } while (0)
#define PG8_LDB(dst, b, h) do { _Pragma("unroll") for (int n = 0; n < 2; ++n) _Pragma("unroll") for (int k = 0; k < 2; ++k) dst[n][k] = *(const LAS bf16x8*)(lds + PG8_SB(b, h) + boff + n * 2048 + k * 1024); } while (0)
#define PG8_MMA(ai, bj, At, Bt) do { __builtin_amdgcn_s_setprio(1); _Pragma("unroll") for (int m = 0; m < 4; ++m) _Pragma("unroll") for (int n = 0; n < 2; ++n) _Pragma("unroll") for (int k = 0; k < 2; ++k) \
        acc[ai][bj][m][n] = __builtin_amdgcn_mfma_f32_16x16x32_bf16(Bt[n][k], At[m][k], acc[ai][bj][m][n], 0, 0, 0); __builtin_amdgcn_s_setprio(0); } while (0)
#define PG8_WAIT_V(n) asm volatile("s_waitcnt vmcnt(" #n ")" ::: "memory")
#define PG8_WAIT_L(n) asm volatile("s_waitcnt lgkmcnt(" #n ")" ::: "memory")
#define PG8_BAR __builtin_amdgcn_s_barrier()
#define PG8_SCHED __builtin_amdgcn_sched_barrier(0)
    Unit cur, nxt; int ui = 0;
    if (!S.next(0, cur)) return;
    f32x4 acc[2][2][4][2];
#pragma unroll
    for (int a = 0; a < 2; ++a)
#pragma unroll
        for (int b = 0; b < 2; ++b)
#pragma unroll
            for (int m = 0; m < 4; ++m)
#pragma unroll
                for (int n = 0; n < 2; ++n) acc[a][b][m][n] = (f32x4){0.f, 0.f, 0.f, 0.f};
    bf16x8 At[4][2], B0[2][2], B1[2][2];
    const GAS char* cA = (const GAS char*)g.A + (size_t)cur.pm * tA; const GAS char* cB = (const GAS char*)g.Bt + (size_t)cur.pn * tB;
    PG8_STAGE(PG8_SB(0, 0), cB, voffB); PG8_STAGE(PG8_SB(0, 1), cB + hB, voffB); PG8_STAGE(PG8_SA(0, 0), cA, voffA); PG8_STAGE(PG8_SA(0, 1), cA + hA, voffA);
    if (wr == 1) PG8_BAR;
    PG8_WAIT_V(2); PG8_BAR;
    PG8_STAGE(PG8_SB(1, 0), cB + kstep, voffB); PG8_STAGE(PG8_SA(1, 0), cA + kstep, voffA); PG8_STAGE(PG8_SB(1, 1), cB + hB + kstep, voffB);
    PG8_WAIT_V(6); PG8_BAR;
    for (;;) {
        const bool has_next = S.next(ui + 1, nxt);
        const GAS char* nA = has_next ? (const GAS char*)g.A + (size_t)nxt.pm * tA : cA; const GAS char* nB = has_next ? (const GAS char*)g.Bt + (size_t)nxt.pn * tB : cB;
        for (int t = 0; t < nt; t += 2) {
            const bool last = (t == nt - 2);
            const GAS char* a1 = cA + (size_t)(t + 1) * kstep;
            const GAS char* a2 = last ? nA : cA + (size_t)(t + 2) * kstep; const GAS char* b2 = last ? nB : cB + (size_t)(t + 2) * kstep;
            const GAS char* a3 = a2 + kstep; const GAS char* b3 = b2 + kstep;
            if constexpr (Epi::MIDK > 0) { if (t == Epi::MIDK) { int z_ = 0; asm volatile("" : "+v"(z_)); const int ln_ = (int)__builtin_amdgcn_mbcnt_hi(~0u, __builtin_amdgcn_mbcnt_lo(~0u, z_)); E.mid(acc, cur, wr, wc, ln_ & 15, ln_ >> 4); } }
            PG8_LDB(B0, 0, 0); PG8_LDB(B1, 0, 1); PG8_SCHED; PG8_LDA(At, 0, 0); PG8_STAGE(PG8_SA(1, 1), a1 + hA, voffA);
            PG8_WAIT_V(8); PG8_WAIT_L(0); PG8_BAR; PG8_MMA(0, 0, At, B0); PG8_MMA(0, 1, At, B1); PG8_BAR; PG8_SCHED;
            PG8_LDA(At, 0, 1); PG8_STAGE(PG8_SB(0, 0), b2, voffB); PG8_STAGE(PG8_SB(0, 1), b2 + hB, voffB); PG8_STAGE(PG8_SA(0, 0), a2, voffA);
            PG8_WAIT_V(8); PG8_WAIT_L(0); PG8_BAR; PG8_MMA(1, 0, At, B0); PG8_MMA(1, 1, At, B1); PG8_BAR; PG8_SCHED;
            PG8_LDB(B0, 1, 0); PG8_LDB(B1, 1, 1); PG8_SCHED; PG8_LDA(At, 1, 0); PG8_STAGE(PG8_SA(0, 1), a2 + hA, voffA);
            PG8_WAIT_V(8); PG8_WAIT_L(0); PG8_BAR; PG8_MMA(0, 0, At, B0); PG8_MMA(0, 1, At, B1); PG8_BAR; PG8_SCHED;
            PG8_LDA(At, 1, 1); PG8_STAGE(PG8_SB(1, 0), b3, voffB); PG8_STAGE(PG8_SB(1, 1), b3 + hB, voffB); PG8_STAGE(PG8_SA(1, 0), a3, voffA);
            PG8_WAIT_V(8); PG8_WAIT_L(0); PG8_BAR; PG8_MMA(1, 0, At, B0); PG8_MMA(1, 1, At, B1); PG8_BAR; PG8_SCHED;
        }
        if constexpr (ALIGN_EPI) { if (wr == 0) PG8_BAR; }
        { int z_ = 0; asm volatile("" : "+v"(z_)); const int ln_ = (int)__builtin_amdgcn_mbcnt_hi(~0u, __builtin_amdgcn_mbcnt_lo(~0u, z_)); E(acc, cur, wr, wc, ln_ & 15, ln_ >> 4); }
        if (!has_next) break;
#pragma unroll
        for (int a = 0; a < 2; ++a)
#pragma unroll
            for (int b = 0; b < 2; ++b)
#pragma unroll
                for (int m = 0; m < 4; ++m)
#pragma unroll
                    for (int n = 0; n < 2; ++n) acc[a][b][m][n] = (f32x4){0.f, 0.f, 0.f, 0.f};
        cur = nxt; cA = nA; cB = nB; ++ui;
        if constexpr (ALIGN_EPI) { if (wr == 1) PG8_BAR; }
    }
    PG8_WAIT_V(0);
    if constexpr (!ALIGN_EPI) { if (wr == 0) PG8_BAR; }
    PG8_BAR;
#undef PG8_SA
#undef PG8_SB
#undef PG8_STAGE
#undef PG8_LDA
#undef PG8_LDB
#undef PG8_MMA
#undef PG8_WAIT_V
#undef PG8_WAIT_L
#undef PG8_BAR
#undef PG8_SCHED
}
}
using pg8::Unit; using pg8::Acc; using pg8::BM; using pg8::HALF;

__device__ __forceinline__ float rstd16(const GAS float* ssq, int row) {
    const GAS f32x4* p = (const GAS f32x4*)(ssq + (size_t)row * 16); const f32x4 a = p[0], b = p[1], c = p[2], d = p[3];
    const float s = ((a[0] + a[1]) + (a[2] + a[3])) + ((b[0] + b[1]) + (b[2] + b[3])) + ((c[0] + c[1]) + (c[2] + c[3])) + ((d[0] + d[1]) + (d[2] + d[3]));
    return __builtin_amdgcn_rsqf(s * (1.f / DM) + EPS);
}
template <int MODE> __device__ __forceinline__ float act1(float v, float lb) {
    if (MODE == 1) return fsilu(v);
    if (MODE == 2) return fgelu(v);
    if (MODE == 3) { const float g = lb + (1.f - lb) * fsigmoid(v); return fmaxf(flog(g), -30.f); }
    return v;
}
struct EpiProj {
    static constexpr bool PERM = true; static constexpr int MIDK = 0;
    GAS bf16* P; GAS float* DT; const GAS float* ssq; const GAS float* lbs;
    __device__ __forceinline__ void mid(Acc&, const Unit&, int, int, int, int) const {}
    template <int MODE> __device__ __forceinline__ void body(const Acc& acc, const Unit& u, int wr, int wc, int fr, int fq) const {
        const int row0 = u.pm * BM + wr * 64 + fr, col0 = u.pn * BM + wc * 32 + 8 * fq;
        f32x4 lb[2][2];
#pragma unroll
        for (int bj = 0; bj < 2; ++bj)
#pragma unroll
            for (int n = 0; n < 2; ++n) lb[bj][n] = (MODE == 3) ? *(const GAS f32x4*)(lbs + (col0 - PC_CF) + bj * HALF + 4 * n) : (f32x4){0.f, 0.f, 0.f, 0.f};
#pragma unroll
        for (int ai = 0; ai < 2; ++ai)
#pragma unroll
            for (int m = 0; m < 4; ++m) { const int row = row0 + ai * HALF + m * 16; const float rs = rstd16(ssq, row); GAS bf16* rowp = P + (size_t)row * NPJ + col0;
#pragma unroll
                for (int bj = 0; bj < 2; ++bj) { const f32x4 v0 = acc[ai][bj][m][0] * rs, v1 = acc[ai][bj][m][1] * rs; u32x4 w;
                    w.x = pk2(act1<MODE>(v0[0], lb[bj][0][0]), act1<MODE>(v0[1], lb[bj][0][1])); w.y = pk2(act1<MODE>(v0[2], lb[bj][0][2]), act1<MODE>(v0[3], lb[bj][0][3]));
                    w.z = pk2(act1<MODE>(v1[0], lb[bj][1][0]), act1<MODE>(v1[1], lb[bj][1][1])); w.w = pk2(act1<MODE>(v1[2], lb[bj][1][2]), act1<MODE>(v1[3], lb[bj][1][3]));
                    *(GAS u32x4*)(rowp + bj * HALF) = w; } }
    }
    __device__ __forceinline__ void operator()(const Acc& acc, const Unit& u, int wr, int wc, int fr, int fq) const {
        const int pn = u.pn;
        if (pn == 17) {
            if (wc == 0 && fq == 0) {
#pragma unroll
                for (int ai = 0; ai < 2; ++ai)
#pragma unroll
                    for (int m = 0; m < 4; ++m) { const int row = u.pm * BM + wr * 64 + fr + ai * HALF + m * 16; const float rs = rstd16(ssq, row);
                        *(GAS f32x4*)(DT + (size_t)row * 8) = acc[ai][0][m][0] * rs; *(GAS f32x4*)(DT + (size_t)row * 8 + 4) = acc[ai][0][m][1] * rs; }
            }
            return;
        }
        if (pn == 4 || pn == 5 || pn == 9 || pn == 10 || pn == 15 || pn == 16) body<1>(acc, u, wr, wc, fr, fq);
        else if (pn == 7 || pn == 8) body<2>(acc, u, wr, wc, fr, fq);
        else if (pn == 11 || pn == 12) body<3>(acc, u, wr, wc, fr, fq);
        else body<0>(acc, u, wr, wc, fr, fq);
    }
};
template <bool MID> struct EpiRes {
    static constexpr bool PERM = false; static constexpr int MIDK = MID ? 8 : 0;
    const GAS bf16* hin; GAS bf16* hb; GAS float* ssq; const GAS float* ssdp;
    __device__ __forceinline__ void mid(Acc& acc, const Unit& u, int wr, int wc, int fr, int fq) const {
#pragma unroll
        for (int ai = 0; ai < 2; ++ai)
#pragma unroll
            for (int m = 0; m < 4; ++m) { const int row = u.pm * BM + wr * 64 + fr + ai * HALF + m * 16;
                const GAS f32x4* p = (const GAS f32x4*)(ssdp + (size_t)row * 16); const f32x4 a = p[0], b = p[1], c = p[2], d = p[3];
                const float s = ((a[0] + a[1]) + (a[2] + a[3])) + ((b[0] + b[1]) + (b[2] + b[3])) + ((c[0] + c[1]) + (c[2] + c[3])) + ((d[0] + d[1]) + (d[2] + d[3]));
                const float rs = __builtin_amdgcn_rsqf(s * (1.f / 512.f) + EPS);
#pragma unroll
                for (int bj = 0; bj < 2; ++bj)
#pragma unroll
                    for (int n = 0; n < 2; ++n) acc[ai][bj][m][n] = acc[ai][bj][m][n] * rs;
                asm volatile("" ::: "memory"); }
    }
    __device__ __forceinline__ void operator()(const Acc& acc, const Unit& u, int wr, int wc, int fr, int fq) const {
        const int row0 = u.pm * BM + wr * 64 + fr, col0 = u.pn * BM + wc * 32 + 4 * fq;
#pragma unroll
        for (int ai = 0; ai < 2; ++ai)
#pragma unroll
            for (int m = 0; m < 4; ++m) { const int row = row0 + ai * HALF + m * 16; const size_t off = (size_t)row * DM + col0; float ss = 0.f;
                if (row < MREAL) {
#pragma unroll
                    for (int bj = 0; bj < 2; ++bj)
#pragma unroll
                        for (int n = 0; n < 2; ++n) { const u32x2 r = *(const GAS u32x2*)(hin + off + bj * HALF + n * 16); f32x4 v = acc[ai][bj][m][n];
                            v[0] += bflo(r.x); v[1] += bfhi(r.x); v[2] += bflo(r.y); v[3] += bfhi(r.y);
                            u32x2 w; w.x = pk2(v[0], v[1]); w.y = pk2(v[2], v[3]); *(GAS u32x2*)(hb + off + bj * HALF + n * 16) = w;
                            ss += (v[0] * v[0] + v[1] * v[1]) + (v[2] * v[2] + v[3] * v[3]); }
                }
                ss += swz_xor<16>(ss); ss = sum_halves(ss);
                if (fq == 0) ssq[(size_t)row * 16 + u.pn * 4 + wc] = ss;
                asm volatile("" ::: "memory"); }
    }
};
struct EpiDbg {
    static constexpr bool PERM = false; static constexpr int MIDK = 8;
    const GAS float* basep; GAS float* hout; const GAS float* ssdp;
    __device__ __forceinline__ void mid(Acc& acc, const Unit& u, int wr, int wc, int fr, int fq) const {
#pragma unroll
        for (int ai = 0; ai < 2; ++ai)
#pragma unroll
            for (int m = 0; m < 4; ++m) { const int row = u.pm * BM + wr * 64 + fr + ai * HALF + m * 16;
                const GAS f32x4* p = (const GAS f32x4*)(ssdp + (size_t)row * 16); const f32x4 a = p[0], b = p[1], c = p[2], d = p[3];
                const float s = ((a[0] + a[1]) + (a[2] + a[3])) + ((b[0] + b[1]) + (b[2] + b[3])) + ((c[0] + c[1]) + (c[2] + c[3])) + ((d[0] + d[1]) + (d[2] + d[3]));
                const float rs = __builtin_amdgcn_rsqf(s * (1.f / 512.f) + EPS);
#pragma unroll
                for (int bj = 0; bj < 2; ++bj)
#pragma unroll
                    for (int n = 0; n < 2; ++n) acc[ai][bj][m][n] = acc[ai][bj][m][n] * rs;
                asm volatile("" ::: "memory"); }
    }
    __device__ __forceinline__ void operator()(const Acc& acc, const Unit& u, int wr, int wc, int fr, int fq) const {
        const int row0 = u.pm * BM + wr * 64 + fr, col0 = u.pn * BM + wc * 32 + 4 * fq;
#pragma unroll
        for (int ai = 0; ai < 2; ++ai)
#pragma unroll
            for (int m = 0; m < 4; ++m) { const int row = row0 + ai * HALF + m * 16; const size_t off = (size_t)row * DM + col0;
#pragma unroll
                for (int bj = 0; bj < 2; ++bj)
#pragma unroll
                    for (int n = 0; n < 2; ++n) { const f32x4 v = *(const GAS f32x4*)(basep + off + bj * HALF + n * 16) + acc[ai][bj][m][n]; *(GAS f32x4*)(hout + off + bj * HALF + n * 16) = v; }
                asm volatile("" ::: "memory"); }
    }
};
struct EpiUp {
    static constexpr bool PERM = true; static constexpr int MIDK = 0;
    GAS bf16* Z; const GAS float* ssq;
    __device__ __forceinline__ void mid(Acc&, const Unit&, int, int, int, int) const {}
    __device__ __forceinline__ void operator()(const Acc& acc, const Unit& u, int wr, int wc, int fr, int fq) const {
        const int row0 = u.pm * BM + wr * 64 + fr, col0 = u.pn * BM + wc * 32 + 8 * fq;
#pragma unroll
        for (int ai = 0; ai < 2; ++ai)
#pragma unroll
            for (int m = 0; m < 4; ++m) { const int row = row0 + ai * HALF + m * 16; const float rs = rstd16(ssq, row); GAS bf16* rowp = Z + (size_t)row * NPJ + col0;
#pragma unroll
                for (int bj = 0; bj < 2; ++bj) { f32x4 v0 = acc[ai][bj][m][0] * rs, v1 = acc[ai][bj][m][1] * rs;
#pragma unroll
                    for (int i = 0; i < 4; ++i) { const float a = fmaxf(v0[i], 0.f), b = fmaxf(v1[i], 0.f); v0[i] = a * a; v1[i] = b * b; }
                    u32x4 w; w.x = pk2(v0[0], v0[1]); w.y = pk2(v0[2], v0[3]); w.z = pk2(v1[0], v1[1]); w.w = pk2(v1[2], v1[3]); *(GAS u32x4*)(rowp + bj * HALF) = w; } }
    }
};
constexpr int PPB_PITCH = 2 * DM;
struct EpiPP {
    static constexpr bool PERM = false; static constexpr int MIDK = 0;
    GAS bf16* PPB;
    __device__ __forceinline__ void mid(Acc&, const Unit&, int, int, int, int) const {}
    __device__ __forceinline__ void operator()(const Acc& acc, const Unit& u, int wr, int wc, int fr, int fq) const {
        const int row0 = u.pm * BM + wr * 64 + fr, col0 = u.pn * BM + wc * 32 + 4 * fq;
#pragma unroll
        for (int ai = 0; ai < 2; ++ai)
#pragma unroll
            for (int m = 0; m < 4; ++m) { const size_t off = (size_t)(row0 + ai * HALF + m * 16) * PPB_PITCH + col0;
#pragma unroll
                for (int bj = 0; bj < 2; ++bj)
#pragma unroll
                    for (int n = 0; n < 2; ++n) { const f32x4 v = acc[ai][bj][m][n]; u32x2 w; w.x = pk2(v[0], v[1]); w.y = pk2(v[2], v[3]); *(GAS u32x2*)(PPB + off + bj * HALF + n * 16) = w; } }
    }
};
struct EpiGate {
    static constexpr bool PERM = false; static constexpr int MIDK = 0;
    const GAS bf16* hin; GAS bf16* hb; const GAS bf16* PPB; const GAS float* ssq_in; GAS float* ssq_out;
    __device__ __forceinline__ void mid(Acc&, const Unit&, int, int, int, int) const {}
    __device__ __forceinline__ void operator()(const Acc& acc, const Unit& u, int wr, int wc, int fr, int fq) const {
        const int row0 = u.pm * BM + wr * 64 + fr, col0 = u.pn * BM + wc * 32 + 4 * fq;
#pragma unroll
        for (int ai = 0; ai < 2; ++ai)
#pragma unroll
            for (int m = 0; m < 4; ++m) { const int row = row0 + ai * HALF + m * 16; const size_t off = (size_t)row * DM + col0; float ss = 0.f;
                if (row < MREAL) { const float rs = rstd16(ssq_in, row); const GAS bf16* prow = PPB + (size_t)row * PPB_PITCH + col0;
#pragma unroll
                    for (int bj = 0; bj < 2; ++bj)
#pragma unroll
                        for (int n = 0; n < 2; ++n) { const f32x4 a = acc[ai][bj][m][n] * rs; const u32x2 pw = *(const GAS u32x2*)(prow + bj * HALF + n * 16);
                            const u32x2 r = *(const GAS u32x2*)(hin + off + bj * HALF + n * 16); f32x4 v;
                            v[0] = bflo(r.x) + fsigmoid(a[0]) * bflo(pw.x); v[1] = bfhi(r.x) + fsigmoid(a[1]) * bfhi(pw.x); v[2] = bflo(r.y) + fsigmoid(a[2]) * bflo(pw.y); v[3] = bfhi(r.y) + fsigmoid(a[3]) * bfhi(pw.y);
                            u32x2 w; w.x = pk2(v[0], v[1]); w.y = pk2(v[2], v[3]); *(GAS u32x2*)(hb + off + bj * HALF + n * 16) = w;
                            ss += (v[0] * v[0] + v[1] * v[1]) + (v[2] * v[2] + v[3] * v[3]); }
                }
                ss += swz_xor<16>(ss); ss = sum_halves(ss);
                if (fq == 0) ssq_out[(size_t)row * 16 + u.pn * 4 + wc] = ss;
                asm volatile("" ::: "memory"); }
    }
};

#define RLX_AGENT __ATOMIC_RELAXED, __HIP_MEMORY_SCOPE_AGENT
#define XB_TMO      128
#define XB_XCNT(j)  (256  + 64 * (j))
#define XB_XSUB(j)  (1280 + 64 * (j))
#define XB_XGEN(j)  (2304 + 64 * (j))
#define XB_TOP      3328
#define XB_TOPGEN   3392
#define XCD_BAR_WORDS 3456
#define XB_SPIN_CAP (1u << 20)
__device__ __forceinline__ unsigned xb_ld(GAS unsigned* p)              { return __hip_atomic_load(p, __ATOMIC_RELAXED, __HIP_MEMORY_SCOPE_AGENT); }
__device__ __forceinline__ unsigned xb_add(GAS unsigned* p, unsigned v) { return __hip_atomic_fetch_add(p, v, __ATOMIC_RELAXED, __HIP_MEMORY_SCOPE_AGENT); }
__device__ __forceinline__ unsigned xb_xcc_id() { return (unsigned)__builtin_amdgcn_s_getreg((3 << 11) | 20) & 0xFu; }
#define XB_SPIN(cond, bar) do { unsigned _sp = 0; while (cond) { __builtin_amdgcn_s_sleep(1); \
    if ((++_sp & 255u) == 0u) { if (xb_ld(&(bar)[XB_TMO])) break; if (_sp > XB_SPIN_CAP) { (void)xb_add(&(bar)[XB_TMO], 1u); break; } } } } while (0)
struct XcdBarrier { GAS unsigned* bar; unsigned x; volatile LAS unsigned* st; };
__device__ __forceinline__ XcdBarrier xcd_barrier_post(GAS unsigned* bar, volatile LAS unsigned* st) {
    XcdBarrier b; b.bar = bar; b.x = xb_xcc_id(); b.st = st;
    if (threadIdx.x == 0) (void)xb_add(&bar[XB_XCNT(b.x)], 1u);
    return b;
}
__device__ __forceinline__ void xcd_barrier_complete(GAS unsigned* bar, unsigned x, unsigned& nloc, unsigned& nx) {
    const unsigned G = gridDim.x * gridDim.y * gridDim.z;
    unsigned sum, cnt, mine, sp = 0u;
    for (;;) {
        sum = 0u; cnt = 0u; mine = 0u;
#pragma unroll
        for (unsigned j = 0; j < 16; ++j) { const unsigned c = xb_ld(&bar[XB_XCNT(j)]); sum += c; cnt += (c > 0u) ? 1u : 0u; mine = (j == x) ? c : mine; }
        if (sum == G) break;
        __builtin_amdgcn_s_sleep(1);
        if ((++sp & 255u) == 0u) { if (xb_ld(&bar[XB_TMO])) break; if (sp > XB_SPIN_CAP) { (void)xb_add(&bar[XB_TMO], 1u); break; } }
    }
    nloc = mine > 0u ? mine : 1u; nx = cnt > 0u ? cnt : 1u;
}
__device__ __forceinline__ void xcd_barrier(const XcdBarrier& b, const int tid) {
    asm volatile("s_waitcnt vmcnt(0)" ::: "memory");
    __syncthreads();
    if (tid == 0) {
        GAS unsigned* bar = b.bar;
        __builtin_amdgcn_s_waitcnt(0);
        unsigned nloc = b.st[0], nx = b.st[1];
        if (nloc == 0u) { xcd_barrier_complete(bar, b.x, nloc, nx); b.st[0] = nloc; b.st[1] = nx; }
        const unsigned old = xb_add(&bar[XB_XSUB(b.x)], 1u);
        const unsigned gen = old / nloc;
        if (old + 1u == (gen + 1u) * nloc) {
            __builtin_amdgcn_fence(__ATOMIC_RELEASE, "agent");
            asm volatile("s_waitcnt vmcnt(0)" ::: "memory");
            const unsigned og = xb_add(&bar[XB_TOP], 1u);
            const unsigned tg = og / nx;
            if (og + 1u == (tg + 1u) * nx) xb_add(&bar[XB_TOPGEN], 1u);
            else XB_SPIN(xb_ld(&bar[XB_TOPGEN]) == tg, bar);
            __builtin_amdgcn_fence(__ATOMIC_ACQUIRE, "agent");
            xb_add(&bar[XB_XGEN(b.x)], 1u);
            asm volatile("s_waitcnt vmcnt(0)" ::: "memory");
        } else {
            XB_SPIN(xb_ld(&bar[XB_XGEN(b.x)]) == gen, bar);
            __builtin_amdgcn_fence(__ATOMIC_ACQUIRE, "agent");
            asm volatile("s_waitcnt vmcnt(0)" ::: "memory");
        }
    }
    __syncthreads();
}

constexpr int CW_GRP = 16384, CW_SMP = 32768, CW_XID = 34816;
__device__ __forceinline__ void wg_arrive(GAS unsigned* ctr, unsigned n, const int tid, const GAS unsigned* xid) {
    asm volatile("s_waitcnt vmcnt(0)" ::: "memory");
    __syncthreads();
    if (tid == 0) {
        bool rel = false;
        if (xid) { const unsigned me = xb_xcc_id() + 1u; const unsigned a = xb_ld((GAS unsigned*)xid), b = xb_ld((GAS unsigned*)xid + 64), c = xb_ld((GAS unsigned*)xid + 128), d = xb_ld((GAS unsigned*)xid + 192);
            rel = !(a == me && b == me && c == me && d == me); }
        if (rel) { __builtin_amdgcn_fence(__ATOMIC_RELEASE, "agent"); asm volatile("s_waitcnt vmcnt(0)" ::: "memory"); }
        (void)xb_add(ctr, n); }
}
__device__ __forceinline__ void st_sc1(GAS float* p, float v) { __hip_atomic_store(p, v, __ATOMIC_RELAXED, __HIP_MEMORY_SCOPE_AGENT); }
__device__ __forceinline__ void st_sc1_2(GAS void* p, unsigned lo, unsigned hi) { __hip_atomic_store((GAS unsigned long long*)p, ((unsigned long long)hi << 32) | lo, __ATOMIC_RELAXED, __HIP_MEMORY_SCOPE_AGENT); }
__device__ __forceinline__ void wg_wait(GAS unsigned* ctr, unsigned target, const int tid, GAS unsigned* bar) {
    if (tid == 0) { XB_SPIN(xb_ld(ctr) < target, bar); __builtin_amdgcn_fence(__ATOMIC_ACQUIRE, "agent"); asm volatile("s_waitcnt vmcnt(0)" ::: "memory"); }
    __syncthreads();
}

struct Frame {
    LAS unsigned char* lds;
    int tid, lane, wave, G, bx;
    const LAS unsigned long long* intab;
    struct InAcc { const LAS unsigned long long* t; __device__ __forceinline__ const GAS float* operator[](int i) const { const unsigned long long v = t[i];
        const unsigned lo = __builtin_amdgcn_readfirstlane((unsigned)v), hi = __builtin_amdgcn_readfirstlane((unsigned)(v >> 32)); return (const GAS float*)(((unsigned long long)hi << 32) | lo); } } in;
    GAS float* out; GAS unsigned char* ws;
    __device__ __forceinline__ GAS unsigned* ctl() const { return (GAS unsigned*)(ws + WS_CTL); }
    __device__ __forceinline__ GAS unsigned* grp(int ph) const { return ctl() + CW_GRP + (ph * 64 + (bx & 63)) * 16; }
    __device__ __forceinline__ GAS unsigned* smp(int l, int s) const { return ctl() + CW_SMP + (l * 4 + s) * 16; }
    __device__ __forceinline__ bool gsy() const { return G == 256 && MK_N_LAUNCHES == 1; }
    __device__ __forceinline__ const GAS unsigned* xid() const { return ctl() + CW_XID + (bx & 63); }
#define FPTR(name, type, off) __device__ __forceinline__ GAS type* name() const { return (GAS type*)(ws + (off)); }
    FPTR(BIG, bf16, WS_BIG) FPTR(HB, bf16, WS_HB) FPTR(HB2, bf16, WS_HB2) FPTR(PB, bf16, WS_PB) FPTR(LA, bf16, WS_LA) FPTR(BB, bf16, WS_BB) FPTR(XA, bf16, WS_XA) FPTR(TS, float, WS_TS) FPTR(PPB, bf16, WS_PPB)
    FPTR(DT, float, WS_DT) FPTR(SSQ_MIX, float, WS_SSQ_MIX) FPTR(SSQ_FFN, float, WS_SSQ_FFN) FPTR(SSQ_PLE, float, WS_SSQ_PLE) FPTR(SSDP, float, WS_SSDP) FPTR(LBS, float, WS_LBS) FPTR(WAT, bf16, WS_WAT)
#undef FPTR
};
__device__ __forceinline__ GAS bf16* w_in_t(GAS unsigned char* ws, int l) { return (GAS bf16*)(ws + WS_WIN) + (size_t)l * NPJP * DM; }
__device__ __forceinline__ GAS bf16* w_out_t(GAS unsigned char* ws, int l) { return (GAS bf16*)(ws + WS_WOUT) + (size_t)l * DM * DMIX; }
__device__ __forceinline__ GAS bf16* w_up_t(GAS unsigned char* ws, int l) { return (GAS bf16*)(ws + WS_WUP) + (size_t)l * DFF * DM; }
__device__ __forceinline__ GAS bf16* w_dn_t(GAS unsigned char* ws, int l) { return (GAS bf16*)(ws + WS_WDN) + (size_t)l * DM * DFF; }
__device__ __forceinline__ GAS bf16* w_g_t(GAS unsigned char* ws, int l) { return (GAS bf16*)(ws + WS_WG) + (size_t)l * DM * DM; }
__device__ __forceinline__ GAS bf16* w_pj_t(GAS unsigned char* ws, int l) { return (GAS bf16*)(ws + WS_WPJ) + (size_t)l * DM * PLE; }

__device__ __forceinline__ int win_src(int n0) {
    if (n0 < 512) return 1536 + n0;
    if (n0 < 1024) return n0 - 512;
    if (n0 < 1536) return 2312 + (n0 - 1024);
    if (n0 < 1792) return 2048 + (n0 - 1536);
    if (n0 < 2304) return 512 + (n0 - 1792);
    if (n0 < 2816) return 1024 + (n0 - 2304);
    if (n0 < 3328) return 2824 + (n0 - 2816);
    if (n0 < 3840) return 3336 + (n0 - 3328);
    if (n0 < 4352) return 3848 + (n0 - 3840);
    return 2304 + (n0 - 4352);
}
__device__ __forceinline__ void p0_item(const GAS float* W, int ldw, GAS bf16* WT, int K, int N, int mode, const GAS float* ks, LAS float* scr, int item, int lane) {
    const int nblk = N / 64, kb = item / nblk, nb = item % nblk, k0 = 64 * kb, n0 = 64 * nb;
    int sn0 = n0, nvalid = 64;
    if (mode == 1) { sn0 = win_src(n0); if (n0 >= NPJ) nvalid = (n0 == NPJ) ? 8 : 0; }
    const int kq = lane >> 4, n4 = (lane & 15) * 4;
    f32x4 v[16];
#pragma unroll
    for (int i = 0; i < 16; ++i) { const int k = k0 + 4 * i + kq; const int sk = (mode == 2) ? ((k < 512) ? 512 + k : (k < 1024 ? k - 512 : k)) : k;
        v[i] = (n4 < nvalid) ? *(const GAS f32x4*)(W + (size_t)sk * ldw + sn0 + n4) : (f32x4){0.f, 0.f, 0.f, 0.f}; }
#pragma unroll
    for (int i = 0; i < 16; ++i) { const int kk = 4 * i + kq, k = k0 + kk; float sc = 1.f;
        if (mode == 2) { if (k < 512) sc = ks[k]; } else if (ks) sc = ks[k];
        LAS float* d = scr + kk * 65 + n4; d[0] = v[i][0] * sc; d[1] = v[i][1] * sc; d[2] = v[i][2] * sc; d[3] = v[i][3] * sc; }
    asm volatile("s_waitcnt lgkmcnt(0)" ::: "memory");
    GAS bf16* orow = WT + (size_t)(n0 + lane) * K + k0;
#pragma unroll
    for (int j = 0; j < 8; ++j) { const LAS float* sp = scr + (8 * j) * 65 + lane;
        u32x4 o; o.x = pk2(sp[0 * 65], sp[1 * 65]); o.y = pk2(sp[2 * 65], sp[3 * 65]); o.z = pk2(sp[4 * 65], sp[5 * 65]); o.w = pk2(sp[6 * 65], sp[7 * 65]);
        *(GAS u32x4*)(orow + 8 * j) = o; }
    asm volatile("s_waitcnt lgkmcnt(0)" ::: "memory");
}
constexpr int WI_IN = (DM / 64) * (NPJP / 64), WI_OUT = (DMIX / 64) * (DM / 64), WI_UP = (DM / 64) * (DFF / 64), WI_DN = (DFF / 64) * (DM / 64), WI_G = (DM / 64) * (DM / 64), WI_PJ = (PLE / 64) * (DM / 64);
constexpr int WI_PER_L = WI_IN + WI_OUT + WI_UP + WI_DN + WI_G + WI_PJ;
__device__ __forceinline__ void wconv_item(Frame& F, LAS float* scr, int it) {
    const int l = it / WI_PER_L; int r = it % WI_PER_L;
    if (r < WI_IN) { p0_item(F.in[I_WIN] + (size_t)l * DM * DIN, DIN, w_in_t(F.ws, l), DM, NPJP, 1, F.in[I_NMIX] + l * DM, scr, r, F.lane); return; } r -= WI_IN;
    if (r < WI_OUT) { p0_item(F.in[I_WOUT] + (size_t)l * DMIX * DM, DM, w_out_t(F.ws, l), DMIX, DM, 2, F.in[I_SNORM] + l * 512, scr, r, F.lane); return; } r -= WI_OUT;
    if (r < WI_UP) { p0_item(F.in[I_WUP] + (size_t)l * DM * DFF, DFF, w_up_t(F.ws, l), DM, DFF, 0, F.in[I_NFFN] + l * DM, scr, r, F.lane); return; } r -= WI_UP;
    if (r < WI_DN) { p0_item(F.in[I_WDN] + (size_t)l * DFF * DM, DM, w_dn_t(F.ws, l), DFF, DM, 0, nullptr, scr, r, F.lane); return; } r -= WI_DN;
    if (r < WI_G) { p0_item(F.in[I_WG] + (size_t)l * DM * DM, DM, w_g_t(F.ws, l), DM, DM, 0, F.in[I_NPLE] + l * DM, scr, r, F.lane); return; } r -= WI_G;
    p0_item(F.in[I_WPJ] + (size_t)l * PLE * DM, DM, w_pj_t(F.ws, l), PLE, DM, 0, nullptr, scr, r, F.lane);
}
__device__ __forceinline__ void p0_prologue(Frame& F) {
    LAS float* scr = (LAS float*)(F.lds + F.wave * 16640);
    const int gw = F.bx * 8 + F.wave, NGW = F.G * 8;
    for (int it = gw; it < WI_IN; it += NGW) wconv_item(F, scr, it);
#pragma nounroll
    for (int m0 = gw; m0 < MREAL; m0 += 4 * NGW) {
        f32x4 v[4][4];
#pragma unroll
        for (int q = 0; q < 4; ++q) { const int m = m0 + q * NGW; const int mc = m < MREAL ? m : m0;
            const GAS float* xr = (mc < MPR) ? F.in[I_XP] + (size_t)mc * DM : F.in[I_XS] + (size_t)(mc - MPR) * DM;
#pragma unroll
            for (int j = 0; j < 4; ++j) v[q][j] = ((const GAS f32x4*)xr)[F.lane + 64 * j]; }
#pragma unroll
        for (int q = 0; q < 4; ++q) { const int m = m0 + q * NGW; float s = 0.f;
#pragma unroll
            for (int j = 0; j < 4; ++j) s += (v[q][j][0] * v[q][j][0] + v[q][j][1] * v[q][j][1]) + (v[q][j][2] * v[q][j][2] + v[q][j][3] * v[q][j][3]);
            s = wave_sum(s);
            if (m < MREAL) {
#pragma unroll
                for (int j = 0; j < 4; ++j) { u32x2 w; w.x = pk2(v[q][j][0], v[q][j][1]); w.y = pk2(v[q][j][2], v[q][j][3]); ((GAS u32x2*)(F.HB() + (size_t)m * DM))[F.lane + 64 * j] = w; }
                if (F.lane < 16) F.SSQ_MIX()[(size_t)m * 16 + F.lane] = (F.lane == 0) ? s : 0.f; } }
    }
    const int gt = F.bx * 512 + F.tid, NGT = F.G * 512;
    for (int e = gt; e < NL * 2 * 8 * 64 * 64; e += NGT) { const int i = e & 63, j = (e >> 6) & 63, h = (e >> 12) & 7, g = (e >> 15) & 1, l = e >> 16;
        F.WAT()[e] = f2bf(F.in[g ? I_WX : I_WA][(((size_t)l * 8 + h) * 64 + i) * 64 + j]); }
    for (int e = gt; e < NL * 512; e += NGT) { const int l = e / 512, c = e % 512;
        float mx = -1e30f; for (int q = 0; q < NL; ++q) mx = fmaxf(mx, F.in[I_HLB][q * 512 + c]);
        float den = 0.f, cs = 0.f, c0 = 0.f; for (int q = 0; q < NL; ++q) den += __expf(F.in[I_HLB][q * 512 + c] - mx);
        for (int q = 0; q <= l; ++q) { const float p = __expf(F.in[I_HLB][q * 512 + c] - mx) / den; cs += p; if (q == 0) c0 = p; }
        F.LBS()[e] = cs - c0; }
}

__device__ __forceinline__ void p2a_rg_item(Frame& F, int l, int item) {
    const int tt = item >> 3, h = item & 7, row0 = tt * 32, lane = F.lane, r = lane & 31, hf = lane >> 5;
    LAS float* xt = (LAS float*)(F.lds + F.wave * 8704);
    const int gc = 64 * h + lane;
    const GAS float* cw = F.in[I_CAW] + l * 4 * 512; const float w0 = cw[gc], w1 = cw[512 + gc], w2 = cw[1024 + gc], w3 = cw[1536 + gc], cb = F.in[I_CAB][l * 512 + gc];
    const GAS bf16* ax = F.BIG() + (size_t)row0 * NPJ + PC_AX + gc;
    const bool first = (row0 % SEQ) == 0;
    float p3 = 0.f, p2 = 0.f, p1 = 0.f;
    if (!first) { p3 = bf2f(ax[-3 * NPJ]); p2 = bf2f(ax[-2 * NPJ]); p1 = bf2f(ax[-1 * NPJ]); }
    bf16 rawx[32];
#pragma unroll
    for (int t = 0; t < 32; ++t) rawx[t] = ax[(size_t)t * NPJ];
    bf16x8 wbr[2][4], wbi[2][4]; float bav[2], bxv[2], lmv[2];
#pragma unroll
    for (int jb = 0; jb < 2; ++jb) {
        const GAS bf16* wr_ = F.WAT() + ((((size_t)l * 2 + 0) * 8 + h) * 64 + 32 * jb + r) * 64 + 8 * hf;
        const GAS bf16* wi_ = F.WAT() + ((((size_t)l * 2 + 1) * 8 + h) * 64 + 32 * jb + r) * 64 + 8 * hf;
#pragma unroll
        for (int s = 0; s < 4; ++s) { wbr[jb][s] = *(const GAS bf16x8*)(wr_ + 16 * s); wbi[jb][s] = *(const GAS bf16x8*)(wi_ + 16 * s); }
        const int gj = 64 * h + 32 * jb + r; bav[jb] = F.in[I_BA][l * 512 + gj]; bxv[jb] = F.in[I_BX][l * 512 + gj]; lmv[jb] = F.in[I_LAM][l * 512 + gj]; }
#pragma unroll
    for (int t = 0; t < 32; ++t) { const float cur = bf2f(rawx[t]); xt[t * 68 + lane] = w0 * p3 + w1 * p2 + w2 * p1 + w3 * cur + cb; p3 = p2; p2 = p1; p1 = cur; }
    if ((row0 + 32) % SEQ == 0) { const int b = row0 / SEQ; GAS float* o = F.out + O_RCP + ((size_t)(l * 8 + b) * 3) * 512 + gc; o[0] = p3; o[512] = p2; o[1024] = p1; }
    bf16x8 af[4];
#pragma unroll
    for (int s = 0; s < 4; ++s) { const f32x4 a = *(const LAS f32x4*)(xt + r * 68 + 16 * s + 8 * hf), b = *(const LAS f32x4*)(xt + r * 68 + 16 * s + 8 * hf + 4);
        u32x4 w; w.x = pk2(a[0], a[1]); w.y = pk2(a[2], a[3]); w.z = pk2(b[0], b[1]); w.w = pk2(b[2], b[3]); af[s] = __builtin_bit_cast(bf16x8, w); }
#pragma unroll
    for (int jb = 0; jb < 2; ++jb) {
        f32x16 ar, ai;
#pragma unroll
        for (int q = 0; q < 16; ++q) { ar[q] = 0.f; ai[q] = 0.f; }
#pragma unroll
        for (int s = 0; s < 4; ++s) { ar = mfma32(af[s], wbr[jb][s], ar); ai = mfma32(af[s], wbi[jb][s], ai); }
        const int j = 32 * jb + r, gj = 64 * h + j;
        const float ba = bav[jb], bx = bxv[jb], c8 = -8.f * fsoftplus(-lmv[jb]);
        bf16 labs[16], bvbs[16];
#pragma unroll
        for (int q = 0; q < 16; ++q) { const int t = rowoff(q, hf); const float rr = fsigmoid(ar[q] + ba), ii = fsigmoid(ai[q] + bx), la = c8 * rr;
            float mult = __builtin_amdgcn_sqrtf(fmaxf(fnegexpm1(2.f * la), 0.f)); if (((row0 + t) % SEQ) == 0) mult = 1.f;
            const float bv = mult * ii * xt[t * 68 + j]; const bf16 lab = f2bf(la), bvb = f2bf(bv); labs[q] = lab; bvbs[q] = bvb;
            ar[q] = fexp(bf2f(lab)); ai[q] = bf2f(bvb); }
#pragma unroll
        for (int k = 0; k < 4; ++k) { const size_t o = (((size_t)tt * 4 + k) * 512 + gj) * 8 + 4 * hf;
            u32x2 wl, wb; wl.x = labs[4 * k] | ((unsigned)labs[4 * k + 1] << 16); wl.y = labs[4 * k + 2] | ((unsigned)labs[4 * k + 3] << 16); wb.x = bvbs[4 * k] | ((unsigned)bvbs[4 * k + 1] << 16); wb.y = bvbs[4 * k + 2] | ((unsigned)bvbs[4 * k + 3] << 16);
            *(GAS u32x2*)(F.LA() + o) = wl; *(GAS u32x2*)(F.BB() + o) = wb; }
        float gA[4], gB[4];
#pragma unroll
        for (int k = 0; k < 4; ++k) { float A_ = 1.f, B_ = 0.f;
#pragma unroll
            for (int i = 0; i < 4; ++i) { B_ = ar[4 * k + i] * B_ + ai[4 * k + i]; A_ *= ar[4 * k + i]; }
            gA[k] = A_; gB[k] = B_; }
        float A_ = 1.f, B_ = 0.f;
#pragma unroll
        for (int k = 0; k < 4; ++k) { const unsigned ua = __float_as_uint(gA[k]), ub = __float_as_uint(gB[k]);
            auto ra = __builtin_amdgcn_permlane32_swap(ua, ua, false, false); auto rb_ = __builtin_amdgcn_permlane32_swap(ub, ub, false, false);
            const float loA = __uint_as_float(ra[0]), hiA = __uint_as_float(ra[1]), loB = __uint_as_float(rb_[0]), hiB = __uint_as_float(rb_[1]);
            B_ = loA * B_ + loB; A_ *= loA; B_ = hiA * B_ + hiB; A_ *= hiA; }
        if (hf == 0) { typedef float f32x2t __attribute__((ext_vector_type(2))); *(GAS f32x2t*)(F.TS() + ((size_t)tt * 512 + gj) * 2) = (f32x2t){A_, B_}; }
    }
}
__device__ __forceinline__ void p2a_conv_item(Frame& F, int l, int item) {
    const int tt = item / 3, g = item % 3, row0 = tt * 32, ch = 256 * g + 4 * F.lane, col = ch < 512 ? PC_XS + ch : PC_B + (ch - 512);
    const GAS float* cw = F.in[I_CBW] + l * 4 * 768 + ch; const f32x4 w0 = *(const GAS f32x4*)cw, w1 = *(const GAS f32x4*)(cw + 768), w2 = *(const GAS f32x4*)(cw + 1536), w3 = *(const GAS f32x4*)(cw + 2304), cb = *(const GAS f32x4*)(F.in[I_CBB] + l * 768 + ch);
    const GAS bf16* src = F.BIG() + (size_t)row0 * NPJ + col;
    const bool first = (row0 % SEQ) == 0;
    f32x4 p3 = {0.f, 0.f, 0.f, 0.f}, p2 = p3, p1 = p3;
    auto ld4 = [](const GAS bf16* p) { const u32x2 w = *(const GAS u32x2*)p; return (f32x4){bflo(w.x), bfhi(w.x), bflo(w.y), bfhi(w.y)}; };
    if (!first) { p3 = ld4(src - 3 * NPJ); p2 = ld4(src - 2 * NPJ); p1 = ld4(src - NPJ); }
    u32x2 raw[32];
#pragma unroll
    for (int t = 0; t < 32; ++t) raw[t] = *(const GAS u32x2*)(src + (size_t)t * NPJ);
#pragma unroll
    for (int t = 0; t < 32; ++t) { const f32x4 cur = (f32x4){bflo(raw[t].x), bfhi(raw[t].x), bflo(raw[t].y), bfhi(raw[t].y)}; const f32x4 y = w0 * p3 + w1 * p2 + w2 * p1 + w3 * cur + cb;
        u32x2 w; w.x = pk2(fsilu(y[0]), fsilu(y[1])); w.y = pk2(fsilu(y[2]), fsilu(y[3])); *(GAS u32x2*)(F.XA() + (size_t)(row0 + t) * 768 + ch) = w; p3 = p2; p2 = p1; p1 = cur; }
    if ((row0 + 32) % SEQ == 0) { const int b = row0 / SEQ; GAS float* o = F.out + O_SCP + ((size_t)(l * 8 + b) * 3) * 768 + ch; *(GAS f32x4*)o = p3; *(GAS f32x4*)(o + 768) = p2; *(GAS f32x4*)(o + 1536) = p1; }
}
__device__ __forceinline__ void p2a_pb_item(Frame& F, int l, int item) {
#pragma unroll
    for (int rr = 0; rr < 8; ++rr) { const int row = 8 * item + rr;
        if (row < MREAL) { const GAS float* s = (row < MPR) ? F.in[I_PP] + ((size_t)l * MPR + row) * PLE : F.in[I_PS] + ((size_t)l * MSM + row - MPR) * PLE;
            const f32x4 v = ((const GAS f32x4*)s)[F.lane]; u32x2 w; w.x = pk2(v[0], v[1]); w.y = pk2(v[2], v[3]); ((GAS u32x2*)(F.PB() + (size_t)row * PLE))[F.lane] = w; } }
}

__device__ __forceinline__ void smp_rg_item(Frame& F, int l, int i, int hh) {
    const int lane = F.lane, c = 64 * hh + lane; const size_t row = (size_t)MPR + i; GAS bf16* pr = F.BIG() + row * NPJ;
    LAS float* sx = (LAS float*)(F.lds + F.wave * 8704);
    const GAS float* st = F.in[I_SRC] + ((size_t)(l * MSM + i) * 3) * 512 + c; const float b0 = st[0], b1 = st[512], b2 = st[1024], cur = bf2f(pr[PC_AX + c]);
    const GAS float* cw = F.in[I_CAW] + l * 4 * 512; const float xa = cw[c] * b0 + cw[512 + c] * b1 + cw[1024 + c] * b2 + cw[1536 + c] * cur + F.in[I_CAB][l * 512 + c];
    { GAS float* o = F.out + O_RCS + ((size_t)(l * MSM + i) * 3) * 512 + c; o[0] = b1; o[512] = b2; o[1024] = cur; }
    sx[lane] = xa;
    const GAS float* wa = F.in[I_WA] + ((size_t)(l * 8 + hh) * 64) * 64 + lane; const GAS float* wx = F.in[I_WX] + ((size_t)(l * 8 + hh) * 64) * 64 + lane;
    const float h0 = F.in[I_SRH][(size_t)(l * MSM + i) * 512 + c], ga = bf2f(pr[PC_AG + c]);
    float ar = 0.f, ai = 0.f;
#pragma nounroll
    for (int hb_ = 0; hb_ < 4; ++hb_) { float wv[16], xv[16];
#pragma unroll
        for (int q = 0; q < 16; ++q) { wv[q] = wa[(16 * hb_ + q) * 64]; xv[q] = wx[(16 * hb_ + q) * 64]; }
#pragma unroll
        for (int q = 0; q < 16; ++q) { const float x = sx[16 * hb_ + q]; ar += x * wv[q]; ai += x * xv[q]; } }
    const float rr = fsigmoid(ar + F.in[I_BA][l * 512 + c]), ii = fsigmoid(ai + F.in[I_BX][l * 512 + c]), la = -8.f * fsoftplus(-F.in[I_LAM][l * 512 + c]) * rr;
    const float a = fexp(la), mult = __builtin_amdgcn_sqrtf(fmaxf(fnegexpm1(2.f * la), 0.f));
    const float hn = a * h0 + mult * ii * xa;
    F.out[O_RHS + (size_t)(l * MSM + i) * 512 + c] = hn; pr[PC_AX + c] = f2bf(hn * ga);
}
__device__ __forceinline__ float smp_conv_b(Frame& F, int l, int i, int ch, const GAS bf16* pr, bool wr) {
    const int col = ch < 512 ? PC_XS + ch : PC_B + (ch - 512);
    const GAS float* st = F.in[I_SSC] + ((size_t)(l * MSM + i) * 3) * 768 + ch; const float b0 = st[0], b1 = st[768], b2 = st[1536], cur = bf2f(pr[col]);
    const GAS float* cw = F.in[I_CBW] + l * 4 * 768;
    if (wr) { GAS float* o = F.out + O_SCS + ((size_t)(l * MSM + i) * 3) * 768 + ch; o[0] = b1; o[768] = b2; o[1536] = cur; }
    return fsilu(cw[ch] * b0 + cw[768 + ch] * b1 + cw[1536 + ch] * b2 + cw[2304 + ch] * cur + F.in[I_CBB][l * 768 + ch]);
}
__device__ __forceinline__ void smp_ssd_item(Frame& F, int l, int i, int hh) {
    const int lane = F.lane, half = lane >> 5, ln = lane & 31, n0 = 4 * ln; const size_t row = (size_t)MPR + i; GAS bf16* pr = F.BIG() + row * NPJ;
    LAS float* sX = (LAS float*)(F.lds + F.wave * 8704); LAS float* sB = sX + 64; LAS float* sC = sB + 128; LAS float* sY = sC + 128;
    const float zg = bf2f(pr[PC_BZ + 64 * hh + lane]);
    const float xh = smp_conv_b(F, l, i, 64 * hh + lane, pr, true);
    const float bq0 = smp_conv_b(F, l, i, 512 + lane, pr, hh == 0), bq1 = smp_conv_b(F, l, i, 576 + lane, pr, hh == 0), cq0 = smp_conv_b(F, l, i, 640 + lane, pr, hh == 0), cq1 = smp_conv_b(F, l, i, 704 + lane, pr, hh == 0);
    sX[lane] = xh; sB[lane] = bq0; sB[64 + lane] = bq1; sC[lane] = cq0; sC[64 + lane] = cq1;
    const float dtv = fsoftplus(F.DT()[row * 8 + hh] + F.in[I_DTB][l * 8 + hh]), dA = fexp(-dtv * __expf(F.in[I_ALOG][l * 8 + hh])), Dh = F.in[I_SSD_D][l * 8 + hh];
    const f32x4 Bn = *(const LAS f32x4*)(sB + n0), Cn = *(const LAS f32x4*)(sC + n0);
    const GAS float* sin_ = F.in[I_SSS] + (((size_t)(l * MSM + i) * 8 + hh) * 64) * 128; GAS float* sout = F.out + O_SSS + (((size_t)(l * MSM + i) * 8 + hh) * 64) * 128;
#pragma nounroll
    for (int hb_ = 0; hb_ < 2; ++hb_) { f32x4 sv[16];
#pragma unroll
        for (int k = 0; k < 16; ++k) sv[k] = *(const GAS f32x4*)(sin_ + (2 * (16 * hb_ + k) + half) * 128 + n0);
#pragma unroll
        for (int k = 0; k < 16; ++k) { const int p = 2 * (16 * hb_ + k) + half; const float xv = sX[p], xdt = dtv * xv;
            const f32x4 sn = sv[k] * dA + Bn * xdt; *(GAS f32x4*)(sout + p * 128 + n0) = sn;
            float yv = (Cn[0] * sn[0] + Cn[1] * sn[1]) + (Cn[2] * sn[2] + Cn[3] * sn[3]);
            yv = sum32(yv);
            if (ln == 0) sY[p] = yv + Dh * xv; } }
    const float yg = sY[lane] * zg; pr[PC_XS + 64 * hh + lane] = f2bf(yg);
    const float ssq = wave_sum(yg * yg);
    if (lane == 0) { F.SSDP()[row * 16 + 2 * hh] = ssq; F.SSDP()[row * 16 + 2 * hh + 1] = 0.f; }
}
__device__ __forceinline__ void smp_hg_item(Frame& F, int l, int i, int hh) {
    const int lane = F.lane; const size_t row = (size_t)MPR + i; GAS bf16* pr = F.BIG() + row * NPJ;
    LAS float* sQ = (LAS float*)(F.lds + F.wave * 8704); LAS float* sFd = sQ + 64; LAS float* sK = sFd + 64;
    const float lf = bf2f(pr[PC_CF + 64 * hh + lane]), vv = bf2f(pr[PC_CI + 64 * hh + lane]), gz = bf2f(pr[PC_CG + 64 * hh + lane]);
    sQ[lane] = bf2f(pr[PC_CQ + 64 * hh + lane]); sFd[lane] = fexp(lf); sK[lane] = fnegexpm1(lf);
    const GAS float* sin_ = F.in[I_SHG] + (((size_t)(l * MSM + i) * 8 + hh) * 64) * 64 + lane; GAS float* sout = F.out + O_HSS + (((size_t)(l * MSM + i) * 8 + hh) * 64) * 64 + lane;
    float o = 0.f;
#pragma nounroll
    for (int hb_ = 0; hb_ < 2; ++hb_) { float sv[32];
#pragma unroll
        for (int k = 0; k < 32; ++k) sv[k] = sin_[(32 * hb_ + k) * 64];
#pragma unroll
        for (int k = 0; k < 32; ++k) { const int dd = 32 * hb_ + k; const float sn = sFd[dd] * sv[k] + sK[dd] * vv; sout[dd * 64] = sn; o += sQ[dd] * sn; } }
    const float ss = wave_sum(o * o); const float rs = __builtin_amdgcn_rsqf(ss * (1.f / 64.f) + EPS);
    pr[PC_CQ + 64 * hh + lane] = f2bf(o * rs * F.in[I_HNORM][l * 64 + lane] * gz);
}
__device__ __forceinline__ void p2a_phase(Frame& F, int l) {
    const int gw = F.bx * 8 + F.wave, NGW = F.G * 8;
    constexpr int N_RG = (MPR / 32) * 8, N_CV = (MPR / 32) * 3, N_PB = MP / 8, N_SM = MSM * 8 * 3;
#pragma nounroll
    for (int it = gw; it < N_SM + N_RG + N_CV + N_PB; it += NGW) {
        if (it < N_SM) { const int m3 = it % 3, th = it / 3, hh = th & 7, i = th >> 3;
            if (m3 == 0) smp_ssd_item(F, l, i, hh); else if (m3 == 1) smp_hg_item(F, l, i, hh); else smp_rg_item(F, l, i, hh); }
        else if (it < N_SM + N_RG) p2a_rg_item(F, l, it - N_SM);
        else if (it < N_SM + N_RG + N_CV) p2a_conv_item(F, l, it - N_SM - N_RG);
        else p2a_pb_item(F, l, it - N_SM - N_RG - N_CV);
    }
}

__device__ __forceinline__ void rg_scan_role(Frame& F, int l, int rid) {
    const int b = rid >> 3, h = rid & 7, lane = F.lane, w = F.wave, gj = 64 * h + lane;
    LAS float* sA = (LAS float*)F.lds; LAS float* sB = sA + 512;
    const size_t rb = (size_t)b * SEQ + 256 * w;
    const GAS bf16* la = F.LA() + rb * 512 + gj; const GAS bf16* bb = F.BB() + rb * 512 + gj;
    float A = 1.f, B = 0.f;
#pragma nounroll
    for (int t = 0; t < 256; t += 8) { float av[8], bv[8];
#pragma unroll
        for (int k = 0; k < 8; ++k) { av[k] = bf2f(la[(size_t)(t + k) * 512]); bv[k] = bf2f(bb[(size_t)(t + k) * 512]); }
#pragma unroll
        for (int k = 0; k < 8; ++k) { const float a = fexp(av[k]); B = a * B + bv[k]; A *= a; } }
    sA[w * 64 + lane] = A; sB[w * 64 + lane] = B;
    WG_BARRIER();
    float hh = 0.f;
    for (int q = 0; q < w; ++q) hh = sA[q * 64 + lane] * hh + sB[q * 64 + lane];
    GAS bf16* pr = F.BIG() + rb * NPJ;
#pragma nounroll
    for (int t = 0; t < 256; t += 8) { float av[8], bv[8], gv[8];
#pragma unroll
        for (int k = 0; k < 8; ++k) { av[k] = bf2f(la[(size_t)(t + k) * 512]); bv[k] = bf2f(bb[(size_t)(t + k) * 512]); gv[k] = bf2f(pr[(size_t)(t + k) * NPJ + PC_AG + gj]); }
#pragma unroll
        for (int k = 0; k < 8; ++k) { hh = fexp(av[k]) * hh + bv[k]; pr[(size_t)(t + k) * NPJ + PC_AX + gj] = f2bf(hh * gv[k]); } }
    if (w == 7) F.out[O_RHP + (size_t)(l * 8 + b) * 512 + gj] = hh;
    WG_BARRIER();
}

__device__ __forceinline__ void rg_apply_role(Frame& F, int l, int rid, int nrole) {
    typedef float f32x2t __attribute__((ext_vector_type(2)));
#pragma nounroll
    for (int bh = rid; bh < 64; bh += nrole) { const int b = bh >> 3, h = bh & 7, lane = F.lane, w = F.wave, gj = 64 * h + lane;
        float hh = 0.f;
        { LAS float* sA = (LAS float*)F.lds; LAS float* sB = sA + 512; f32x2t ab[8]; float A_ = 1.f, B_ = 0.f;
#pragma unroll
          for (int k = 0; k < 8; ++k) ab[k] = *(const GAS f32x2t*)(F.TS() + ((size_t)(64 * b + 8 * w + k) * 512 + gj) * 2);
#pragma unroll
          for (int k = 0; k < 8; ++k) { B_ = ab[k].x * B_ + ab[k].y; A_ *= ab[k].x; }
          sA[w * 64 + lane] = A_; sB[w * 64 + lane] = B_;
          WG_BARRIER();
          for (int v = 0; v < w; ++v) hh = sA[v * 64 + lane] * hh + sB[v * 64 + lane]; }
        const size_t rb = (size_t)b * SEQ + 256 * w;
        GAS bf16* pr = F.BIG() + rb * NPJ;
#define RG_LOAD(LW, BW, GV, T0) do { const size_t to_ = (((rb + (T0)) >> 5) * 4 * 512 + gj) * 8; \
            _Pragma("unroll") for (int g = 0; g < 4; ++g) { LW[g] = *(const GAS u32x4*)(F.LA() + to_ + (size_t)g * 512 * 8); BW[g] = *(const GAS u32x4*)(F.BB() + to_ + (size_t)g * 512 * 8); } \
            _Pragma("unroll") for (int k = 0; k < 32; ++k) GV[k] = pr[(size_t)((T0) + k) * NPJ + PC_AG + gj]; } while (0)
#define RG_RUN(LW, BW, GV, T0) do { float yv_[32]; \
            _Pragma("unroll") for (int g = 0; g < 4; ++g) { const unsigned lws[4] = {LW[g].x, LW[g].y, LW[g].z, LW[g].w}, bws[4] = {BW[g].x, BW[g].y, BW[g].z, BW[g].w}; \
                _Pragma("unroll") for (int j = 0; j < 4; ++j) { hh = fexp(bflo(lws[j])) * hh + bflo(bws[j]); yv_[8 * g + 2 * j] = hh * bf2f(GV[8 * g + 2 * j]); hh = fexp(bfhi(lws[j])) * hh + bfhi(bws[j]); yv_[8 * g + 2 * j + 1] = hh * bf2f(GV[8 * g + 2 * j + 1]); } } \
            _Pragma("unroll") for (int k = 0; k < 32; ++k) pr[(size_t)((T0) + k) * NPJ + PC_AX + gj] = f2bf(yv_[k]); } while (0)
        u32x4 lwA[4], bwA[4], lwB[4], bwB[4]; bf16 gvA[32], gvB[32];
        RG_LOAD(lwA, bwA, gvA, 0);
#pragma nounroll
        for (int t0 = 0; t0 < 256; t0 += 64) {
            RG_LOAD(lwB, bwB, gvB, t0 + 32);
            RG_RUN(lwA, bwA, gvA, t0);
            if (t0 + 64 < 256) RG_LOAD(lwA, bwA, gvA, t0 + 64);
            RG_RUN(lwB, bwB, gvB, t0 + 32);
        }
#undef RG_LOAD
#undef RG_RUN
        if (w == 7) F.out[O_RHP + (size_t)(l * 8 + b) * 512 + gj] = hh; }
}

constexpr int SLD = 136;
__device__ __forceinline__ void ssd_role(Frame& F, int l, int rid) {
    const int b = rid >> 3, h = rid & 7, tid = F.tid, lane = F.lane, w = F.wave, r = lane & 31, hf = lane >> 5;
    LAS bf16* sC = (LAS bf16*)F.lds; LAS bf16* sBG = sC + 128 * SLD; LAS bf16* sBw = sBG + 128 * SLD; LAS bf16* sXT = sBw + 128 * SLD; LAS bf16* sS = sXT + 64 * SLD;
    LAS float* sCum = (LAS float*)(sS + 64 * SLD); LAS float* sDt = sCum + 128; LAS float* sW = sDt + 128; LAS float* sEc = sW + 128; LAS float* sTmp = sEc + 128;
    const float a_neg = -__expf(F.in[I_ALOG][l * 8 + h]), dtb = F.in[I_DTB][l * 8 + h], Dh = F.in[I_SSD_D][l * 8 + h];
    f32x16 accS;
#ifdef DBG_SSD2
    unsigned mism = 0;
#pragma nounroll
    for (int rep = 0; rep < 2; ++rep) {
#endif
#pragma unroll
    for (int q = 0; q < 16; ++q) accS[q] = 0.f;
    for (int e = tid; e < 64 * SLD; e += 512) sS[e] = 0;
    WG_BARRIER();
#pragma nounroll
    for (int c = 0; c < 16; ++c) {
        const size_t row0 = (size_t)b * SEQ + 128 * c;
#pragma unroll
        for (int i = 0; i < 4; ++i) { const int rr = (tid >> 4) + 32 * i, ck = tid & 15; const GAS bf16* src = F.XA() + (row0 + rr) * 768 + 512 + 8 * ck;
            *(LAS u32x4*)(sBG + rr * SLD + 8 * ck) = *(const GAS u32x4*)src; *(LAS u32x4*)(sC + rr * SLD + 8 * ck) = *(const GAS u32x4*)(src + 128); }
        if (w == 0) { const int t0 = 2 * lane; const float d0 = fsoftplus(F.DT()[(row0 + t0) * 8 + h] + dtb), d1 = fsoftplus(F.DT()[(row0 + t0 + 1) * 8 + h] + dtb);
            const float a0 = d0 * a_neg, a1 = d1 * a_neg; float s = a0 + a1;
#pragma unroll
            for (int o = 1; o < 64; o <<= 1) { const float v = bperm(s, lane - o); if (lane >= o) s += v; }
            const float c1 = s, c0 = s - a1, last = __int_as_float(__builtin_amdgcn_readlane(__float_as_int(s), 63));
            sCum[t0] = c0; sCum[t0 + 1] = c1; sEc[t0] = fexp(c0); sEc[t0 + 1] = fexp(c1); sW[t0] = fexp(last - c0) * d0; sW[t0 + 1] = fexp(last - c1) * d1; sDt[t0] = d0; sDt[t0 + 1] = d1;
            if (lane == 0) sTmp[0] = fexp(last); }
        WG_BARRIER();
        { const int s = tid & 127, pg = tid >> 7; const GAS bf16* src = F.XA() + (row0 + s) * 768;
            const u32x4 x0 = *(const GAS u32x4*)(src + 64 * h + 16 * pg), x1 = *(const GAS u32x4*)(src + 64 * h + 16 * pg + 8);
            const unsigned xw[8] = {x0.x, x0.y, x0.z, x0.w, x1.x, x1.y, x1.z, x1.w};
#pragma unroll
            for (int j = 0; j < 8; ++j) { sXT[(16 * pg + 2 * j) * SLD + s] = (bf16)(xw[j] & 0xffffu); sXT[(16 * pg + 2 * j + 1) * SLD + s] = (bf16)(xw[j] >> 16); }
            const float ws = sW[s];
#pragma unroll
            for (int q4 = 0; q4 < 4; ++q4) { const u32x4 bq = *(const GAS u32x4*)(src + 512 + 32 * pg + 8 * q4); const unsigned bw[4] = {bq.x, bq.y, bq.z, bq.w};
#pragma unroll
                for (int j = 0; j < 4; ++j) { const int n = 32 * pg + 8 * q4 + 2 * j; sBw[n * SLD + s] = f2bf(bflo(bw[j]) * ws); sBw[(n + 1) * SLD + s] = f2bf(bfhi(bw[j]) * ws); } } }
#if DBG_V == 1
        WG_BARRIER();
#endif
        f32x16 cbv[2];
#pragma unroll
        for (int q = 0; q < 2; ++q) { const int blk = 2 * w + q, tb = blk >> 2, sb = blk & 3; f32x16 a_;
#pragma unroll
            for (int z = 0; z < 16; ++z) a_[z] = 0.f;
            if (sb <= tb) {
#pragma unroll
                for (int ks = 0; ks < 8; ++ks) { const bf16x8 a = *(const LAS bf16x8*)(sC + (32 * tb + r) * SLD + 16 * ks + 8 * hf), bb = *(const LAS bf16x8*)(sBG + (32 * sb + r) * SLD + 16 * ks + 8 * hf); a_ = mfma32(a, bb, a_); } }
            cbv[q] = a_; }
        const int tby = w >> 1, pb = w & 1;
        f32x16 y;
#pragma unroll
        for (int z = 0; z < 16; ++z) y[z] = 0.f;
#pragma unroll
        for (int ks = 0; ks < 8; ++ks) { const bf16x8 a = *(const LAS bf16x8*)(sC + (32 * tby + r) * SLD + 16 * ks + 8 * hf), bs = *(const LAS bf16x8*)(sS + (32 * pb + r) * SLD + 16 * ks + 8 * hf); y = mfma32(a, bs, y); }
        WG_BARRIER();
#pragma unroll
        for (int q = 0; q < 2; ++q) { const int blk = 2 * w + q, tb = blk >> 2, sb = blk & 3;
            if (sb <= tb) { const int s_ = 32 * sb + r; const float cs = sCum[s_], ds = sDt[s_];
#pragma unroll
                for (int z = 0; z < 16; ++z) { const int t = 32 * tb + rowoff(z, hf); const float gv = (s_ <= t) ? cbv[q][z] * fexp(sCum[t] - cs) * ds : 0.f; sBG[t * SLD + s_] = f2bf(gv); } } }
#pragma unroll
        for (int z = 0; z < 16; ++z) y[z] *= sEc[32 * tby + rowoff(z, hf)];
        WG_BARRIER();
        for (int ks = 0; ks < 2 * (tby + 1); ++ks) { const bf16x8 a = *(const LAS bf16x8*)(sBG + (32 * tby + r) * SLD + 16 * ks + 8 * hf), bx = *(const LAS bf16x8*)(sXT + (32 * pb + r) * SLD + 16 * ks + 8 * hf); y = mfma32(a, bx, y); }
        { const int p = 32 * pb + r, col = 64 * h + p;
#pragma unroll
            for (int z = 0; z < 16; ++z) { const int t = 32 * tby + rowoff(z, hf); GAS bf16* pr = F.BIG() + (row0 + t) * NPJ;
                const float yv = y[z] + Dh * bf2f(sXT[p * SLD + t]); const float yg = yv * bf2f(pr[PC_BZ + col]);
#ifdef DBG_SSD2
                if (rep == 1) { if (l == 1 && pr[PC_XS + col] != f2bf(yg)) ++mism; } else
#endif
                pr[PC_XS + col] = f2bf(yg);
                const float ss = sum32(yg * yg);
                if (r == 0) F.SSDP()[(row0 + t) * 16 + 2 * h + pb] = ss; } }
#if DBG_V == 2
        WG_BARRIER();
#endif
        { const int pbs = w >> 2, nb = w & 3; const float dec = sTmp[0];
#pragma unroll
            for (int z = 0; z < 16; ++z) accS[z] *= dec;
#pragma unroll
            for (int ks = 0; ks < 8; ++ks) { const bf16x8 a = *(const LAS bf16x8*)(sXT + (32 * pbs + r) * SLD + 16 * ks + 8 * hf), bw = *(const LAS bf16x8*)(sBw + (32 * nb + r) * SLD + 16 * ks + 8 * hf); accS = mfma32(a, bw, accS); }
#pragma unroll
            for (int z = 0; z < 16; ++z) sS[(32 * pbs + rowoff(z, hf)) * SLD + 32 * nb + r] = f2bf(accS[z]); }
        WG_BARRIER();
    }
#ifdef DBG_SSD2
    }
    { const float mt = wave_sum((float)mism); if (lane == 0 && l == 1) F.out[(size_t)(16000 + rid * 8 + w) * DM] = 1000.f * mt; }
#endif
    { const int pbs = w >> 2, nb = w & 3; GAS float* o = F.out + O_SSP + ((size_t)(l * 8 + b) * 8 + h) * 64 * 128;
#pragma unroll
        for (int z = 0; z < 16; ++z) o[(32 * pbs + rowoff(z, hf)) * 128 + 32 * nb + r] = accS[z]; }
}


__device__ __forceinline__ void ssd_role2(Frame& F, int l, int rid) {
    const int b = rid >> 4, h = (rid >> 1) & 7, ph = rid & 1, tid = F.tid, lane = F.lane, w = F.wave, r = lane & 31, hf = lane >> 5;
    LAS bf16* sC = (LAS bf16*)F.lds; LAS bf16* sBG = sC + 128 * SLD; LAS bf16* sBw = sBG + 128 * SLD; LAS bf16* sXT = sBw + 128 * SLD; LAS bf16* sS = sXT + 32 * SLD;
    LAS float* sScan = (LAS float*)(sS + 32 * SLD); LAS float* sYo = sScan + 2 * 528;
    const float a_neg = -__expf(F.in[I_ALOG][l * 8 + h]), dtb = F.in[I_DTB][l * 8 + h], Dh = F.in[I_SSD_D][l * 8 + h];
    const int pcol = 64 * h + 32 * ph;
    f32x16 accS;
#pragma unroll
    for (int q = 0; q < 16; ++q) accS[q] = 0.f;
    for (int e = tid; e < 32 * SLD; e += 512) sS[e] = 0;
    u32x4 rx, rbq[4], rc[4], rzv; float rd0 = 0.f, rd1 = 0.f;
    const int s_ = tid & 127, pg = tid >> 7, ot = tid >> 2, ock = tid & 3;
#define SSD_LOAD(ROW0) do { \
        { const GAS bf16* src = F.XA() + ((ROW0) + s_) * 768; rx = *(const GAS u32x4*)(src + pcol + 8 * pg); } \
        _Pragma("unroll") for (int i4 = 0; i4 < 4; ++i4) rbq[i4] = *(const GAS u32x4*)(F.XA() + ((ROW0) + (tid >> 4) + 32 * i4) * 768 + 512 + 8 * (tid & 15)); \
        _Pragma("unroll") for (int i4 = 0; i4 < 4; ++i4) rc[i4] = *(const GAS u32x4*)(F.XA() + ((ROW0) + (tid >> 4) + 32 * i4) * 768 + 640 + 8 * (tid & 15)); \
        rzv = *(const GAS u32x4*)(F.BIG() + ((ROW0) + ot) * NPJ + PC_BZ + pcol + 8 * ock); } while (0)
#define SSD_LOAD_DT(ROW0) do { rd0 = F.DT()[((ROW0) + 2 * lane) * 8 + h]; rd1 = F.DT()[((ROW0) + 2 * lane + 1) * 8 + h]; } while (0)
#define SSD_SCAN(SET) do { LAS float* q_ = sScan + (SET) * 528; const int t0 = 2 * lane; const float d0 = fsoftplus(rd0 + dtb), d1 = fsoftplus(rd1 + dtb); \
        const float a0 = d0 * a_neg, a1 = d1 * a_neg; float sc_ = a0 + a1; \
        _Pragma("unroll") for (int o = 1; o < 64; o <<= 1) { const float v = bperm(sc_, lane - o); if (lane >= o) sc_ += v; } \
        const float c1 = sc_, c0 = sc_ - a1, last = __int_as_float(__builtin_amdgcn_readlane(__float_as_int(sc_), 63)); \
        q_[t0] = c0; q_[t0 + 1] = c1; q_[384 + t0] = fexp(c0); q_[384 + t0 + 1] = fexp(c1); q_[256 + t0] = fexp(last - c0) * d0; q_[256 + t0 + 1] = fexp(last - c1) * d1; q_[128 + t0] = d0; q_[128 + t0 + 1] = d1; \
        if (lane == 0) q_[512] = fexp(last); } while (0)
    SSD_LOAD((size_t)b * SEQ);
    if (w == 1) { SSD_LOAD_DT((size_t)b * SEQ); SSD_SCAN(0); SSD_LOAD_DT((size_t)b * SEQ + 128); }
    WG_BARRIER();
#pragma nounroll
    for (int c = 0; c < 16; ++c) {
        const size_t row0 = (size_t)b * SEQ + 128 * c;
        LAS float* sCum = sScan + (c & 1) * 528; LAS float* sDt = sCum + 128; LAS float* sW = sDt + 128; LAS float* sEc = sW + 128; LAS float* sTmp = sEc + 128;
#pragma unroll
        for (int i = 0; i < 4; ++i) { *(LAS u32x4*)(sC + ((tid >> 4) + 32 * i) * SLD + 8 * (tid & 15)) = rc[i]; *(LAS u32x4*)(sBG + ((tid >> 4) + 32 * i) * SLD + 8 * (tid & 15)) = rbq[i]; }
        { const unsigned xw[4] = {rx.x, rx.y, rx.z, rx.w};
#pragma unroll
            for (int j = 0; j < 4; ++j) { sXT[(8 * pg + 2 * j) * SLD + s_] = (bf16)(xw[j] & 0xffffu); sXT[(8 * pg + 2 * j + 1) * SLD + s_] = (bf16)(xw[j] >> 16); }
 }
        const u32x4 zcur = rzv;
        if (c + 1 < 16) SSD_LOAD(row0 + 128);
        WG_BARRIER();
        { const float ws_ = sW[s_];
#pragma unroll
            for (int q4 = 0; q4 < 4; ++q4) { const u32x4 bq = *(const LAS u32x4*)(sBG + s_ * SLD + 32 * pg + 8 * q4); const unsigned bw[4] = {bq.x, bq.y, bq.z, bq.w};
#pragma unroll
                for (int j = 0; j < 4; ++j) { const int n = 32 * pg + 8 * q4 + 2 * j; sBw[n * SLD + s_] = f2bf(bflo(bw[j]) * ws_); sBw[(n + 1) * SLD + s_] = f2bf(bfhi(bw[j]) * ws_); } } }
        f32x16 cbv[2];
#pragma unroll
        for (int q = 0; q < 2; ++q) { const int blk = 2 * w + q, tb = blk >> 2, sb = blk & 3; f32x16 a_;
#pragma unroll
            for (int z = 0; z < 16; ++z) a_[z] = 0.f;
            if (sb <= tb) {
#pragma unroll
                for (int ks = 0; ks < 8; ++ks) { const bf16x8 a = *(const LAS bf16x8*)(sC + (32 * tb + r) * SLD + 16 * ks + 8 * hf), bb = *(const LAS bf16x8*)(sBG + (32 * sb + r) * SLD + 16 * ks + 8 * hf); a_ = mfma32(a, bb, a_); } }
            cbv[q] = a_; }
        f32x16 y;
#pragma unroll
        for (int z = 0; z < 16; ++z) y[z] = 0.f;
        if (w < 4) {
#pragma unroll
            for (int ks = 0; ks < 8; ++ks) { const bf16x8 a = *(const LAS bf16x8*)(sC + (32 * w + r) * SLD + 16 * ks + 8 * hf), bs = *(const LAS bf16x8*)(sS + r * SLD + 16 * ks + 8 * hf); y = mfma32(a, bs, y); } }
        if (w == 1 && c + 1 < 16) { SSD_SCAN((c + 1) & 1); if (c + 2 < 16) SSD_LOAD_DT(row0 + 256); }
        WG_BARRIER();
#pragma unroll
        for (int q = 0; q < 2; ++q) { const int blk = 2 * w + q, tb = blk >> 2, sb = blk & 3;
            if (sb <= tb) { const int sq = 32 * sb + r; const float cs = sCum[sq], ds = sDt[sq]; float ct[16];
#pragma unroll
                for (int z = 0; z < 16; ++z) ct[z] = sCum[32 * tb + rowoff(z, hf)];
#pragma unroll
                for (int z = 0; z < 16; ++z) { const int t = 32 * tb + rowoff(z, hf); const float gu = cbv[q][z] * fexp(fminf(ct[z] - cs, 0.f)) * ds; sBG[t * SLD + sq] = f2bf((sq <= t) ? gu : 0.f); } } }
        if (w < 4) {
#pragma unroll
            for (int z = 0; z < 16; ++z) y[z] *= sEc[32 * w + rowoff(z, hf)]; }
        WG_BARRIER();
        if (w < 4) {
            for (int ks = 0; ks < 2 * (w + 1); ++ks) { const bf16x8 a = *(const LAS bf16x8*)(sBG + (32 * w + r) * SLD + 16 * ks + 8 * hf), bx = *(const LAS bf16x8*)(sXT + r * SLD + 16 * ks + 8 * hf); y = mfma32(a, bx, y); }
#pragma unroll
            for (int z = 0; z < 16; ++z) { const int t = 32 * w + rowoff(z, hf); sYo[t * 36 + r] = y[z] + Dh * bf2f(sXT[r * SLD + t]); }
        } else { const int nb = w - 4; const float dec = sTmp[0];
#pragma unroll
            for (int z = 0; z < 16; ++z) accS[z] *= dec;
#pragma unroll
            for (int ks = 0; ks < 8; ++ks) { const bf16x8 a = *(const LAS bf16x8*)(sXT + r * SLD + 16 * ks + 8 * hf), bw = *(const LAS bf16x8*)(sBw + (32 * nb + r) * SLD + 16 * ks + 8 * hf); accS = mfma32(a, bw, accS); }
#pragma unroll
            for (int z = 0; z < 16; ++z) sS[rowoff(z, hf) * SLD + 32 * nb + r] = f2bf(accS[z]); }
        WG_BARRIER();
        { const f32x4 ya = *(const LAS f32x4*)(sYo + ot * 36 + 8 * ock), yb = *(const LAS f32x4*)(sYo + ot * 36 + 8 * ock + 4);
            const float g0 = ya[0] * bflo(zcur.x), g1 = ya[1] * bfhi(zcur.x), g2 = ya[2] * bflo(zcur.y), g3 = ya[3] * bfhi(zcur.y), g4 = yb[0] * bflo(zcur.z), g5 = yb[1] * bfhi(zcur.z), g6 = yb[2] * bflo(zcur.w), g7 = yb[3] * bfhi(zcur.w);
            u32x4 ow; ow.x = pk2(g0, g1); ow.y = pk2(g2, g3); ow.z = pk2(g4, g5); ow.w = pk2(g6, g7);
            *(GAS u32x4*)(F.BIG() + (row0 + ot) * NPJ + PC_XS + pcol + 8 * ock) = ow;
            float ss = ((g0 * g0 + g1 * g1) + (g2 * g2 + g3 * g3)) + ((g4 * g4 + g5 * g5) + (g6 * g6 + g7 * g7));
            ss += dpp_f<0xB1>(ss); ss += dpp_f<0x4E>(ss);
            if (ock == 0) F.SSDP()[(row0 + ot) * 16 + 2 * h + ph] = ss; }
    }
#undef SSD_LOAD
#undef SSD_LOAD_DT
#undef SSD_SCAN
    if (w >= 4) { const int nb = w - 4; GAS float* o = F.out + O_SSP + ((size_t)(l * 8 + b) * 8 + h) * 64 * 128;
#pragma unroll
        for (int z = 0; z < 16; ++z) o[(32 * ph + rowoff(z, hf)) * 128 + 32 * nb + r] = accS[z]; }
    WG_BARRIER();
}

constexpr int HLD = 72;
template <bool DRY> __device__ __forceinline__ void hgrn_role(Frame& F, int l, int rid) {
    const int b = rid >> 3, h = rid & 7, tid = F.tid, lane = F.lane, w = F.wave, r = lane & 31, hf = lane >> 5;
    LAS bf16* sQe = (LAS bf16*)F.lds; LAS bf16* sKe = sQe + 64 * HLD; LAS bf16* sQb = sKe + 64 * HLD; LAS bf16* sKdT = sQb + 64 * HLD; LAS bf16* sVT = sKdT + 64 * HLD; LAS bf16* sAtt = sVT + 64 * HLD; LAS bf16* sST = sAtt + 64 * HLD;
    LAS float* sO = (LAS float*)(sST + 64 * HLD); LAS float* sPart = sO + 64 * 68; LAS float* sBl = sPart + 512;
    f32x16 accS;
#pragma unroll
    for (int q = 0; q < 16; ++q) accS[q] = 0.f;
    for (int e = tid; e < 64 * HLD; e += 512) sST[e] = 0;
    WG_BARRIER();
    const int d = lane, col = 64 * h + d;
    bf16 rq[8], rlf[8], rv[8]; u32x4 rgz;
#define HG_LOAD(ROW0) do { _Pragma("unroll") for (int i = 0; i < 8; ++i) { const GAS bf16* pr_ = F.BIG() + ((ROW0) + 8 * w + i) * NPJ; rq[i] = pr_[PC_CQ + col]; rlf[i] = pr_[PC_CF + col]; rv[i] = pr_[PC_CI + col]; } \
        rgz = *(const GAS u32x4*)(F.BIG() + ((ROW0) + (tid >> 3)) * NPJ + PC_CG + 64 * h + 8 * (tid & 7)); } while (0)
    HG_LOAD((size_t)b * SEQ);
    const f32x4 n0 = *(const GAS f32x4*)(F.in[I_HNORM] + l * 64 + 8 * (tid & 7)), n1 = *(const GAS f32x4*)(F.in[I_HNORM] + l * 64 + 8 * (tid & 7) + 4);
#pragma nounroll
    for (int c = 0; c < 32; ++c) {
        const size_t row0 = (size_t)b * SEQ + 64 * c;
        float q[8], lf[8], v[8], bc[8];
#pragma unroll
        for (int i = 0; i < 8; ++i) { q[i] = bf2f(rq[i]); lf[i] = bf2f(rlf[i]); v[i] = bf2f(rv[i]); }
        const u32x4 gz = rgz;
        if (c + 1 < 32) HG_LOAD(row0 + 64);
        float run = 0.f;
#pragma unroll
        for (int i = 0; i < 8; ++i) { run += lf[i]; bc[i] = run; }
        sPart[w * 64 + d] = run;
        WG_BARRIER();
        float pre = 0.f, bm = 0.f, bl = 0.f;
#pragma unroll
        for (int q8 = 0; q8 < 8; ++q8) { const float pv = sPart[q8 * 64 + d]; if (q8 < w) pre += pv; if (q8 < 4) bm += pv; bl += pv; }
        unsigned kdw[4], vw[4];
#pragma unroll
        for (int i = 0; i < 8; i += 2) { float kd2[2];
#pragma unroll
            for (int u = 0; u < 2; ++u) { const int ii = i + u; const float bt = pre + bc[ii]; const float k = 1.f - fexp(lf[ii]);
                const float e1 = fexp(__builtin_amdgcn_fmed3f(bt - bm, -80.f, 80.f)), e2 = frcp(e1);
                const int t = 8 * w + ii; sQe[t * HLD + d] = f2bf(q[ii] * e1); sKe[t * HLD + d] = f2bf(k * e2); sQb[t * HLD + d] = f2bf(q[ii] * fexp(bt)); kd2[u] = k * fexp(bl - bt); }
            kdw[i >> 1] = pk2(kd2[0], kd2[1]); vw[i >> 1] = pk2(v[i], v[i + 1]); }
        *(LAS u32x4*)(sKdT + d * HLD + 8 * w) = (u32x4){kdw[0], kdw[1], kdw[2], kdw[3]};
        *(LAS u32x4*)(sVT + d * HLD + 8 * w) = (u32x4){vw[0], vw[1], vw[2], vw[3]};
        if (w == 0) sBl[d] = fexp(bl);
        WG_BARRIER();
        f32x16 o;
#pragma unroll
        for (int z = 0; z < 16; ++z) o[z] = 0.f;
        const int tb = (w >> 1) & 1, eb = w & 1;
        if (w < 4) {
#pragma unroll
            for (int ks = 0; ks < 4; ++ks) { const bf16x8 a = *(const LAS bf16x8*)(sQb + (32 * tb + r) * HLD + 16 * ks + 8 * hf), bs = *(const LAS bf16x8*)(sST + (32 * eb + r) * HLD + 16 * ks + 8 * hf); o = mfma32(a, bs, o); }
        } else if (w < 7) { const int blk = w - 4, tba = blk == 0 ? 0 : 1, sba = blk == 2 ? 1 : 0;
#pragma unroll
            for (int ks = 0; ks < 4; ++ks) { const bf16x8 a = *(const LAS bf16x8*)(sQe + (32 * tba + r) * HLD + 16 * ks + 8 * hf), bk = *(const LAS bf16x8*)(sKe + (32 * sba + r) * HLD + 16 * ks + 8 * hf); o = mfma32(a, bk, o); }
#pragma unroll
            for (int z = 0; z < 16; ++z) { const int t = 32 * tba + rowoff(z, hf), s_ = 32 * sba + r; sAtt[t * HLD + s_] = f2bf((s_ <= t) ? o[z] : 0.f); }
        }
        WG_BARRIER();
        if (w < 4) {
            for (int ks = 0; ks < 2 * (tb + 1); ++ks) { const bf16x8 a = *(const LAS bf16x8*)(sAtt + (32 * tb + r) * HLD + 16 * ks + 8 * hf), bv = *(const LAS bf16x8*)(sVT + (32 * eb + r) * HLD + 16 * ks + 8 * hf); o = mfma32(a, bv, o); }
#pragma unroll
            for (int z = 0; z < 16; ++z) sO[(32 * tb + rowoff(z, hf)) * 68 + 32 * eb + r] = o[z];
        } else { const int db = (w >> 1) & 1;
#pragma unroll
            for (int z = 0; z < 16; ++z) accS[z] *= sBl[32 * db + rowoff(z, hf)];
#pragma unroll
            for (int ks = 0; ks < 4; ++ks) { const bf16x8 a = *(const LAS bf16x8*)(sKdT + (32 * db + r) * HLD + 16 * ks + 8 * hf), bv = *(const LAS bf16x8*)(sVT + (32 * eb + r) * HLD + 16 * ks + 8 * hf); accS = mfma32(a, bv, accS); }
#pragma unroll
            for (int z = 0; z < 16; ++z) sST[(32 * eb + r) * HLD + 32 * db + rowoff(z, hf)] = f2bf(accS[z]);
        }
        WG_BARRIER();
        { const int t = tid >> 3, eg = tid & 7; const f32x4 o0 = *(const LAS f32x4*)(sO + t * 68 + 8 * eg), o1 = *(const LAS f32x4*)(sO + t * 68 + 8 * eg + 4);
            float ss = (o0[0] * o0[0] + o0[1] * o0[1]) + (o0[2] * o0[2] + o0[3] * o0[3]) + (o1[0] * o1[0] + o1[1] * o1[1]) + (o1[2] * o1[2] + o1[3] * o1[3]);
            ss += swz_xor<1>(ss); ss += swz_xor<2>(ss); ss += swz_xor<4>(ss);
            const float rs = __builtin_amdgcn_rsqf(ss * (1.f / 64.f) + EPS);
            GAS bf16* pr = F.BIG() + (row0 + t) * NPJ;
            u32x4 ow; ow.x = pk2(o0[0] * rs * n0[0] * bflo(gz.x), o0[1] * rs * n0[1] * bfhi(gz.x)); ow.y = pk2(o0[2] * rs * n0[2] * bflo(gz.y), o0[3] * rs * n0[3] * bfhi(gz.y));
            ow.z = pk2(o1[0] * rs * n1[0] * bflo(gz.z), o1[1] * rs * n1[1] * bfhi(gz.z)); ow.w = pk2(o1[2] * rs * n1[2] * bflo(gz.w), o1[3] * rs * n1[3] * bfhi(gz.w));
            if (DRY) *(GAS u32x4*)(F.HB() + (size_t)(row0 + t) * DM + 64 * h + 8 * eg) = ow; else *(GAS u32x4*)(pr + PC_CQ + 64 * h + 8 * eg) = ow; }
    }
    if (w >= 4 && !DRY) { const int db = (w >> 1) & 1, eb = w & 1; GAS float* o = F.out + O_HSP + ((size_t)(l * 8 + b) * 8 + h) * 64 * 64;
#pragma unroll
        for (int z = 0; z < 16; ++z) o[(32 * db + rowoff(z, hf)) * 64 + 32 * eb + r] = accS[z]; }
    WG_BARRIER();
}

#ifndef SAMPLE_MASK
#define SAMPLE_MASK 7
#endif
template <bool DRY> __device__ __forceinline__ void sample_role(Frame& F, int l, int rid, int nrole) {
    const int tid = F.tid, lane = F.lane, w = F.wave;
    LAS float* sXa = (LAS float*)F.lds; LAS float* sX = sXa + 512; LAS float* sQ = sX + 768; LAS float* sFd = sQ + 512; LAS float* sK = sFd + 512; LAS float* sDt = sK + 512; LAS float* sY = sDt + 32;
#pragma nounroll
    for (int i = rid; i < MSM; i += nrole) { const size_t row = (size_t)MPR + i; GAS bf16* pr = F.BIG() + row * NPJ;
        { const int c = tid; const GAS float* st = F.in[I_SRC] + ((size_t)(l * MSM + i) * 3) * 512 + c; const float b0 = st[0], b1 = st[512], b2 = st[1024], cur = bf2f(pr[PC_AX + c]);
            const GAS float* cw = F.in[I_CAW] + l * 4 * 512; sXa[c] = cw[c] * b0 + cw[512 + c] * b1 + cw[1024 + c] * b2 + cw[1536 + c] * cur + F.in[I_CAB][l * 512 + c];
            GAS float* o = F.out + O_RCS + ((size_t)(l * MSM + i) * 3) * 512 + c; o[0] = b1; o[512] = b2; o[1024] = cur; }
        for (int ch = tid; ch < 768; ch += 512) { const int col = ch < 512 ? PC_XS + ch : PC_B + (ch - 512);
            const GAS float* st = F.in[I_SSC] + ((size_t)(l * MSM + i) * 3) * 768 + ch; const float b0 = st[0], b1 = st[768], b2 = st[1536], cur = bf2f(pr[col]);
            const GAS float* cw = F.in[I_CBW] + l * 4 * 768; sX[ch] = fsilu(cw[ch] * b0 + cw[768 + ch] * b1 + cw[1536 + ch] * b2 + cw[2304 + ch] * cur + F.in[I_CBB][l * 768 + ch]);
            GAS float* o = F.out + O_SCS + ((size_t)(l * MSM + i) * 3) * 768 + ch; o[0] = b1; o[768] = b2; o[1536] = cur; }
        { const int c = tid; sQ[c] = bf2f(pr[PC_CQ + c]); const float lf = bf2f(pr[PC_CF + c]); sFd[c] = fexp(lf); sK[c] = fnegexpm1(lf); }
        if (tid < 8) { const float dtv = fsoftplus(F.DT()[row * 8 + tid] + F.in[I_DTB][l * 8 + tid]); sDt[tid] = dtv; sDt[8 + tid] = fexp(-dtv * __expf(F.in[I_ALOG][l * 8 + tid])); }
        WG_BARRIER();
        if (SAMPLE_MASK & 1) { const int c = tid, hh = c >> 6, j = c & 63; const GAS float* wa = F.in[I_WA] + ((size_t)(l * 8 + hh) * 64) * 64 + j; const GAS float* wx = F.in[I_WX] + ((size_t)(l * 8 + hh) * 64) * 64 + j;
            float ar = 0.f, ai = 0.f;
#pragma unroll 32
            for (int q = 0; q < 64; ++q) { const float xv = sXa[64 * hh + q]; ar += xv * wa[q * 64]; ai += xv * wx[q * 64]; }
            const float rr = fsigmoid(ar + F.in[I_BA][l * 512 + c]), ii = fsigmoid(ai + F.in[I_BX][l * 512 + c]), la = -8.f * fsoftplus(-F.in[I_LAM][l * 512 + c]) * rr;
            const float a = fexp(la), mult = __builtin_amdgcn_sqrtf(fmaxf(fnegexpm1(2.f * la), 0.f));
            const float hn = a * F.in[I_SRH][(size_t)(l * MSM + i) * 512 + c] + mult * ii * sXa[c];
            F.out[O_RHS + (size_t)(l * MSM + i) * 512 + c] = hn; if (!DRY) pr[PC_AX + c] = f2bf(hn * bf2f(pr[PC_AG + c])); }
#ifdef DBG_BAR
        asm volatile("s_waitcnt vmcnt(0) lgkmcnt(0)" ::: "memory");
#endif
        if (SAMPLE_MASK & 2) { const int hh = w, half = lane >> 5, ln = lane & 31, n0 = 4 * ln; const float dA = sDt[8 + hh], dtv = sDt[hh], Dh = F.in[I_SSD_D][l * 8 + hh];
            const f32x4 Bn = *(const LAS f32x4*)(sX + 512 + n0), Cn = *(const LAS f32x4*)(sX + 640 + n0);
            const GAS float* sin_ = F.in[I_SSS] + (((size_t)(l * MSM + i) * 8 + hh) * 64) * 128; GAS float* sout = F.out + O_SSS + (((size_t)(l * MSM + i) * 8 + hh) * 64) * 128;
#pragma unroll
            for (int hb_ = 0; hb_ < 2; ++hb_) { f32x4 sv[16];
#pragma unroll
                for (int k = 0; k < 16; ++k) sv[k] = *(const GAS f32x4*)(sin_ + (2 * (16 * hb_ + k) + half) * 128 + n0);
#pragma unroll
                for (int k = 0; k < 16; ++k) { const int p = 2 * (16 * hb_ + k) + half; const float xv = sX[64 * hh + p], xdt = dtv * xv;
                    const f32x4 sn = sv[k] * dA + Bn * xdt; *(GAS f32x4*)(sout + p * 128 + n0) = sn;
                    float yv = (Cn[0] * sn[0] + Cn[1] * sn[1]) + (Cn[2] * sn[2] + Cn[3] * sn[3]);
                    yv = sum32(yv);
                    if (ln == 0) sY[64 * hh + p] = yv + Dh * xv; } }
            { const float yg = sY[64 * hh + lane] * bf2f(pr[PC_BZ + 64 * hh + lane]); if (!DRY) pr[PC_XS + 64 * hh + lane] = f2bf(yg);
              const float ssq = wave_sum(yg * yg);
#ifdef DBG_YG
              if (l == 1) { F.out[(size_t)i * DM + 64 * hh + lane] = yg; F.out[(size_t)(128 + i) * DM + 64 * hh + lane] = bf2f(pr[PC_BZ + 64 * hh + lane]); F.out[(size_t)(256 + i) * DM + 64 * hh + lane] = sY[64 * hh + lane]; F.out[(size_t)(384 + i) * DM + 64 * hh + lane] = ssq; }
#endif
              if (lane == 0) { F.SSDP()[row * 16 + 2 * hh] = ssq; F.SSDP()[row * 16 + 2 * hh + 1] = 0.f; } } }
        if (SAMPLE_MASK & 4) { const int hh = w, e = lane; const float vv = bf2f(pr[PC_CI + 64 * hh + e]);
            const GAS float* sin_ = F.in[I_SHG] + (((size_t)(l * MSM + i) * 8 + hh) * 64) * 64 + e; GAS float* sout = F.out + O_HSS + (((size_t)(l * MSM + i) * 8 + hh) * 64) * 64 + e;
            float o = 0.f;
#pragma unroll
            for (int hb_ = 0; hb_ < 2; ++hb_) { float sv[32];
#pragma unroll
                for (int k = 0; k < 32; ++k) sv[k] = sin_[(32 * hb_ + k) * 64];
#pragma unroll
                for (int k = 0; k < 32; ++k) { const int dd = 32 * hb_ + k; const float sn = sFd[64 * hh + dd] * sv[k] + sK[64 * hh + dd] * vv; sout[dd * 64] = sn; o += sQ[64 * hh + dd] * sn; } }
            const float ss = wave_sum(o * o); const float rs = __builtin_amdgcn_rsqf(ss * (1.f / 64.f) + EPS);
            if (!DRY) pr[PC_CQ + 64 * hh + e] = f2bf(o * rs * F.in[I_HNORM][l * 64 + e] * bf2f(pr[PC_CG + 64 * hh + e])); }
        WG_BARRIER();
    }
}
__device__ __forceinline__ void p2b_phase(Frame& F, int l) {
    constexpr int N_SSD = 128, N_HG = 64, N_SMP = 0, N_RGA = 64;
#pragma nounroll
    for (int rid = F.bx; rid < 256; rid += F.G) {
#define RFRESH() do { int z_ = 0; asm volatile("" : "+v"(z_)); F.lane = __builtin_amdgcn_mbcnt_hi(~0u, __builtin_amdgcn_mbcnt_lo(~0u, z_)); F.tid = F.wave * 64 + F.lane; } while (0)
        const int kind = rid < N_SSD ? 0 : (rid < N_SSD + N_HG ? 1 : (rid < N_SSD + N_HG + N_SMP ? 2 : 3));
        switch (kind) {
        case 0: RFRESH(); ssd_role2(F, l, rid);
#ifdef DBG_REPEAT_SSD
            ssd_role2(F, l, rid);
#endif
            break;
        case 1:
#ifdef DBG_REPEAT_HG
            hgrn_role<true>(F, l, rid - N_SSD);
#endif
            RFRESH(); hgrn_role<false>(F, l, rid - N_SSD); break;
        case 2: break;
        default: RFRESH(); rg_apply_role(F, l, rid - N_SSD - N_HG - N_SMP, N_RGA);
            __syncthreads();
            if (l == 1) { RFRESH();
                pg8::Gemm g{F.PB(), w_pj_t(F.ws, l), PLE, PLE}; pg8::StaticOrder S; S.init(MPR, DM, N_RGA, rid - N_SSD - N_HG - N_SMP); EpiPP E{(GAS bf16*)F.out}; pg8::gemm_phase<EpiPP, true>(F.lds, F.tid, g, S, E);
                asm volatile("s_waitcnt vmcnt(0)" ::: "memory"); __syncthreads(); }
            if (l == 0) { RFRESH(); for (int it = (rid - N_SSD - N_HG - N_SMP) * 8 + F.wave; it < NL * WI_PER_L - WI_IN; it += N_RGA * 8) wconv_item(F, (LAS float*)(F.lds + F.wave * 16640), WI_IN + it); }
#ifdef DBG_REPEAT_RG
            rg_apply_role(F, l, rid - N_SSD - N_HG - N_SMP, N_RGA);
#endif
            break;
        }
    }
}


template <int KC> __device__ __forceinline__ f32x4 sgemm_tile(Frame& F, const GAS bf16* A, int lda, const GAS bf16* Bt, int ldb, int kbeg, int klen, int rb, int cg) {
    const int lane = F.lane, w = F.wave, tid = F.tid, r = lane & 31, hf = lane >> 5;
    const int nch = klen / KC; constexpr int SK = KC + 8;
    LAS bf16* sA = (LAS bf16*)F.lds; LAS bf16* sB = sA + 32 * 520;
    constexpr int ppr = KC >> 3, NPC = (96 * ppr) / 512;
    u32x4 st[NPC];
#define SG_LOAD(CH) do { _Pragma("unroll") for (int i = 0; i < NPC; ++i) { const int p = tid + 512 * i; { const int row = p / ppr, pc = p % ppr; \
            const GAS bf16* src = (row < 32) ? A + (size_t)(MPR + 32 * rb + row) * lda : Bt + (size_t)(64 * cg + row - 32) * ldb; st[i] = *(const GAS u32x4*)(src + kbeg + (CH) * KC + 8 * pc); } } } while (0)
    SG_LOAD(0);
    f32x16 a0, a1;
#pragma unroll
    for (int q = 0; q < 16; ++q) { a0[q] = 0.f; a1[q] = 0.f; }
    constexpr int kw = KC >> 3;
#pragma nounroll
    for (int ch = 0; ch < nch; ++ch) {
#pragma unroll
        for (int i = 0; i < NPC; ++i) { const int p = tid + 512 * i; { const int row = p / ppr, pc = p % ppr; *(LAS u32x4*)((row < 32 ? sA + row * SK : sB + (row - 32) * SK) + 8 * pc) = st[i]; } }
        WG_BARRIER();
        if (ch + 1 < nch) SG_LOAD(ch + 1);
        for (int k = 0; k < kw; k += 16) { const bf16x8 af = *(const LAS bf16x8*)(sA + r * SK + w * kw + k + 8 * hf), b0 = *(const LAS bf16x8*)(sB + r * SK + w * kw + k + 8 * hf), b1 = *(const LAS bf16x8*)(sB + (32 + r) * SK + w * kw + k + 8 * hf);
            a0 = mfma32(af, b0, a0); a1 = mfma32(af, b1, a1); }
        WG_BARRIER();
    }
#undef SG_LOAD
    LAS float* part = (LAS float*)F.lds + w * 2048;
#pragma unroll
    for (int q = 0; q < 16; ++q) { const int row = rowoff(q, hf); part[row * 64 + r] = a0[q]; part[row * 64 + 32 + r] = a1[q]; }
    WG_BARRIER();
    const LAS float* pr_ = (const LAS float*)F.lds + (F.tid >> 4) * 64 + 4 * (F.tid & 15);
    f32x4 v = *(const LAS f32x4*)pr_;
#pragma unroll
    for (int q = 1; q < 8; ++q) v = v + *(const LAS f32x4*)(pr_ + q * 2048);
    WG_BARRIER();
    return v;
}
__device__ __forceinline__ float sum16(float v) { return sum16r(v); }
__device__ __forceinline__ f32x4 load_bf4(const GAS bf16* p) { const u32x2 w = *(const GAS u32x2*)p; f32x4 v; v[0] = bflo(w.x); v[1] = bfhi(w.x); v[2] = bflo(w.y); v[3] = bfhi(w.y); return v; }
__device__ __forceinline__ void store_bf4_sc1(GAS bf16* p, f32x4 v) { st_sc1_2(p, pk2(v[0], v[1]), pk2(v[2], v[3])); }
__device__ __forceinline__ void store_bf4(GAS bf16* p, f32x4 v) { u32x2 w; w.x = pk2(v[0], v[1]); w.y = pk2(v[2], v[3]); *(GAS u32x2*)p = w; }
template <int MODE> __device__ __forceinline__ f32x4 act4(f32x4 v, f32x4 lb) { return (f32x4){act1<MODE>(v[0], lb[0]), act1<MODE>(v[1], lb[1]), act1<MODE>(v[2], lb[2]), act1<MODE>(v[3], lb[3])}; }
__device__ __forceinline__ void sample_p1(Frame& F, int l, int u0) {
    for (int u = u0; u < 4 * (NPJP / 64); u += (F.G != 256 ? F.G : 128)) { const int rb = u & 3, cg = u >> 2;
        if (64 * cg >= NPJ + 64) continue;
        const f32x4 v = sgemm_tile<256>(F, F.HB(), DM, w_in_t(F.ws, l), DM, 0, DM, rb, cg);
        const int row = MPR + 32 * rb + (F.tid >> 4), col = 64 * cg + 4 * (F.tid & 15); const float rs = rstd16(F.SSQ_MIX(), row); const f32x4 x = v * rs;
        if (col >= NPJ) { if (col < NPJ + 8) *(GAS f32x4*)(F.DT() + (size_t)row * 8 + (col - NPJ)) = x; continue; }
        const int pn = col >> 8; f32x4 o;
        if (pn == 4 || pn == 5 || pn == 9 || pn == 10 || pn == 15 || pn == 16) o = act4<1>(x, x);
        else if (pn == 7 || pn == 8) o = act4<2>(x, x);
        else if (pn == 11 || pn == 12) o = act4<3>(x, *(const GAS f32x4*)(F.LBS() + l * 512 + (col - PC_CF)));
        else o = x;
        store_bf4(F.BIG() + (size_t)row * NPJ + col, o); }
}
__device__ __forceinline__ void sample_p3(Frame& F, int l, int u0) {
    for (int u = u0; u < 4 * (DM / 64); u += F.G) { const int rb = u & 3, cg = u >> 2;
        const f32x4 vb = sgemm_tile<256>(F, F.BIG(), NPJ, w_out_t(F.ws, l), DMIX, 0, 512, rb, cg);
        const f32x4 va = sgemm_tile<256>(F, F.BIG(), NPJ, w_out_t(F.ws, l), DMIX, 512, 1024, rb, cg);
        const int row = MPR + 32 * rb + (F.tid >> 4), col = 64 * cg + 4 * (F.tid & 15);
        const GAS f32x4* p = (const GAS f32x4*)(F.SSDP() + (size_t)row * 16); const f32x4 a = p[0], b = p[1], c = p[2], d = p[3];
        const float sb = ((a[0] + a[1]) + (a[2] + a[3])) + ((b[0] + b[1]) + (b[2] + b[3])) + ((c[0] + c[1]) + (c[2] + c[3])) + ((d[0] + d[1]) + (d[2] + d[3]));
        const float rsb = __builtin_amdgcn_rsqf(sb * (1.f / 512.f) + EPS);
        const f32x4 h = load_bf4(F.HB() + (size_t)row * DM + col) + vb * rsb + va;
        store_bf4_sc1(F.HB() + (size_t)row * DM + col, h);
        const float ss = sum16((h[0] * h[0] + h[1] * h[1]) + (h[2] * h[2] + h[3] * h[3]));
        if ((F.tid & 15) == 0) st_sc1(F.SSQ_FFN() + (size_t)row * 16 + cg, ss); }
}
__device__ __forceinline__ void sample_p4(Frame& F, int l, int u0, int ustride) {
#pragma nounroll
    for (int u = u0; u < 4 * (DFF / 64); u += ustride) { const int rb = u & 3, cg = u >> 2;
        const f32x4 v = sgemm_tile<256>(F, F.HB(), DM, w_up_t(F.ws, l), DM, 0, DM, rb, cg);
        const int row = MPR + 32 * rb + (F.tid >> 4), col = 64 * cg + 4 * (F.tid & 15); const float rs = rstd16(F.SSQ_FFN(), row);
        f32x4 x = v * rs;
#pragma unroll
        for (int i = 0; i < 4; ++i) { const float t_ = fmaxf(x[i], 0.f); x[i] = t_ * t_; }
        store_bf4_sc1(F.BIG() + (size_t)row * NPJ + col, x); }
}
__device__ __forceinline__ void sample_p5(Frame& F, int l, int u0) {
    for (int u = u0; u < 4 * (DM / 64); u += F.G) { const int rb = u & 3, cg = u >> 2;
#ifdef DBG_TAIL2
        (void)sgemm_tile<256>(F, F.BIG(), DFF, w_dn_t(F.ws, l), DFF, 0, DFF, rb, cg);
#endif
        const f32x4 v = sgemm_tile<256>(F, F.BIG(), NPJ, w_dn_t(F.ws, l), DFF, 0, DFF, rb, cg);
        const int row = MPR + 32 * rb + (F.tid >> 4), col = 64 * cg + 4 * (F.tid & 15);
        const f32x4 h = load_bf4(F.HB() + (size_t)row * DM + col) + v;
        store_bf4_sc1(F.HB2() + (size_t)row * DM + col, h);
        const float ss = sum16((h[0] * h[0] + h[1] * h[1]) + (h[2] * h[2] + h[3] * h[3]));
        if ((F.tid & 15) == 0) st_sc1(F.SSQ_PLE() + (size_t)row * 16 + cg, ss); }
}
__device__ __forceinline__ void sample_p6(Frame& F, int l, int u0) {
    for (int u = u0; u < 4 * (DM / 64); u += F.G) { const int rb = u & 3, cg = u >> 2;
        const f32x4 pp = sgemm_tile<256>(F, F.PB(), PLE, w_pj_t(F.ws, l), PLE, 0, PLE, rb, cg);
        const f32x4 g = sgemm_tile<256>(F, F.HB2(), DM, w_g_t(F.ws, l), DM, 0, DM, rb, cg);
        const int row = MPR + 32 * rb + (F.tid >> 4), col = 64 * cg + 4 * (F.tid & 15); const float rs = rstd16(F.SSQ_PLE(), row);
        f32x4 h = load_bf4(F.HB2() + (size_t)row * DM + col);
#pragma unroll
        for (int i = 0; i < 4; ++i) h[i] += fsigmoid(g[i] * rs) * pp[i];
        store_bf4_sc1(F.HB() + (size_t)row * DM + col, h);
        const float ss = sum16((h[0] * h[0] + h[1] * h[1]) + (h[2] * h[2] + h[3] * h[3]));
        if ((F.tid & 15) == 0) st_sc1(F.SSQ_MIX() + (size_t)row * 16 + cg, ss); }
}

__device__ __forceinline__ void final_row(Frame& F, int m) {
    const float rs = rstd16(F.SSQ_MIX(), m); GAS f32x4* yr = (GAS f32x4*)(F.out + (size_t)m * DM); const GAS u32x4* hr = (const GAS u32x4*)(F.HB() + (size_t)m * DM);
#pragma unroll
    for (int j = 0; j < 2; ++j) { const u32x4 w = hr[F.lane + 64 * j]; const f32x4 g0 = ((const GAS f32x4*)F.in[I_NFIN])[2 * (F.lane + 64 * j)], g1 = ((const GAS f32x4*)F.in[I_NFIN])[2 * (F.lane + 64 * j) + 1];
        f32x4 a, b; a[0] = bflo(w.x); a[1] = bfhi(w.x); a[2] = bflo(w.y); a[3] = bfhi(w.y); b[0] = bflo(w.z); b[1] = bfhi(w.z); b[2] = bflo(w.w); b[3] = bfhi(w.w);
        yr[2 * (F.lane + 64 * j)] = a * rs * g0; yr[2 * (F.lane + 64 * j) + 1] = b * rs * g1; }
}
__device__ __forceinline__ void final_phase(Frame& F) {
    int m0 = F.bx * 8 + F.wave, m1 = MREAL, ms = F.G * 8;
    if (F.gsy()) {
        if (F.bx < 16) { wg_wait(F.smp(1, 3), 64u, F.tid, F.ctl() + CW_BAR); final_row(F, MPR + F.bx * 8 + F.wave); }
        m0 = (8 * (F.bx & 7) + ((F.bx >> 3) & 7)) * 256 + (F.bx >> 6) * 64 + F.wave * 8; m1 = m0 + 8; ms = 1; }
#pragma nounroll
    for (int m = m0; m < m1; m += ms) final_row(F, m);
}

struct Args { const float* in[N_IN]; float* out; unsigned char* ws; int ph_lo, ph_hi, li, pad; };
constexpr int N_PHASES = 16;
#ifdef DBG_OUTMASK
#define DBG_EXTRA_PH 1
#else
#define DBG_EXTRA_PH 0
#endif

__global__ void __launch_bounds__(512, 2) fwd_kernel(Args args) {
    extern __shared__ __attribute__((aligned(16))) unsigned char lds_raw[];
    volatile LAS unsigned* MISC = (volatile LAS unsigned*)((LAS unsigned char*)lds_raw + LDSCTL_OFF);
    for (int u = threadIdx.x; u < (LDS_BYTES - LDSCTL_OFF) / 4; u += 512) MISC[u] = 0u;
    __syncthreads();
    if (threadIdx.x < N_IN) ((LAS unsigned long long*)((LAS unsigned char*)lds_raw + LDSCTL_OFF + 256))[threadIdx.x] = (unsigned long long)args.in[threadIdx.x];
    __syncthreads();
    XcdBarrier bar; bar.bar = (GAS unsigned*)(args.ws + WS_CTL) + CW_BAR; bar.x = 0; bar.st = nullptr;
    if (MK_N_LAUNCHES == 1) bar = xcd_barrier_post((GAS unsigned*)(args.ws + WS_CTL) + CW_BAR, MISC + 8);
    if (threadIdx.x == 0) __hip_atomic_store((GAS unsigned*)(args.ws + WS_CTL) + CW_XID + blockIdx.x, xb_xcc_id() + 1u, __ATOMIC_RELAXED, __HIP_MEMORY_SCOPE_AGENT);
    const int lo = args.ph_lo, hi = args.ph_hi;
#ifndef PHASE_MASK
#define PHASE_MASK 0xFFFFu
#endif
    const int wave0 = __builtin_amdgcn_readfirstlane(threadIdx.x >> 6);
#pragma nounroll
    for (int ph = lo; ph < hi; ++ph) {
#ifdef DBG_XBAR
        if (ph == 1) for (int xb_ = 0; xb_ < DBG_XBAR; ++xb_) { XcdBarrier b5 = bar; int w5_ = wave0, z5_ = 0; asm volatile("" : "+s"(b5.bar), "+s"(b5.x), "+s"(w5_), "+v"(z5_)); xcd_barrier(b5, w5_ * 64 + (int)__builtin_amdgcn_mbcnt_hi(~0u, __builtin_amdgcn_mbcnt_lo(~0u, z5_))); }
#endif
        if (ph > lo) { XcdBarrier b2 = bar; int w_ = wave0, z_ = 0, gq_ = gridDim.x, bq_ = blockIdx.x; asm volatile("" : "+s"(b2.bar), "+s"(b2.x), "+s"(w_), "+v"(z_), "+s"(gq_), "+s"(bq_));
            const int t_ = w_ * 64 + (int)__builtin_amdgcn_mbcnt_hi(~0u, __builtin_amdgcn_mbcnt_lo(~0u, z_));
            if (gq_ == 256 && MK_N_LAUNCHES == 1 && (ph == 15 || ph == 8 || (ph - 1) % 7 >= 4)) wg_wait(b2.bar - CW_BAR + CW_GRP + (ph * 64 + (bq_ & 63)) * 16, 4u, t_, b2.bar);
            else xcd_barrier(b2, t_); }
#ifdef DBG_STAMP
        if (blockIdx.x == 0 && wave0 == 0) { int zs_ = 0; asm volatile("" : "+v"(zs_)); if (__builtin_amdgcn_mbcnt_hi(~0u, __builtin_amdgcn_mbcnt_lo(~0u, zs_)) == 0) ((volatile LAS unsigned*)((LAS unsigned char*)lds_raw + LDSCTL_OFF))[140 + ph] = (unsigned)__builtin_amdgcn_s_memrealtime(); }
#endif
        Frame F;
        F.lds = (LAS unsigned char*)lds_raw;
        int wv_ = wave0, g_ = gridDim.x, b_ = blockIdx.x; GAS unsigned char* ws = (GAS unsigned char*)args.ws;
        asm volatile("" : "+s"(wv_), "+s"(g_), "+s"(b_), "+s"(ws));
        F.wave = wv_; F.G = g_; F.bx = b_;
#define FRESH() do { int z_ = 0; asm volatile("" : "+v"(z_)); F.lane = __builtin_amdgcn_mbcnt_hi(~0u, __builtin_amdgcn_mbcnt_lo(~0u, z_)); F.tid = F.wave * 64 + F.lane; } while (0)
        GAS float* out_ = (GAS float*)args.out; asm volatile("" : "+s"(out_));
        F.intab = (const LAS unsigned long long*)((LAS unsigned char*)lds_raw + LDSCTL_OFF + 256); F.in.t = F.intab; F.out = out_; F.ws = ws;
#ifdef DBG_OUTMASK
        if (ph == 16) {
            const size_t offs[13] = {0, (size_t)MPR * DM, O_RCP, O_RHP, O_SCP, O_SSP, O_HSP, O_RCS, O_RHS, O_SCS, O_SSS, O_HSS, O_END};
            int z2_ = 0; asm volatile("" : "+v"(z2_)); const int ln_ = __builtin_amdgcn_mbcnt_hi(~0u, __builtin_amdgcn_mbcnt_lo(~0u, z2_));
            for (int o_ = 0; o_ < 12; ++o_) { const float sc_ = ((DBG_OUTMASK >> o_) & 1) ? DBG_OUTSCALE : 0.f;
                for (size_t e = offs[o_] + (size_t)F.bx * 512 + F.wave * 64 + ln_; e < offs[o_ + 1]; e += (size_t)F.G * 512) F.out[e] = F.out[e] * sc_; }
            continue; }
#endif
        const int l = (ph - 1) / 7; const int k = (ph == 0) ? 0 : (ph == 15 ? 8 : 1 + (ph - 1) % 7);
        if (!((PHASE_MASK >> k) & 1u)) continue;
#ifdef DBG_CUT
        if (ph > DBG_CUT && ph != 15) continue;
#endif
#ifdef DBG_CUT2
        if (ph > DBG_CUT2) continue;
#endif
#ifdef DBG_REPEAT_K
        for (int rep_ = 0; rep_ < ((k == DBG_REPEAT_K) ? 2 : 1); ++rep_) {
        if (rep_) { XcdBarrier b4 = bar; int w4_ = wave0, z4_ = 0; asm volatile("" : "+s"(b4.bar), "+s"(b4.x), "+s"(w4_), "+v"(z4_)); xcd_barrier(b4, w4_ * 64 + (int)__builtin_amdgcn_mbcnt_hi(~0u, __builtin_amdgcn_mbcnt_lo(~0u, z4_))); }
#endif
        switch (k) {
        case 0: FRESH(); p0_prologue(F);
#ifdef DBG_CUT
            { const int sizes[N_IN] = {16777216,131072,393216,131072,589824,16777216,8388608,8388608,65536,2048,8929280,4096,1024,65536,1024,65536,1024,1024,6144,1536,16,16,16,1024,1024,128,3145728,2048,8388608,8388608,2048,2097152,524288,1024};
              for (int t = F.bx; t < N_IN * 4; t += F.G) { const int ti = t >> 2, part = t & 3; const int n = sizes[ti]; const int q0 = (int)((long)n * part / 4), q1 = (int)((long)n * (part + 1) / 4);
                  const GAS float* p = F.in[ti]; float sacc = 0.f; for (int e = q0 + F.tid; e < q1; e += 512) sacc += fabsf(p[e]);
                  sacc = wave_sum(sacc); if (F.lane == 0) __hip_atomic_fetch_add((GAS float*)(F.ws + 65536) + t, sacc, __ATOMIC_RELAXED, __HIP_MEMORY_SCOPE_AGENT); } }
#endif
            break;
        case 1: {
            FRESH();
            pg8::Gemm g{F.HB(), w_in_t(ws, l), DM, DM}; pg8::StaticOrder S; S.init(MPR, NPJP, F.G, F.bx);
            EpiProj E{F.BIG(), F.DT(), F.SSQ_MIX(), F.LBS() + l * 512};
            pg8::gemm_phase<EpiProj, true>(F.lds, F.tid, g, S, E); FRESH();
            if (F.bx >= 128 || F.G != 256) { if (l == 1 && F.gsy()) wg_wait(F.smp(0, 3), 64u, F.tid, F.ctl() + CW_BAR); sample_p1(F, l, F.G != 256 ? F.bx : F.bx - 128); } } break;
        case 2: FRESH(); p2a_phase(F, l); break;
        case 3: FRESH(); p2b_phase(F, l); break;
        case 4: {
            FRESH();
#ifdef DBG_DRY3
            { pg8::Gemm g{F.BIG(), w_out_t(ws, l), NPJ, DMIX}; pg8::StaticOrder S; S.init(MPR, DM, F.G, F.bx); EpiPP E{F.PPB()}; pg8::gemm_phase<EpiPP, true>(F.lds, F.tid, g, S, E); asm volatile("s_waitcnt vmcnt(0)" ::: "memory"); __syncthreads(); FRESH(); }
#endif
#ifdef DBG_SELF
            if (l == 1) {
                for (int rep = 0; rep < 2; ++rep) {
                    FRESH();
                    pg8::Gemm g{F.BIG(), w_out_t(ws, l), NPJ, DMIX}; pg8::StaticOrder S; S.init(8192, DM, F.G, F.bx);
                    EpiDbg E{F.out, (GAS float*)(F.ws + WS_RT) + (size_t)rep * 8192 * DM + (rep ? 131072 : 0), F.SSDP()};
                    pg8::gemm_phase<EpiDbg, true>(F.lds, F.tid, g, S, E);
                    asm volatile("s_waitcnt vmcnt(0)" ::: "memory"); __syncthreads();
                }
                break; }
#endif
#ifdef DBG_RD
            if (l == 1) { if (F.bx < 4) { for (int e = F.tid; e < 128 * 1536; e += 512) { const int r_ = e / 1536, c_ = e % 1536;
                    F.out[(size_t)(F.bx * 256 + 2 * r_ + (c_ >> 10)) * DM + (c_ & 1023)] = bf2f(F.BIG()[(size_t)(MPR + r_) * NPJ + c_]); }
                  for (int e = F.tid; e < 128 * 16; e += 512) F.out[(size_t)(1024 + F.bx * 2) * DM + e] = F.SSDP()[(size_t)MPR * 16 + e]; }
                break; }
#endif
            pg8::Gemm g{F.BIG(), w_out_t(ws, l), NPJ, DMIX}; pg8::StaticOrder S; S.init(MPR, DM, F.G, F.bx);
            EpiRes<true> E{F.HB(), F.HB(), F.SSQ_FFN(), F.SSDP()};
            pg8::gemm_phase<EpiRes<true>, true>(F.lds, F.tid, g, S, E); FRESH();
            if (!F.gsy()) sample_p3(F, l, F.G - 1 - F.bx);
            else { wg_arrive(F.grp(ph + 1), 1u, F.tid, F.xid()); const int g_ = F.bx & 63; if (g_ >= 16 && g_ < 32) { sample_p3(F, l, 4 * (g_ - 16) + (F.bx >> 6)); wg_arrive(F.smp(l, 0), 1u, F.tid, nullptr); }   } } break;
        case 5: {
            FRESH();
            pg8::Gemm g{F.HB(), w_up_t(ws, l), DM, DM}; pg8::StaticOrder S; S.init(MPR, DFF, F.G, F.bx);
            EpiUp E{F.BIG(), F.SSQ_FFN()};
            pg8::gemm_phase<EpiUp, true>(F.lds, F.tid, g, S, E); FRESH();
            if (!F.gsy()) sample_p4(F, l, F.G - 1 - F.bx, F.G);
            else { wg_arrive(F.grp(ph + 1), 1u, F.tid, F.xid()); const int g_ = F.bx & 63;
                if (g_ >= 32) { wg_wait(F.smp(l, 0), 64u, F.tid, F.ctl() + CW_BAR); sample_p4(F, l, 4 * (g_ - 32) + (F.bx >> 6), 128); wg_arrive(F.smp(l, 1), 2u, F.tid, nullptr); } } } break;
        case 6: {
            FRESH();
#ifdef DBG_DRY5
            { pg8::Gemm g{F.BIG(), w_dn_t(ws, l), DFF, DFF}; pg8::StaticOrder S; S.init(MPR, DM, F.G, F.bx); EpiPP E{F.PPB()}; pg8::gemm_phase<EpiPP, true>(F.lds, F.tid, g, S, E); asm volatile("s_waitcnt vmcnt(0)" ::: "memory"); __syncthreads(); FRESH(); }
#endif
            pg8::Gemm g{F.BIG(), w_dn_t(ws, l), NPJ, DFF}; pg8::StaticOrder S; S.init(MPR, DM, F.G, F.bx);
            EpiRes<false> E{F.HB(), F.HB2(), F.SSQ_PLE(), nullptr};
            pg8::gemm_phase<EpiRes<false>, true>(F.lds, F.tid, g, S, E); FRESH();
            if (!F.gsy()) sample_p5(F, l, F.G - 1 - F.bx);
            else { wg_arrive(F.grp(ph + 1), 1u, F.tid, F.xid()); const int g_ = F.bx & 63; if (g_ < 16) { wg_wait(F.smp(l, 1), 256u, F.tid, F.ctl() + CW_BAR); sample_p5(F, l, 4 * g_ + (F.bx >> 6)); wg_arrive(F.smp(l, 2), 1u, F.tid, nullptr); } } } break;
        case 7: {
            FRESH();
            if (l == 0) { pg8::Gemm g{F.PB(), w_pj_t(ws, l), PLE, PLE}; pg8::StaticOrder S; S.init(MPR, DM, F.G, F.bx); EpiPP E{(GAS bf16*)F.out}; pg8::gemm_phase<EpiPP, true>(F.lds, F.tid, g, S, E);
                asm volatile("s_waitcnt vmcnt(0)" ::: "memory"); __syncthreads(); }
            FRESH();
            { pg8::Gemm g{F.HB2(), w_g_t(ws, l), DM, DM}; pg8::StaticOrder S; S.init(MPR, DM, F.G, F.bx); EpiGate E{F.HB2(), F.HB(), (const GAS bf16*)F.out, F.SSQ_PLE(), F.SSQ_MIX()}; pg8::gemm_phase<EpiGate, true>(F.lds, F.tid, g, S, E); } FRESH();
            if (!F.gsy()) sample_p6(F, l, F.G - 1 - F.bx);
            else { wg_arrive(F.grp(l == 0 ? 8 : 15), 1u, F.tid, F.xid()); const int g_ = F.bx & 63; if (g_ >= 16 && g_ < 32) { wg_wait(F.smp(l, 2), 64u, F.tid, F.ctl() + CW_BAR); sample_p6(F, l, 4 * (g_ - 16) + (F.bx >> 6)); wg_arrive(F.smp(l, 3), 1u, F.tid, nullptr); } } } break;
        default: FRESH();
#ifdef DBG_SELF
            { const GAS float* t1 = (const GAS float*)(F.ws + WS_RT); const GAS float* t2 = t1 + (size_t)8192 * DM + 131072; unsigned cnt = 0;
              for (size_t e = (size_t)F.bx * 512 + F.tid; e < (size_t)8192 * DM; e += (size_t)F.G * 512) cnt += (t1[e] != t2[e]) ? 1u : 0u;
              cnt = (unsigned)wave_sum((float)cnt);
              if (F.lane == 0) F.out[(size_t)(F.bx * 8 + F.wave) * DM] = 1000.f * (float)cnt; }
            break;
#endif
#ifdef DBG_CK
            { GAS float* yo = F.out + (size_t)MPR * DM;
              const int gw = F.bx * 8 + F.wave, NGW = F.G * 8;
              for (int it = gw; it < 128 * (24 + 16 + 1); it += NGW) { const int blk = it % 128, g = it / 128; float sacc = 0.f;
#ifdef DBG_CK2
                  if (g < 12) { for (int e = F.lane; e < 128 * 64; e += 64) sacc += fabsf(bf2f(F.XA()[(size_t)(blk * 128 + (e >> 6)) * 768 + g * 64 + (e & 63)])); }
                  else if (g < 20) { for (int e = F.lane; e < 128 * 64; e += 64) sacc += fabsf(bf2f(F.BIG()[(size_t)(blk * 128 + (e >> 6)) * NPJ + PC_BZ + (g - 12) * 64 + (e & 63)])); }
                  else if (g < 21) { for (int e = F.lane; e < 128 * 8; e += 64) sacc += fabsf(F.DT()[(size_t)blk * 128 * 8 + e]); }
                  else if (g < 24) { }
#else
                  if (g < 24) { for (int e = F.lane; e < 128 * 64; e += 64) sacc += fabsf(bf2f(F.BIG()[(size_t)(blk * 128 + (e >> 6)) * NPJ + g * 64 + (e & 63)])); }
#endif
                  else if (g < 40) { for (int e = F.lane; e < 128 * 64; e += 64) sacc += fabsf(F.out[(size_t)(blk * 128 + (e >> 6)) * DM + (g - 24) * 64 + (e & 63)]); }
                  else { for (int e = F.lane; e < 128 * 16; e += 64) sacc += fabsf(F.SSDP()[(size_t)blk * 128 * 16 + e]); }
                  sacc = wave_sum(sacc); if (F.lane == 0) yo[it] = (g >= DBG_CK_LO && g < DBG_CK_HI) ? sacc : 0.f; } }
            break;
#endif
#ifdef DBG_COPY
            for (int e = F.bx * 512 + F.tid; e < 128 * DM; e += F.G * 512) F.out[(size_t)MPR * DM + e] = F.out[(size_t)DBG_COPY * DM + e];
            break;
#endif
#ifdef DBG_CUT
            { const int gw = F.bx * 8 + F.wave, NGW = F.G * 8;
              for (int m = gw; m < MREAL; m += NGW) { float s0 = 0.f, s1 = 0.f, s2 = 0.f;
                  const GAS bf16* b = F.BIG() + (size_t)m * NPJ; for (int c = F.lane; c < NPJ; c += 64) s0 += fabsf(bf2f(b[c]));
                  const GAS bf16* hb = F.HB() + (size_t)m * DM; for (int c = F.lane; c < DM; c += 64) s1 += fabsf(bf2f(hb[c]));
                  const GAS bf16* h2 = F.HB2() + (size_t)m * DM; for (int c = F.lane; c < DM; c += 64) s2 += fabsf(bf2f(h2[c]));
                  s0 = wave_sum(s0); s1 = wave_sum(s1); s2 = wave_sum(s2);
                  float s3 = 0.f, s4 = 0.f; if (m < 1024) { const GAS float* si = F.in[I_SSS] + ((size_t)(1024 + m)) * 8192; for (int c = F.lane; c < 8192; c += 64) s3 += fabsf(si[c]);
                      const GAS float* s0i = F.in[I_SSS] + ((size_t)m) * 8192; for (int c = F.lane; c < 8192; c += 64) s4 += fabsf(s0i[c]); }
                  s3 = wave_sum(s3); s4 = wave_sum(s4);
                  if (F.lane == 0) { GAS float* o = F.out + (size_t)m * DM; o[8] = s3; o[9] = s4; if (m < N_IN * 4) o[10] = ((GAS float*)(F.ws + 65536))[m]; o[0] = s0; o[1] = s1; o[2] = s2; o[3] = F.DT()[(size_t)m * 8 + 3]; o[4] = F.SSQ_MIX()[(size_t)m * 16 + 5]; o[5] = F.SSQ_FFN()[(size_t)m * 16 + 5]; o[6] = F.SSQ_PLE()[(size_t)m * 16 + 5]; o[7] = F.SSDP()[(size_t)m * 16 + 5]; } } }
#else
#ifndef DBG_NOFINAL
            final_phase(F);
#endif
#ifdef DBG_SANOUT
            asm volatile("s_waitcnt vmcnt(0)" ::: "memory"); { XcdBarrier b3 = bar; xcd_barrier(b3, F.tid); }
            for (size_t e = (size_t)F.bx * 512 + F.tid; e < O_END; e += (size_t)F.G * 512) { const float v = F.out[e]; if (!(fabsf(v) < 1e30f)) F.out[e] = 12345.f; }
#endif
#endif
            break;
        }
#ifdef DBG_REPEAT_K
        }
#endif
    }
#ifdef DBG_STAMP
    if (blockIdx.x == 0 && wave0 == 0 && __builtin_amdgcn_mbcnt_hi(~0u, __builtin_amdgcn_mbcnt_lo(~0u, 0)) == 0) { asm volatile("s_waitcnt vmcnt(0)" ::: "memory"); const unsigned te = (unsigned)__builtin_amdgcn_s_memrealtime();
        volatile LAS unsigned* M2 = (volatile LAS unsigned*)((LAS unsigned char*)lds_raw + LDSCTL_OFF); const unsigned t0 = M2[140 + DBG_STAMP], t1 = (DBG_STAMP == 15) ? te : M2[141 + DBG_STAMP];
        ((GAS float*)args.out)[0] = -0.01f * (float)(t1 - t0); }
#endif
}

extern "C" void kernel_launch(void* const* d_in, const int* in_sizes, int n_in, void* d_out, int out_size, void* d_ws, size_t ws_size, hipStream_t stream) {
    static int grid = 0;
    if (grid == 0) {
        if (n_in != N_IN || (size_t)out_size != O_END || ws_size < WS_END) { fprintf(stderr, "kernel_launch: unexpected shapes: n_in %d out %d ws %zu (need %zu)\n", n_in, out_size, ws_size, (size_t)WS_END); grid = -1; return; }
        int dev = 0, cus = 0, per_cu = 0;
        if (hipGetDevice(&dev) != hipSuccess || hipDeviceGetAttribute(&cus, hipDeviceAttributeMultiprocessorCount, dev) != hipSuccess) { grid = -1; return; }
        if (hipFuncSetAttribute((const void*)fwd_kernel, hipFuncAttributeMaxDynamicSharedMemorySize, LDS_BYTES) != hipSuccess) { fprintf(stderr, "kernel_launch: hipFuncSetAttribute failed\n"); grid = -1; return; }
        if (hipOccupancyMaxActiveBlocksPerMultiprocessor(&per_cu, (const void*)fwd_kernel, 512, LDS_BYTES) != hipSuccess || per_cu < 1) { fprintf(stderr, "kernel_launch: occupancy query says %d blocks per CU\n", per_cu); (void)hipGetLastError(); grid = -1; return; }
        grid = cus;
        if (grid > 256) grid = 256;
    }
    if (grid < 0) return;
    if (hipMemsetAsync((char*)d_ws + WS_CTL, 0, CTL_ZERO_BYTES, stream) != hipSuccess) return;
#ifdef DBG_FILLOUT
    (void)hipMemsetAsync(d_out, 0, (size_t)O_END * 4, stream);
#endif
#ifdef DBG_FILL
    (void)hipMemsetAsync((char*)d_ws + CTL_ZERO_BYTES, DBG_FILL, WS_END - CTL_ZERO_BYTES, stream);
#endif
    Args a{};
    for (int i = 0; i < N_IN; ++i) a.in[i] = (const float*)d_in[i];
    a.out = (float*)d_out; a.ws = (unsigned char*)d_ws;
    if (MK_N_LAUNCHES == 1) { a.ph_lo = 0; a.ph_hi = N_PHASES; a.li = 0; hipLaunchKernelGGL(fwd_kernel, dim3(grid), dim3(512), LDS_BYTES, stream, a); }
    else for (int p = 0; p < N_PHASES + DBG_EXTRA_PH; ++p) { a.ph_lo = p; a.ph_hi = p + 1; a.li = p; hipLaunchKernelGGL(fwd_kernel, dim3(grid), dim3(512), LDS_BYTES, stream, a); }
}
```

```cpp
#include <hip/hip_runtime.h>
#include <cstdio>
#include <cstdint>

#define LAS __attribute__((address_space(3)))
#define GAS __attribute__((address_space(1)))
typedef unsigned short bf16;
typedef short bf16x8 __attribute__((ext_vector_type(8)));
typedef float f32x4 __attribute__((ext_vector_type(4)));
typedef float f32x16 __attribute__((ext_vector_type(16)));
typedef unsigned u32x4 __attribute__((ext_vector_type(4)));
typedef unsigned u32x2 __attribute__((ext_vector_type(2)));
typedef GAS unsigned gu32;

#ifndef MK_N_LAUNCHES
#define MK_N_LAUNCHES 1
#endif

constexpr int DM = 1024, NBATCH = 8, SEQ = 2048, MPR = NBATCH * SEQ, MSM = 128, MREAL = MPR + MSM, MP = 16640  ;
constexpr int NPJ = 4352, NPJP = 4608, DFF = 4096, PLE = 256, DMIX = 1536, NL = 2, DIN = 4360;
constexpr int PC_XS = 0, PC_AX = 512, PC_CQ = 1024, PC_B = 1536, PC_C = 1664, PC_AG = 1792, PC_BZ = 2304, PC_CF = 2816, PC_CI = 3328, PC_CG = 3840;
constexpr float EPS = 1e-6f;
enum { I_XP = 0, I_XS, I_SRC, I_SRH, I_SSC, I_SSS, I_SHG, I_PP, I_PS, I_NMIX, I_WIN, I_CAW, I_CAB, I_WA, I_BA, I_WX, I_BX, I_LAM, I_CBW, I_CBB, I_DTB, I_ALOG, I_SSD_D, I_SNORM,
       I_HLB, I_HNORM, I_WOUT, I_NFFN, I_WUP, I_WDN, I_NPLE, I_WG, I_WPJ, I_NFIN, N_IN };
constexpr size_t O_Y = 0, O_RCP = (size_t)MREAL * DM, O_RHP = O_RCP + 2 * 8 * 3 * 512, O_SCP = O_RHP + 2 * 8 * 512, O_SSP = O_SCP + 2 * 8 * 3 * 768, O_HSP = O_SSP + 2 * 8 * 8 * 64 * 128,
                 O_RCS = O_HSP + 2 * 8 * 8 * 64 * 64, O_RHS = O_RCS + 2 * 128 * 3 * 512, O_SCS = O_RHS + 2 * 128 * 512, O_SSS = O_SCS + 2 * 128 * 3 * 768, O_HSS = O_SSS + (size_t)2 * 128 * 8 * 64 * 128,
                 O_END = O_HSS + (size_t)2 * 128 * 8 * 64 * 64;
static_assert(O_END == 44830720, "output size");

constexpr size_t MiB = 1u << 20;
constexpr size_t WS_CTL = 0, CTL_ZERO_BYTES = 1 * MiB;
constexpr size_t WS_WIN = 1 * MiB, WS_WOUT = 19 * MiB, WS_WUP = 25 * MiB, WS_WDN = 41 * MiB, WS_WG = 57 * MiB, WS_WPJ = 61 * MiB, WS_WAT = 62 * MiB, WS_LBS = 62 * MiB + 512 * 1024;
constexpr size_t KiB64 = 65536;
constexpr size_t WS_PB = 63 * MiB, WS_HB = WS_PB + 132 * KiB64  , WS_BIG = WS_HB + 520 * KiB64  , WS_RT = WS_BIG + 2211 * KiB64  ;
constexpr size_t WS_LA = WS_RT, WS_BB = WS_RT + 16 * MiB, WS_XA = WS_RT + 32 * MiB, WS_PPB = WS_RT, WS_HB2 = WS_RT + 520 * KiB64, WS_TS = WS_RT + 56 * MiB  ;
constexpr size_t WS_DT = WS_RT + 1040 * KiB64  , WS_SSQ_MIX = WS_DT + 12 * KiB64, WS_SSQ_FFN = WS_SSQ_MIX + 17 * KiB64, WS_SSQ_PLE = WS_SSQ_FFN + 17 * KiB64, WS_SSDP = WS_SSQ_PLE + 17 * KiB64, WS_END = WS_SSDP + 17 * KiB64;
static_assert(WS_PB + (size_t)MP * PLE * 2 <= WS_HB && WS_HB + (size_t)MP * DM * 2 <= WS_BIG && WS_BIG + (size_t)MP * NPJ * 2 <= WS_RT && WS_XA + (size_t)MPR * 768 * 2 <= WS_DT && WS_PPB + (size_t)MP * DM * 2 <= WS_HB2 &&
              WS_HB2 + (size_t)MP * DM * 2 <= WS_DT && WS_DT + (size_t)MP * 8 * 4 <= WS_SSQ_MIX && (size_t)MP * 16 * 4 <= 17 * KiB64 && WS_END <= 313 * MiB, "ws map");
constexpr int CW_TMO = 0, CW_BAR = 4096;

constexpr int SCR_BYTES = 147456, LDSCTL_OFF = SCR_BYTES, LDS_BYTES = SCR_BYTES + 1024;

typedef float f32x2v_ __attribute__((ext_vector_type(2))); typedef __bf16 bf16x2v_ __attribute__((ext_vector_type(2)));
__device__ __forceinline__ unsigned pk2(float lo, float hi) { const f32x2v_ v = {lo, hi}; return __builtin_bit_cast(unsigned, __builtin_convertvector(v, bf16x2v_)); }
__device__ __forceinline__ bf16 f2bf(float f) { return (bf16)(pk2(f, 0.f) & 0xffffu); }
__device__ __forceinline__ float bf2f(bf16 b) { return __uint_as_float(((unsigned)b) << 16); }
__device__ __forceinline__ float bflo(unsigned w) { return __uint_as_float(w << 16); }
__device__ __forceinline__ float bfhi(unsigned w) { return __uint_as_float(w & 0xffff0000u); }
__device__ __forceinline__ float fexp(float x) { return __builtin_amdgcn_exp2f(x * 1.44269504089f); }
__device__ __forceinline__ float frcp(float x) { return __builtin_amdgcn_rcpf(x); }
__device__ __forceinline__ float fsigmoid(float x) { return frcp(1.f + fexp(-x)); }
__device__ __forceinline__ float fsilu(float x) { return x * fsigmoid(x); }
__device__ __forceinline__ float fgelu(float x) { const float u = x + 0.044715f * x * x * x; return x * frcp(1.f + fexp(-1.5957691216f * u)); }
__device__ __forceinline__ float flog(float x) { return __builtin_amdgcn_logf(x) * 0.69314718056f; }
__device__ __forceinline__ float fsoftplus(float x) {
    if (x > 20.f) return x;
    const float e = fexp(x);
    if (e < 0.05f) return e * (1.f - e * (0.5f - e * (0.33333333f - e * (0.25f - 0.2f * e))));
    return flog(1.f + e);
}
__device__ __forceinline__ float fnegexpm1(float x) {
    if (x > -0.5f && x < 0.5f) return -(x * (1.f + x * 0.5f * (1.f + x * 0.33333333f * (1.f + x * 0.25f * (1.f + x * 0.2f * (1.f + x * 0.16666667f))))));
    return 1.f - fexp(x);
}
template <int X> __device__ __forceinline__ float swz_xor(float v) { return __int_as_float(__builtin_amdgcn_ds_swizzle(__float_as_int(v), (X << 10) | 0x1f)); }
__device__ __forceinline__ float sum_halves(float v) {
    const unsigned u = __float_as_uint(v); auto r = __builtin_amdgcn_permlane32_swap(u, u, false, false); return __uint_as_float(r[0]) + __uint_as_float(r[1]); }
template <int CTRL> __device__ __forceinline__ float dpp_f(float v) { return __int_as_float(__builtin_amdgcn_update_dpp(0, __float_as_int(v), CTRL, 0xF, 0xF, true)); }
__device__ __forceinline__ float sum16r(float v) {
    v += dpp_f<0xB1>(v); v += dpp_f<0x4E>(v); v += dpp_f<0x141>(v); v += dpp_f<0x140>(v); return v; }
__device__ __forceinline__ float sum32(float v) { v = sum16r(v); v += swz_xor<16>(v); return v; }
__device__ __forceinline__ float wave_sum(float v) { return sum_halves(sum32(v)); }
__device__ __forceinline__ float bperm(float v, int srclane) { return __int_as_float(__builtin_amdgcn_ds_bpermute(srclane << 2, __float_as_int(v))); }
__device__ __forceinline__ f32x16 mfma32(bf16x8 a, bf16x8 b, f32x16 c) { return __builtin_amdgcn_mfma_f32_32x32x16_bf16(a, b, c, 0, 0, 0); }
__device__ __forceinline__ int rowoff(int reg, int hf) { return (reg & 3) + 8 * (reg >> 2) + 4 * hf; }
#ifndef DBG_V
#define DBG_V 0
#endif
#if DBG_V == 3
#define WG_BARRIER() do { asm volatile("s_waitcnt vmcnt(0) lgkmcnt(0)" ::: "memory"); __syncthreads(); } while (0)
#else
#define WG_BARRIER() __syncthreads()
#endif

namespace pg8 {
constexpr int BM = 256, BK = 64, HALF = 128, HTB = HALF * BK * 2, STAGE_BYTES = 8 * HTB, NXCD = 8, WGM = 8;
__host__ __device__ __forceinline__ int lds_byte(int r, int c) { const int st = (r >> 4) * 2 + (c >> 5), rr = r & 15, cc = c & 31, ob = rr * 64 + cc * 2; return st * 1024 + (ob ^ (((ob >> 9) & 1) << 5)); }
__host__ __device__ __forceinline__ void stage_rc(int b, int& R, int& C) { const int st = b / 1024, sb = b % 1024, swz = sb ^ (((sb >> 9) & 1) << 5); R = (st >> 1) * 16 + swz / 64; C = (st & 1) * 32 + (swz % 64) / 2; }
__host__ __device__ __forceinline__ int perm32(int rho) { const int n = rho >> 4, i = rho & 15; return 8 * (i >> 2) + 4 * n + (i & 3); }
struct Unit { int pm, pn; };
struct Gemm { const GAS bf16* A; const GAS bf16* Bt; int lda, K; };
struct StaticOrder {
    int nM, nN, nwg, G, c;
    __device__ void init(int M, int N, int G_, int c_) { nM = M / BM; nN = N / BM; nwg = nM * nN; G = G_; c = c_; }
    __device__ bool next(int i, Unit& u) const {
        const long L = (long)i * G + c; if (L >= nwg) return false;
        int wgid = (int)L; { const int q = nwg / NXCD, r = nwg % NXCD, xcd = wgid % NXCD, off = wgid / NXCD; wgid = (xcd < r ? xcd * (q + 1) : r * (q + 1) + (xcd - r) * q) + off; }
        const int nig = WGM * nN, gid = wgid / nig, fm = gid * WGM, gsz = (nM - fm) < WGM ? (nM - fm) : WGM;
        u.pm = fm + ((wgid % nig) % gsz); u.pn = (wgid % nig) / gsz; return true;
    }
};
typedef f32x4 Acc[2][2][4][2];

struct TabJob { const GAS float* src; float scale; int on; };
constexpr int TAB_OFF = 131072;
template <class Epi, bool ALIGN_EPI>
__device__ __forceinline__ void gemm_phase(LAS unsigned char* lds, const int tid, const Gemm g, const StaticOrder& S, const Epi& E, const TabJob tj = TabJob{nullptr, 0.f, 0}) {
    const int wid = __builtin_amdgcn_readfirstlane(tid >> 6), lane = tid & 63, wr = wid >> 2, wc = wid & 3, fr = lane & 15, fq = lane >> 4;
    const int K = g.K, nt = K / BK, lda = g.lda;
    unsigned voffA[2], voffB[2];
#pragma unroll
    for (int i = 0; i < 2; ++i) { int R, C; stage_rc(tid * 16 + i * 8192, R, C); const int Rb = Epi::PERM ? ((R & ~31) + perm32(R & 31)) : R;
        voffA[i] = (unsigned)(R * lda + C) * 2u; voffB[i] = (unsigned)(Rb * K + C) * 2u; }
    const size_t kstep = (size_t)(BK * 2);
    const size_t hA = (size_t)HALF * lda * 2, hB = (size_t)HALF * K * 2, tA = 2 * hA, tB = 2 * hB;
    const unsigned ldsw = (unsigned)wid * 1024u;
    const int aoff = lds_byte(wr * 64 + fr, fq * 8), boff = lds_byte(wc * 32 + fr, fq * 8);
#define PG8_SA(b, h) (((b) * 2 + (h)) * HTB)
#define PG8_SB(b, h) ((4 + (b) * 2 + (h)) * HTB)
#define PG8_STAGE(bufoff, gbase, voff) do { _Pragma("unroll") for (int _i = 0; _i < 2; ++_i) \
        __builtin_amdgcn_global_load_lds((const GAS unsigned*)((const GAS char*)(gbase) + (voff)[_i]), (LAS unsigned*)(lds + (bufoff) + ldsw + _i * 8192), 16, 0, 0); } while (0)
#define PG8_LDA(dst, b, h) do { _Pragma("unroll") for (int m = 0; m < 4; ++m) _Pragma("unroll") for (int k = 0; k < 2; ++k) dst[m][k] = *(const LAS bf16x8*)(lds + PG8_SA(b, h) + aoff + m * 2048 + k * 1024); } while (0)
#define PG8_LDB(dst, b, h) do { _Pragma("unroll") for (int n = 0; n < 2; ++n) _Pragma("unroll") for (int k = 0; k < 2; ++k) dst[n][k] = *(const LAS bf16x8*)(lds + PG8_SB(b, h) + boff + n * 2048 + k * 1024); } while (0)
#define PG8_MMA(ai, bj, At, Bt) do { __builtin_amdgcn_s_setprio(1); _Pragma("unroll") for (int m = 0; m < 4; ++m) _Pragma("unroll") for (int n = 0; n < 2; ++n) _Pragma("unroll") for (int k = 0; k < 2; ++k) \
        acc[ai][bj][m][n] = __builtin_amdgcn_mfma_f32_16x16x32_bf16(Bt[n][k], At[m][k], acc[ai][bj][m][n], 0, 0, 0); __builtin_amdgcn_s_setprio(0); } while (0)
#define PG8_WAIT_V(n) asm volatile("s_waitcnt vmcnt(" #n ")" ::: "memory")
#define PG8_WAIT_L(n) asm volatile("s_waitcnt lgkmcnt(" #n ")" ::: "memory")
#define PG8_BAR __builtin_amdgcn_s_barrier()
#define PG8_SCHED __builtin_amdgcn_sched_barrier(0)
    Unit cur, nxt; int ui = 0;
    if (!S.next(0, cur)) return;
    f32x4 acc[2][2][4][2];
#pragma unroll
    for (int a = 0; a < 2; ++a)
#pragma unroll
        for (int b = 0; b < 2; ++b)
#pragma unroll
            for (int m = 0; m < 4; ++m)
#pragma unroll
                for (int n = 0; n < 2; ++n) acc[a][b][m][n] = (f32x4){0.f, 0.f, 0.f, 0.f};
    bf16x8 At[4][2], B0[2][2], B1[2][2];
    const GAS char* cA = (const GAS char*)g.A + (size_t)cur.pm * tA; const GAS char* cB = (const GAS char*)g.Bt + (size_t)cur.pn * tB;
    const bool tjon = tj.on && tid < 256; f32x4 tj0 = {0.f, 0.f, 0.f, 0.f}, tj1 = tj0, tj2 = tj0, tj3 = tj0;
    if (tjon) { const GAS f32x4* p_ = (const GAS f32x4*)(tj.src + (size_t)(cur.pm * BM + tid) * 16); tj0 = p_[0]; tj1 = p_[1]; tj2 = p_[2]; tj3 = p_[3]; }
    PG8_STAGE(PG8_SB(0, 0), cB, voffB); PG8_STAGE(PG8_SB(0, 1), cB + hB, voffB); PG8_STAGE(PG8_SA(0, 0), cA, voffA); PG8_STAGE(PG8_SA(0, 1), cA + hA, voffA);
    if (tjon) { const float s_ = ((tj0[0] + tj0[1]) + (tj0[2] + tj0[3])) + ((tj1[0] + tj1[1]) + (tj1[2] + tj1[3])) + ((tj2[0] + tj2[1]) + (tj2[2] + tj2[3])) + ((tj3[0] + tj3[1]) + (tj3[2] + tj3[3]));
        ((LAS float*)(lds + TAB_OFF))[tid] = __builtin_amdgcn_rsqf(s_ * tj.scale + 1e-6f); }
    if (wr == 1) PG8_BAR;
    PG8_WAIT_V(2); PG8_BAR;
    PG8_STAGE(PG8_SB(1, 0), cB + kstep, voffB); PG8_STAGE(PG8_SA(1, 0), cA + kstep, voffA); PG8_STAGE(PG8_SB(1, 1), cB + hB + kstep, voffB);
    PG8_WAIT_V(6); PG8_BAR;
    for (;;) {
        const bool has_next = S.next(ui + 1, nxt);
        const GAS char* nA = has_next ? (const GAS char*)g.A + (size_t)nxt.pm * tA : cA; const GAS char* nB = has_next ? (const GAS char*)g.Bt + (size_t)nxt.pn * tB : cB;
        for (int t = 0; t < nt; t += 2) {
            const bool last = (t == nt - 2);
            const GAS char* a1 = cA + (size_t)(t + 1) * kstep;
            const GAS char* a2 = last ? nA : cA + (size_t)(t + 2) * kstep; const GAS char* b2 = last ? nB : cB + (size_t)(t + 2) * kstep;
            const GAS char* a3 = a2 + kstep; const GAS char* b3 = b2 + kstep;
            if constexpr (Epi::MIDK > 0) { if (t == Epi::MIDK) { int z_ = 0; asm volatile("" : "+v"(z_)); const int ln_ = (int)__builtin_amdgcn_mbcnt_hi(~0u, __builtin_amdgcn_mbcnt_lo(~0u, z_)); E.mid(acc, cur, wr, wc, ln_ & 15, ln_ >> 4); } }
            PG8_LDB(B0, 0, 0); PG8_LDB(B1, 0, 1); PG8_SCHED; PG8_LDA(At, 0, 0); PG8_STAGE(PG8_SA(1, 1), a1 + hA, voffA);
            PG8_WAIT_V(8); PG8_WAIT_L(0); PG8_BAR; PG8_MMA(0, 0, At, B0); PG8_MMA(0, 1, At, B1); PG8_BAR; PG8_SCHED;
            PG8_LDA(At, 0, 1); PG8_STAGE(PG8_SB(0, 0), b2, voffB); PG8_STAGE(PG8_SB(0, 1), b2 + hB, voffB); PG8_STAGE(PG8_SA(0, 0), a2, voffA);
            PG8_WAIT_V(8); PG8_WAIT_L(0); PG8_BAR; PG8_MMA(1, 0, At, B0); PG8_MMA(1, 1, At, B1); PG8_BAR; PG8_SCHED;
            PG8_LDB(B0, 1, 0); PG8_LDB(B1, 1, 1); PG8_SCHED; PG8_LDA(At, 1, 0); PG8_STAGE(PG8_SA(0, 1), a2 + hA, voffA);
            PG8_WAIT_V(8); PG8_WAIT_L(0); PG8_BAR; PG8_MMA(0, 0, At, B0); PG8_MMA(0, 1, At, B1); PG8_BAR; PG8_SCHED;
            PG8_LDA(At, 1, 1); PG8_STAGE(PG8_SB(1, 0), b3, voffB); PG8_STAGE(PG8_SB(1, 1), b3 + hB, voffB); PG8_STAGE(PG8_SA(1, 0), a3, voffA);
            PG8_WAIT_V(8); PG8_WAIT_L(0); PG8_BAR; PG8_MMA(1, 0, At, B0); PG8_MMA(1, 1, At, B1); PG8_BAR; PG8_SCHED;
        }
        if constexpr (ALIGN_EPI) { if (wr == 0) PG8_BAR; }
        { int z_ = 0; asm volatile("" : "+v"(z_)); const int ln_ = (int)__builtin_amdgcn_mbcnt_hi(~0u, __builtin_amdgcn_mbcnt_lo(~0u, z_)); E(acc, cur, wr, wc, ln_ & 15, ln_ >> 4); }
        if (!has_next) break;
#pragma unroll
        for (int a = 0; a < 2; ++a)
#pragma unroll
            for (int b = 0; b < 2; ++b)
#pragma unroll
                for (int m = 0; m < 4; ++m)
#pragma unroll
                    for (int n = 0; n < 2; ++n) acc[a][b][m][n] = (f32x4){0.f, 0.f, 0.f, 0.f};
        cur = nxt; cA = nA; cB = nB; ++ui;
        if constexpr (ALIGN_EPI) { if (wr == 1) PG8_BAR; }
    }
    PG8_WAIT_V(0);
    if constexpr (!ALIGN_EPI) { if (wr == 0) PG8_BAR; }
    PG8_BAR;
#undef PG8_SA
#undef PG8_SB
#undef PG8_STAGE
#undef PG8_LDA
#undef PG8_LDB
#undef PG8_MMA
#undef PG8_WAIT_V
#undef PG8_WAIT_L
#undef PG8_BAR
#undef PG8_SCHED
}
}
using pg8::Unit; using pg8::Acc; using pg8::BM; using pg8::HALF;

__device__ __forceinline__ float rstd16(const GAS float* ssq, int row) {
    const GAS f32x4* p = (const GAS f32x4*)(ssq + (size_t)row * 16); const f32x4 a = p[0], b = p[1], c = p[2], d = p[3];
    const float s = ((a[0] + a[1]) + (a[2] + a[3])) + ((b[0] + b[1]) + (b[2] + b[3])) + ((c[0] + c[1]) + (c[2] + c[3])) + ((d[0] + d[1]) + (d[2] + d[3]));
    return __builtin_amdgcn_rsqf(s * (1.f / DM) + EPS);
}
constexpr int RSTAB_OFF = 131072;
__device__ __forceinline__ const LAS float* ssd_rstd_table(LAS unsigned char* lds, const GAS float* ssdp, int pm, int tid) {
    LAS float* tab = (LAS float*)(lds + RSTAB_OFF);
    if (tid < 256) { const GAS f32x4* p = (const GAS f32x4*)(ssdp + (size_t)(pm * 256 + tid) * 16); const f32x4 a = p[0], b = p[1], c = p[2], d = p[3];
        const float s_ = ((a[0] + a[1]) + (a[2] + a[3])) + ((b[0] + b[1]) + (b[2] + b[3])) + ((c[0] + c[1]) + (c[2] + c[3])) + ((d[0] + d[1]) + (d[2] + d[3]));
        tab[tid] = __builtin_amdgcn_rsqf(s_ * (1.f / 512.f) + EPS); }
    __syncthreads();
    return tab;
}
__device__ __forceinline__ const LAS float* rstd_table(LAS unsigned char* lds, const GAS float* ssq, int pm, int tid) {
    LAS float* tab = (LAS float*)(lds + RSTAB_OFF);
    if (tid < 256) tab[tid] = rstd16(ssq, pm * 256 + tid);
    __syncthreads();
    return tab;
}
template <int MODE> __device__ __forceinline__ float act1(float v, float lb) {
    if (MODE == 1) return fsilu(v);
    if (MODE == 2) return fgelu(v);
    if (MODE == 3) { const float g = lb + (1.f - lb) * fsigmoid(v); return fmaxf(flog(g), -30.f); }
    return v;
}
struct EpiProj {
    static constexpr bool PERM = true; static constexpr int MIDK = 0;
    GAS bf16* P; GAS float* DT; const GAS float* ssq; const GAS float* lbs; const LAS float* rst;
    __device__ __forceinline__ void mid(Acc&, const Unit&, int, int, int, int) const {}
    template <int MODE> __device__ __forceinline__ void body(const Acc& acc, const Unit& u, int wr, int wc, int fr, int fq) const {
        const int row0 = u.pm * BM + wr * 64 + fr, col0 = u.pn * BM + wc * 32 + 8 * fq;
        f32x4 lb[2][2];
#pragma unroll
        for (int bj = 0; bj < 2; ++bj)
#pragma unroll
            for (int n = 0; n < 2; ++n) lb[bj][n] = (MODE == 3) ? *(const GAS f32x4*)(lbs + (col0 - PC_CF) + bj * HALF + 4 * n) : (f32x4){0.f, 0.f, 0.f, 0.f};
#pragma unroll
        for (int ai = 0; ai < 2; ++ai)
#pragma unroll
            for (int m = 0; m < 4; ++m) { const int row = row0 + ai * HALF + m * 16; const float rs = rst ? rst[wr * 64 + fr + ai * HALF + m * 16] : rstd16(ssq, row); GAS bf16* rowp = P + (size_t)row * NPJ + col0;
#pragma unroll
                for (int bj = 0; bj < 2; ++bj) { const f32x4 v0 = acc[ai][bj][m][0] * rs, v1 = acc[ai][bj][m][1] * rs; u32x4 w;
                    w.x = pk2(act1<MODE>(v0[0], lb[bj][0][0]), act1<MODE>(v0[1], lb[bj][0][1])); w.y = pk2(act1<MODE>(v0[2], lb[bj][0][2]), act1<MODE>(v0[3], lb[bj][0][3]));
                    w.z = pk2(act1<MODE>(v1[0], lb[bj][1][0]), act1<MODE>(v1[1], lb[bj][1][1])); w.w = pk2(act1<MODE>(v1[2], lb[bj][1][2]), act1<MODE>(v1[3], lb[bj][1][3]));
                    *(GAS u32x4*)(rowp + bj * HALF) = w; } }
    }
    __device__ __forceinline__ void operator()(const Acc& acc, const Unit& u, int wr, int wc, int fr, int fq) const {
        const int pn = u.pn;
        if (pn == 17) {
            if (wc == 0 && fq == 0) {
#pragma unroll
                for (int ai = 0; ai < 2; ++ai)
#pragma unroll
                    for (int m = 0; m < 4; ++m) { const int row = u.pm * BM + wr * 64 + fr + ai * HALF + m * 16; const float rs = rst ? rst[wr * 64 + fr + ai * HALF + m * 16] : rstd16(ssq, row);
                        *(GAS f32x4*)(DT + (size_t)row * 8) = acc[ai][0][m][0] * rs; *(GAS f32x4*)(DT + (size_t)row * 8 + 4) = acc[ai][0][m][1] * rs; }
            }
            return;
        }
        if (pn == 4 || pn == 5 || pn == 9 || pn == 10 || pn == 15 || pn == 16) body<1>(acc, u, wr, wc, fr, fq);
        else if (pn == 7 || pn == 8) body<2>(acc, u, wr, wc, fr, fq);
        else if (pn == 11 || pn == 12) body<3>(acc, u, wr, wc, fr, fq);
        else body<0>(acc, u, wr, wc, fr, fq);
    }
};
template <bool MID> struct EpiRes {
    static constexpr bool PERM = false; static constexpr int MIDK = MID ? 8 : 0;
    const GAS bf16* hin; GAS bf16* hb; GAS float* ssq; const GAS float* ssdp; const LAS float* rst;
    __device__ __forceinline__ void mid(Acc& acc, const Unit& u, int wr, int wc, int fr, int fq) const {
#pragma unroll
        for (int ai = 0; ai < 2; ++ai)
#pragma unroll
            for (int m = 0; m < 4; ++m) { const int row = u.pm * BM + wr * 64 + fr + ai * HALF + m * 16;
                float rs;
                if (rst) rs = rst[wr * 64 + fr + ai * HALF + m * 16];
                else { const GAS f32x4* p = (const GAS f32x4*)(ssdp + (size_t)row * 16); const f32x4 a = p[0], b = p[1], c = p[2], d = p[3];
                    const float s = ((a[0] + a[1]) + (a[2] + a[3])) + ((b[0] + b[1]) + (b[2] + b[3])) + ((c[0] + c[1]) + (c[2] + c[3])) + ((d[0] + d[1]) + (d[2] + d[3]));
                    rs = __builtin_amdgcn_rsqf(s * (1.f / 512.f) + EPS); }
#pragma unroll
                for (int bj = 0; bj < 2; ++bj)
#pragma unroll
                    for (int n = 0; n < 2; ++n) acc[ai][bj][m][n] = acc[ai][bj][m][n] * rs;
                asm volatile("" ::: "memory"); }
    }
    __device__ __forceinline__ void operator()(const Acc& acc, const Unit& u, int wr, int wc, int fr, int fq) const {
        const int row0 = u.pm * BM + wr * 64 + fr, col0 = u.pn * BM + wc * 32 + 4 * fq;
#pragma unroll
        for (int ai = 0; ai < 2; ++ai)
#pragma unroll
            for (int m = 0; m < 4; ++m) { const int row = row0 + ai * HALF + m * 16; const size_t off = (size_t)row * DM + col0; float ss = 0.f;
                if (row < MREAL) {
#pragma unroll
                    for (int bj = 0; bj < 2; ++bj)
#pragma unroll
                        for (int n = 0; n < 2; ++n) { const u32x2 r = *(const GAS u32x2*)(hin + off + bj * HALF + n * 16); f32x4 v = acc[ai][bj][m][n];
                            v[0] += bflo(r.x); v[1] += bfhi(r.x); v[2] += bflo(r.y); v[3] += bfhi(r.y);
                            u32x2 w; w.x = pk2(v[0], v[1]); w.y = pk2(v[2], v[3]); *(GAS u32x2*)(hb + off + bj * HALF + n * 16) = w;
                            ss += (v[0] * v[0] + v[1] * v[1]) + (v[2] * v[2] + v[3] * v[3]); }
                }
                ss += swz_xor<16>(ss); ss = sum_halves(ss);
                if (fq == 0) ssq[(size_t)row * 16 + u.pn * 4 + wc] = ss;
                asm volatile("" ::: "memory"); }
    }
};
struct EpiDbg {
    static constexpr bool PERM = false; static constexpr int MIDK = 8;
    const GAS float* basep; GAS float* hout; const GAS float* ssdp;
    __device__ __forceinline__ void mid(Acc& acc, const Unit& u, int wr, int wc, int fr, int fq) const {
#pragma unroll
        for (int ai = 0; ai < 2; ++ai)
#pragma unroll
            for (int m = 0; m < 4; ++m) { const int row = u.pm * BM + wr * 64 + fr + ai * HALF + m * 16;
                const GAS f32x4* p = (const GAS f32x4*)(ssdp + (size_t)row * 16); const f32x4 a = p[0], b = p[1], c = p[2], d = p[3];
                const float s = ((a[0] + a[1]) + (a[2] + a[3])) + ((b[0] + b[1]) + (b[2] + b[3])) + ((c[0] + c[1]) + (c[2] + c[3])) + ((d[0] + d[1]) + (d[2] + d[3]));
                const float rs = __builtin_amdgcn_rsqf(s * (1.f / 512.f) + EPS);
#pragma unroll
                for (int bj = 0; bj < 2; ++bj)
#pragma unroll
                    for (int n = 0; n < 2; ++n) acc[ai][bj][m][n] = acc[ai][bj][m][n] * rs;
                asm volatile("" ::: "memory"); }
    }
    __device__ __forceinline__ void operator()(const Acc& acc, const Unit& u, int wr, int wc, int fr, int fq) const {
        const int row0 = u.pm * BM + wr * 64 + fr, col0 = u.pn * BM + wc * 32 + 4 * fq;
#pragma unroll
        for (int ai = 0; ai < 2; ++ai)
#pragma unroll
            for (int m = 0; m < 4; ++m) { const int row = row0 + ai * HALF + m * 16; const size_t off = (size_t)row * DM + col0;
#pragma unroll
                for (int bj = 0; bj < 2; ++bj)
#pragma unroll
                    for (int n = 0; n < 2; ++n) { const f32x4 v = *(const GAS f32x4*)(basep + off + bj * HALF + n * 16) + acc[ai][bj][m][n]; *(GAS f32x4*)(hout + off + bj * HALF + n * 16) = v; }
                asm volatile("" ::: "memory"); }
    }
};
struct EpiUp {
    static constexpr bool PERM = true; static constexpr int MIDK = 0;
    GAS bf16* Z; const GAS float* ssq; const LAS float* rst;
    __device__ __forceinline__ void mid(Acc&, const Unit&, int, int, int, int) const {}
    __device__ __forceinline__ void operator()(const Acc& acc, const Unit& u, int wr, int wc, int fr, int fq) const {
        const int row0 = u.pm * BM + wr * 64 + fr, col0 = u.pn * BM + wc * 32 + 8 * fq;
#pragma unroll
        for (int ai = 0; ai < 2; ++ai)
#pragma unroll
            for (int m = 0; m < 4; ++m) { const int row = row0 + ai * HALF + m * 16; const float rs = rst ? rst[wr * 64 + fr + ai * HALF + m * 16] : rstd16(ssq, row); GAS bf16* rowp = Z + (size_t)row * NPJ + col0;
#pragma unroll
                for (int bj = 0; bj < 2; ++bj) { f32x4 v0 = acc[ai][bj][m][0] * rs, v1 = acc[ai][bj][m][1] * rs;
#pragma unroll
                    for (int i = 0; i < 4; ++i) { const float a = fmaxf(v0[i], 0.f), b = fmaxf(v1[i], 0.f); v0[i] = a * a; v1[i] = b * b; }
                    u32x4 w; w.x = pk2(v0[0], v0[1]); w.y = pk2(v0[2], v0[3]); w.z = pk2(v1[0], v1[1]); w.w = pk2(v1[2], v1[3]); *(GAS u32x4*)(rowp + bj * HALF) = w; } }
    }
};
constexpr int PPB_PITCH = 2 * DM;
struct EpiPP {
    static constexpr bool PERM = false; static constexpr int MIDK = 0;
    GAS bf16* PPB;
    __device__ __forceinline__ void mid(Acc&, const Unit&, int, int, int, int) const {}
    __device__ __forceinline__ void operator()(const Acc& acc, const Unit& u, int wr, int wc, int fr, int fq) const {
        const int row0 = u.pm * BM + wr * 64 + fr, col0 = u.pn * BM + wc * 32 + 4 * fq;
#pragma unroll
        for (int ai = 0; ai < 2; ++ai)
#pragma unroll
            for (int m = 0; m < 4; ++m) { const size_t off = (size_t)(row0 + ai * HALF + m * 16) * PPB_PITCH + col0;
#pragma unroll
                for (int bj = 0; bj < 2; ++bj)
#pragma unroll
                    for (int n = 0; n < 2; ++n) { const f32x4 v = acc[ai][bj][m][n]; u32x2 w; w.x = pk2(v[0], v[1]); w.y = pk2(v[2], v[3]); *(GAS u32x2*)(PPB + off + bj * HALF + n * 16) = w; } }
    }
};
struct EpiGate {
    static constexpr bool PERM = false; static constexpr int MIDK = 0;
    const GAS bf16* hin; GAS bf16* hb; const GAS bf16* PPB; const GAS float* ssq_in; GAS float* ssq_out; const LAS float* rst;
    __device__ __forceinline__ void mid(Acc&, const Unit&, int, int, int, int) const {}
    __device__ __forceinline__ void operator()(const Acc& acc, const Unit& u, int wr, int wc, int fr, int fq) const {
        const int row0 = u.pm * BM + wr * 64 + fr, col0 = u.pn * BM + wc * 32 + 4 * fq;
#pragma unroll
        for (int ai = 0; ai < 2; ++ai)
#pragma unroll
            for (int m = 0; m < 4; ++m) { const int row = row0 + ai * HALF + m * 16; const size_t off = (size_t)row * DM + col0; float ss = 0.f;
                if (row < MREAL) { const float rs = rst ? rst[wr * 64 + fr + ai * HALF + m * 16] : rstd16(ssq_in, row); const GAS bf16* prow = PPB + (size_t)row * PPB_PITCH + col0;
#pragma unroll
                    for (int bj = 0; bj < 2; ++bj)
#pragma unroll
                        for (int n = 0; n < 2; ++n) { const f32x4 a = acc[ai][bj][m][n] * rs; const u32x2 pw = *(const GAS u32x2*)(prow + bj * HALF + n * 16);
                            const u32x2 r = *(const GAS u32x2*)(hin + off + bj * HALF + n * 16); f32x4 v;
                            v[0] = bflo(r.x) + fsigmoid(a[0]) * bflo(pw.x); v[1] = bfhi(r.x) + fsigmoid(a[1]) * bfhi(pw.x); v[2] = bflo(r.y) + fsigmoid(a[2]) * bflo(pw.y); v[3] = bfhi(r.y) + fsigmoid(a[3]) * bfhi(pw.y);
                            u32x2 w; w.x = pk2(v[0], v[1]); w.y = pk2(v[2], v[3]); *(GAS u32x2*)(hb + off + bj * HALF + n * 16) = w;
                            ss += (v[0] * v[0] + v[1] * v[1]) + (v[2] * v[2] + v[3] * v[3]); }
                }
                ss += swz_xor<16>(ss); ss = sum_halves(ss);
                if (fq == 0) ssq_out[(size_t)row * 16 + u.pn * 4 + wc] = ss;
                asm volatile("" ::: "memory"); }
    }
};

#define RLX_AGENT __ATOMIC_RELAXED, __HIP_MEMORY_SCOPE_AGENT
#define XB_TMO      128
#define XB_XCNT(j)  (256  + 64 * (j))
#define XB_XSUB(j)  (1280 + 64 * (j))
#define XB_XGEN(j)  (2304 + 64 * (j))
#define XB_TOP      3328
#define XB_TOPGEN   3392
#define XCD_BAR_WORDS 3456
#define XB_SPIN_CAP (1u << 20)
__device__ __forceinline__ unsigned xb_ld(GAS unsigned* p)              { return __hip_atomic_load(p, __ATOMIC_RELAXED, __HIP_MEMORY_SCOPE_AGENT); }
__device__ __forceinline__ unsigned xb_add(GAS unsigned* p, unsigned v) { return __hip_atomic_fetch_add(p, v, __ATOMIC_RELAXED, __HIP_MEMORY_SCOPE_AGENT); }
__device__ __forceinline__ unsigned xb_xcc_id() { return (unsigned)__builtin_amdgcn_s_getreg((3 << 11) | 20) & 0xFu; }
#define XB_SPIN(cond, bar) do { unsigned _sp = 0; while (cond) { __builtin_amdgcn_s_sleep(1); \
    if ((++_sp & 255u) == 0u) { if (xb_ld(&(bar)[XB_TMO])) break; if (_sp > XB_SPIN_CAP) { (void)xb_add(&(bar)[XB_TMO], 1u); break; } } } } while (0)
struct XcdBarrier { GAS unsigned* bar; unsigned x; volatile LAS unsigned* st; };
__device__ __forceinline__ XcdBarrier xcd_barrier_post(GAS unsigned* bar, volatile LAS unsigned* st) {
    XcdBarrier b; b.bar = bar; b.x = xb_xcc_id(); b.st = st;
    if (threadIdx.x == 0) (void)xb_add(&bar[XB_XCNT(b.x)], 1u);
    return b;
}
__device__ __forceinline__ void xcd_barrier_complete(GAS unsigned* bar, unsigned x, unsigned& nloc, unsigned& nx) {
    const unsigned G = gridDim.x * gridDim.y * gridDim.z;
    unsigned sum, cnt, mine, sp = 0u;
    for (;;) {
        sum = 0u; cnt = 0u; mine = 0u;
#pragma unroll
        for (unsigned j = 0; j < 16; ++j) { const unsigned c = xb_ld(&bar[XB_XCNT(j)]); sum += c; cnt += (c > 0u) ? 1u : 0u; mine = (j == x) ? c : mine; }
        if (sum == G) break;
        __builtin_amdgcn_s_sleep(1);
        if ((++sp & 255u) == 0u) { if (xb_ld(&bar[XB_TMO])) break; if (sp > XB_SPIN_CAP) { (void)xb_add(&bar[XB_TMO], 1u); break; } }
    }
    nloc = mine > 0u ? mine : 1u; nx = cnt > 0u ? cnt : 1u;
}
__device__ __forceinline__ void xcd_barrier(const XcdBarrier& b, const int tid) {
    asm volatile("s_waitcnt vmcnt(0)" ::: "memory");
    __syncthreads();
    if (tid == 0) {
        GAS unsigned* bar = b.bar;
        __builtin_amdgcn_s_waitcnt(0);
        unsigned nloc = b.st[0], nx = b.st[1];
        if (nloc == 0u) { xcd_barrier_complete(bar, b.x, nloc, nx); b.st[0] = nloc; b.st[1] = nx; }
        const unsigned old = xb_add(&bar[XB_XSUB(b.x)], 1u);
        const unsigned gen = old / nloc;
        if (old + 1u == (gen + 1u) * nloc) {
            __builtin_amdgcn_fence(__ATOMIC_RELEASE, "agent");
            asm volatile("s_waitcnt vmcnt(0)" ::: "memory");
            const unsigned og = xb_add(&bar[XB_TOP], 1u);
            const unsigned tg = og / nx;
            if (og + 1u == (tg + 1u) * nx) xb_add(&bar[XB_TOPGEN], 1u);
            else XB_SPIN(xb_ld(&bar[XB_TOPGEN]) == tg, bar);
            __builtin_amdgcn_fence(__ATOMIC_ACQUIRE, "agent");
            xb_add(&bar[XB_XGEN(b.x)], 1u);
            asm volatile("s_waitcnt vmcnt(0)" ::: "memory");
        } else {
            XB_SPIN(xb_ld(&bar[XB_XGEN(b.x)]) == gen, bar);
            __builtin_amdgcn_fence(__ATOMIC_ACQUIRE, "agent");
            asm volatile("s_waitcnt vmcnt(0)" ::: "memory");
        }
    }
    __syncthreads();
}

constexpr int CW_GRP = 16384, CW_SMP = 32768, CW_XID = 34816;
__device__ __forceinline__ void wg_arrive(GAS unsigned* ctr, unsigned n, const int tid, const GAS unsigned* xid) {
    asm volatile("s_waitcnt vmcnt(0)" ::: "memory");
    __syncthreads();
    if (tid == 0) {
        bool rel = false;
        if (xid) { const unsigned me = xb_xcc_id() + 1u; const unsigned a = xb_ld((GAS unsigned*)xid), b = xb_ld((GAS unsigned*)xid + 64), c = xb_ld((GAS unsigned*)xid + 128), d = xb_ld((GAS unsigned*)xid + 192);
            rel = !(a == me && b == me && c == me && d == me); }
        if (rel) { __builtin_amdgcn_fence(__ATOMIC_RELEASE, "agent"); asm volatile("s_waitcnt vmcnt(0)" ::: "memory"); }
        (void)xb_add(ctr, n); }
}
__device__ __forceinline__ void st_sc1(GAS float* p, float v) { __hip_atomic_store(p, v, __ATOMIC_RELAXED, __HIP_MEMORY_SCOPE_AGENT); }
__device__ __forceinline__ void st_sc1_2(GAS void* p, unsigned lo, unsigned hi) { __hip_atomic_store((GAS unsigned long long*)p, ((unsigned long long)hi << 32) | lo, __ATOMIC_RELAXED, __HIP_MEMORY_SCOPE_AGENT); }
__device__ __forceinline__ void wg_wait(GAS unsigned* ctr, unsigned target, const int tid, GAS unsigned* bar) {
    if (tid == 0) { unsigned sp_ = 0u;
        while (xb_ld(ctr) < target) { if ((++sp_ & 1023u) == 0u) { if (xb_ld(&bar[XB_TMO])) break; if (sp_ > XB_SPIN_CAP) { (void)xb_add(&bar[XB_TMO], 1u); break; } } }
        __builtin_amdgcn_fence(__ATOMIC_ACQUIRE, "agent"); asm volatile("s_waitcnt vmcnt(0)" ::: "memory"); }
    __syncthreads();
}

struct Frame {
    LAS unsigned char* lds;
    int tid, lane, wave, G, bx;
    const LAS unsigned long long* intab;
    struct InAcc { const LAS unsigned long long* t; __device__ __forceinline__ const GAS float* operator[](int i) const { const unsigned long long v = t[i];
        const unsigned lo = __builtin_amdgcn_readfirstlane((unsigned)v), hi = __builtin_amdgcn_readfirstlane((unsigned)(v >> 32)); return (const GAS float*)(((unsigned long long)hi << 32) | lo); } } in;
    GAS float* out; GAS unsigned char* ws;
    __device__ __forceinline__ GAS unsigned* ctl() const { return (GAS unsigned*)(ws + WS_CTL); }
    __device__ __forceinline__ GAS unsigned* grp(int ph) const { return ctl() + CW_GRP + (ph * 64 + (bx & 63)) * 16; }
    __device__ __forceinline__ GAS unsigned* smp(int l, int s) const { return ctl() + CW_SMP + (l * 4 + s) * 16; }
    __device__ __forceinline__ bool gsy() const { return G == 256 && MK_N_LAUNCHES == 1; }
    __device__ __forceinline__ const GAS unsigned* xid() const { return ctl() + CW_XID + (bx & 63); }
#define FPTR(name, type, off) __device__ __forceinline__ GAS type* name() const { return (GAS type*)(ws + (off)); }
    FPTR(BIG, bf16, WS_BIG) FPTR(HB, bf16, WS_HB) FPTR(HB2, bf16, WS_HB2) FPTR(PB, bf16, WS_PB) FPTR(LA, bf16, WS_LA) FPTR(BB, bf16, WS_BB) FPTR(XA, bf16, WS_XA) FPTR(TS, float, WS_TS) FPTR(PPB, bf16, WS_PPB)
    FPTR(DT, float, WS_DT) FPTR(SSQ_MIX, float, WS_SSQ_MIX) FPTR(SSQ_FFN, float, WS_SSQ_FFN) FPTR(SSQ_PLE, float, WS_SSQ_PLE) FPTR(SSDP, float, WS_SSDP) FPTR(LBS, float, WS_LBS) FPTR(WAT, bf16, WS_WAT)
#undef FPTR
};
__device__ __forceinline__ GAS bf16* w_in_t(GAS unsigned char* ws, int l) { return (GAS bf16*)(ws + WS_WIN) + (size_t)l * NPJP * DM; }
__device__ __forceinline__ GAS bf16* w_out_t(GAS unsigned char* ws, int l) { return (GAS bf16*)(ws + WS_WOUT) + (size_t)l * DM * DMIX; }
__device__ __forceinline__ GAS bf16* w_up_t(GAS unsigned char* ws, int l) { return (GAS bf16*)(ws + WS_WUP) + (size_t)l * DFF * DM; }
__device__ __forceinline__ GAS bf16* w_dn_t(GAS unsigned char* ws, int l) { return (GAS bf16*)(ws + WS_WDN) + (size_t)l * DM * DFF; }
__device__ __forceinline__ GAS bf16* w_g_t(GAS unsigned char* ws, int l) { return (GAS bf16*)(ws + WS_WG) + (size_t)l * DM * DM; }
__device__ __forceinline__ GAS bf16* w_pj_t(GAS unsigned char* ws, int l) { return (GAS bf16*)(ws + WS_WPJ) + (size_t)l * DM * PLE; }

__device__ __forceinline__ int win_src(int n0) {
    if (n0 < 512) return 1536 + n0;
    if (n0 < 1024) return n0 - 512;
    if (n0 < 1536) return 2312 + (n0 - 1024);
    if (n0 < 1792) return 2048 + (n0 - 1536);
    if (n0 < 2304) return 512 + (n0 - 1792);
    if (n0 < 2816) return 1024 + (n0 - 2304);
    if (n0 < 3328) return 2824 + (n0 - 2816);
    if (n0 < 3840) return 3336 + (n0 - 3328);
    if (n0 < 4352) return 3848 + (n0 - 3840);
    return 2304 + (n0 - 4352);
}
__device__ __forceinline__ void p0_item(const GAS float* W, int ldw, GAS bf16* WT, int K, int N, int mode, const GAS float* ks, LAS float* scr, int item, int lane) {
    const int nblk = N / 64, kb = item / nblk, nb = item % nblk, k0 = 64 * kb, n0 = 64 * nb;
    int sn0 = n0, nvalid = 64;
    if (mode == 1) { sn0 = win_src(n0); if (n0 >= NPJ) nvalid = (n0 == NPJ) ? 8 : 0; }
    const int kq = lane >> 4, n4 = (lane & 15) * 4;
    f32x4 v[16];
#pragma unroll
    for (int i = 0; i < 16; ++i) { const int k = k0 + 4 * i + kq; const int sk = (mode == 2) ? ((k < 512) ? 512 + k : (k < 1024 ? k - 512 : k)) : k;
        v[i] = (n4 < nvalid) ? *(const GAS f32x4*)(W + (size_t)sk * ldw + sn0 + n4) : (f32x4){0.f, 0.f, 0.f, 0.f}; }
#pragma unroll
    for (int i = 0; i < 16; ++i) { const int kk = 4 * i + kq, k = k0 + kk; float sc = 1.f;
        if (mode == 2) { if (k < 512) sc = ks[k]; } else if (ks) sc = ks[k];
        LAS float* d = scr + kk * 65 + n4; d[0] = v[i][0] * sc; d[1] = v[i][1] * sc; d[2] = v[i][2] * sc; d[3] = v[i][3] * sc; }
    asm volatile("s_waitcnt lgkmcnt(0)" ::: "memory");
    GAS bf16* orow = WT + (size_t)(n0 + lane) * K + k0;
#pragma unroll
    for (int j = 0; j < 8; ++j) { const LAS float* sp = scr + (8 * j) * 65 + lane;
        u32x4 o; o.x = pk2(sp[0 * 65], sp[1 * 65]); o.y = pk2(sp[2 * 65], sp[3 * 65]); o.z = pk2(sp[4 * 65], sp[5 * 65]); o.w = pk2(sp[6 * 65], sp[7 * 65]);
        *(GAS u32x4*)(orow + 8 * j) = o; }
    asm volatile("s_waitcnt lgkmcnt(0)" ::: "memory");
}
constexpr int WI_IN = (DM / 64) * (NPJP / 64), WI_OUT = (DMIX / 64) * (DM / 64), WI_UP = (DM / 64) * (DFF / 64), WI_DN = (DFF / 64) * (DM / 64), WI_G = (DM / 64) * (DM / 64), WI_PJ = (PLE / 64) * (DM / 64);
constexpr int WI_PER_L = WI_IN + WI_OUT + WI_UP + WI_DN + WI_G + WI_PJ;
__device__ __forceinline__ void wconv_item(Frame& F, LAS float* scr, int it) {
    const int l = it / WI_PER_L; int r = it % WI_PER_L;
    if (r < WI_IN) { p0_item(F.in[I_WIN] + (size_t)l * DM * DIN, DIN, w_in_t(F.ws, l), DM, NPJP, 1, F.in[I_NMIX] + l * DM, scr, r, F.lane); return; } r -= WI_IN;
    if (r < WI_OUT) { p0_item(F.in[I_WOUT] + (size_t)l * DMIX * DM, DM, w_out_t(F.ws, l), DMIX, DM, 2, F.in[I_SNORM] + l * 512, scr, r, F.lane); return; } r -= WI_OUT;
    if (r < WI_UP) { p0_item(F.in[I_WUP] + (size_t)l * DM * DFF, DFF, w_up_t(F.ws, l), DM, DFF, 0, F.in[I_NFFN] + l * DM, scr, r, F.lane); return; } r -= WI_UP;
    if (r < WI_DN) { p0_item(F.in[I_WDN] + (size_t)l * DFF * DM, DM, w_dn_t(F.ws, l), DFF, DM, 0, nullptr, scr, r, F.lane); return; } r -= WI_DN;
    if (r < WI_G) { p0_item(F.in[I_WG] + (size_t)l * DM * DM, DM, w_g_t(F.ws, l), DM, DM, 0, F.in[I_NPLE] + l * DM, scr, r, F.lane); return; } r -= WI_G;
    p0_item(F.in[I_WPJ] + (size_t)l * PLE * DM, DM, w_pj_t(F.ws, l), PLE, DM, 0, nullptr, scr, r, F.lane);
}
__device__ __forceinline__ void p0_prologue(Frame& F) {
    LAS float* scr = (LAS float*)(F.lds + F.wave * 16640);
    const int gw = F.bx * 8 + F.wave, NGW = F.G * 8;
    for (int it = gw; it < WI_IN; it += NGW) wconv_item(F, scr, it);
#pragma nounroll
    for (int m0 = gw; m0 < MREAL; m0 += 4 * NGW) {
        f32x4 v[4][4];
#pragma unroll
        for (int q = 0; q < 4; ++q) { const int m = m0 + q * NGW; const int mc = m < MREAL ? m : m0;
            const GAS float* xr = (mc < MPR) ? F.in[I_XP] + (size_t)mc * DM : F.in[I_XS] + (size_t)(mc - MPR) * DM;
#pragma unroll
            for (int j = 0; j < 4; ++j) v[q][j] = ((const GAS f32x4*)xr)[F.lane + 64 * j]; }
#pragma unroll
        for (int q = 0; q < 4; ++q) { const int m = m0 + q * NGW; float s = 0.f;
#pragma unroll
            for (int j = 0; j < 4; ++j) s += (v[q][j][0] * v[q][j][0] + v[q][j][1] * v[q][j][1]) + (v[q][j][2] * v[q][j][2] + v[q][j][3] * v[q][j][3]);
            s = wave_sum(s);
            if (m < MREAL) {
#pragma unroll
                for (int j = 0; j < 4; ++j) { u32x2 w; w.x = pk2(v[q][j][0], v[q][j][1]); w.y = pk2(v[q][j][2], v[q][j][3]); ((GAS u32x2*)(F.HB() + (size_t)m * DM))[F.lane + 64 * j] = w; }
                if (F.lane < 16) F.SSQ_MIX()[(size_t)m * 16 + F.lane] = (F.lane == 0) ? s : 0.f; } }
    }
    const int gt = F.bx * 512 + F.tid, NGT = F.G * 512;
    for (int e = gt; e < NL * 2 * 8 * 64 * 64; e += NGT) { const int i = e & 63, j = (e >> 6) & 63, h = (e >> 12) & 7, g = (e >> 15) & 1, l = e >> 16;
        F.WAT()[e] = f2bf(F.in[g ? I_WX : I_WA][(((size_t)l * 8 + h) * 64 + i) * 64 + j]); }
    for (int e = gt; e < NL * 512; e += NGT) { const int l = e / 512, c = e % 512;
        float mx = -1e30f; for (int q = 0; q < NL; ++q) mx = fmaxf(mx, F.in[I_HLB][q * 512 + c]);
        float den = 0.f, cs = 0.f, c0 = 0.f; for (int q = 0; q < NL; ++q) den += __expf(F.in[I_HLB][q * 512 + c] - mx);
        for (int q = 0; q <= l; ++q) { const float p = __expf(F.in[I_HLB][q * 512 + c] - mx) / den; cs += p; if (q == 0) c0 = p; }
        F.LBS()[e] = cs - c0; }
}

__device__ __forceinline__ void p2a_rg_item(Frame& F, int l, int item) {
    const int tt = item >> 3, h = item & 7, row0 = tt * 32, lane = F.lane, r = lane & 31, hf = lane >> 5;
    LAS float* xt = (LAS float*)(F.lds + F.wave * 8704);
    const int gc = 64 * h + lane;
    const GAS float* cw = F.in[I_CAW] + l * 4 * 512; const float w0 = cw[gc], w1 = cw[512 + gc], w2 = cw[1024 + gc], w3 = cw[1536 + gc], cb = F.in[I_CAB][l * 512 + gc];
    const GAS bf16* ax = F.BIG() + (size_t)row0 * NPJ + PC_AX + gc;
    const bool first = (row0 % SEQ) == 0;
    float p3 = 0.f, p2 = 0.f, p1 = 0.f;
    if (!first) { p3 = bf2f(ax[-3 * NPJ]); p2 = bf2f(ax[-2 * NPJ]); p1 = bf2f(ax[-1 * NPJ]); }
    bf16 rawx[32];
#pragma unroll
    for (int t = 0; t < 32; ++t) rawx[t] = ax[(size_t)t * NPJ];
    bf16x8 wbr[2][4], wbi[2][4]; float bav[2], bxv[2], lmv[2];
#pragma unroll
    for (int jb = 0; jb < 2; ++jb) {
        const GAS bf16* wr_ = F.WAT() + ((((size_t)l * 2 + 0) * 8 + h) * 64 + 32 * jb + r) * 64 + 8 * hf;
        const GAS bf16* wi_ = F.WAT() + ((((size_t)l * 2 + 1) * 8 + h) * 64 + 32 * jb + r) * 64 + 8 * hf;
#pragma unroll
        for (int s = 0; s < 4; ++s) { wbr[jb][s] = *(const GAS bf16x8*)(wr_ + 16 * s); wbi[jb][s] = *(const GAS bf16x8*)(wi_ + 16 * s); }
        const int gj = 64 * h + 32 * jb + r; bav[jb] = F.in[I_BA][l * 512 + gj]; bxv[jb] = F.in[I_BX][l * 512 + gj]; lmv[jb] = F.in[I_LAM][l * 512 + gj]; }
#pragma unroll
    for (int t = 0; t < 32; ++t) { const float cur = bf2f(rawx[t]); xt[t * 68 + lane] = w0 * p3 + w1 * p2 + w2 * p1 + w3 * cur + cb; p3 = p2; p2 = p1; p1 = cur; }
    if ((row0 + 32) % SEQ == 0) { const int b = row0 / SEQ; GAS float* o = F.out + O_RCP + ((size_t)(l * 8 + b) * 3) * 512 + gc; o[0] = p3; o[512] = p2; o[1024] = p1; }
    bf16x8 af[4];
#pragma unroll
    for (int s = 0; s < 4; ++s) { const f32x4 a = *(const LAS f32x4*)(xt + r * 68 + 16 * s + 8 * hf), b = *(const LAS f32x4*)(xt + r * 68 + 16 * s + 8 * hf + 4);
        u32x4 w; w.x = pk2(a[0], a[1]); w.y = pk2(a[2], a[3]); w.z = pk2(b[0], b[1]); w.w = pk2(b[2], b[3]); af[s] = __builtin_bit_cast(bf16x8, w); }
#pragma unroll
    for (int jb = 0; jb < 2; ++jb) {
        f32x16 ar, ai;
#pragma unroll
        for (int q = 0; q < 16; ++q) { ar[q] = 0.f; ai[q] = 0.f; }
#pragma unroll
        for (int s = 0; s < 4; ++s) { ar = mfma32(af[s], wbr[jb][s], ar); ai = mfma32(af[s], wbi[jb][s], ai); }
        const int j = 32 * jb + r, gj = 64 * h + j;
        const float ba = bav[jb], bx = bxv[jb], c8 = -8.f * fsoftplus(-lmv[jb]);
        bf16 labs[16], bvbs[16];
#pragma unroll
        for (int q = 0; q < 16; ++q) { const int t = rowoff(q, hf); const float rr = fsigmoid(ar[q] + ba), ii = fsigmoid(ai[q] + bx), la = c8 * rr;
            float mult = __builtin_amdgcn_sqrtf(fmaxf(fnegexpm1(2.f * la), 0.f)); if (((row0 + t) % SEQ) == 0) mult = 1.f;
            const float bv = mult * ii * xt[t * 68 + j]; const bf16 lab = f2bf(la), bvb = f2bf(bv); labs[q] = lab; bvbs[q] = bvb;
            ar[q] = fexp(bf2f(lab)); ai[q] = bf2f(bvb); }
#pragma unroll
        for (int k = 0; k < 4; ++k) { const size_t o = (((size_t)tt * 4 + k) * 512 + gj) * 8 + 4 * hf;
            u32x2 wl, wb; wl.x = labs[4 * k] | ((unsigned)labs[4 * k + 1] << 16); wl.y = labs[4 * k + 2] | ((unsigned)labs[4 * k + 3] << 16); wb.x = bvbs[4 * k] | ((unsigned)bvbs[4 * k + 1] << 16); wb.y = bvbs[4 * k + 2] | ((unsigned)bvbs[4 * k + 3] << 16);
            *(GAS u32x2*)(F.LA() + o) = wl; *(GAS u32x2*)(F.BB() + o) = wb; }
        float gA[4], gB[4];
#pragma unroll
        for (int k = 0; k < 4; ++k) { float A_ = 1.f, B_ = 0.f;
#pragma unroll
            for (int i = 0; i < 4; ++i) { B_ = ar[4 * k + i] * B_ + ai[4 * k + i]; A_ *= ar[4 * k + i]; }
            gA[k] = A_; gB[k] = B_; }
        float A_ = 1.f, B_ = 0.f;
#pragma unroll
        for (int k = 0; k < 4; ++k) { const unsigned ua = __float_as_uint(gA[k]), ub = __float_as_uint(gB[k]);
            auto ra = __builtin_amdgcn_permlane32_swap(ua, ua, false, false); auto rb_ = __builtin_amdgcn_permlane32_swap(ub, ub, false, false);
            const float loA = __uint_as_float(ra[0]), hiA = __uint_as_float(ra[1]), loB = __uint_as_float(rb_[0]), hiB = __uint_as_float(rb_[1]);
            B_ = loA * B_ + loB; A_ *= loA; B_ = hiA * B_ + hiB; A_ *= hiA; }
        if (hf == 0) { typedef float f32x2t __attribute__((ext_vector_type(2))); *(GAS f32x2t*)(F.TS() + ((size_t)tt * 512 + gj) * 2) = (f32x2t){A_, B_}; }
    }
}
__device__ __forceinline__ void p2a_conv_item(Frame& F, int l, int item) {
    const int tt = item / 3, g = item % 3, row0 = tt * 32, ch = 256 * g + 4 * F.lane, col = ch < 512 ? PC_XS + ch : PC_B + (ch - 512);
    const GAS float* cw = F.in[I_CBW] + l * 4 * 768 + ch; const f32x4 w0 = *(const GAS f32x4*)cw, w1 = *(const GAS f32x4*)(cw + 768), w2 = *(const GAS f32x4*)(cw + 1536), w3 = *(const GAS f32x4*)(cw + 2304), cb = *(const GAS f32x4*)(F.in[I_CBB] + l * 768 + ch);
    const GAS bf16* src = F.BIG() + (size_t)row0 * NPJ + col;
    const bool first = (row0 % SEQ) == 0;
    f32x4 p3 = {0.f, 0.f, 0.f, 0.f}, p2 = p3, p1 = p3;
    auto ld4 = [](const GAS bf16* p) { const u32x2 w = *(const GAS u32x2*)p; return (f32x4){bflo(w.x), bfhi(w.x), bflo(w.y), bfhi(w.y)}; };
    if (!first) { p3 = ld4(src - 3 * NPJ); p2 = ld4(src - 2 * NPJ); p1 = ld4(src - NPJ); }
    u32x2 raw[32];
#pragma unroll
    for (int t = 0; t < 32; ++t) raw[t] = *(const GAS u32x2*)(src + (size_t)t * NPJ);
#pragma unroll
    for (int t = 0; t < 32; ++t) { const f32x4 cur = (f32x4){bflo(raw[t].x), bfhi(raw[t].x), bflo(raw[t].y), bfhi(raw[t].y)}; const f32x4 y = w0 * p3 + w1 * p2 + w2 * p1 + w3 * cur + cb;
        u32x2 w; w.x = pk2(fsilu(y[0]), fsilu(y[1])); w.y = pk2(fsilu(y[2]), fsilu(y[3])); *(GAS u32x2*)(F.XA() + (size_t)(row0 + t) * 768 + ch) = w; p3 = p2; p2 = p1; p1 = cur; }
    if ((row0 + 32) % SEQ == 0) { const int b = row0 / SEQ; GAS float* o = F.out + O_SCP + ((size_t)(l * 8 + b) * 3) * 768 + ch; *(GAS f32x4*)o = p3; *(GAS f32x4*)(o + 768) = p2; *(GAS f32x4*)(o + 1536) = p1; }
}
__device__ __forceinline__ void p2a_pb_item(Frame& F, int l, int item) {
#pragma unroll
    for (int rr = 0; rr < 8; ++rr) { const int row = 8 * item + rr;
        if (row < MREAL) { const GAS float* s = (row < MPR) ? F.in[I_PP] + ((size_t)l * MPR + row) * PLE : F.in[I_PS] + ((size_t)l * MSM + row - MPR) * PLE;
            const f32x4 v = ((const GAS f32x4*)s)[F.lane]; u32x2 w; w.x = pk2(v[0], v[1]); w.y = pk2(v[2], v[3]); ((GAS u32x2*)(F.PB() + (size_t)row * PLE))[F.lane] = w; } }
}

__device__ __forceinline__ void smp_rg_item(Frame& F, int l, int i, int hh) {
    const int lane = F.lane, c = 64 * hh + lane; const size_t row = (size_t)MPR + i; GAS bf16* pr = F.BIG() + row * NPJ;
    LAS float* sx = (LAS float*)(F.lds + F.wave * 8704);
    const GAS float* st = F.in[I_SRC] + ((size_t)(l * MSM + i) * 3) * 512 + c; const float b0 = st[0], b1 = st[512], b2 = st[1024], cur = bf2f(pr[PC_AX + c]);
    const GAS float* cw = F.in[I_CAW] + l * 4 * 512; const float xa = cw[c] * b0 + cw[512 + c] * b1 + cw[1024 + c] * b2 + cw[1536 + c] * cur + F.in[I_CAB][l * 512 + c];
    { GAS float* o = F.out + O_RCS + ((size_t)(l * MSM + i) * 3) * 512 + c; o[0] = b1; o[512] = b2; o[1024] = cur; }
    sx[lane] = xa;
    const GAS float* wa = F.in[I_WA] + ((size_t)(l * 8 + hh) * 64) * 64 + lane; const GAS float* wx = F.in[I_WX] + ((size_t)(l * 8 + hh) * 64) * 64 + lane;
    const float h0 = F.in[I_SRH][(size_t)(l * MSM + i) * 512 + c], ga = bf2f(pr[PC_AG + c]);
    float ar = 0.f, ai = 0.f;
#pragma nounroll
    for (int hb_ = 0; hb_ < 4; ++hb_) { float wv[16], xv[16];
#pragma unroll
        for (int q = 0; q < 16; ++q) { wv[q] = wa[(16 * hb_ + q) * 64]; xv[q] = wx[(16 * hb_ + q) * 64]; }
#pragma unroll
        for (int q = 0; q < 16; ++q) { const float x = sx[16 * hb_ + q]; ar += x * wv[q]; ai += x * xv[q]; } }
    const float rr = fsigmoid(ar + F.in[I_BA][l * 512 + c]), ii = fsigmoid(ai + F.in[I_BX][l * 512 + c]), la = -8.f * fsoftplus(-F.in[I_LAM][l * 512 + c]) * rr;
    const float a = fexp(la), mult = __builtin_amdgcn_sqrtf(fmaxf(fnegexpm1(2.f * la), 0.f));
    const float hn = a * h0 + mult * ii * xa;
    F.out[O_RHS + (size_t)(l * MSM + i) * 512 + c] = hn; pr[PC_AX + c] = f2bf(hn * ga);
}
__device__ __forceinline__ float smp_conv_b(Frame& F, int l, int i, int ch, const GAS bf16* pr, bool wr) {
    const int col = ch < 512 ? PC_XS + ch : PC_B + (ch - 512);
    const GAS float* st = F.in[I_SSC] + ((size_t)(l * MSM + i) * 3) * 768 + ch; const float b0 = st[0], b1 = st[768], b2 = st[1536], cur = bf2f(pr[col]);
    const GAS float* cw = F.in[I_CBW] + l * 4 * 768;
    if (wr) { GAS float* o = F.out + O_SCS + ((size_t)(l * MSM + i) * 3) * 768 + ch; o[0] = b1; o[768] = b2; o[1536] = cur; }
    return fsilu(cw[ch] * b0 + cw[768 + ch] * b1 + cw[1536 + ch] * b2 + cw[2304 + ch] * cur + F.in[I_CBB][l * 768 + ch]);
}
__device__ __forceinline__ void smp_ssd_item(Frame& F, int l, int i, int hh) {
    const int lane = F.lane, half = lane >> 5, ln = lane & 31, n0 = 4 * ln; const size_t row = (size_t)MPR + i; GAS bf16* pr = F.BIG() + row * NPJ;
    LAS float* sX = (LAS float*)(F.lds + F.wave * 8704); LAS float* sB = sX + 64; LAS float* sC = sB + 128; LAS float* sY = sC + 128;
    const float zg = bf2f(pr[PC_BZ + 64 * hh + lane]);
    const float xh = smp_conv_b(F, l, i, 64 * hh + lane, pr, true);
    const float bq0 = smp_conv_b(F, l, i, 512 + lane, pr, hh == 0), bq1 = smp_conv_b(F, l, i, 576 + lane, pr, hh == 0), cq0 = smp_conv_b(F, l, i, 640 + lane, pr, hh == 0), cq1 = smp_conv_b(F, l, i, 704 + lane, pr, hh == 0);
    sX[lane] = xh; sB[lane] = bq0; sB[64 + lane] = bq1; sC[lane] = cq0; sC[64 + lane] = cq1;
    const float dtv = fsoftplus(F.DT()[row * 8 + hh] + F.in[I_DTB][l * 8 + hh]), dA = fexp(-dtv * __expf(F.in[I_ALOG][l * 8 + hh])), Dh = F.in[I_SSD_D][l * 8 + hh];
    const f32x4 Bn = *(const LAS f32x4*)(sB + n0), Cn = *(const LAS f32x4*)(sC + n0);
    const GAS float* sin_ = F.in[I_SSS] + (((size_t)(l * MSM + i) * 8 + hh) * 64) * 128; GAS float* sout = F.out + O_SSS + (((size_t)(l * MSM + i) * 8 + hh) * 64) * 128;
#pragma nounroll
    for (int hb_ = 0; hb_ < 2; ++hb_) { f32x4 sv[16];
#pragma unroll
        for (int k = 0; k < 16; ++k) sv[k] = *(const GAS f32x4*)(sin_ + (2 * (16 * hb_ + k) + half) * 128 + n0);
#pragma unroll
        for (int k = 0; k < 16; ++k) { const int p = 2 * (16 * hb_ + k) + half; const float xv = sX[p], xdt = dtv * xv;
            const f32x4 sn = sv[k] * dA + Bn * xdt; *(GAS f32x4*)(sout + p * 128 + n0) = sn;
            float yv = (Cn[0] * sn[0] + Cn[1] * sn[1]) + (Cn[2] * sn[2] + Cn[3] * sn[3]);
            yv = sum32(yv);
            if (ln == 0) sY[p] = yv + Dh * xv; } }
    const float yg = sY[lane] * zg; pr[PC_XS + 64 * hh + lane] = f2bf(yg);
    const float ssq = wave_sum(yg * yg);
    if (lane == 0) { F.SSDP()[row * 16 + 2 * hh] = ssq; F.SSDP()[row * 16 + 2 * hh + 1] = 0.f; }
}
__device__ __forceinline__ void smp_hg_item(Frame& F, int l, int i, int hh) {
    const int lane = F.lane; const size_t row = (size_t)MPR + i; GAS bf16* pr = F.BIG() + row * NPJ;
    LAS float* sQ = (LAS float*)(F.lds + F.wave * 8704); LAS float* sFd = sQ + 64; LAS float* sK = sFd + 64;
    const float lf = bf2f(pr[PC_CF + 64 * hh + lane]), vv = bf2f(pr[PC_CI + 64 * hh + lane]), gz = bf2f(pr[PC_CG + 64 * hh + lane]);
    sQ[lane] = bf2f(pr[PC_CQ + 64 * hh + lane]); sFd[lane] = fexp(lf); sK[lane] = fnegexpm1(lf);
    const GAS float* sin_ = F.in[I_SHG] + (((size_t)(l * MSM + i) * 8 + hh) * 64) * 64 + lane; GAS float* sout = F.out + O_HSS + (((size_t)(l * MSM + i) * 8 + hh) * 64) * 64 + lane;
    float o = 0.f;
#pragma nounroll
    for (int hb_ = 0; hb_ < 2; ++hb_) { float sv[32];
#pragma unroll
        for (int k = 0; k < 32; ++k) sv[k] = sin_[(32 * hb_ + k) * 64];
#pragma unroll
        for (int k = 0; k < 32; ++k) { const int dd = 32 * hb_ + k; const float sn = sFd[dd] * sv[k] + sK[dd] * vv; sout[dd * 64] = sn; o += sQ[dd] * sn; } }
    const float ss = wave_sum(o * o); const float rs = __builtin_amdgcn_rsqf(ss * (1.f / 64.f) + EPS);
    pr[PC_CQ + 64 * hh + lane] = f2bf(o * rs * F.in[I_HNORM][l * 64 + lane] * gz);
}
__device__ __forceinline__ void p2a_phase(Frame& F, int l) {
    const int gw = F.bx * 8 + F.wave, NGW = F.G * 8;
    constexpr int N_RG = (MPR / 32) * 8, N_CV = (MPR / 32) * 3, N_PB = MP / 8, N_SM = MSM * 8 * 3;
#pragma nounroll
    for (int it = gw; it < N_SM + N_RG + N_CV + N_PB; it += NGW) {
        if (it < N_SM) { const int m3 = it % 3, th = it / 3, hh = th & 7, i = th >> 3;
            if (m3 == 0) smp_ssd_item(F, l, i, hh); else if (m3 == 1) smp_hg_item(F, l, i, hh); else smp_rg_item(F, l, i, hh); }
        else if (it < N_SM + N_RG) p2a_rg_item(F, l, it - N_SM);
        else if (it < N_SM + N_RG + N_CV) p2a_conv_item(F, l, it - N_SM - N_RG);
        else p2a_pb_item(F, l, it - N_SM - N_RG - N_CV);
    }
}

__device__ __forceinline__ void rg_scan_role(Frame& F, int l, int rid) {
    const int b = rid >> 3, h = rid & 7, lane = F.lane, w = F.wave, gj = 64 * h + lane;
    LAS float* sA = (LAS float*)F.lds; LAS float* sB = sA + 512;
    const size_t rb = (size_t)b * SEQ + 256 * w;
    const GAS bf16* la = F.LA() + rb * 512 + gj; const GAS bf16* bb = F.BB() + rb * 512 + gj;
    float A = 1.f, B = 0.f;
#pragma nounroll
    for (int t = 0; t < 256; t += 8) { float av[8], bv[8];
#pragma unroll
        for (int k = 0; k < 8; ++k) { av[k] = bf2f(la[(size_t)(t + k) * 512]); bv[k] = bf2f(bb[(size_t)(t + k) * 512]); }
#pragma unroll
        for (int k = 0; k < 8; ++k) { const float a = fexp(av[k]); B = a * B + bv[k]; A *= a; } }
    sA[w * 64 + lane] = A; sB[w * 64 + lane] = B;
    WG_BARRIER();
    float hh = 0.f;
    for (int q = 0; q < w; ++q) hh = sA[q * 64 + lane] * hh + sB[q * 64 + lane];
    GAS bf16* pr = F.BIG() + rb * NPJ;
#pragma nounroll
    for (int t = 0; t < 256; t += 8) { float av[8], bv[8], gv[8];
#pragma unroll
        for (int k = 0; k < 8; ++k) { av[k] = bf2f(la[(size_t)(t + k) * 512]); bv[k] = bf2f(bb[(size_t)(t + k) * 512]); gv[k] = bf2f(pr[(size_t)(t + k) * NPJ + PC_AG + gj]); }
#pragma unroll
        for (int k = 0; k < 8; ++k) { hh = fexp(av[k]) * hh + bv[k]; pr[(size_t)(t + k) * NPJ + PC_AX + gj] = f2bf(hh * gv[k]); } }
    if (w == 7) F.out[O_RHP + (size_t)(l * 8 + b) * 512 + gj] = hh;
    WG_BARRIER();
}

__device__ __forceinline__ void rg_apply_role(Frame& F, int l, int rid, int nrole) {
    typedef float f32x2t __attribute__((ext_vector_type(2)));
#pragma nounroll
    for (int bh = rid; bh < 64; bh += nrole) { const int b = bh >> 3, h = bh & 7, lane = F.lane, w = F.wave, gj = 64 * h + lane;
        float hh = 0.f;
        { LAS float* sA = (LAS float*)F.lds; LAS float* sB = sA + 512; f32x2t ab[8]; float A_ = 1.f, B_ = 0.f;
#pragma unroll
          for (int k = 0; k < 8; ++k) ab[k] = *(const GAS f32x2t*)(F.TS() + ((size_t)(64 * b + 8 * w + k) * 512 + gj) * 2);
#pragma unroll
          for (int k = 0; k < 8; ++k) { B_ = ab[k].x * B_ + ab[k].y; A_ *= ab[k].x; }
          sA[w * 64 + lane] = A_; sB[w * 64 + lane] = B_;
          WG_BARRIER();
          for (int v = 0; v < w; ++v) hh = sA[v * 64 + lane] * hh + sB[v * 64 + lane]; }
        const size_t rb = (size_t)b * SEQ + 256 * w;
        GAS bf16* pr = F.BIG() + rb * NPJ;
#define RG_LOAD(LW, BW, GV, T0) do { const size_t to_ = ((((rb + (T0)) >> 5) * 4 + ((((T0) >> 3) & 3))) * 512 + gj) * 8; \
            _Pragma("unroll") for (int g = 0; g < 2; ++g) { LW[g] = *(const GAS u32x4*)(F.LA() + to_ + (size_t)g * 512 * 8); BW[g] = *(const GAS u32x4*)(F.BB() + to_ + (size_t)g * 512 * 8); } \
            _Pragma("unroll") for (int k = 0; k < 16; ++k) GV[k] = pr[(size_t)((T0) + k) * NPJ + PC_AG + gj]; } while (0)
#define RG_RUN(LW, BW, GV, T0) do { float yv_[16]; \
            _Pragma("unroll") for (int g = 0; g < 2; ++g) { const unsigned lws[4] = {LW[g].x, LW[g].y, LW[g].z, LW[g].w}, bws[4] = {BW[g].x, BW[g].y, BW[g].z, BW[g].w}; \
                _Pragma("unroll") for (int j = 0; j < 4; ++j) { hh = fexp(bflo(lws[j])) * hh + bflo(bws[j]); yv_[8 * g + 2 * j] = hh * bf2f(GV[8 * g + 2 * j]); hh = fexp(bfhi(lws[j])) * hh + bfhi(bws[j]); yv_[8 * g + 2 * j + 1] = hh * bf2f(GV[8 * g + 2 * j + 1]); } } \
            _Pragma("unroll") for (int k = 0; k < 16; ++k) pr[(size_t)((T0) + k) * NPJ + PC_AX + gj] = f2bf(yv_[k]); } while (0)
        u32x4 lwA[2], bwA[2], lwB[2], bwB[2]; bf16 gvA[16], gvB[16];
        RG_LOAD(lwA, bwA, gvA, 0);
#pragma nounroll
        for (int t0 = 0; t0 < 256; t0 += 32) {
            RG_LOAD(lwB, bwB, gvB, t0 + 16);
            RG_RUN(lwA, bwA, gvA, t0);
            if (t0 + 32 < 256) RG_LOAD(lwA, bwA, gvA, t0 + 32);
            RG_RUN(lwB, bwB, gvB, t0 + 16);
        }
#undef RG_LOAD
#undef RG_RUN
        if (w == 7) F.out[O_RHP + (size_t)(l * 8 + b) * 512 + gj] = hh; }
}

constexpr int SLD = 136;
__device__ __forceinline__ void ssd_role(Frame& F, int l, int rid) {
    const int b = rid >> 3, h = rid & 7, tid = F.tid, lane = F.lane, w = F.wave, r = lane & 31, hf = lane >> 5;
    LAS bf16* sC = (LAS bf16*)F.lds; LAS bf16* sBG = sC + 128 * SLD; LAS bf16* sBw = sBG + 128 * SLD; LAS bf16* sXT = sBw + 128 * SLD; LAS bf16* sS = sXT + 64 * SLD;
    LAS float* sCum = (LAS float*)(sS + 64 * SLD); LAS float* sDt = sCum + 128; LAS float* sW = sDt + 128; LAS float* sEc = sW + 128; LAS float* sTmp = sEc + 128;
    const float a_neg = -__expf(F.in[I_ALOG][l * 8 + h]), dtb = F.in[I_DTB][l * 8 + h], Dh = F.in[I_SSD_D][l * 8 + h];
    f32x16 accS;
#ifdef DBG_SSD2
    unsigned mism = 0;
#pragma nounroll
    for (int rep = 0; rep < 2; ++rep) {
#endif
#pragma unroll
    for (int q = 0; q < 16; ++q) accS[q] = 0.f;
    for (int e = tid; e < 64 * SLD; e += 512) sS[e] = 0;
    WG_BARRIER();
#pragma nounroll
    for (int c = 0; c < 16; ++c) {
        const size_t row0 = (size_t)b * SEQ + 128 * c;
#pragma unroll
        for (int i = 0; i < 4; ++i) { const int rr = (tid >> 4) + 32 * i, ck = tid & 15; const GAS bf16* src = F.XA() + (row0 + rr) * 768 + 512 + 8 * ck;
            *(LAS u32x4*)(sBG + rr * SLD + 8 * ck) = *(const GAS u32x4*)src; *(LAS u32x4*)(sC + rr * SLD + 8 * ck) = *(const GAS u32x4*)(src + 128); }
        if (w == 0) { const int t0 = 2 * lane; const float d0 = fsoftplus(F.DT()[(row0 + t0) * 8 + h] + dtb), d1 = fsoftplus(F.DT()[(row0 + t0 + 1) * 8 + h] + dtb);
            const float a0 = d0 * a_neg, a1 = d1 * a_neg; float s = a0 + a1;
#pragma unroll
            for (int o = 1; o < 64; o <<= 1) { const float v = bperm(s, lane - o); if (lane >= o) s += v; }
            const float c1 = s, c0 = s - a1, last = __int_as_float(__builtin_amdgcn_readlane(__float_as_int(s), 63));
            sCum[t0] = c0; sCum[t0 + 1] = c1; sEc[t0] = fexp(c0); sEc[t0 + 1] = fexp(c1); sW[t0] = fexp(last - c0) * d0; sW[t0 + 1] = fexp(last - c1) * d1; sDt[t0] = d0; sDt[t0 + 1] = d1;
            if (lane == 0) sTmp[0] = fexp(last); }
        WG_BARRIER();
        { const int s = tid & 127, pg = tid >> 7; const GAS bf16* src = F.XA() + (row0 + s) * 768;
            const u32x4 x0 = *(const GAS u32x4*)(src + 64 * h + 16 * pg), x1 = *(const GAS u32x4*)(src + 64 * h + 16 * pg + 8);
            const unsigned xw[8] = {x0.x, x0.y, x0.z, x0.w, x1.x, x1.y, x1.z, x1.w};
#pragma unroll
            for (int j = 0; j < 8; ++j) { sXT[(16 * pg + 2 * j) * SLD + s] = (bf16)(xw[j] & 0xffffu); sXT[(16 * pg + 2 * j + 1) * SLD + s] = (bf16)(xw[j] >> 16); }
            const float ws = sW[s];
#pragma unroll
            for (int q4 = 0; q4 < 4; ++q4) { const u32x4 bq = *(const GAS u32x4*)(src + 512 + 32 * pg + 8 * q4); const unsigned bw[4] = {bq.x, bq.y, bq.z, bq.w};
#pragma unroll
                for (int j = 0; j < 4; ++j) { const int n = 32 * pg + 8 * q4 + 2 * j; sBw[n * SLD + s] = f2bf(bflo(bw[j]) * ws); sBw[(n + 1) * SLD + s] = f2bf(bfhi(bw[j]) * ws); } } }
#if DBG_V == 1
        WG_BARRIER();
#endif
        f32x16 cbv[2];
#pragma unroll
        for (int q = 0; q < 2; ++q) { const int blk = 2 * w + q, tb = blk >> 2, sb = blk & 3; f32x16 a_;
#pragma unroll
            for (int z = 0; z < 16; ++z) a_[z] = 0.f;
            if (sb <= tb) {
#pragma unroll
                for (int ks = 0; ks < 8; ++ks) { const bf16x8 a = *(const LAS bf16x8*)(sC + (32 * tb + r) * SLD + 16 * ks + 8 * hf), bb = *(const LAS bf16x8*)(sBG + (32 * sb + r) * SLD + 16 * ks + 8 * hf); a_ = mfma32(a, bb, a_); } }
            cbv[q] = a_; }
        const int tby = w >> 1, pb = w & 1;
        f32x16 y;
#pragma unroll
        for (int z = 0; z < 16; ++z) y[z] = 0.f;
#pragma unroll
        for (int ks = 0; ks < 8; ++ks) { const bf16x8 a = *(const LAS bf16x8*)(sC + (32 * tby + r) * SLD + 16 * ks + 8 * hf), bs = *(const LAS bf16x8*)(sS + (32 * pb + r) * SLD + 16 * ks + 8 * hf); y = mfma32(a, bs, y); }
        WG_BARRIER();
#pragma unroll
        for (int q = 0; q < 2; ++q) { const int blk = 2 * w + q, tb = blk >> 2, sb = blk & 3;
            if (sb <= tb) { const int s_ = 32 * sb + r; const float cs = sCum[s_], ds = sDt[s_];
#pragma unroll
                for (int z = 0; z < 16; ++z) { const int t = 32 * tb + rowoff(z, hf); const float gv = (s_ <= t) ? cbv[q][z] * fexp(sCum[t] - cs) * ds : 0.f; sBG[t * SLD + s_] = f2bf(gv); } } }
#pragma unroll
        for (int z = 0; z < 16; ++z) y[z] *= sEc[32 * tby + rowoff(z, hf)];
        WG_BARRIER();
        for (int ks = 0; ks < 2 * (tby + 1); ++ks) { const bf16x8 a = *(const LAS bf16x8*)(sBG + (32 * tby + r) * SLD + 16 * ks + 8 * hf), bx = *(const LAS bf16x8*)(sXT + (32 * pb + r) * SLD + 16 * ks + 8 * hf); y = mfma32(a, bx, y); }
        { const int p = 32 * pb + r, col = 64 * h + p;
#pragma unroll
            for (int z = 0; z < 16; ++z) { const int t = 32 * tby + rowoff(z, hf); GAS bf16* pr = F.BIG() + (row0 + t) * NPJ;
                const float yv = y[z] + Dh * bf2f(sXT[p * SLD + t]); const float yg = yv * bf2f(pr[PC_BZ + col]);
#ifdef DBG_SSD2
                if (rep == 1) { if (l == 1 && pr[PC_XS + col] != f2bf(yg)) ++mism; } else
#endif
                pr[PC_XS + col] = f2bf(yg);
                const float ss = sum32(yg * yg);
                if (r == 0) F.SSDP()[(row0 + t) * 16 + 2 * h + pb] = ss; } }
#if DBG_V == 2
        WG_BARRIER();
#endif
        { const int pbs = w >> 2, nb = w & 3; const float dec = sTmp[0];
#pragma unroll
            for (int z = 0; z < 16; ++z) accS[z] *= dec;
#pragma unroll
            for (int ks = 0; ks < 8; ++ks) { const bf16x8 a = *(const LAS bf16x8*)(sXT + (32 * pbs + r) * SLD + 16 * ks + 8 * hf), bw = *(const LAS bf16x8*)(sBw + (32 * nb + r) * SLD + 16 * ks + 8 * hf); accS = mfma32(a, bw, accS); }
#pragma unroll
            for (int z = 0; z < 16; ++z) sS[(32 * pbs + rowoff(z, hf)) * SLD + 32 * nb + r] = f2bf(accS[z]); }
        WG_BARRIER();
    }
#ifdef DBG_SSD2
    }
    { const float mt = wave_sum((float)mism); if (lane == 0 && l == 1) F.out[(size_t)(16000 + rid * 8 + w) * DM] = 1000.f * mt; }
#endif
    { const int pbs = w >> 2, nb = w & 3; GAS float* o = F.out + O_SSP + ((size_t)(l * 8 + b) * 8 + h) * 64 * 128;
#pragma unroll
        for (int z = 0; z < 16; ++z) o[(32 * pbs + rowoff(z, hf)) * 128 + 32 * nb + r] = accS[z]; }
}


__device__ __forceinline__ void ssd_role2(Frame& F, int l, int rid) {
    const int b = rid >> 4, h = (rid >> 1) & 7, ph = rid & 1, tid = F.tid, lane = F.lane, w = F.wave, r = lane & 31, hf = lane >> 5;
    LAS bf16* sC = (LAS bf16*)F.lds; LAS bf16* sBG = sC + 128 * SLD; LAS bf16* sBw = sBG + 128 * SLD; LAS bf16* sXT = sBw + 128 * SLD; LAS bf16* sS = sXT + 32 * SLD;
    LAS float* sScan = (LAS float*)(sS + 32 * SLD); LAS float* sYo = sScan + 2 * 528;
    const float a_neg = -__expf(F.in[I_ALOG][l * 8 + h]), dtb = F.in[I_DTB][l * 8 + h], Dh = F.in[I_SSD_D][l * 8 + h];
    const int pcol = 64 * h + 32 * ph;
    f32x16 accS;
#pragma unroll
    for (int q = 0; q < 16; ++q) accS[q] = 0.f;
    for (int e = tid; e < 32 * SLD; e += 512) sS[e] = 0;
    u32x4 rx, rbq[4], rc[4], rzv; float rd0 = 0.f, rd1 = 0.f;
    const int s_ = tid & 127, pg = tid >> 7, ot = tid >> 2, ock = tid & 3;
#define SSD_LOAD(ROW0) do { \
        { const GAS bf16* src = F.XA() + ((ROW0) + s_) * 768; rx = *(const GAS u32x4*)(src + pcol + 8 * pg); } \
        _Pragma("unroll") for (int i4 = 0; i4 < 4; ++i4) rbq[i4] = *(const GAS u32x4*)(F.XA() + ((ROW0) + (tid >> 4) + 32 * i4) * 768 + 512 + 8 * (tid & 15)); \
        _Pragma("unroll") for (int i4 = 0; i4 < 4; ++i4) rc[i4] = *(const GAS u32x4*)(F.XA() + ((ROW0) + (tid >> 4) + 32 * i4) * 768 + 640 + 8 * (tid & 15)); \
        rzv = *(const GAS u32x4*)(F.BIG() + ((ROW0) + ot) * NPJ + PC_BZ + pcol + 8 * ock); } while (0)
#define SSD_LOAD_DT(ROW0) do { rd0 = F.DT()[((ROW0) + 2 * lane) * 8 + h]; rd1 = F.DT()[((ROW0) + 2 * lane + 1) * 8 + h]; } while (0)
#define SSD_SCAN(SET) do { LAS float* q_ = sScan + (SET) * 528; const int t0 = 2 * lane; const float d0 = fsoftplus(rd0 + dtb), d1 = fsoftplus(rd1 + dtb); \
        const float a0 = d0 * a_neg, a1 = d1 * a_neg; float sc_ = a0 + a1; \
        _Pragma("unroll") for (int o = 1; o < 64; o <<= 1) { const float v = bperm(sc_, lane - o); if (lane >= o) sc_ += v; } \
        const float c1 = sc_, c0 = sc_ - a1, last = __int_as_float(__builtin_amdgcn_readlane(__float_as_int(sc_), 63)); \
        q_[t0] = c0; q_[t0 + 1] = c1; q_[384 + t0] = fexp(c0); q_[384 + t0 + 1] = fexp(c1); q_[256 + t0] = fexp(last - c0) * d0; q_[256 + t0 + 1] = fexp(last - c1) * d1; q_[128 + t0] = d0; q_[128 + t0 + 1] = d1; \
        if (lane == 0) q_[512] = fexp(last); } while (0)
    SSD_LOAD((size_t)b * SEQ);
    if (w == 1) { SSD_LOAD_DT((size_t)b * SEQ); SSD_SCAN(0); SSD_LOAD_DT((size_t)b * SEQ + 128); }
    WG_BARRIER();
#pragma nounroll
    for (int c = 0; c < 16; ++c) {
        const size_t row0 = (size_t)b * SEQ + 128 * c;
        LAS float* sCum = sScan + (c & 1) * 528; LAS float* sDt = sCum + 128; LAS float* sW = sDt + 128; LAS float* sEc = sW + 128; LAS float* sTmp = sEc + 128;
#pragma unroll
        for (int i = 0; i < 4; ++i) { *(LAS u32x4*)(sC + ((tid >> 4) + 32 * i) * SLD + 8 * (tid & 15)) = rc[i]; *(LAS u32x4*)(sBG + ((tid >> 4) + 32 * i) * SLD + 8 * (tid & 15)) = rbq[i]; }
        { const unsigned xw[4] = {rx.x, rx.y, rx.z, rx.w};
#pragma unroll
            for (int j = 0; j < 4; ++j) { sXT[(8 * pg + 2 * j) * SLD + s_] = (bf16)(xw[j] & 0xffffu); sXT[(8 * pg + 2 * j + 1) * SLD + s_] = (bf16)(xw[j] >> 16); }
 }
        const u32x4 zcur = rzv;
        if (c + 1 < 16) SSD_LOAD(row0 + 128);
        WG_BARRIER();
        { const float ws_ = sW[s_];
#pragma unroll
            for (int q4 = 0; q4 < 4; ++q4) { const u32x4 bq = *(const LAS u32x4*)(sBG + s_ * SLD + 32 * pg + 8 * q4); const unsigned bw[4] = {bq.x, bq.y, bq.z, bq.w};
#pragma unroll
                for (int j = 0; j < 4; ++j) { const int n = 32 * pg + 8 * q4 + 2 * j; sBw[n * SLD + s_] = f2bf(bflo(bw[j]) * ws_); sBw[(n + 1) * SLD + s_] = f2bf(bfhi(bw[j]) * ws_); } } }
        f32x16 cbv[2];
#pragma unroll
        for (int q = 0; q < 2; ++q) { const int blk = 2 * w + q, tb = blk >> 2, sb = blk & 3; f32x16 a_;
#pragma unroll
            for (int z = 0; z < 16; ++z) a_[z] = 0.f;
            if (sb <= tb) {
#pragma unroll
                for (int ks = 0; ks < 8; ++ks) { const bf16x8 a = *(const LAS bf16x8*)(sC + (32 * tb + r) * SLD + 16 * ks + 8 * hf), bb = *(const LAS bf16x8*)(sBG + (32 * sb + r) * SLD + 16 * ks + 8 * hf); a_ = mfma32(a, bb, a_); } }
            cbv[q] = a_; }
        f32x16 y;
#pragma unroll
        for (int z = 0; z < 16; ++z) y[z] = 0.f;
        if (w < 4) {
#pragma unroll
            for (int ks = 0; ks < 8; ++ks) { const bf16x8 a = *(const LAS bf16x8*)(sC + (32 * w + r) * SLD + 16 * ks + 8 * hf), bs = *(const LAS bf16x8*)(sS + r * SLD + 16 * ks + 8 * hf); y = mfma32(a, bs, y); } }
        if (w == 1 && c + 1 < 16) { SSD_SCAN((c + 1) & 1); if (c + 2 < 16) SSD_LOAD_DT(row0 + 256); }
        WG_BARRIER();
#pragma unroll
        for (int q = 0; q < 2; ++q) { const int blk = 2 * w + q, tb = blk >> 2, sb = blk & 3;
            if (sb <= tb) { const int sq = 32 * sb + r; const float cs = sCum[sq], ds = sDt[sq]; float ct[16];
#pragma unroll
                for (int z = 0; z < 16; ++z) ct[z] = sCum[32 * tb + rowoff(z, hf)];
#pragma unroll
                for (int z = 0; z < 16; ++z) { const int t = 32 * tb + rowoff(z, hf); const float gu = cbv[q][z] * fexp(fminf(ct[z] - cs, 0.f)) * ds; sBG[t * SLD + sq] = f2bf((sq <= t) ? gu : 0.f); } } }
        if (w < 4) {
#pragma unroll
            for (int z = 0; z < 16; ++z) y[z] *= sEc[32 * w + rowoff(z, hf)]; }
        WG_BARRIER();
        if (w < 4) {
            for (int ks = 0; ks < 2 * (w + 1); ++ks) { const bf16x8 a = *(const LAS bf16x8*)(sBG + (32 * w + r) * SLD + 16 * ks + 8 * hf), bx = *(const LAS bf16x8*)(sXT + r * SLD + 16 * ks + 8 * hf); y = mfma32(a, bx, y); }
#pragma unroll
            for (int z = 0; z < 16; ++z) { const int t = 32 * w + rowoff(z, hf); sYo[t * 36 + r] = y[z] + Dh * bf2f(sXT[r * SLD + t]); }
        } else { const int nb = w - 4; const float dec = sTmp[0];
#pragma unroll
            for (int z = 0; z < 16; ++z) accS[z] *= dec;
#pragma unroll
            for (int ks = 0; ks < 8; ++ks) { const bf16x8 a = *(const LAS bf16x8*)(sXT + r * SLD + 16 * ks + 8 * hf), bw = *(const LAS bf16x8*)(sBw + (32 * nb + r) * SLD + 16 * ks + 8 * hf); accS = mfma32(a, bw, accS); }
#pragma unroll
            for (int z = 0; z < 16; ++z) sS[rowoff(z, hf) * SLD + 32 * nb + r] = f2bf(accS[z]); }
        WG_BARRIER();
        { const f32x4 ya = *(const LAS f32x4*)(sYo + ot * 36 + 8 * ock), yb = *(const LAS f32x4*)(sYo + ot * 36 + 8 * ock + 4);
            const float g0 = ya[0] * bflo(zcur.x), g1 = ya[1] * bfhi(zcur.x), g2 = ya[2] * bflo(zcur.y), g3 = ya[3] * bfhi(zcur.y), g4 = yb[0] * bflo(zcur.z), g5 = yb[1] * bfhi(zcur.z), g6 = yb[2] * bflo(zcur.w), g7 = yb[3] * bfhi(zcur.w);
            u32x4 ow; ow.x = pk2(g0, g1); ow.y = pk2(g2, g3); ow.z = pk2(g4, g5); ow.w = pk2(g6, g7);
            *(GAS u32x4*)(F.BIG() + (row0 + ot) * NPJ + PC_XS + pcol + 8 * ock) = ow;
            float ss = ((g0 * g0 + g1 * g1) + (g2 * g2 + g3 * g3)) + ((g4 * g4 + g5 * g5) + (g6 * g6 + g7 * g7));
            ss += dpp_f<0xB1>(ss); ss += dpp_f<0x4E>(ss);
            if (ock == 0) F.SSDP()[(row0 + ot) * 16 + 2 * h + ph] = ss; }
    }
#undef SSD_LOAD
#undef SSD_LOAD_DT
#undef SSD_SCAN
    if (w >= 4) { const int nb = w - 4; GAS float* o = F.out + O_SSP + ((size_t)(l * 8 + b) * 8 + h) * 64 * 128;
#pragma unroll
        for (int z = 0; z < 16; ++z) o[(32 * ph + rowoff(z, hf)) * 128 + 32 * nb + r] = accS[z]; }
    WG_BARRIER();
}

constexpr int HLD = 72;
template <bool DRY> __device__ __forceinline__ void hgrn_role(Frame& F, int l, int rid) {
    const int b = rid >> 3, h = rid & 7, tid = F.tid, lane = F.lane, w = F.wave, r = lane & 31, hf = lane >> 5;
    LAS bf16* sQe = (LAS bf16*)F.lds; LAS bf16* sKe = sQe + 64 * HLD; LAS bf16* sQb = sKe + 64 * HLD; LAS bf16* sKdT = sQb + 64 * HLD; LAS bf16* sVT = sKdT + 64 * HLD; LAS bf16* sAtt = sVT + 64 * HLD; LAS bf16* sST = sAtt + 64 * HLD;
    LAS float* sO = (LAS float*)(sST + 64 * HLD); LAS float* sPart = sO + 64 * 68; LAS float* sBl = sPart + 512;
    f32x16 accS;
#pragma unroll
    for (int q = 0; q < 16; ++q) accS[q] = 0.f;
    for (int e = tid; e < 64 * HLD; e += 512) sST[e] = 0;
    WG_BARRIER();
    const int d = lane, col = 64 * h + d;
    bf16 rq[8], rlf[8], rv[8]; u32x4 rgz;
#define HG_LOAD(ROW0) do { _Pragma("unroll") for (int i = 0; i < 8; ++i) { const GAS bf16* pr_ = F.BIG() + ((ROW0) + 8 * w + i) * NPJ; rq[i] = pr_[PC_CQ + col]; rlf[i] = pr_[PC_CF + col]; rv[i] = pr_[PC_CI + col]; } \
        rgz = *(const GAS u32x4*)(F.BIG() + ((ROW0) + (tid >> 3)) * NPJ + PC_CG + 64 * h + 8 * (tid & 7)); } while (0)
    HG_LOAD((size_t)b * SEQ);
    const f32x4 n0 = *(const GAS f32x4*)(F.in[I_HNORM] + l * 64 + 8 * (tid & 7)), n1 = *(const GAS f32x4*)(F.in[I_HNORM] + l * 64 + 8 * (tid & 7) + 4);
#pragma nounroll
    for (int c = 0; c < 32; ++c) {
        const size_t row0 = (size_t)b * SEQ + 64 * c;
        float q[8], lf[8], v[8], bc[8];
#pragma unroll
        for (int i = 0; i < 8; ++i) { q[i] = bf2f(rq[i]); lf[i] = bf2f(rlf[i]); v[i] = bf2f(rv[i]); }
        const u32x4 gz = rgz;
        if (c + 1 < 32) HG_LOAD(row0 + 64);
        float run = 0.f;
#pragma unroll
        for (int i = 0; i < 8; ++i) { run += lf[i]; bc[i] = run; }
        sPart[w * 64 + d] = run;
        WG_BARRIER();
        float pre = 0.f, bm = 0.f, bl = 0.f;
#pragma unroll
        for (int q8 = 0; q8 < 8; ++q8) { const float pv = sPart[q8 * 64 + d]; if (q8 < w) pre += pv; if (q8 < 4) bm += pv; bl += pv; }
        unsigned kdw[4], vw[4];
        float fl[8], pf[8], sf[8];
#pragma unroll
        for (int ii = 0; ii < 8; ++ii) fl[ii] = fexp(lf[ii]);
        { float pr_ = fexp(pre);
#pragma unroll
          for (int ii = 0; ii < 8; ++ii) { pr_ *= fl[ii]; pf[ii] = pr_; }
          float sr_ = fexp(bl - pre - run);
#pragma unroll
          for (int ii = 7; ii >= 0; --ii) { sf[ii] = sr_; sr_ *= fl[ii]; } }
#pragma unroll
        for (int i = 0; i < 8; i += 2) { float kd2[2];
#pragma unroll
            for (int u = 0; u < 2; ++u) { const int ii = i + u; const float bt = pre + bc[ii]; const float k = 1.f - fl[ii];
                const float e1 = fexp(__builtin_amdgcn_fmed3f(bt - bm, -80.f, 80.f)), e2 = frcp(e1);
                const int t = 8 * w + ii; sQe[t * HLD + d] = f2bf(q[ii] * e1); sKe[t * HLD + d] = f2bf(k * e2); sQb[t * HLD + d] = f2bf(q[ii] * pf[ii]); kd2[u] = k * sf[ii]; }
            kdw[i >> 1] = pk2(kd2[0], kd2[1]); vw[i >> 1] = pk2(v[i], v[i + 1]); }
        *(LAS u32x4*)(sKdT + d * HLD + 8 * w) = (u32x4){kdw[0], kdw[1], kdw[2], kdw[3]};
        *(LAS u32x4*)(sVT + d * HLD + 8 * w) = (u32x4){vw[0], vw[1], vw[2], vw[3]};
        if (w == 0) sBl[d] = fexp(bl);
        WG_BARRIER();
        f32x16 o;
#pragma unroll
        for (int z = 0; z < 16; ++z) o[z] = 0.f;
        const int tb = (w >> 1) & 1, eb = w & 1;
        if (w < 4) {
#pragma unroll
            for (int ks = 0; ks < 4; ++ks) { const bf16x8 a = *(const LAS bf16x8*)(sQb + (32 * tb + r) * HLD + 16 * ks + 8 * hf), bs = *(const LAS bf16x8*)(sST + (32 * eb + r) * HLD + 16 * ks + 8 * hf); o = mfma32(a, bs, o); }
        } else if (w < 7) { const int blk = w - 4, tba = blk == 0 ? 0 : 1, sba = blk == 2 ? 1 : 0;
#pragma unroll
            for (int ks = 0; ks < 4; ++ks) { const bf16x8 a = *(const LAS bf16x8*)(sQe + (32 * tba + r) * HLD + 16 * ks + 8 * hf), bk = *(const LAS bf16x8*)(sKe + (32 * sba + r) * HLD + 16 * ks + 8 * hf); o = mfma32(a, bk, o); }
#pragma unroll
            for (int z = 0; z < 16; ++z) { const int t = 32 * tba + rowoff(z, hf), s_ = 32 * sba + r; sAtt[t * HLD + s_] = f2bf((s_ <= t) ? o[z] : 0.f); }
        }
        WG_BARRIER();
        if (w < 4) {
            for (int ks = 0; ks < 2 * (tb + 1); ++ks) { const bf16x8 a = *(const LAS bf16x8*)(sAtt + (32 * tb + r) * HLD + 16 * ks + 8 * hf), bv = *(const LAS bf16x8*)(sVT + (32 * eb + r) * HLD + 16 * ks + 8 * hf); o = mfma32(a, bv, o); }
#pragma unroll
            for (int z = 0; z < 16; ++z) sO[(32 * tb + rowoff(z, hf)) * 68 + 32 * eb + r] = o[z];
        } else { const int db = (w >> 1) & 1;
#pragma unroll
            for (int z = 0; z < 16; ++z) accS[z] *= sBl[32 * db + rowoff(z, hf)];
#pragma unroll
            for (int ks = 0; ks < 4; ++ks) { const bf16x8 a = *(const LAS bf16x8*)(sKdT + (32 * db + r) * HLD + 16 * ks + 8 * hf), bv = *(const LAS bf16x8*)(sVT + (32 * eb + r) * HLD + 16 * ks + 8 * hf); accS = mfma32(a, bv, accS); }
#pragma unroll
            for (int z = 0; z < 16; ++z) sST[(32 * eb + r) * HLD + 32 * db + rowoff(z, hf)] = f2bf(accS[z]);
        }
        WG_BARRIER();
        { const int t = tid >> 3, eg = tid & 7; const f32x4 o0 = *(const LAS f32x4*)(sO + t * 68 + 8 * eg), o1 = *(const LAS f32x4*)(sO + t * 68 + 8 * eg + 4);
            float ss = (o0[0] * o0[0] + o0[1] * o0[1]) + (o0[2] * o0[2] + o0[3] * o0[3]) + (o1[0] * o1[0] + o1[1] * o1[1]) + (o1[2] * o1[2] + o1[3] * o1[3]);
            ss += swz_xor<1>(ss); ss += swz_xor<2>(ss); ss += swz_xor<4>(ss);
            const float rs = __builtin_amdgcn_rsqf(ss * (1.f / 64.f) + EPS);
            GAS bf16* pr = F.BIG() + (row0 + t) * NPJ;
            u32x4 ow; ow.x = pk2(o0[0] * rs * n0[0] * bflo(gz.x), o0[1] * rs * n0[1] * bfhi(gz.x)); ow.y = pk2(o0[2] * rs * n0[2] * bflo(gz.y), o0[3] * rs * n0[3] * bfhi(gz.y));
            ow.z = pk2(o1[0] * rs * n1[0] * bflo(gz.z), o1[1] * rs * n1[1] * bfhi(gz.z)); ow.w = pk2(o1[2] * rs * n1[2] * bflo(gz.w), o1[3] * rs * n1[3] * bfhi(gz.w));
            if (DRY) *(GAS u32x4*)(F.HB() + (size_t)(row0 + t) * DM + 64 * h + 8 * eg) = ow; else *(GAS u32x4*)(pr + PC_CQ + 64 * h + 8 * eg) = ow; }
    }
    if (w >= 4 && !DRY) { const int db = (w >> 1) & 1, eb = w & 1; GAS float* o = F.out + O_HSP + ((size_t)(l * 8 + b) * 8 + h) * 64 * 64;
#pragma unroll
        for (int z = 0; z < 16; ++z) o[(32 * db + rowoff(z, hf)) * 64 + 32 * eb + r] = accS[z]; }
    WG_BARRIER();
}

#ifndef SAMPLE_MASK
#define SAMPLE_MASK 7
#endif
template <bool DRY> __device__ __forceinline__ void sample_role(Frame& F, int l, int rid, int nrole) {
    const int tid = F.tid, lane = F.lane, w = F.wave;
    LAS float* sXa = (LAS float*)F.lds; LAS float* sX = sXa + 512; LAS float* sQ = sX + 768; LAS float* sFd = sQ + 512; LAS float* sK = sFd + 512; LAS float* sDt = sK + 512; LAS float* sY = sDt + 32;
#pragma nounroll
    for (int i = rid; i < MSM; i += nrole) { const size_t row = (size_t)MPR + i; GAS bf16* pr = F.BIG() + row * NPJ;
        { const int c = tid; const GAS float* st = F.in[I_SRC] + ((size_t)(l * MSM + i) * 3) * 512 + c; const float b0 = st[0], b1 = st[512], b2 = st[1024], cur = bf2f(pr[PC_AX + c]);
            const GAS float* cw = F.in[I_CAW] + l * 4 * 512; sXa[c] = cw[c] * b0 + cw[512 + c] * b1 + cw[1024 + c] * b2 + cw[1536 + c] * cur + F.in[I_CAB][l * 512 + c];
            GAS float* o = F.out + O_RCS + ((size_t)(l * MSM + i) * 3) * 512 + c; o[0] = b1; o[512] = b2; o[1024] = cur; }
        for (int ch = tid; ch < 768; ch += 512) { const int col = ch < 512 ? PC_XS + ch : PC_B + (ch - 512);
            const GAS float* st = F.in[I_SSC] + ((size_t)(l * MSM + i) * 3) * 768 + ch; const float b0 = st[0], b1 = st[768], b2 = st[1536], cur = bf2f(pr[col]);
            const GAS float* cw = F.in[I_CBW] + l * 4 * 768; sX[ch] = fsilu(cw[ch] * b0 + cw[768 + ch] * b1 + cw[1536 + ch] * b2 + cw[2304 + ch] * cur + F.in[I_CBB][l * 768 + ch]);
            GAS float* o = F.out + O_SCS + ((size_t)(l * MSM + i) * 3) * 768 + ch; o[0] = b1; o[768] = b2; o[1536] = cur; }
        { const int c = tid; sQ[c] = bf2f(pr[PC_CQ + c]); const float lf = bf2f(pr[PC_CF + c]); sFd[c] = fexp(lf); sK[c] = fnegexpm1(lf); }
        if (tid < 8) { const float dtv = fsoftplus(F.DT()[row * 8 + tid] + F.in[I_DTB][l * 8 + tid]); sDt[tid] = dtv; sDt[8 + tid] = fexp(-dtv * __expf(F.in[I_ALOG][l * 8 + tid])); }
        WG_BARRIER();
        if (SAMPLE_MASK & 1) { const int c = tid, hh = c >> 6, j = c & 63; const GAS float* wa = F.in[I_WA] + ((size_t)(l * 8 + hh) * 64) * 64 + j; const GAS float* wx = F.in[I_WX] + ((size_t)(l * 8 + hh) * 64) * 64 + j;
            float ar = 0.f, ai = 0.f;
#pragma unroll 32
            for (int q = 0; q < 64; ++q) { const float xv = sXa[64 * hh + q]; ar += xv * wa[q * 64]; ai += xv * wx[q * 64]; }
            const float rr = fsigmoid(ar + F.in[I_BA][l * 512 + c]), ii = fsigmoid(ai + F.in[I_BX][l * 512 + c]), la = -8.f * fsoftplus(-F.in[I_LAM][l * 512 + c]) * rr;
            const float a = fexp(la), mult = __builtin_amdgcn_sqrtf(fmaxf(fnegexpm1(2.f * la), 0.f));
            const float hn = a * F.in[I_SRH][(size_t)(l * MSM + i) * 512 + c] + mult * ii * sXa[c];
            F.out[O_RHS + (size_t)(l * MSM + i) * 512 + c] = hn; if (!DRY) pr[PC_AX + c] = f2bf(hn * bf2f(pr[PC_AG + c])); }
#ifdef DBG_BAR
        asm volatile("s_waitcnt vmcnt(0) lgkmcnt(0)" ::: "memory");
#endif
        if (SAMPLE_MASK & 2) { const int hh = w, half = lane >> 5, ln = lane & 31, n0 = 4 * ln; const float dA = sDt[8 + hh], dtv = sDt[hh], Dh = F.in[I_SSD_D][l * 8 + hh];
            const f32x4 Bn = *(const LAS f32x4*)(sX + 512 + n0), Cn = *(const LAS f32x4*)(sX + 640 + n0);
            const GAS float* sin_ = F.in[I_SSS] + (((size_t)(l * MSM + i) * 8 + hh) * 64) * 128; GAS float* sout = F.out + O_SSS + (((size_t)(l * MSM + i) * 8 + hh) * 64) * 128;
#pragma unroll
            for (int hb_ = 0; hb_ < 2; ++hb_) { f32x4 sv[16];
#pragma unroll
                for (int k = 0; k < 16; ++k) sv[k] = *(const GAS f32x4*)(sin_ + (2 * (16 * hb_ + k) + half) * 128 + n0);
#pragma unroll
                for (int k = 0; k < 16; ++k) { const int p = 2 * (16 * hb_ + k) + half; const float xv = sX[64 * hh + p], xdt = dtv * xv;
                    const f32x4 sn = sv[k] * dA + Bn * xdt; *(GAS f32x4*)(sout + p * 128 + n0) = sn;
                    float yv = (Cn[0] * sn[0] + Cn[1] * sn[1]) + (Cn[2] * sn[2] + Cn[3] * sn[3]);
                    yv = sum32(yv);
                    if (ln == 0) sY[64 * hh + p] = yv + Dh * xv; } }
            { const float yg = sY[64 * hh + lane] * bf2f(pr[PC_BZ + 64 * hh + lane]); if (!DRY) pr[PC_XS + 64 * hh + lane] = f2bf(yg);
              const float ssq = wave_sum(yg * yg);
#ifdef DBG_YG
              if (l == 1) { F.out[(size_t)i * DM + 64 * hh + lane] = yg; F.out[(size_t)(128 + i) * DM + 64 * hh + lane] = bf2f(pr[PC_BZ + 64 * hh + lane]); F.out[(size_t)(256 + i) * DM + 64 * hh + lane] = sY[64 * hh + lane]; F.out[(size_t)(384 + i) * DM + 64 * hh + lane] = ssq; }
#endif
              if (lane == 0) { F.SSDP()[row * 16 + 2 * hh] = ssq; F.SSDP()[row * 16 + 2 * hh + 1] = 0.f; } } }
        if (SAMPLE_MASK & 4) { const int hh = w, e = lane; const float vv = bf2f(pr[PC_CI + 64 * hh + e]);
            const GAS float* sin_ = F.in[I_SHG] + (((size_t)(l * MSM + i) * 8 + hh) * 64) * 64 + e; GAS float* sout = F.out + O_HSS + (((size_t)(l * MSM + i) * 8 + hh) * 64) * 64 + e;
            float o = 0.f;
#pragma unroll
            for (int hb_ = 0; hb_ < 2; ++hb_) { float sv[32];
#pragma unroll
                for (int k = 0; k < 32; ++k) sv[k] = sin_[(32 * hb_ + k) * 64];
#pragma unroll
                for (int k = 0; k < 32; ++k) { const int dd = 32 * hb_ + k; const float sn = sFd[64 * hh + dd] * sv[k] + sK[64 * hh + dd] * vv; sout[dd * 64] = sn; o += sQ[64 * hh + dd] * sn; } }
            const float ss = wave_sum(o * o); const float rs = __builtin_amdgcn_rsqf(ss * (1.f / 64.f) + EPS);
            if (!DRY) pr[PC_CQ + 64 * hh + e] = f2bf(o * rs * F.in[I_HNORM][l * 64 + e] * bf2f(pr[PC_CG + 64 * hh + e])); }
        WG_BARRIER();
    }
}
__device__ __forceinline__ void p2b_phase(Frame& F, int l) {
    constexpr int N_SSD = 128, N_HG = 64, N_SMP = 0, N_RGA = 64;
#pragma nounroll
    for (int rid = F.bx; rid < 256; rid += F.G) {
#define RFRESH() do { int z_ = 0; asm volatile("" : "+v"(z_)); F.lane = __builtin_amdgcn_mbcnt_hi(~0u, __builtin_amdgcn_mbcnt_lo(~0u, z_)); F.tid = F.wave * 64 + F.lane; } while (0)
        const int kind = rid < N_SSD ? 0 : (rid < N_SSD + N_HG ? 1 : (rid < N_SSD + N_HG + N_SMP ? 2 : 3));
        switch (kind) {
        case 0: RFRESH(); ssd_role2(F, l, rid);
#ifdef DBG_REPEAT_SSD
            ssd_role2(F, l, rid);
#endif
            break;
        case 1:
#ifdef DBG_REPEAT_HG
            hgrn_role<true>(F, l, rid - N_SSD);
#endif
            RFRESH(); hgrn_role<false>(F, l, rid - N_SSD); break;
        case 2: break;
        default: RFRESH(); rg_apply_role(F, l, rid - N_SSD - N_HG - N_SMP, N_RGA);
            __syncthreads();
            if (l == 1) { RFRESH();
                pg8::Gemm g{F.PB(), w_pj_t(F.ws, l), PLE, PLE}; pg8::StaticOrder S; S.init(MPR, DM, N_RGA, rid - N_SSD - N_HG - N_SMP); EpiPP E{(GAS bf16*)F.out}; pg8::gemm_phase<EpiPP, true>(F.lds, F.tid, g, S, E);
                asm volatile("s_waitcnt vmcnt(0)" ::: "memory"); __syncthreads(); }
            if (l == 0) { RFRESH(); for (int it = (rid - N_SSD - N_HG - N_SMP) * 8 + F.wave; it < NL * WI_PER_L - WI_IN; it += N_RGA * 8) wconv_item(F, (LAS float*)(F.lds + F.wave * 16640), WI_IN + it); }
#ifdef DBG_REPEAT_RG
            rg_apply_role(F, l, rid - N_SSD - N_HG - N_SMP, N_RGA);
#endif
            break;
        }
    }
}


template <int KC> __device__ __forceinline__ f32x4 sgemm_tile(Frame& F, const GAS bf16* A, int lda, const GAS bf16* Bt, int ldb, int kbeg, int klen, int rb, int cg) {
    const int lane = F.lane, w = F.wave, tid = F.tid, r = lane & 31, hf = lane >> 5;
    const int nch = klen / KC; constexpr int SK = KC + 8;
    LAS bf16* sA = (LAS bf16*)F.lds; LAS bf16* sB = sA + 32 * 520;
    constexpr int ppr = KC >> 3, NPC = (96 * ppr) / 512;
    u32x4 st[NPC];
#define SG_LOAD(CH) do { _Pragma("unroll") for (int i = 0; i < NPC; ++i) { const int p = tid + 512 * i; { const int row = p / ppr, pc = p % ppr; \
            const GAS bf16* src = (row < 32) ? A + (size_t)(MPR + 32 * rb + row) * lda : Bt + (size_t)(64 * cg + row - 32) * ldb; st[i] = *(const GAS u32x4*)(src + kbeg + (CH) * KC + 8 * pc); } } } while (0)
    SG_LOAD(0);
    f32x16 a0, a1;
#pragma unroll
    for (int q = 0; q < 16; ++q) { a0[q] = 0.f; a1[q] = 0.f; }
    constexpr int kw = KC >> 3;
#pragma nounroll
    for (int ch = 0; ch < nch; ++ch) {
#pragma unroll
        for (int i = 0; i < NPC; ++i) { const int p = tid + 512 * i; { const int row = p / ppr, pc = p % ppr; *(LAS u32x4*)((row < 32 ? sA + row * SK : sB + (row - 32) * SK) + 8 * pc) = st[i]; } }
        WG_BARRIER();
        if (ch + 1 < nch) SG_LOAD(ch + 1);
        for (int k = 0; k < kw; k += 16) { const bf16x8 af = *(const LAS bf16x8*)(sA + r * SK + w * kw + k + 8 * hf), b0 = *(const LAS bf16x8*)(sB + r * SK + w * kw + k + 8 * hf), b1 = *(const LAS bf16x8*)(sB + (32 + r) * SK + w * kw + k + 8 * hf);
            a0 = mfma32(af, b0, a0); a1 = mfma32(af, b1, a1); }
        WG_BARRIER();
    }
#undef SG_LOAD
    LAS float* part = (LAS float*)F.lds + w * 2048;
#pragma unroll
    for (int q = 0; q < 16; ++q) { const int row = rowoff(q, hf); part[row * 64 + r] = a0[q]; part[row * 64 + 32 + r] = a1[q]; }
    WG_BARRIER();
    const LAS float* pr_ = (const LAS float*)F.lds + (F.tid >> 4) * 64 + 4 * (F.tid & 15);
    f32x4 v = *(const LAS f32x4*)pr_;
#pragma unroll
    for (int q = 1; q < 8; ++q) v = v + *(const LAS f32x4*)(pr_ + q * 2048);
    WG_BARRIER();
    return v;
}
__device__ __forceinline__ float sum16(float v) { return sum16r(v); }
__device__ __forceinline__ f32x4 load_bf4(const GAS bf16* p) { const u32x2 w = *(const GAS u32x2*)p; f32x4 v; v[0] = bflo(w.x); v[1] = bfhi(w.x); v[2] = bflo(w.y); v[3] = bfhi(w.y); return v; }
__device__ __forceinline__ void store_bf4_sc1(GAS bf16* p, f32x4 v) { st_sc1_2(p, pk2(v[0], v[1]), pk2(v[2], v[3])); }
__device__ __forceinline__ void store_bf4(GAS bf16* p, f32x4 v) { u32x2 w; w.x = pk2(v[0], v[1]); w.y = pk2(v[2], v[3]); *(GAS u32x2*)p = w; }
template <int MODE> __device__ __forceinline__ f32x4 act4(f32x4 v, f32x4 lb) { return (f32x4){act1<MODE>(v[0], lb[0]), act1<MODE>(v[1], lb[1]), act1<MODE>(v[2], lb[2]), act1<MODE>(v[3], lb[3])}; }
__device__ __forceinline__ void sample_p1(Frame& F, int l, int u0) {
    for (int u = u0; u < 4 * (NPJP / 64); u += (F.G != 256 ? F.G : 128)) { const int rb = u & 3, cg = u >> 2;
        if (64 * cg >= NPJ + 64) continue;
        const f32x4 v = sgemm_tile<256>(F, F.HB(), DM, w_in_t(F.ws, l), DM, 0, DM, rb, cg);
        const int row = MPR + 32 * rb + (F.tid >> 4), col = 64 * cg + 4 * (F.tid & 15); const float rs = rstd16(F.SSQ_MIX(), row); const f32x4 x = v * rs;
        if (col >= NPJ) { if (col < NPJ + 8) *(GAS f32x4*)(F.DT() + (size_t)row * 8 + (col - NPJ)) = x; continue; }
        const int pn = col >> 8; f32x4 o;
        if (pn == 4 || pn == 5 || pn == 9 || pn == 10 || pn == 15 || pn == 16) o = act4<1>(x, x);
        else if (pn == 7 || pn == 8) o = act4<2>(x, x);
        else if (pn == 11 || pn == 12) o = act4<3>(x, *(const GAS f32x4*)(F.LBS() + l * 512 + (col - PC_CF)));
        else o = x;
        store_bf4(F.BIG() + (size_t)row * NPJ + col, o); }
}
__device__ __forceinline__ void sample_p3(Frame& F, int l, int u0) {
    for (int u = u0; u < 4 * (DM / 64); u += F.G) { const int rb = u & 3, cg = u >> 2;
        const f32x4 vb = sgemm_tile<256>(F, F.BIG(), NPJ, w_out_t(F.ws, l), DMIX, 0, 512, rb, cg);
        const f32x4 va = sgemm_tile<256>(F, F.BIG(), NPJ, w_out_t(F.ws, l), DMIX, 512, 1024, rb, cg);
        const int row = MPR + 32 * rb + (F.tid >> 4), col = 64 * cg + 4 * (F.tid & 15);
        const GAS f32x4* p = (const GAS f32x4*)(F.SSDP() + (size_t)row * 16); const f32x4 a = p[0], b = p[1], c = p[2], d = p[3];
        const float sb = ((a[0] + a[1]) + (a[2] + a[3])) + ((b[0] + b[1]) + (b[2] + b[3])) + ((c[0] + c[1]) + (c[2] + c[3])) + ((d[0] + d[1]) + (d[2] + d[3]));
        const float rsb = __builtin_amdgcn_rsqf(sb * (1.f / 512.f) + EPS);
        const f32x4 h = load_bf4(F.HB() + (size_t)row * DM + col) + vb * rsb + va;
        store_bf4_sc1(F.HB() + (size_t)row * DM + col, h);
        const float ss = sum16((h[0] * h[0] + h[1] * h[1]) + (h[2] * h[2] + h[3] * h[3]));
        if ((F.tid & 15) == 0) st_sc1(F.SSQ_FFN() + (size_t)row * 16 + cg, ss); }
}
__device__ __forceinline__ void sample_p4(Frame& F, int l, int u0, int ustride) {
#pragma nounroll
    for (int u = u0; u < 4 * (DFF / 64); u += ustride) { const int rb = u & 3, cg = u >> 2;
        const f32x4 v = sgemm_tile<256>(F, F.HB(), DM, w_up_t(F.ws, l), DM, 0, DM, rb, cg);
        const int row = MPR + 32 * rb + (F.tid >> 4), col = 64 * cg + 4 * (F.tid & 15); const float rs = rstd16(F.SSQ_FFN(), row);
        f32x4 x = v * rs;
#pragma unroll
        for (int i = 0; i < 4; ++i) { const float t_ = fmaxf(x[i], 0.f); x[i] = t_ * t_; }
        store_bf4_sc1(F.BIG() + (size_t)row * NPJ + col, x); }
}
__device__ __forceinline__ void sample_p5(Frame& F, int l, int u0) {
    for (int u = u0; u < 4 * (DM / 64); u += F.G) { const int rb = u & 3, cg = u >> 2;
#ifdef DBG_TAIL2
        (void)sgemm_tile<256>(F, F.BIG(), DFF, w_dn_t(F.ws, l), DFF, 0, DFF, rb, cg);
#endif
        const f32x4 v = sgemm_tile<256>(F, F.BIG(), NPJ, w_dn_t(F.ws, l), DFF, 0, DFF, rb, cg);
        const int row = MPR + 32 * rb + (F.tid >> 4), col = 64 * cg + 4 * (F.tid & 15);
        const f32x4 h = load_bf4(F.HB() + (size_t)row * DM + col) + v;
        store_bf4_sc1(F.HB2() + (size_t)row * DM + col, h);
        const float ss = sum16((h[0] * h[0] + h[1] * h[1]) + (h[2] * h[2] + h[3] * h[3]));
        if ((F.tid & 15) == 0) st_sc1(F.SSQ_PLE() + (size_t)row * 16 + cg, ss); }
}
__device__ __forceinline__ void sample_p6(Frame& F, int l, int u0) {
    for (int u = u0; u < 4 * (DM / 64); u += F.G) { const int rb = u & 3, cg = u >> 2;
        const f32x4 pp = sgemm_tile<256>(F, F.PB(), PLE, w_pj_t(F.ws, l), PLE, 0, PLE, rb, cg);
        const f32x4 g = sgemm_tile<256>(F, F.HB2(), DM, w_g_t(F.ws, l), DM, 0, DM, rb, cg);
        const int row = MPR + 32 * rb + (F.tid >> 4), col = 64 * cg + 4 * (F.tid & 15); const float rs = rstd16(F.SSQ_PLE(), row);
        f32x4 h = load_bf4(F.HB2() + (size_t)row * DM + col);
#pragma unroll
        for (int i = 0; i < 4; ++i) h[i] += fsigmoid(g[i] * rs) * pp[i];
        store_bf4_sc1(F.HB() + (size_t)row * DM + col, h);
        const float ss = sum16((h[0] * h[0] + h[1] * h[1]) + (h[2] * h[2] + h[3] * h[3]));
        if ((F.tid & 15) == 0) st_sc1(F.SSQ_MIX() + (size_t)row * 16 + cg, ss); }
}

__device__ __forceinline__ void final_row(Frame& F, int m) {
    const float rs = rstd16(F.SSQ_MIX(), m); GAS f32x4* yr = (GAS f32x4*)(F.out + (size_t)m * DM); const GAS u32x4* hr = (const GAS u32x4*)(F.HB() + (size_t)m * DM);
#pragma unroll
    for (int j = 0; j < 2; ++j) { const u32x4 w = hr[F.lane + 64 * j]; const f32x4 g0 = ((const GAS f32x4*)F.in[I_NFIN])[2 * (F.lane + 64 * j)], g1 = ((const GAS f32x4*)F.in[I_NFIN])[2 * (F.lane + 64 * j) + 1];
        f32x4 a, b; a[0] = bflo(w.x); a[1] = bfhi(w.x); a[2] = bflo(w.y); a[3] = bfhi(w.y); b[0] = bflo(w.z); b[1] = bfhi(w.z); b[2] = bflo(w.w); b[3] = bfhi(w.w);
        yr[2 * (F.lane + 64 * j)] = a * rs * g0; yr[2 * (F.lane + 64 * j) + 1] = b * rs * g1; }
}
__device__ __forceinline__ void final_phase(Frame& F) {
    int m0 = F.bx * 8 + F.wave, m1 = MREAL, ms = F.G * 8;
    if (F.gsy()) {
        if (F.bx < 16) { wg_wait(F.smp(1, 3), 64u, F.tid, F.ctl() + CW_BAR); final_row(F, MPR + F.bx * 8 + F.wave); }
        m0 = (8 * (F.bx & 7) + ((F.bx >> 3) & 7)) * 256 + (F.bx >> 6) * 64 + F.wave * 8; m1 = m0 + 8; ms = 1; }
#pragma nounroll
    for (int m = m0; m < m1; m += ms) final_row(F, m);
}

struct Args { const float* in[N_IN]; float* out; unsigned char* ws; int ph_lo, ph_hi, li, pad; };
constexpr int N_PHASES = 16;
#ifdef DBG_OUTMASK
#define DBG_EXTRA_PH 1
#else
#define DBG_EXTRA_PH 0
#endif

__global__ void __launch_bounds__(512, 2) fwd_kernel(Args args) {
    extern __shared__ __attribute__((aligned(16))) unsigned char lds_raw[];
    volatile LAS unsigned* MISC = (volatile LAS unsigned*)((LAS unsigned char*)lds_raw + LDSCTL_OFF);
    for (int u = threadIdx.x; u < (LDS_BYTES - LDSCTL_OFF) / 4; u += 512) MISC[u] = 0u;
    __syncthreads();
    if (threadIdx.x < N_IN) ((LAS unsigned long long*)((LAS unsigned char*)lds_raw + LDSCTL_OFF + 256))[threadIdx.x] = (unsigned long long)args.in[threadIdx.x];
    __syncthreads();
    XcdBarrier bar; bar.bar = (GAS unsigned*)(args.ws + WS_CTL) + CW_BAR; bar.x = 0; bar.st = nullptr;
    if (MK_N_LAUNCHES == 1) bar = xcd_barrier_post((GAS unsigned*)(args.ws + WS_CTL) + CW_BAR, MISC + 8);
    if (threadIdx.x == 0) __hip_atomic_store((GAS unsigned*)(args.ws + WS_CTL) + CW_XID + blockIdx.x, xb_xcc_id() + 1u, __ATOMIC_RELAXED, __HIP_MEMORY_SCOPE_AGENT);
    const int lo = args.ph_lo, hi = args.ph_hi;
#ifndef PHASE_MASK
#define PHASE_MASK 0xFFFFu
#endif
    const int wave0 = __builtin_amdgcn_readfirstlane(threadIdx.x >> 6);
#pragma nounroll
    for (int ph = lo; ph < hi; ++ph) {
#ifdef DBG_XBAR
        if (ph == 1) for (int xb_ = 0; xb_ < DBG_XBAR; ++xb_) { XcdBarrier b5 = bar; int w5_ = wave0, z5_ = 0; asm volatile("" : "+s"(b5.bar), "+s"(b5.x), "+s"(w5_), "+v"(z5_)); xcd_barrier(b5, w5_ * 64 + (int)__builtin_amdgcn_mbcnt_hi(~0u, __builtin_amdgcn_mbcnt_lo(~0u, z5_))); }
#endif
        if (ph > lo) { XcdBarrier b2 = bar; int w_ = wave0, z_ = 0, gq_ = gridDim.x, bq_ = blockIdx.x; asm volatile("" : "+s"(b2.bar), "+s"(b2.x), "+s"(w_), "+v"(z_), "+s"(gq_), "+s"(bq_));
            const int t_ = w_ * 64 + (int)__builtin_amdgcn_mbcnt_hi(~0u, __builtin_amdgcn_mbcnt_lo(~0u, z_));
            if (gq_ == 256 && MK_N_LAUNCHES == 1 && (ph == 15 || ph == 8 || (ph - 1) % 7 >= 4)) wg_wait(b2.bar - CW_BAR + CW_GRP + (ph * 64 + (bq_ & 63)) * 16, 4u, t_, b2.bar);
            else xcd_barrier(b2, t_); }
#ifdef DBG_STAMP
        if (blockIdx.x == 0 && wave0 == 0) { int zs_ = 0; asm volatile("" : "+v"(zs_)); if (__builtin_amdgcn_mbcnt_hi(~0u, __builtin_amdgcn_mbcnt_lo(~0u, zs_)) == 0) ((volatile LAS unsigned*)((LAS unsigned char*)lds_raw + LDSCTL_OFF))[140 + ph] = (unsigned)__builtin_amdgcn_s_memrealtime(); }
#endif
        Frame F;
        F.lds = (LAS unsigned char*)lds_raw;
        int wv_ = wave0, g_ = gridDim.x, b_ = blockIdx.x; GAS unsigned char* ws = (GAS unsigned char*)args.ws;
        asm volatile("" : "+s"(wv_), "+s"(g_), "+s"(b_), "+s"(ws));
        F.wave = wv_; F.G = g_; F.bx = b_;
#define FRESH() do { int z_ = 0; asm volatile("" : "+v"(z_)); F.lane = __builtin_amdgcn_mbcnt_hi(~0u, __builtin_amdgcn_mbcnt_lo(~0u, z_)); F.tid = F.wave * 64 + F.lane; } while (0)
        GAS float* out_ = (GAS float*)args.out; asm volatile("" : "+s"(out_));
        F.intab = (const LAS unsigned long long*)((LAS unsigned char*)lds_raw + LDSCTL_OFF + 256); F.in.t = F.intab; F.out = out_; F.ws = ws;
#ifdef DBG_OUTMASK
        if (ph == 16) {
            const size_t offs[13] = {0, (size_t)MPR * DM, O_RCP, O_RHP, O_SCP, O_SSP, O_HSP, O_RCS, O_RHS, O_SCS, O_SSS, O_HSS, O_END};
            int z2_ = 0; asm volatile("" : "+v"(z2_)); const int ln_ = __builtin_amdgcn_mbcnt_hi(~0u, __builtin_amdgcn_mbcnt_lo(~0u, z2_));
            for (int o_ = 0; o_ < 12; ++o_) { const float sc_ = ((DBG_OUTMASK >> o_) & 1) ? DBG_OUTSCALE : 0.f;
                for (size_t e = offs[o_] + (size_t)F.bx * 512 + F.wave * 64 + ln_; e < offs[o_ + 1]; e += (size_t)F.G * 512) F.out[e] = F.out[e] * sc_; }
            continue; }
#endif
        const int l = (ph - 1) / 7; const int k = (ph == 0) ? 0 : (ph == 15 ? 8 : 1 + (ph - 1) % 7);
        if (!((PHASE_MASK >> k) & 1u)) continue;
#ifdef DBG_CUT
        if (ph > DBG_CUT && ph != 15) continue;
#endif
#ifdef DBG_CUT2
        if (ph > DBG_CUT2) continue;
#endif
#ifdef DBG_REPEAT_K
        for (int rep_ = 0; rep_ < ((k == DBG_REPEAT_K) ? 2 : 1); ++rep_) {
        if (rep_) { XcdBarrier b4 = bar; int w4_ = wave0, z4_ = 0; asm volatile("" : "+s"(b4.bar), "+s"(b4.x), "+s"(w4_), "+v"(z4_)); xcd_barrier(b4, w4_ * 64 + (int)__builtin_amdgcn_mbcnt_hi(~0u, __builtin_amdgcn_mbcnt_lo(~0u, z4_))); }
#endif
        switch (k) {
        case 0: FRESH(); p0_prologue(F);
#ifdef DBG_CUT
            { const int sizes[N_IN] = {16777216,131072,393216,131072,589824,16777216,8388608,8388608,65536,2048,8929280,4096,1024,65536,1024,65536,1024,1024,6144,1536,16,16,16,1024,1024,128,3145728,2048,8388608,8388608,2048,2097152,524288,1024};
              for (int t = F.bx; t < N_IN * 4; t += F.G) { const int ti = t >> 2, part = t & 3; const int n = sizes[ti]; const int q0 = (int)((long)n * part / 4), q1 = (int)((long)n * (part + 1) / 4);
                  const GAS float* p = F.in[ti]; float sacc = 0.f; for (int e = q0 + F.tid; e < q1; e += 512) sacc += fabsf(p[e]);
                  sacc = wave_sum(sacc); if (F.lane == 0) __hip_atomic_fetch_add((GAS float*)(F.ws + 65536) + t, sacc, __ATOMIC_RELAXED, __HIP_MEMORY_SCOPE_AGENT); } }
#endif
            break;
        case 1: {
            FRESH();
            pg8::Gemm g{F.HB(), w_in_t(ws, l), DM, DM}; pg8::StaticOrder S; S.init(MPR, NPJP, F.G, F.bx);
            const LAS float* rst_ = (F.G == 256) ? (const LAS float*)(F.lds + pg8::TAB_OFF) : nullptr;
            EpiProj E{F.BIG(), F.DT(), F.SSQ_MIX(), F.LBS() + l * 512, rst_};
            pg8::gemm_phase<EpiProj, true>(F.lds, F.tid, g, S, E, pg8::TabJob{F.SSQ_MIX(), 1.f / DM, F.G == 256}); FRESH();
            if (F.bx >= 128 || F.G != 256) { if (l == 1 && F.gsy()) wg_wait(F.smp(0, 3), 64u, F.tid, F.ctl() + CW_BAR); sample_p1(F, l, F.G != 256 ? F.bx : F.bx - 128); } } break;
        case 2: FRESH(); p2a_phase(F, l); break;
        case 3: FRESH(); p2b_phase(F, l); break;
        case 4: {
            FRESH();
#ifdef DBG_DRY3
            { pg8::Gemm g{F.BIG(), w_out_t(ws, l), NPJ, DMIX}; pg8::StaticOrder S; S.init(MPR, DM, F.G, F.bx); EpiPP E{F.PPB()}; pg8::gemm_phase<EpiPP, true>(F.lds, F.tid, g, S, E); asm volatile("s_waitcnt vmcnt(0)" ::: "memory"); __syncthreads(); FRESH(); }
#endif
#ifdef DBG_SELF
            if (l == 1) {
                for (int rep = 0; rep < 2; ++rep) {
                    FRESH();
                    pg8::Gemm g{F.BIG(), w_out_t(ws, l), NPJ, DMIX}; pg8::StaticOrder S; S.init(8192, DM, F.G, F.bx);
                    EpiDbg E{F.out, (GAS float*)(F.ws + WS_RT) + (size_t)rep * 8192 * DM + (rep ? 131072 : 0), F.SSDP()};
                    pg8::gemm_phase<EpiDbg, true>(F.lds, F.tid, g, S, E);
                    asm volatile("s_waitcnt vmcnt(0)" ::: "memory"); __syncthreads();
                }
                break; }
#endif
#ifdef DBG_RD
            if (l == 1) { if (F.bx < 4) { for (int e = F.tid; e < 128 * 1536; e += 512) { const int r_ = e / 1536, c_ = e % 1536;
                    F.out[(size_t)(F.bx * 256 + 2 * r_ + (c_ >> 10)) * DM + (c_ & 1023)] = bf2f(F.BIG()[(size_t)(MPR + r_) * NPJ + c_]); }
                  for (int e = F.tid; e < 128 * 16; e += 512) F.out[(size_t)(1024 + F.bx * 2) * DM + e] = F.SSDP()[(size_t)MPR * 16 + e]; }
                break; }
#endif
            pg8::Gemm g{F.BIG(), w_out_t(ws, l), NPJ, DMIX}; pg8::StaticOrder S; S.init(MPR, DM, F.G, F.bx);
            const LAS float* rst_ = (F.G == 256) ? (const LAS float*)(F.lds + pg8::TAB_OFF) : nullptr;
            EpiRes<true> E{F.HB(), F.HB(), F.SSQ_FFN(), F.SSDP(), rst_};
            pg8::gemm_phase<EpiRes<true>, true>(F.lds, F.tid, g, S, E, pg8::TabJob{F.SSDP(), 1.f / 512.f, F.G == 256}); FRESH();
            if (!F.gsy()) sample_p3(F, l, F.G - 1 - F.bx);
            else { wg_arrive(F.grp(ph + 1), 1u, F.tid, F.xid()); const int g_ = F.bx & 63; if (g_ >= 16 && g_ < 32) { sample_p3(F, l, 4 * (g_ - 16) + (F.bx >> 6)); wg_arrive(F.smp(l, 0), 1u, F.tid, nullptr); }   } } break;
        case 5: {
            FRESH();
            pg8::Gemm g{F.HB(), w_up_t(ws, l), DM, DM}; pg8::StaticOrder S; S.init(MPR, DFF, F.G, F.bx);
            const LAS float* rst_ = (F.G == 256) ? (const LAS float*)(F.lds + pg8::TAB_OFF) : nullptr;
            EpiUp E{F.BIG(), F.SSQ_FFN(), rst_};
            pg8::gemm_phase<EpiUp, true>(F.lds, F.tid, g, S, E, pg8::TabJob{F.SSQ_FFN(), 1.f / DM, F.G == 256}); FRESH();
            if (!F.gsy()) sample_p4(F, l, F.G - 1 - F.bx, F.G);
            else { wg_arrive(F.grp(ph + 1), 1u, F.tid, F.xid()); const int g_ = F.bx & 63;
                if (g_ >= 32) { wg_wait(F.smp(l, 0), 64u, F.tid, F.ctl() + CW_BAR); sample_p4(F, l, 4 * (g_ - 32) + (F.bx >> 6), 128); wg_arrive(F.smp(l, 1), 2u, F.tid, nullptr); } } } break;
        case 6: {
            FRESH();
#ifdef DBG_DRY5
            { pg8::Gemm g{F.BIG(), w_dn_t(ws, l), DFF, DFF}; pg8::StaticOrder S; S.init(MPR, DM, F.G, F.bx); EpiPP E{F.PPB()}; pg8::gemm_phase<EpiPP, true>(F.lds, F.tid, g, S, E); asm volatile("s_waitcnt vmcnt(0)" ::: "memory"); __syncthreads(); FRESH(); }
#endif
            pg8::Gemm g{F.BIG(), w_dn_t(ws, l), NPJ, DFF}; pg8::StaticOrder S; S.init(MPR, DM, F.G, F.bx);
            EpiRes<false> E{F.HB(), F.HB2(), F.SSQ_PLE(), nullptr, nullptr};
            pg8::gemm_phase<EpiRes<false>, true>(F.lds, F.tid, g, S, E); FRESH();
            if (!F.gsy()) sample_p5(F, l, F.G - 1 - F.bx);
            else { wg_arrive(F.grp(ph + 1), 1u, F.tid, F.xid()); const int g_ = F.bx & 63; if (g_ < 16) { wg_wait(F.smp(l, 1), 256u, F.tid, F.ctl() + CW_BAR); sample_p5(F, l, 4 * g_ + (F.bx >> 6)); wg_arrive(F.smp(l, 2), 1u, F.tid, nullptr); } } } break;
        case 7: {
            FRESH();
            if (l == 0) { pg8::Gemm g{F.PB(), w_pj_t(ws, l), PLE, PLE}; pg8::StaticOrder S; S.init(MPR, DM, F.G, F.bx); EpiPP E{(GAS bf16*)F.out}; pg8::gemm_phase<EpiPP, true>(F.lds, F.tid, g, S, E);
                asm volatile("s_waitcnt vmcnt(0)" ::: "memory"); __syncthreads(); }
            FRESH();
            { pg8::Gemm g{F.HB2(), w_g_t(ws, l), DM, DM}; pg8::StaticOrder S; S.init(MPR, DM, F.G, F.bx); const LAS float* rst_ = (F.G == 256) ? (const LAS float*)(F.lds + pg8::TAB_OFF) : nullptr; EpiGate E{F.HB2(), F.HB(), (const GAS bf16*)F.out, F.SSQ_PLE(), F.SSQ_MIX(), rst_}; pg8::gemm_phase<EpiGate, true>(F.lds, F.tid, g, S, E, pg8::TabJob{F.SSQ_PLE(), 1.f / DM, F.G == 256}); } FRESH();
            if (!F.gsy()) sample_p6(F, l, F.G - 1 - F.bx);
            else { wg_arrive(F.grp(l == 0 ? 8 : 15), 1u, F.tid, F.xid()); const int g_ = F.bx & 63; if (g_ >= 16 && g_ < 32) { wg_wait(F.smp(l, 2), 64u, F.tid, F.ctl() + CW_BAR); sample_p6(F, l, 4 * (g_ - 16) + (F.bx >> 6)); wg_arrive(F.smp(l, 3), 1u, F.tid, nullptr); } } } break;
        default: FRESH();
#ifdef DBG_SELF
            { const GAS float* t1 = (const GAS float*)(F.ws + WS_RT); const GAS float* t2 = t1 + (size_t)8192 * DM + 131072; unsigned cnt = 0;
              for (size_t e = (size_t)F.bx * 512 + F.tid; e < (size_t)8192 * DM; e += (size_t)F.G * 512) cnt += (t1[e] != t2[e]) ? 1u : 0u;
              cnt = (unsigned)wave_sum((float)cnt);
              if (F.lane == 0) F.out[(size_t)(F.bx * 8 + F.wave) * DM] = 1000.f * (float)cnt; }
            break;
#endif
#ifdef DBG_CK
            { GAS float* yo = F.out + (size_t)MPR * DM;
              const int gw = F.bx * 8 + F.wave, NGW = F.G * 8;
              for (int it = gw; it < 128 * (24 + 16 + 1); it += NGW) { const int blk = it % 128, g = it / 128; float sacc = 0.f;
#ifdef DBG_CK2
                  if (g < 12) { for (int e = F.lane; e < 128 * 64; e += 64) sacc += fabsf(bf2f(F.XA()[(size_t)(blk * 128 + (e >> 6)) * 768 + g * 64 + (e & 63)])); }
                  else if (g < 20) { for (int e = F.lane; e < 128 * 64; e += 64) sacc += fabsf(bf2f(F.BIG()[(size_t)(blk * 128 + (e >> 6)) * NPJ + PC_BZ + (g - 12) * 64 + (e & 63)])); }
                  else if (g < 21) { for (int e = F.lane; e < 128 * 8; e += 64) sacc += fabsf(F.DT()[(size_t)blk * 128 * 8 + e]); }
                  else if (g < 24) { }
#else
                  if (g < 24) { for (int e = F.lane; e < 128 * 64; e += 64) sacc += fabsf(bf2f(F.BIG()[(size_t)(blk * 128 + (e >> 6)) * NPJ + g * 64 + (e & 63)])); }
#endif
                  else if (g < 40) { for (int e = F.lane; e < 128 * 64; e += 64) sacc += fabsf(F.out[(size_t)(blk * 128 + (e >> 6)) * DM + (g - 24) * 64 + (e & 63)]); }
                  else { for (int e = F.lane; e < 128 * 16; e += 64) sacc += fabsf(F.SSDP()[(size_t)blk * 128 * 16 + e]); }
                  sacc = wave_sum(sacc); if (F.lane == 0) yo[it] = (g >= DBG_CK_LO && g < DBG_CK_HI) ? sacc : 0.f; } }
            break;
#endif
#ifdef DBG_COPY
            for (int e = F.bx * 512 + F.tid; e < 128 * DM; e += F.G * 512) F.out[(size_t)MPR * DM + e] = F.out[(size_t)DBG_COPY * DM + e];
            break;
#endif
#ifdef DBG_CUT
            { const int gw = F.bx * 8 + F.wave, NGW = F.G * 8;
              for (int m = gw; m < MREAL; m += NGW) { float s0 = 0.f, s1 = 0.f, s2 = 0.f;
                  const GAS bf16* b = F.BIG() + (size_t)m * NPJ; for (int c = F.lane; c < NPJ; c += 64) s0 += fabsf(bf2f(b[c]));
                  const GAS bf16* hb = F.HB() + (size_t)m * DM; for (int c = F.lane; c < DM; c += 64) s1 += fabsf(bf2f(hb[c]));
                  const GAS bf16* h2 = F.HB2() + (size_t)m * DM; for (int c = F.lane; c < DM; c += 64) s2 += fabsf(bf2f(h2[c]));
                  s0 = wave_sum(s0); s1 = wave_sum(s1); s2 = wave_sum(s2);
                  float s3 = 0.f, s4 = 0.f; if (m < 1024) { const GAS float* si = F.in[I_SSS] + ((size_t)(1024 + m)) * 8192; for (int c = F.lane; c < 8192; c += 64) s3 += fabsf(si[c]);
                      const GAS float* s0i = F.in[I_SSS] + ((size_t)m) * 8192; for (int c = F.lane; c < 8192; c += 64) s4 += fabsf(s0i[c]); }
                  s3 = wave_sum(s3); s4 = wave_sum(s4);
                  if (F.lane == 0) { GAS float* o = F.out + (size_t)m * DM; o[8] = s3; o[9] = s4; if (m < N_IN * 4) o[10] = ((GAS float*)(F.ws + 65536))[m]; o[0] = s0; o[1] = s1; o[2] = s2; o[3] = F.DT()[(size_t)m * 8 + 3]; o[4] = F.SSQ_MIX()[(size_t)m * 16 + 5]; o[5] = F.SSQ_FFN()[(size_t)m * 16 + 5]; o[6] = F.SSQ_PLE()[(size_t)m * 16 + 5]; o[7] = F.SSDP()[(size_t)m * 16 + 5]; } } }
#else
#ifndef DBG_NOFINAL
            final_phase(F);
#endif
#ifdef DBG_SANOUT
            asm volatile("s_waitcnt vmcnt(0)" ::: "memory"); { XcdBarrier b3 = bar; xcd_barrier(b3, F.tid); }
            for (size_t e = (size_t)F.bx * 512 + F.tid; e < O_END; e += (size_t)F.G * 512) { const float v = F.out[e]; if (!(fabsf(v) < 1e30f)) F.out[e] = 12345.f; }
#endif
#endif
            break;
        }
#ifdef DBG_REPEAT_K
        }
#endif
    }
#ifdef DBG_STAMP
    if (blockIdx.x == 0 && wave0 == 0 && __builtin_amdgcn_mbcnt_hi(~0u, __builtin_amdgcn_mbcnt_lo(~0u, 0)) == 0) { asm volatile("s_waitcnt vmcnt(0)" ::: "memory"); const unsigned te = (unsigned)__builtin_amdgcn_s_memrealtime();
        volatile LAS unsigned* M2 = (volatile LAS unsigned*)((LAS unsigned char*)lds_raw + LDSCTL_OFF); const unsigned t0 = M2[140 + DBG_STAMP], t1 = (DBG_STAMP == 15) ? te : M2[141 + DBG_STAMP];
        ((GAS float*)args.out)[0] = -0.01f * (float)(t1 - t0); }
#endif
}

extern "C" void kernel_launch(void* const* d_in, const int* in_sizes, int n_in, void* d_out, int out_size, void* d_ws, size_t ws_size, hipStream_t stream) {
    static int grid = 0;
    if (grid == 0) {
        if (n_in != N_IN || (size_t)out_size != O_END || ws_size < WS_END) { fprintf(stderr, "kernel_launch: unexpected shapes: n_in %d out %d ws %zu (need %zu)\n", n_in, out_size, ws_size, (size_t)WS_END); grid = -1; return; }
        int dev = 0, cus = 0, per_cu = 0;
        if (hipGetDevice(&dev) != hipSuccess || hipDeviceGetAttribute(&cus, hipDeviceAttributeMultiprocessorCount, dev) != hipSuccess) { grid = -1; return; }
        if (hipFuncSetAttribute((const void*)fwd_kernel, hipFuncAttributeMaxDynamicSharedMemorySize, LDS_BYTES) != hipSuccess) { fprintf(stderr, "kernel_launch: hipFuncSetAttribute failed\n"); grid = -1; return; }
        if (hipOccupancyMaxActiveBlocksPerMultiprocessor(&per_cu, (const void*)fwd_kernel, 512, LDS_BYTES) != hipSuccess || per_cu < 1) { fprintf(stderr, "kernel_launch: occupancy query says %d blocks per CU\n", per_cu); (void)hipGetLastError(); grid = -1; return; }
        grid = cus;
        if (grid > 256) grid = 256;
    }
    if (grid < 0) return;
    if (hipMemsetAsync((char*)d_ws + WS_CTL, 0, CTL_ZERO_BYTES, stream) != hipSuccess) return;
#ifdef DBG_FILLOUT
    (void)hipMemsetAsync(d_out, 0, (size_t)O_END * 4, stream);
#endif
#ifdef DBG_FILL
    (void)hipMemsetAsync((char*)d_ws + CTL_ZERO_BYTES, DBG_FILL, WS_END - CTL_ZERO_BYTES, stream);
#endif
    Args a{};
    for (int i = 0; i < N_IN; ++i) a.in[i] = (const float*)d_in[i];
    a.out = (float*)d_out; a.ws = (unsigned char*)d_ws;
    if (MK_N_LAUNCHES == 1) { a.ph_lo = 0; a.ph_hi = N_PHASES; a.li = 0; hipLaunchKernelGGL(fwd_kernel, dim3(grid), dim3(512), LDS_BYTES, stream, a); }
    else for (int p = 0; p < N_PHASES + DBG_EXTRA_PH; ++p) { a.ph_lo = p; a.ph_hi = p + 1; a.li = p; hipLaunchKernelGGL(fwd_kernel, dim3(grid), dim3(512), LDS_BYTES, stream, a); }
}
```
